# Optimizing an MI355X kernel written in HIP

```python
import jax, jax.numpy as jnp
from jax import lax
import numpy as np

D_MODEL = 1024
BATCH = 16
SEQ = 2048
DEPTH = 2

CHUNK = 64
PLE_DIM = 256
D_FF = 2816
EPS = 1e-6

RNN_WIDTH = 1024
RNN_BLOCKS = 16
RNN_BLOCK = RNN_WIDTH // RNN_BLOCKS
CONV_WIDTH = 4
LRU_C = 8.0

MLA_HEADS = 16
Q_LORA = 384
KV_LORA = 256
QK_NOPE = 64
QK_ROPE = 32
V_DIM = 64
ROPE_THETA = 10000.0
Q_BLOCK = 128

SGU_WIDTH = 1024
SGU_GROUPS = 8
SGU_GROUP = SGU_WIDTH // SGU_GROUPS
SGU_LEN = 128

N_BRANCH = 3
IN_SIZES = (RNN_WIDTH, RNN_WIDTH, Q_LORA, KV_LORA, QK_ROPE, 2 * SGU_WIDTH, N_BRANCH * D_MODEL)
W_IN_COLS = RNN_WIDTH * 2 + Q_LORA + KV_LORA + QK_ROPE + 2 * SGU_WIDTH + N_BRANCH * D_MODEL

kernel_name = "hybrid_rglru_mla_sgu_macaron_block"


def _split_points(sizes):
    pts, acc = [], 0
    for s in sizes[:-1]:
        acc += s
        pts.append(acc)
    return pts


def rms_norm(x, g):
    xf = x.astype(jnp.float32)
    y = xf * lax.rsqrt(jnp.mean(xf * xf, axis=-1, keepdims=True) + EPS)
    return (y * g.astype(jnp.float32)).astype(x.dtype)


def layer_norm(x, g, b):
    xf = x.astype(jnp.float32)
    mu = jnp.mean(xf, axis=-1, keepdims=True)
    var = jnp.mean(jnp.square(xf - mu), axis=-1, keepdims=True)
    y = (xf - mu) * lax.rsqrt(var + EPS)
    return (y * g.astype(jnp.float32) + b.astype(jnp.float32)).astype(x.dtype)


def swiglu_ffn(x, norm_g, w_gu, w_down):
    h = rms_norm(x, norm_g) @ w_gu
    gate, up = jnp.split(h, 2, axis=-1)
    return (jax.nn.silu(gate) * up) @ w_down


def causal_depthwise_conv(x, w, b):
    S = x.shape[1]
    xp = jnp.pad(x, ((0, 0), (CONV_WIDTH - 1, 0), (0, 0)))
    out = b
    for k in range(CONV_WIDTH):
        out = out + xp[:, k:k + S] * w[k]
    return out


def rg_lru(x, w_a, b_a, w_x, b_x, lam):
    B, S, _ = x.shape
    xb = x.reshape(B, S, RNN_BLOCKS, RNN_BLOCK)
    r = jax.nn.sigmoid(jnp.einsum('bsnc,ncd->bsnd', xb, w_a).reshape(B, S, RNN_WIDTH) + b_a)
    i = jax.nn.sigmoid(jnp.einsum('bsnc,ncd->bsnd', xb, w_x).reshape(B, S, RNN_WIDTH) + b_x)
    log_a = -LRU_C * r.astype(jnp.float32) * jax.nn.softplus(-lam.astype(jnp.float32))
    a = jnp.exp(log_a)
    mult = jnp.sqrt(-jnp.expm1(2.0 * log_a))
    first = (jnp.arange(S) == 0)[None, :, None]
    mult = jnp.where(first, jnp.ones((), jnp.float32), mult)
    u = mult * (i * x).astype(jnp.float32)

    def combine(c1, c2):
        a1, b1 = c1
        a2, b2 = c2
        return a1 * a2, a2 * b1 + b2

    _, h = lax.associative_scan(combine, (a, u), axis=1)
    return h.astype(x.dtype)


def apply_rope(x, cos, sin):
    half = QK_ROPE // 2
    x1 = x[..., :half].astype(jnp.float32)
    x2 = x[..., half:].astype(jnp.float32)
    out = jnp.concatenate([x1 * cos - x2 * sin, x1 * sin + x2 * cos], axis=-1)
    return out.astype(x.dtype)


def mla_attention(c_q, c_kv, k_r, q_norm, w_uq, kv_norm, w_ukv):
    B, S, _ = c_q.shape
    half = QK_ROPE // 2
    inv_freq = ROPE_THETA ** (-jnp.arange(half, dtype=jnp.float32) / half)
    ang = jnp.arange(S, dtype=jnp.float32)[:, None] * inv_freq[None, :]
    cos, sin = jnp.cos(ang), jnp.sin(ang)

    q = (rms_norm(c_q, q_norm) @ w_uq).reshape(B, S, MLA_HEADS, QK_NOPE + QK_ROPE)
    q_nope = q[..., :QK_NOPE]
    q_rope = apply_rope(q[..., QK_NOPE:], cos[None, :, None, :], sin[None, :, None, :])
    kv = (rms_norm(c_kv, kv_norm) @ w_ukv).reshape(B, S, MLA_HEADS, QK_NOPE + V_DIM)
    k_nope, v = kv[..., :QK_NOPE], kv[..., QK_NOPE:]
    k_rope = apply_rope(k_r, cos[None], sin[None])
    scale = (QK_NOPE + QK_ROPE) ** -0.5

    outs = []
    for qb in range(S // Q_BLOCK):
        q0, kend = qb * Q_BLOCK, (qb + 1) * Q_BLOCK
        s = (jnp.einsum('bqhd,bkhd->bhqk', q_nope[:, q0:kend], k_nope[:, :kend])
             + jnp.einsum('bqhr,bkr->bhqk', q_rope[:, q0:kend], k_rope[:, :kend]))
        s = s.astype(jnp.float32) * scale
        qi = q0 + jnp.arange(Q_BLOCK)
        kj = jnp.arange(kend)
        mask = (kj[None, :] // CHUNK) <= (qi[:, None] // CHUNK)
        s = jnp.where(mask[None, None], s, -1e30)
        pr = jax.nn.softmax(s, axis=-1).astype(v.dtype)
        outs.append(jnp.einsum('bhqk,bkhd->bqhd', pr, v[:, :kend]))
    o = jnp.concatenate(outs, axis=1)
    return o.reshape(B, S, MLA_HEADS * V_DIM)


def spatial_gating(z, ln_g, ln_b, w_s, b_s):
    B, S, _ = z.shape
    u, v = jnp.split(z, 2, axis=-1)
    v = layer_norm(v, ln_g, ln_b)
    vb = v.reshape(B, S // SGU_LEN, SGU_LEN, SGU_GROUPS, SGU_GROUP)
    t = jnp.arange(SGU_LEN)
    mask = (t[None, :] // CHUNK) <= (t[:, None] // CHUNK)
    w = jnp.where(mask[None], w_s, jnp.zeros((), w_s.dtype))
    sp = jnp.einsum('gts,bnsgc->bntgc', w, vb) + b_s.T[None, None, :, :, None]
    return u * sp.reshape(B, S, SGU_WIDTH)


def parallel_mixer(x, mix_norm, w_in, conv_w, conv_b, lru_w_a, lru_b_a, lru_w_x, lru_b_x,
                   lru_lambda, w_read_a, mla_q_norm, mla_w_uq, mla_kv_norm, mla_w_ukv,
                   w_read_b, sgu_norm_g, sgu_norm_b, sgu_w_s, sgu_b_s, w_read_c,
                   gate_bias, w_out):
    B, S, _ = x.shape
    n = rms_norm(x, mix_norm)
    z = n @ w_in
    xa, ga, cq, ckv, kr, zc, gl = jnp.split(z, _split_points(IN_SIZES), axis=-1)
    ya = rg_lru(causal_depthwise_conv(xa, conv_w, conv_b),
                lru_w_a, lru_b_a, lru_w_x, lru_b_x, lru_lambda) * jax.nn.gelu(ga)
    ya = ya @ w_read_a
    yb = mla_attention(cq, ckv, kr, mla_q_norm, mla_w_uq, mla_kv_norm, mla_w_ukv) @ w_read_b
    yc = spatial_gating(jax.nn.gelu(zc), sgu_norm_g, sgu_norm_b, sgu_w_s, sgu_b_s) @ w_read_c
    g = jax.nn.sigmoid(gl + gate_bias).reshape(B, S, N_BRANCH, D_MODEL)
    merged = g[:, :, 0] * ya + g[:, :, 1] * yb + g[:, :, 2] * yc
    return merged @ w_out


def setup_inputs(seed: int = 0) -> dict:
    key = jax.random.key(seed)
    ks = iter(jax.random.split(key, 64))
    f32 = jnp.float32

    def dense(shape, fan_in):
        return jax.random.normal(next(ks), shape, f32) * (fan_in ** -0.5)

    def gain(shape):
        return 1.0 + 0.05 * jax.random.normal(next(ks), shape, f32)

    def bias(shape, scale=0.01):
        return scale * jax.random.normal(next(ks), shape, f32)

    L = DEPTH
    a0 = jax.random.uniform(next(ks), (L, RNN_WIDTH), f32, 0.9, 0.999)
    inputs = {
        "x": jax.random.normal(next(ks), (BATCH, SEQ, D_MODEL), f32),
        "p": jax.random.normal(next(ks), (DEPTH, BATCH, SEQ, PLE_DIM), f32),
        "ffn1_norm": gain((L, D_MODEL)),
        "ffn1_w_gu": dense((L, D_MODEL, 2 * D_FF), D_MODEL),
        "ffn1_w_down": dense((L, D_FF, D_MODEL), D_FF),
        "mix_norm": gain((L, D_MODEL)),
        "w_in": dense((L, D_MODEL, W_IN_COLS), D_MODEL),
        "conv_w": dense((L, CONV_WIDTH, RNN_WIDTH), CONV_WIDTH),
        "conv_b": bias((L, RNN_WIDTH)),
        "lru_w_a": dense((L, RNN_BLOCKS, RNN_BLOCK, RNN_BLOCK), RNN_BLOCK),
        "lru_b_a": bias((L, RNN_WIDTH)),
        "lru_w_x": dense((L, RNN_BLOCKS, RNN_BLOCK, RNN_BLOCK), RNN_BLOCK),
        "lru_b_x": bias((L, RNN_WIDTH)),
        "lru_lambda": jnp.log(a0) - jnp.log1p(-a0),
        "w_read_a": dense((L, RNN_WIDTH, D_MODEL), RNN_WIDTH),
        "mla_q_norm": gain((L, Q_LORA)),
        "mla_w_uq": dense((L, Q_LORA, MLA_HEADS * (QK_NOPE + QK_ROPE)), Q_LORA),
        "mla_kv_norm": gain((L, KV_LORA)),
        "mla_w_ukv": dense((L, KV_LORA, MLA_HEADS * (QK_NOPE + V_DIM)), KV_LORA),
        "w_read_b": dense((L, MLA_HEADS * V_DIM, D_MODEL), MLA_HEADS * V_DIM),
        "sgu_norm_g": gain((L, SGU_WIDTH)),
        "sgu_norm_b": bias((L, SGU_WIDTH)),
        "sgu_w_s": dense((L, SGU_GROUPS, SGU_LEN, SGU_LEN), SGU_LEN),
        "sgu_b_s": 1.0 + bias((L, SGU_GROUPS, SGU_LEN), 0.1),
        "w_read_c": dense((L, SGU_WIDTH, D_MODEL), SGU_WIDTH),
        "gate_bias": bias((L, N_BRANCH * D_MODEL)),
        "w_out": dense((L, D_MODEL, D_MODEL), D_MODEL),
        "ffn2_norm": gain((L, D_MODEL)),
        "ffn2_w_gu": dense((L, D_MODEL, 2 * D_FF), D_MODEL),
        "ffn2_w_down": dense((L, D_FF, D_MODEL), D_FF),
        "ple_norm": gain((L, D_MODEL)),
        "ple_w_gate": dense((L, D_MODEL, D_MODEL), D_MODEL),
        "ple_w_proj": dense((L, PLE_DIM, D_MODEL), PLE_DIM),
        "final_norm": gain((D_MODEL,)),
    }
    return inputs


def reference(x, p, ffn1_norm, ffn1_w_gu, ffn1_w_down, mix_norm, w_in, conv_w, conv_b,
              lru_w_a, lru_b_a, lru_w_x, lru_b_x, lru_lambda, w_read_a, mla_q_norm,
              mla_w_uq, mla_kv_norm, mla_w_ukv, w_read_b, sgu_norm_g, sgu_norm_b,
              sgu_w_s, sgu_b_s, w_read_c, gate_bias, w_out, ffn2_norm, ffn2_w_gu,
              ffn2_w_down, ple_norm, ple_w_gate, ple_w_proj, final_norm):
    for i in range(DEPTH):
        x = x + 0.5 * swiglu_ffn(x, ffn1_norm[i], ffn1_w_gu[i], ffn1_w_down[i])
        x = x + parallel_mixer(x, mix_norm[i], w_in[i], conv_w[i], conv_b[i], lru_w_a[i],
                               lru_b_a[i], lru_w_x[i], lru_b_x[i], lru_lambda[i], w_read_a[i],
                               mla_q_norm[i], mla_w_uq[i], mla_kv_norm[i], mla_w_ukv[i],
                               w_read_b[i], sgu_norm_g[i], sgu_norm_b[i], sgu_w_s[i],
                               sgu_b_s[i], w_read_c[i], gate_bias[i], w_out[i])
        x = x + 0.5 * swiglu_ffn(x, ffn2_norm[i], ffn2_w_gu[i], ffn2_w_down[i])
        gate = jax.nn.sigmoid(rms_norm(x, ple_norm[i]) @ ple_w_gate[i])
        x = x + (p[i] @ ple_w_proj[i]) * gate
    return rms_norm(x, final_norm)
```

```cpp
#include <hip/hip_runtime.h>
#include <hip/hip_cooperative_groups.h>
#include <cstdio>
#include <cstdint>
namespace cg = cooperative_groups;
namespace pg8 {
#define PG8_LAS __attribute__((address_space(3)))
typedef unsigned short bf16_t;
typedef short bf16x8 __attribute__((ext_vector_type(8)));
typedef float f32x4 __attribute__((ext_vector_type(4)));
typedef unsigned u32x4 __attribute__((ext_vector_type(4)));
typedef unsigned u32x2 __attribute__((ext_vector_type(2)));
constexpr int BM = 256, BK = 64, HALF = 128, HTB = HALF * BK * 2  , STAGE_BYTES = 8 * HTB, NXCD = 8, WGM = 8;

__host__ __device__ __forceinline__ int lds_byte(int r, int c) { const int st = (r >> 4) * 2 + (c >> 5), rr = r & 15, cc = c & 31, ob = rr * 64 + cc * 2; return st * 1024 + (ob ^ (((ob >> 9) & 1) << 5)); }
__host__ __device__ __forceinline__ void stage_rc(int b, int& R, int& C) { const int st = b / 1024, sb = b % 1024, swz = sb ^ (((sb >> 9) & 1) << 5); R = (st >> 1) * 16 + swz / 64; C = (st & 1) * 32 + (swz % 64) / 2; }
__host__ __device__ __forceinline__ int perm32(int rho) { const int n = rho >> 4, i = rho & 15; return 8 * (i >> 2) + 4 * n + (i & 3); }

struct Unit { int pm, pn; };
struct Gemm { const bf16_t* A; const bf16_t* Bt; int M, N, K, lda, ldb, apn; };

struct StaticOrder {
    int nM, nN, nwg, G, c;
    __host__ __device__ void init(int M, int N, int G_, int c_) { nM = M / BM; nN = N / BM; nwg = nM * nN; G = G_; c = c_; }
    __host__ __device__ bool next(int i, Unit& u) const {
        const long L = (long)i * G + c; if (L >= nwg) return false;
        int wgid = (int)L; { const int q = nwg / NXCD, r = nwg % NXCD, xcd = wgid % NXCD, off = wgid / NXCD; wgid = (xcd < r ? xcd * (q + 1) : r * (q + 1) + (xcd - r) * q) + off; }
        const int nig = WGM * nN, gid = wgid / nig, fm = gid * WGM, gsz = (nM - fm) < WGM ? (nM - fm) : WGM;
        u.pm = fm + ((wgid % nig) % gsz); u.pn = (wgid % nig) / gsz; return true;
    }
    __device__ __forceinline__ void a_ready(const Unit&) const {}
    __device__ __forceinline__ void done(const Unit&) const {}
};
__device__ __forceinline__ int tid_opaque() { int t = threadIdx.x; asm volatile("" : "+v"(t)); return t; }
typedef float f32x2_t __attribute__((ext_vector_type(2))); typedef __bf16 bf16x2_t __attribute__((ext_vector_type(2)));
__device__ __forceinline__ unsigned cvt_pk_bf16(float lo, float hi) { const f32x2_t v = {lo, hi}; const bf16x2_t b = __builtin_convertvector(v, bf16x2_t); return __builtin_bit_cast(unsigned, b); }

template <class Epi, class Sched, bool ALIGN_EPI = false, bool SP2 = false>
__device__ __forceinline__ void gemm_phase(PG8_LAS unsigned char* lds, const Gemm g, const Sched& S, const Epi& E) {
    const int tid = pg8::tid_opaque(), wid = __builtin_amdgcn_readfirstlane(tid >> 6), lane = tid & 63, wr = wid >> 2, wc = wid & 3, fr = lane & 15, fq = lane >> 4;
    const int K = g.K, nt = K / BK;
    unsigned voffA[2], voffB[2];
#pragma unroll
    for (int i = 0; i < 2; ++i) { int R, C; stage_rc(tid * 16 + i * 8192, R, C); const int Rb = Epi::PERM ? ((R & ~31) + perm32(R & 31)) : R;
        voffA[i] = (unsigned)(R * g.lda + C) * 2u; voffB[i] = (unsigned)(Rb * g.ldb + C) * 2u; }
    const size_t kstep = (size_t)(BK * 2);
    const size_t hstepA = (size_t)HALF * g.lda * 2, hstepB = (size_t)HALF * g.ldb * 2;
    const size_t tstepA = 2 * hstepA, tstepB = 2 * hstepB; const size_t apn = (size_t)g.apn * 2;
    const unsigned ldsw = (unsigned)wid * 1024u;
    const int aoff = lds_byte(wr * 64 + fr, fq * 8), boff = lds_byte(wc * 32 + fr, fq * 8);
#define PG8_SA(b, h) (((b) * 2 + (h)) * HTB)
#define PG8_SB(b, h) ((4 + (b) * 2 + (h)) * HTB)
#define PG8_STAGE(bufoff, gbase, voff) do { _Pragma("unroll") for (int _i = 0; _i < 2; ++_i) \
        __builtin_amdgcn_global_load_lds((const unsigned*)((const char*)(gbase) + (voff)[_i]), (PG8_LAS unsigned*)(lds + (bufoff) + ldsw + _i * 8192), 16, 0, 0); } while (0)
#define PG8_LDA(dst, b, h) do { _Pragma("unroll") for (int m = 0; m < 4; ++m) _Pragma("unroll") for (int k = 0; k < 2; ++k) dst[m][k] = *(const PG8_LAS bf16x8*)(lds + PG8_SA(b, h) + aoff + m * 2048 + k * 1024); } while (0)
#define PG8_LDB(dst, b, h) do { _Pragma("unroll") for (int n = 0; n < 2; ++n) _Pragma("unroll") for (int k = 0; k < 2; ++k) dst[n][k] = *(const PG8_LAS bf16x8*)(lds + PG8_SB(b, h) + boff + n * 2048 + k * 1024); } while (0)
#define PG8_MMA(ai, bj, At, Bt) do { __builtin_amdgcn_s_setprio(1); _Pragma("unroll") for (int m = 0; m < 4; ++m) _Pragma("unroll") for (int n = 0; n < 2; ++n) _Pragma("unroll") for (int k = 0; k < 2; ++k) \
        acc[ai][bj][m][n] = __builtin_amdgcn_mfma_f32_16x16x32_bf16(Bt[n][k], At[m][k], acc[ai][bj][m][n], 0, 0, 0); __builtin_amdgcn_s_setprio(0); } while (0)
#define PG8_WAIT_V(n) asm volatile("s_waitcnt vmcnt(" #n ")" ::: "memory")
#define PG8_WAIT_L(n) asm volatile("s_waitcnt lgkmcnt(" #n ")" ::: "memory")
#define PG8_BAR __builtin_amdgcn_s_barrier()
#define PG8_SCHED __builtin_amdgcn_sched_barrier(0)
    Unit cur, nxt; int ui = 0;
    if (!S.next(0, cur)) return;
    f32x4 acc[2][2][4][2];
#pragma unroll
    for (int a = 0; a < 2; ++a)
#pragma unroll
        for (int b = 0; b < 2; ++b)
#pragma unroll
            for (int m = 0; m < 4; ++m)
#pragma unroll
                for (int n = 0; n < 2; ++n) acc[a][b][m][n] = (f32x4){0.f, 0.f, 0.f, 0.f};
    bf16x8 At[4][2], B0[2][2], B1[2][2];
    const char* cA = (const char*)g.A + (size_t)cur.pm * tstepA + (size_t)cur.pn * apn; const char* cB = (const char*)g.Bt + (size_t)cur.pn * tstepB;
    S.a_ready(cur);
    if constexpr (SP2) {
        PG8_STAGE(PG8_SB(0, 0), cB, voffB); PG8_STAGE(PG8_SB(0, 1), cB + hstepB, voffB); PG8_STAGE(PG8_SA(0, 0), cA, voffA); PG8_STAGE(PG8_SA(0, 1), cA + hstepA, voffA);
        if (wr == 1) PG8_BAR;
        PG8_WAIT_V(2); PG8_BAR;
        PG8_STAGE(PG8_SB(1, 0), cB + kstep, voffB); PG8_STAGE(PG8_SA(1, 0), cA + kstep, voffA); PG8_STAGE(PG8_SB(1, 1), cB + hstepB + kstep, voffB);
        PG8_WAIT_V(6); PG8_BAR;
    } else {
        PG8_STAGE(PG8_SB(0, 0), cB, voffB); PG8_STAGE(PG8_SA(0, 0), cA, voffA); PG8_STAGE(PG8_SB(0, 1), cB + hstepB, voffB); PG8_STAGE(PG8_SA(0, 1), cA + hstepA, voffA);
        if (wr == 1) PG8_BAR;
        PG8_WAIT_V(4); PG8_BAR;
        PG8_STAGE(PG8_SB(1, 0), cB + kstep, voffB); PG8_STAGE(PG8_SA(1, 0), cA + kstep, voffA); PG8_STAGE(PG8_SB(1, 1), cB + hstepB + kstep, voffB);
        PG8_WAIT_V(6); PG8_BAR;
    }
    for (;;) {
        const bool has_next = S.next(ui + 1, nxt);
        const char* nA = has_next ? (const char*)g.A + (size_t)nxt.pm * tstepA + (size_t)nxt.pn * apn : cA; const char* nB = has_next ? (const char*)g.Bt + (size_t)nxt.pn * tstepB : cB;
        for (int t = 0; t < nt; t += 2) {
            const bool last = (t == nt - 2);
            const char* a1 = cA + (size_t)(t + 1) * kstep;
            const char* a2 = last ? nA : cA + (size_t)(t + 2) * kstep; const char* b2 = last ? nB : cB + (size_t)(t + 2) * kstep;
            const char* a3 = a2 + kstep; const char* b3 = b2 + kstep;
            if (last && has_next) S.a_ready(nxt);
            if constexpr (SP2) {
            PG8_LDB(B0, 0, 0); PG8_LDB(B1, 0, 1); PG8_SCHED; PG8_LDA(At, 0, 0); PG8_STAGE(PG8_SA(1, 1), a1 + hstepA, voffA);
            PG8_WAIT_V(8); PG8_WAIT_L(0); PG8_BAR; PG8_MMA(0, 0, At, B0); PG8_MMA(0, 1, At, B1); PG8_BAR; PG8_SCHED;
            PG8_LDA(At, 0, 1); PG8_STAGE(PG8_SB(0, 0), b2, voffB); PG8_STAGE(PG8_SB(0, 1), b2 + hstepB, voffB); PG8_STAGE(PG8_SA(0, 0), a2, voffA);
            PG8_WAIT_V(8); PG8_WAIT_L(0); PG8_BAR; PG8_MMA(1, 0, At, B0); PG8_MMA(1, 1, At, B1); PG8_BAR; PG8_SCHED;
            PG8_LDB(B0, 1, 0); PG8_LDB(B1, 1, 1); PG8_SCHED; PG8_LDA(At, 1, 0); PG8_STAGE(PG8_SA(0, 1), a2 + hstepA, voffA);
            PG8_WAIT_V(8); PG8_WAIT_L(0); PG8_BAR; PG8_MMA(0, 0, At, B0); PG8_MMA(0, 1, At, B1); PG8_BAR; PG8_SCHED;
            PG8_LDA(At, 1, 1); PG8_STAGE(PG8_SB(1, 0), b3, voffB); PG8_STAGE(PG8_SB(1, 1), b3 + hstepB, voffB); PG8_STAGE(PG8_SA(1, 0), a3, voffA);
            PG8_WAIT_V(8); PG8_WAIT_L(0); PG8_BAR; PG8_MMA(1, 0, At, B0); PG8_MMA(1, 1, At, B1); PG8_BAR; PG8_SCHED;
            } else {
            PG8_LDB(B0, 0, 0); PG8_SCHED; PG8_LDA(At, 0, 0); PG8_STAGE(PG8_SA(1, 1), a1 + hstepA, voffA);
            PG8_WAIT_L(8); PG8_BAR; PG8_WAIT_L(0); PG8_MMA(0, 0, At, B0); PG8_BAR; PG8_SCHED;
            PG8_LDB(B1, 0, 1); PG8_STAGE(PG8_SB(0, 0), b2, voffB);
            PG8_BAR; PG8_WAIT_L(0); PG8_MMA(0, 1, At, B1); PG8_BAR;
            PG8_LDA(At, 0, 1); PG8_STAGE(PG8_SA(0, 0), a2, voffA);
            PG8_BAR; PG8_WAIT_L(0); PG8_MMA(1, 0, At, B0); PG8_BAR; PG8_SCHED;
            PG8_STAGE(PG8_SB(0, 1), b2 + hstepB, voffB);
            PG8_WAIT_V(6); PG8_BAR; PG8_MMA(1, 1, At, B1); PG8_BAR;
            PG8_LDB(B0, 1, 0); PG8_SCHED; PG8_LDA(At, 1, 0); PG8_STAGE(PG8_SA(0, 1), a2 + hstepA, voffA);
            PG8_WAIT_L(8); PG8_BAR; PG8_WAIT_L(0); PG8_MMA(0, 0, At, B0); PG8_BAR; PG8_SCHED;
            PG8_LDB(B1, 1, 1); PG8_STAGE(PG8_SB(1, 0), b3, voffB);
            PG8_BAR; PG8_WAIT_L(0); PG8_MMA(0, 1, At, B1); PG8_BAR;
            PG8_LDA(At, 1, 1); PG8_STAGE(PG8_SA(1, 0), a3, voffA);
            PG8_BAR; PG8_WAIT_L(0); PG8_MMA(1, 0, At, B0); PG8_BAR; PG8_SCHED;
            PG8_STAGE(PG8_SB(1, 1), b3 + hstepB, voffB);
            PG8_WAIT_V(6); PG8_BAR; PG8_MMA(1, 1, At, B1); PG8_BAR;
            }
        }
        if constexpr (ALIGN_EPI) { if (wr == 0) PG8_BAR; }
        if constexpr (!Epi::AFTER_DRAIN) { E(acc, cur, wr, wc, fr, fq); S.done(cur); }
        if (!has_next) break;
#pragma unroll
        for (int a = 0; a < 2; ++a)
#pragma unroll
            for (int b = 0; b < 2; ++b)
#pragma unroll
                for (int m = 0; m < 4; ++m)
#pragma unroll
                    for (int n = 0; n < 2; ++n) acc[a][b][m][n] = (f32x4){0.f, 0.f, 0.f, 0.f};
        cur = nxt; cA = nA; cB = nB; ++ui;
        if constexpr (ALIGN_EPI) { if (wr == 1) PG8_BAR; }
    }
    PG8_WAIT_V(0);
    if constexpr (!ALIGN_EPI) { if (wr == 0) PG8_BAR; }
    PG8_BAR;
    if constexpr (Epi::AFTER_DRAIN) { E.fused(acc, cur, wr, wc, fr, fq, lds, wid, lane); S.done(cur); }
#undef PG8_SA
#undef PG8_SB
#undef PG8_STAGE
#undef PG8_LDA
#undef PG8_LDB
#undef PG8_MMA
#undef PG8_WAIT_V
#undef PG8_WAIT_L
#undef PG8_BAR
#undef PG8_SCHED
}
}

using pg8::bf16_t; using pg8::bf16x8; using pg8::f32x4; using pg8::u32x4; using pg8::u32x2; using pg8::Unit; using pg8::cvt_pk_bf16;
typedef float f32x16 __attribute__((ext_vector_type(16)));
typedef float f32x2 __attribute__((ext_vector_type(2)));
#define LAS __attribute__((address_space(3)))

constexpr int T = 32768, DM = 1024, TC = 16384, DFF = 2816, ZLD = 3840;
constexpr int ZC_XA = 0, ZC_GA = 1024, ZC_U = 2048, ZC_CKV = 3072, ZC_CQ = 3328, ZC_KR = 3712;
constexpr float EPS = 1e-6f, LOG2E = 1.4426950408889634f;
constexpr float QSCALE = 0.10206207261596577f * 1.4426950408889634f;
constexpr size_t MiB = (size_t)1 << 20;
constexpr size_t WS_W = 0, WS_XB = 64 * MiB, WS_SSQ = 128 * MiB, WS_SMALL = 130 * MiB, WS_BIG = 132 * MiB;
constexpr size_t SM_ROPE = 0, SM_RSQ = 256 * 1024, SM_RSKV = 320 * 1024, SM_MEANV = 384 * 1024, SM_RSTDV = 448 * 1024, SM_SP8 = 512 * 1024;
constexpr size_t B_H = 0, B_PB = 176 * MiB, B_GP = 192 * MiB;
constexpr size_t B_Z = 0, B_VTS = 120 * MiB, B_XC = 152 * MiB, B_LA = 184 * MiB, B_U = 216 * MiB, B_Q = 248 * MiB, B_KN = 296 * MiB, B_VT = 328 * MiB, B_KR = 360 * MiB;
constexpr size_t B_G3 = 248 * MiB, B_MERGED = 184 * MiB;
constexpr size_t WS_NEED = WS_BIG + 361 * MiB;
constexpr size_t O_WGU1 = 0, O_WD1 = O_WGU1 + 5632 * 1024, O_WIN = O_WD1 + 1024 * 2816, O_WINV = O_WIN + 3840 * 1024, O_WING = O_WINV + 1024 * 1024,
                 O_WLRU = O_WING + 3072 * 1024, O_WRA = O_WLRU + 2048 * 128, O_WRB = O_WRA + 1024 * 1024, O_WRC = O_WRB + 1024 * 1024, O_WOUT = O_WRC + 1024 * 1024,
                 O_WPG = O_WOUT + 1024 * 1024, O_WUQ = O_WPG + 1024 * 1024, O_WKVK = O_WUQ + 1536 * 384, O_WKVV = O_WKVK + 1024 * 256, O_WGU2 = O_WKVV + 1024 * 256,
                 O_WD2 = O_WGU2 + 5632 * 1024, O_WPLE = O_WD2 + 1024 * 2816, O_WSGU = O_WPLE + 1024 * 256, O_WEND = O_WSGU + 8 * 128 * 128;
static_assert(O_WEND * 2 <= 64 * MiB, "weights fit");
constexpr int LDS_BYTES = 131072;
#ifndef DBG_STOP
#define DBG_STOP 0
#endif
#ifndef DBG_BR
#define DBG_BR 7
#endif

struct Params { const float* in[34]; float* out; unsigned char* ws; };

__device__ __forceinline__ float fexp2(float x) { return __builtin_amdgcn_exp2f(x); }
__device__ __forceinline__ float frcp(float x) { return __builtin_amdgcn_rcpf(x); }
__device__ __forceinline__ float sigm(float x) { return frcp(1.f + fexp2(-LOG2E * x)); }
__device__ __forceinline__ float gelu_t(float x) { const float t = x + 0.044715f * x * x * x; return x * frcp(1.f + fexp2(-2.3022081985f * t)); }
__device__ __forceinline__ float bflo(unsigned w) { return __uint_as_float(w << 16); }
__device__ __forceinline__ float bfhi(unsigned w) { return __uint_as_float(w & 0xffff0000u); }
__device__ __forceinline__ bf16_t f2bf(float v) { return (bf16_t)(cvt_pk_bf16(v, 0.f) & 0xffffu); }
__device__ __forceinline__ float wave_sum(float v) {
#pragma unroll
    for (int o = 1; o < 64; o <<= 1) v += __shfl_xor(v, o);
    return v;
}
constexpr size_t SSQ_PLANE = (size_t)T * 4;
__device__ __forceinline__ float rstd16(const float* ssq, size_t row) {
    const float* q = ssq + row * 4; const f32x4 a = *(const f32x4*)q, b = *(const f32x4*)(q + SSQ_PLANE), c = *(const f32x4*)(q + 2 * SSQ_PLANE), d = *(const f32x4*)(q + 3 * SSQ_PLANE);
    const float s = ((a.x + a.y) + (a.z + a.w)) + ((b.x + b.y) + (b.z + b.w)) + ((c.x + c.y) + (c.z + c.w)) + ((d.x + d.y) + (d.z + d.w));
    return __builtin_amdgcn_rsqf(s * (1.0f / 1024.0f) + EPS);
}
__device__ __forceinline__ u32x4 pack8(const f32x4 v0, const f32x4 v1) { u32x4 w; w.x = cvt_pk_bf16(v0[0], v0[1]); w.y = cvt_pk_bf16(v0[2], v0[3]); w.z = cvt_pk_bf16(v1[0], v1[1]); w.w = cvt_pk_bf16(v1[2], v1[3]); return w; }
__device__ __forceinline__ void unpack8(const u32x4 w, f32x4& v0, f32x4& v1) { v0 = (f32x4){bflo(w.x), bfhi(w.x), bflo(w.y), bfhi(w.y)}; v1 = (f32x4){bflo(w.z), bfhi(w.z), bflo(w.w), bfhi(w.w)}; }

template <int ACT, int RS> struct EpiRow {
    static constexpr bool PERM = true, AFTER_DRAIN = false;
    bf16_t* O; int ldc; const float* rs; const float* bias; int t0, t1;
    __device__ __forceinline__ void operator()(const f32x4 (&acc)[2][2][4][2], const Unit& u, int wr, int wc, int fr, int fq) const {
        const int row0 = u.pm * 256 + wr * 64 + fr, col0 = u.pn * 256 + wc * 32 + 8 * fq;
        const bool act = (ACT == 1) ? (u.pn >= t0 && u.pn < t1) : true;
        f32x4 bv[2][2];
#pragma unroll
        for (int bj = 0; bj < 2; ++bj)
#pragma unroll
            for (int n = 0; n < 2; ++n) bv[bj][n] = bias ? *(const f32x4*)(bias + col0 + bj * 128 + 4 * n) : (f32x4){0.f, 0.f, 0.f, 0.f};
#pragma unroll
        for (int ai = 0; ai < 2; ++ai)
#pragma unroll
            for (int m = 0; m < 4; ++m) {
                const size_t row = (size_t)(row0 + ai * 128 + m * 16); const float s = (RS == 0) ? rstd16(rs, row) : rs[row];
                bf16_t* rowp = O + row * ldc + col0;
#pragma unroll
                for (int bj = 0; bj < 2; ++bj) {
                    f32x4 v0 = acc[ai][bj][m][0] * s + bv[bj][0], v1 = acc[ai][bj][m][1] * s + bv[bj][1];
                    if (ACT == 1) { if (act) {
#pragma unroll
                        for (int e = 0; e < 4; ++e) { v0[e] = gelu_t(v0[e]); v1[e] = gelu_t(v1[e]); } } }
                    if (ACT == 2) {
#pragma unroll
                        for (int e = 0; e < 4; ++e) { v0[e] = sigm(v0[e]); v1[e] = sigm(v1[e]); } }
                    *(u32x4*)(rowp + bj * 128) = pack8(v0, v1);
                }
                asm volatile("" ::: "memory");
            }
    }
};
struct EpiSwiglu {
    static constexpr bool PERM = true, AFTER_DRAIN = false;
    bf16_t* H; const float* ssq;
    __device__ __forceinline__ void operator()(const f32x4 (&acc)[2][2][4][2], const Unit& u, int wr, int wc, int fr, int fq) const {
        const int row0 = u.pm * 256 + wr * 64 + fr, col0 = u.pn * 128 + wc * 32 + 8 * fq;
#pragma unroll
        for (int ai = 0; ai < 2; ++ai)
#pragma unroll
            for (int m = 0; m < 4; ++m) {
                const size_t row = (size_t)(row0 + ai * 128 + m * 16); const float s = rstd16(ssq, row);
                f32x4 h0, h1;
#pragma unroll
                for (int e = 0; e < 4; ++e) { const float g0 = acc[ai][0][m][0][e] * s, g1 = acc[ai][0][m][1][e] * s; h0[e] = g0 * sigm(g0) * (acc[ai][1][m][0][e] * s); h1[e] = g1 * sigm(g1) * (acc[ai][1][m][1][e] * s); }
                *(u32x4*)(H + row * DFF + col0) = pack8(h0, h1);
                asm volatile("" ::: "memory");
            }
    }
};
template <bool GATED> struct EpiResid {
    static constexpr bool PERM = false, AFTER_DRAIN = false;
    const float* Xs; float* Xd; bf16_t* XB; float* ssq; const bf16_t* GP; float alpha;
    __device__ __forceinline__ void operator()(const f32x4 (&acc)[2][2][4][2], const Unit& u, int wr, int wc, int fr, int fq) const {
        const int col0 = u.pn * 256 + wc * 32 + 4 * fq;
#pragma unroll
        for (int ai = 0; ai < 2; ++ai)
#pragma unroll
            for (int m = 0; m < 4; ++m) {
                const size_t row = (size_t)(u.pm * 256 + ai * 128 + wr * 64 + m * 16 + fr); const size_t off = row * DM + col0; float ss = 0.f;
#pragma unroll
                for (int bj = 0; bj < 2; ++bj)
#pragma unroll
                    for (int n = 0; n < 2; ++n) {
                        const size_t o = off + bj * 128 + n * 16; f32x4 a = acc[ai][bj][m][n] * alpha;
                        if (GATED) { const u32x2 g = *(const u32x2*)(GP + o); a[0] *= bflo(g.x); a[1] *= bfhi(g.x); a[2] *= bflo(g.y); a[3] *= bfhi(g.y); }
                        const f32x4 xv = *(const f32x4*)(Xs + o) + a;
                        *(f32x4*)(Xd + o) = xv; u32x2 w; w.x = cvt_pk_bf16(xv[0], xv[1]); w.y = cvt_pk_bf16(xv[2], xv[3]); *(u32x2*)(XB + o) = w;
                        ss += (xv[0] * xv[0] + xv[1] * xv[1]) + (xv[2] * xv[2] + xv[3] * xv[3]);
                    }
                ss += __shfl_xor(ss, 16); ss += __shfl_xor(ss, 32);
                if (fq == 0) ssq[(size_t)u.pn * SSQ_PLANE + row * 4 + wc] = ss;
                asm volatile("" ::: "memory");
            }
    }
};
template <int ACT, int RS> struct EpiCol {
    static constexpr bool PERM = true, AFTER_DRAIN = false;
    bf16_t* O; int ldc; const float* rs;
    __device__ __forceinline__ void operator()(const f32x4 (&acc)[2][2][4][2], const Unit& u, int wr, int wc, int fr, int fq) const {
        const int row0 = u.pm * 256 + wr * 64 + fr, col0 = u.pn * 256 + wc * 32 + 8 * fq;
#pragma unroll
        for (int bj = 0; bj < 2; ++bj) {
            const int col = col0 + bj * 128; f32x4 c0, c1;
            if (RS == 0) {
#pragma unroll
                for (int e = 0; e < 4; ++e) { c0[e] = rstd16(rs, (size_t)(col + e)); asm volatile("" ::: "memory"); c1[e] = rstd16(rs, (size_t)(col + 4 + e)); asm volatile("" ::: "memory"); }
            } else { c0 = *(const f32x4*)(rs + col); c1 = *(const f32x4*)(rs + col + 4); }
#pragma unroll
            for (int ai = 0; ai < 2; ++ai)
#pragma unroll
                for (int m = 0; m < 4; ++m) {
                    f32x4 v0 = acc[ai][bj][m][0] * c0, v1 = acc[ai][bj][m][1] * c1;
                    if (ACT == 1) {
#pragma unroll
                        for (int e = 0; e < 4; ++e) { v0[e] = gelu_t(v0[e]); v1[e] = gelu_t(v1[e]); } }
                    *(u32x4*)(O + (size_t)(row0 + ai * 128 + m * 16) * ldc + col) = pack8(v0, v1);
                    asm volatile("" ::: "memory");
                }
        }
    }
};
struct EpiLru {
    static constexpr bool PERM = true, AFTER_DRAIN = false;
    const bf16_t* XC; bf16_t* LA; bf16_t* U; const float* ba; const float* bx; const float* sp8;
    __device__ __forceinline__ void operator()(const f32x4 (&acc)[2][2][4][2], const Unit& u, int wr, int wc, int fr, int fq) const {
        const int row0 = u.pm * 256 + wr * 64 + fr, ch0 = (u.pn * 256 + wc * 32 + 8 * fq) >> 1;
#pragma unroll
        for (int bj = 0; bj < 2; ++bj) {
            const int ch = ch0 + bj * 64; const f32x4 vba = *(const f32x4*)(ba + ch), vbx = *(const f32x4*)(bx + ch), vsp = *(const f32x4*)(sp8 + ch);
#pragma unroll
            for (int ai = 0; ai < 2; ++ai)
#pragma unroll
                for (int m = 0; m < 4; ++m) {
                    const int row = row0 + ai * 128 + m * 16; const size_t o = (size_t)row * DM + ch; const bool first = (row & 2047) == 0;
                    const u32x2 xw = *(const u32x2*)(XC + o); const float xc[4] = {bflo(xw.x), bfhi(xw.x), bflo(xw.y), bfhi(xw.y)};
                    const f32x4 v0 = acc[ai][bj][m][0], v1 = acc[ai][bj][m][1]; const float ga[4] = {v0[0], v0[2], v1[0], v1[2]}, gx[4] = {v0[1], v0[3], v1[1], v1[3]};
                    float la[4], uu[4];
#pragma unroll
                    for (int e = 0; e < 4; ++e) { const float r = sigm(ga[e] + vba[e]), ig = sigm(gx[e] + vbx[e]); la[e] = -vsp[e] * r;
                        const float a2 = fexp2(2.f * LOG2E * la[e]); const float mult = first ? 1.f : sqrtf(fmaxf(1.f - a2, 0.f)); uu[e] = mult * ig * xc[e]; }
                    u32x2 wl, wu; wl.x = cvt_pk_bf16(la[0], la[1]); wl.y = cvt_pk_bf16(la[2], la[3]); wu.x = cvt_pk_bf16(uu[0], uu[1]); wu.y = cvt_pk_bf16(uu[2], uu[3]);
                    *(u32x2*)(LA + o) = wl; *(u32x2*)(U + o) = wu;
                    asm volatile("" ::: "memory");
                }
        }
    }
};
struct EpiQ {
    static constexpr bool PERM = true, AFTER_DRAIN = false;
    bf16_t* Q; const float* rsq; const float* rope;
    __device__ __forceinline__ void operator()(const f32x4 (&acc)[2][2][4][2], const Unit& u, int wr, int wc, int fr, int fq) const {
        const int row0 = u.pm * 256 + wr * 64 + fr, col0 = u.pn * 256 + wc * 32 + 8 * fq;
#pragma unroll
        for (int ai = 0; ai < 2; ++ai)
#pragma unroll
            for (int m = 0; m < 4; ++m) {
                const int row = row0 + ai * 128 + m * 16; const float s = rsq[row] * QSCALE; const int pos = row & 2047;
#pragma unroll
                for (int bj = 0; bj < 2; ++bj) {
                    const int col = col0 + bj * 128, d = col % 96; f32x4 v0 = acc[ai][bj][m][0] * s, v1 = acc[ai][bj][m][1] * s;
                    if (d >= 64) { const int i0 = (d - 64) >> 1; const f32x4 t0 = *(const f32x4*)(rope + (pos * 16 + i0) * 2), t1 = *(const f32x4*)(rope + (pos * 16 + i0 + 2) * 2);
                        const f32x4 a = v0, b = v1;
                        v0[0] = a[0] * t0[0] - a[1] * t0[1]; v0[1] = a[0] * t0[1] + a[1] * t0[0]; v0[2] = a[2] * t0[2] - a[3] * t0[3]; v0[3] = a[2] * t0[3] + a[3] * t0[2];
                        v1[0] = b[0] * t1[0] - b[1] * t1[1]; v1[1] = b[0] * t1[1] + b[1] * t1[0]; v1[2] = b[2] * t1[2] - b[3] * t1[3]; v1[3] = b[2] * t1[3] + b[3] * t1[2]; }
                    *(u32x4*)(Q + (size_t)row * 1536 + col) = pack8(v0, v1);
                }
                asm volatile("" ::: "memory");
            }
    }
};
struct EpiMerge {
    static constexpr bool PERM = true, AFTER_DRAIN = false;
    const bf16_t* G3; bf16_t* MG; int branch; int first;
    __device__ __forceinline__ void operator()(const f32x4 (&acc)[2][2][4][2], const Unit& u, int wr, int wc, int fr, int fq) const {
        const int row0 = u.pm * 256 + wr * 64 + fr, col0 = u.pn * 256 + wc * 32 + 8 * fq;
#pragma unroll
        for (int ai = 0; ai < 2; ++ai)
#pragma unroll
            for (int m = 0; m < 4; ++m) {
                const size_t row = (size_t)(row0 + ai * 128 + m * 16);
#pragma unroll
                for (int bj = 0; bj < 2; ++bj) {
                    const int col = col0 + bj * 128; f32x4 g0, g1; unpack8(*(const u32x4*)(G3 + row * 3072 + branch * 1024 + col), g0, g1);
                    f32x4 v0 = acc[ai][bj][m][0] * g0, v1 = acc[ai][bj][m][1] * g1;
                    if (!first) { f32x4 p0, p1; unpack8(*(const u32x4*)(MG + row * DM + col), p0, p1); v0 += p0; v1 += p1; }
                    *(u32x4*)(MG + row * DM + col) = pack8(v0, v1);
                }
                asm volatile("" ::: "memory");
            }
    }
};

enum { MAP_ID = 0, MAP_SWIGLU, MAP_WIN, MAP_UQ, MAP_KVK, MAP_KVV };
struct Job { const float* W; const float* gain; bf16_t* dst; int ldw, K, dN, map, off; };
__device__ __forceinline__ int srcmap(int map, int off, int n) {
    switch (map) {
    case MAP_SWIGLU: return (n >> 8) * 128 + (n & 127) + ((n & 128) ? DFF : 0);
    case MAP_WIN: if (n < 2048) return n; if (n < 3072) return 2720 + (n - 2048); if (n < 3328) return 2432 + (n - 3072); if (n < 3712) return 2048 + (n - 3328);
                  if (n < 3744) { const int j = n - 3712, i = j >> 1; return 2688 + ((j & 1) ? 16 + i : i); } return -1;
    case MAP_UQ: { const int h = n / 96, d = n % 96; if (d < 64) return n; const int j = d - 64, i = j >> 1; return h * 96 + 64 + ((j & 1) ? 16 + i : i); }
    case MAP_KVK: return (n >> 6) * 128 + (n & 63);
    case MAP_KVV: return (n >> 6) * 128 + 64 + (n & 63);
    default: return n + off;
    }
}
#define JOB(Wp, GAIN, DST, LDW, KK, DN, MAP, OFF) do { J.W = (Wp); J.gain = (GAIN); J.dst = wb + (DST); J.ldw = (LDW); J.K = (KK); J.dN = (DN); J.map = (MAP); J.off = (OFF); } while (0)
__device__ __forceinline__ void get_job(const Params& p, int L, int j, bf16_t* wb, Job& J) {
    const size_t M1 = 1024 * 1024;
    switch (j) {
    case 0: JOB(p.in[3] + (size_t)L * 1024 * 5632, p.in[2] + L * 1024, O_WGU1, 5632, 1024, 5632, MAP_SWIGLU, 0); break;
    case 1: JOB(p.in[4] + (size_t)L * 2816 * 1024, nullptr, O_WD1, 1024, 2816, 1024, MAP_ID, 0); break;
    case 2: JOB(p.in[6] + (size_t)L * 1024 * 7840, p.in[5] + L * 1024, O_WIN, 7840, 1024, 3840, MAP_WIN, 0); break;
    case 3: JOB(p.in[6] + (size_t)L * 1024 * 7840, p.in[5] + L * 1024, O_WINV, 7840, 1024, 1024, MAP_ID, 3744); break;
    case 4: JOB(p.in[6] + (size_t)L * 1024 * 7840, p.in[5] + L * 1024, O_WING, 7840, 1024, 3072, MAP_ID, 4768); break;
    case 5: JOB(p.in[14] + L * M1, nullptr, O_WRA, 1024, 1024, 1024, MAP_ID, 0); break;
    case 6: JOB(p.in[19] + L * M1, nullptr, O_WRB, 1024, 1024, 1024, MAP_ID, 0); break;
    case 7: JOB(p.in[24] + L * M1, nullptr, O_WRC, 1024, 1024, 1024, MAP_ID, 0); break;
    case 8: JOB(p.in[26] + L * M1, nullptr, O_WOUT, 1024, 1024, 1024, MAP_ID, 0); break;
    case 9: JOB(p.in[31] + L * M1, p.in[30] + L * 1024, O_WPG, 1024, 1024, 1024, MAP_ID, 0); break;
    case 10: JOB(p.in[16] + (size_t)L * 384 * 1536, p.in[15] + L * 384, O_WUQ, 1536, 384, 1536, MAP_UQ, 0); break;
    case 11: JOB(p.in[18] + (size_t)L * 256 * 2048, p.in[17] + L * 256, O_WKVK, 2048, 256, 1024, MAP_KVK, 0); break;
    case 12: JOB(p.in[18] + (size_t)L * 256 * 2048, p.in[17] + L * 256, O_WKVV, 2048, 256, 1024, MAP_KVV, 0); break;
    case 13: JOB(p.in[28] + (size_t)L * 1024 * 5632, p.in[27] + L * 1024, O_WGU2, 5632, 1024, 5632, MAP_SWIGLU, 0); break;
    case 14: JOB(p.in[29] + (size_t)L * 2816 * 1024, nullptr, O_WD2, 1024, 2816, 1024, MAP_ID, 0); break;
    default: JOB(p.in[32] + (size_t)L * 256 * 1024, nullptr, O_WPLE, 1024, 256, 1024, MAP_ID, 0); break;
    }
}
constexpr int NJOBS = 16;
__device__ __forceinline__ void tr_item(const Job& J, int item, LAS float* scr, int lane) {
    const int nblk = J.dN >> 5, kb = item / nblk, nb = item % nblk, k0 = 64 * kb, n0 = 32 * nb;
    const int sc = srcmap(J.map, J.off, n0 + (lane & 31));
#pragma unroll 8
    for (int i = 0; i < 32; ++i) { const int kk = 2 * i + (lane >> 5); float v = (sc >= 0) ? J.W[(size_t)(k0 + kk) * J.ldw + sc] : 0.f; if (J.gain) v *= J.gain[k0 + kk]; scr[kk * 33 + (lane & 31)] = v; }
    asm volatile("s_waitcnt lgkmcnt(0)" ::: "memory");
    const int c = lane & 7;
#pragma unroll
    for (int j = 0; j < 4; ++j) { const int n = (lane >> 3) + 8 * j; const LAS float* s = scr + (8 * c) * 33 + n;
        u32x4 o; o.x = cvt_pk_bf16(s[0 * 33], s[1 * 33]); o.y = cvt_pk_bf16(s[2 * 33], s[3 * 33]); o.z = cvt_pk_bf16(s[4 * 33], s[5 * 33]); o.w = cvt_pk_bf16(s[6 * 33], s[7 * 33]);
        *(u32x4*)(J.dst + (size_t)(n0 + n) * J.K + k0 + 8 * c) = o; }
    asm volatile("s_waitcnt lgkmcnt(0)" ::: "memory");
}
__device__ __forceinline__ void phase0(const Params& p, int L, LAS unsigned char* lds, int G, int blk) {
    const int tid = pg8::tid_opaque(), lane = tid & 63, wave = tid >> 6;
    const int gw = blk * 8 + wave, NGW = G * 8, gt = blk * 512 + tid, NGT = G * 512;
    bf16_t* wb = (bf16_t*)(p.ws + WS_W);
    LAS float* scr = (LAS float*)(lds + wave * 8448);
    int total = 0;
    for (int j = 0; j < NJOBS; ++j) { Job J; get_job(p, L, j, wb, J); total += (J.K >> 6) * (J.dN >> 5); }
    for (int it = gw; it < total; it += NGW) {
        int r = it;
        for (int j = 0; j < NJOBS; ++j) { Job J; get_job(p, L, j, wb, J); const int n = (J.K >> 6) * (J.dN >> 5); if (r < n) { tr_item(J, r, scr, lane); break; } r -= n; }
    }
    { bf16_t* d = wb + O_WLRU; const float* wa = p.in[9] + (size_t)L * 65536; const float* wx = p.in[11] + (size_t)L * 65536;
      for (int i = gt; i < 2048 * 128; i += NGT) { const int n = i >> 7, k = i & 127, ch = n >> 1, nb = ch >> 6, dd = ch & 63;
          float v = 0.f; if ((k >> 6) == (nb & 1)) v = ((n & 1) ? wx : wa)[(size_t)nb * 4096 + (k & 63) * 64 + dd]; d[i] = f2bf(v); } }
    { bf16_t* d = wb + O_WSGU; const float* w = p.in[22] + (size_t)L * 131072;
      for (int i = gt; i < 131072; i += NGT) { const int t = (i >> 7) & 127, s = i & 127; d[i] = f2bf(((s >> 6) <= (t >> 6)) ? w[i] : 0.f); } }
    { float* sp = (float*)(p.ws + WS_SMALL + SM_SP8); const float* lam = p.in[13] + L * 1024;
      for (int i = gt; i < 1024; i += NGT) sp[i] = 8.f * 0.6931471805599453f * __builtin_amdgcn_logf(1.f + fexp2(-LOG2E * lam[i])); }
    if (L == 0) {
        float* rope = (float*)(p.ws + WS_SMALL + SM_ROPE);
        for (int i = gt; i < 2048 * 16; i += NGT) { const int pos = i >> 4, k = i & 15; const float inv = fexp2(-(float)k * (13.287712379549449f / 16.f)); const float ang = (float)pos * inv;
            double rev = (double)ang * 0.15915494309189535; rev -= floor(rev); const float fr = (float)rev; rope[2 * i] = __builtin_amdgcn_cosf(fr); rope[2 * i + 1] = __builtin_amdgcn_sinf(fr); }
        const float* x = p.in[0]; bf16_t* XB = (bf16_t*)(p.ws + WS_XB); float* ssq = (float*)(p.ws + WS_SSQ);
        for (int m = gw; m < T; m += NGW) {
            const f32x4* xr = (const f32x4*)(x + (size_t)m * DM) + lane; u32x2* o8 = (u32x2*)(XB + (size_t)m * DM) + lane; float s = 0.f;
#pragma unroll
            for (int j = 0; j < 4; ++j) { const f32x4 v = xr[64 * j]; s += (v[0] * v[0] + v[1] * v[1]) + (v[2] * v[2] + v[3] * v[3]); u32x2 w; w.x = cvt_pk_bf16(v[0], v[1]); w.y = cvt_pk_bf16(v[2], v[3]); o8[64 * j] = w; }
            s = wave_sum(s);
            if (lane < 16) ssq[(size_t)(lane >> 2) * SSQ_PLANE + (size_t)m * 4 + (lane & 3)] = (lane == 0) ? s : 0.f;
        }
    }
}

__device__ __forceinline__ void pb_convert(const Params& p, int L, int G, int blk) {
    const int tid = pg8::tid_opaque(), gt = blk * 512 + tid, NGT = G * 512;
    const f32x4* src = (const f32x4*)(p.in[1] + (size_t)L * T * 256); u32x2* d = (u32x2*)(p.ws + WS_BIG + B_PB);
    for (int i = gt; i < T * 256 / 4; i += NGT) { const f32x4 v = src[i]; u32x2 w; w.x = cvt_pk_bf16(v[0], v[1]); w.y = cvt_pk_bf16(v[2], v[3]); d[i] = w; }
}
__device__ __forceinline__ void e1_rows(const Params& p, int L, const bf16_t* Z, bf16_t* XC, float* RSQ, float* RSKV, bf16_t* KR, const float* rope, int G, int blk) {
    const int tid = pg8::tid_opaque(), lane = tid & 63, wave = tid >> 6, gw = blk * 8 + wave, NGW = G * 8;
    const float* cw = p.in[7] + (size_t)L * 4096; const float* cb = p.in[8] + L * 1024;
    for (int rb = blk * 64 + wave * 8; rb < TC; rb += G * 64)
    for (int r = rb; r < rb + 8; ++r) {
        const bf16_t* zr = Z + (size_t)r * ZLD; const int pos = r & 2047;
#pragma unroll
        for (int hf = 0; hf < 2; ++hf) {
            const int c0 = hf * 512 + 8 * lane; f32x4 a0 = *(const f32x4*)(cb + c0), a1 = *(const f32x4*)(cb + c0 + 4);
#pragma unroll
            for (int k = 0; k < 4; ++k) { if (pos - 3 + k >= 0) { f32x4 x0, x1; unpack8(*(const u32x4*)(zr + (ptrdiff_t)(k - 3) * ZLD + ZC_XA + c0), x0, x1);
                a0 += *(const f32x4*)(cw + k * 1024 + c0) * x0; a1 += *(const f32x4*)(cw + k * 1024 + c0 + 4) * x1; } }
            *(u32x4*)(XC + (size_t)r * DM + c0) = pack8(a0, a1);
        }
        float sq = 0.f;
        if (lane < 48) { f32x4 x0, x1; unpack8(*(const u32x4*)(zr + ZC_CQ + 8 * lane), x0, x1); sq = (x0[0] * x0[0] + x0[1] * x0[1]) + (x0[2] * x0[2] + x0[3] * x0[3]) + (x1[0] * x1[0] + x1[1] * x1[1]) + (x1[2] * x1[2] + x1[3] * x1[3]); }
        sq = wave_sum(sq);
        float sk; { const u32x2 w = *(const u32x2*)(zr + ZC_CKV + 4 * lane); const float a = bflo(w.x), b = bfhi(w.x), c = bflo(w.y), d = bfhi(w.y); sk = (a * a + b * b) + (c * c + d * d); }
        sk = wave_sum(sk);
        if (lane == 0) { RSQ[r] = __builtin_amdgcn_rsqf(sq * (1.f / 384.f) + EPS); RSKV[r] = __builtin_amdgcn_rsqf(sk * (1.f / 256.f) + EPS); }
        if (lane < 16) { const unsigned w = *(const unsigned*)(zr + ZC_KR + 2 * lane); const float x1 = bflo(w), x2 = bfhi(w); const f32x2 cs = *(const f32x2*)(rope + (pos * 16 + lane) * 2);
            *(unsigned*)(KR + (size_t)r * 32 + 2 * lane) = cvt_pk_bf16(x1 * cs[0] - x2 * cs[1], x1 * cs[1] + x2 * cs[0]); }
    }
}
__device__ __forceinline__ void e2_stats(LAS unsigned char* lds, const bf16_t* VTS, float* MEANV, float* RSTDV, int G, int blk) {
    const int tid = pg8::tid_opaque(), lane = tid & 63, wave = tid >> 6, tg = lane & 7, cr = lane >> 3;
    LAS float* part = (LAS float*)lds;
    for (int unit = blk; unit < TC / 64; unit += G) {
        const int tok0 = unit * 64; float s[8], q[8];
#pragma unroll
        for (int e = 0; e < 8; ++e) { s[e] = 0.f; q[e] = 0.f; }
#pragma unroll 4
        for (int it = 0; it < 16; ++it) { const int c = wave * 128 + it * 8 + cr; f32x4 x0, x1; unpack8(*(const u32x4*)(VTS + (size_t)c * TC + tok0 + 8 * tg), x0, x1);
#pragma unroll
            for (int e = 0; e < 4; ++e) { s[e] += x0[e]; q[e] += x0[e] * x0[e]; s[4 + e] += x1[e]; q[4 + e] += x1[e] * x1[e]; } }
#pragma unroll
        for (int e = 0; e < 8; ++e) { s[e] += __shfl_xor(s[e], 8); s[e] += __shfl_xor(s[e], 16); s[e] += __shfl_xor(s[e], 32); q[e] += __shfl_xor(q[e], 8); q[e] += __shfl_xor(q[e], 16); q[e] += __shfl_xor(q[e], 32); }
        if (cr == 0) {
#pragma unroll
            for (int e = 0; e < 8; ++e) { part[(wave * 64 + 8 * tg + e) * 2] = s[e]; part[(wave * 64 + 8 * tg + e) * 2 + 1] = q[e]; } }
        __syncthreads();
        if (tid < 64) { float ss = 0.f, qq = 0.f;
#pragma unroll
            for (int w = 0; w < 8; ++w) { ss += part[(w * 64 + tid) * 2]; qq += part[(w * 64 + tid) * 2 + 1]; }
            const float mean = ss * (1.f / 1024.f); const float var = fmaxf(qq * (1.f / 1024.f) - mean * mean, 0.f);
            MEANV[tok0 + tid] = mean; RSTDV[tok0 + tid] = __builtin_amdgcn_rsqf(var + EPS); }
        __syncthreads();
    }
}
__device__ __forceinline__ void scan_units(LAS unsigned char* lds, const bf16_t* LA, const bf16_t* U, bf16_t* Z, int G, int blk) {
    const int tid = pg8::tid_opaque(), cp = tid & 31, seg = tid >> 5;
    LAS f32x4* sc = (LAS f32x4*)lds;
    for (int idx = blk; idx < 128; idx += G) {
        const int b = idx >> 4, ch = (idx & 15) * 64 + 2 * cp; const size_t row0 = (size_t)b * 2048 + seg * 128;
        const unsigned* lap = (const unsigned*)(LA + row0 * DM + ch); const unsigned* up = (const unsigned*)(U + row0 * DM + ch);
        float h0 = 0.f, h1 = 0.f, s0 = 0.f, s1 = 0.f;
#pragma unroll 8
        for (int t = 0; t < 128; ++t) { const unsigned lw = lap[(size_t)t * 512], uw = up[(size_t)t * 512]; const float l0 = bflo(lw), l1 = bfhi(lw);
            h0 = fexp2(LOG2E * l0) * h0 + bflo(uw); h1 = fexp2(LOG2E * l1) * h1 + bfhi(uw); s0 += l0; s1 += l1; }
        sc[seg * 32 + cp] = (f32x4){s0, s1, h0, h1};
        __syncthreads();
        float c0 = 0.f, c1 = 0.f;
        for (int j = 0; j < seg; ++j) { const f32x4 v = sc[j * 32 + cp]; c0 = fexp2(LOG2E * v[0]) * c0 + v[2]; c1 = fexp2(LOG2E * v[1]) * c1 + v[3]; }
        h0 = c0; h1 = c1;
        unsigned* gp = (unsigned*)(Z + row0 * ZLD + ZC_GA + ch);
#pragma unroll 8
        for (int t = 0; t < 128; ++t) { const unsigned lw = lap[(size_t)t * 512], uw = up[(size_t)t * 512], gw = gp[(size_t)t * (ZLD / 2)];
            h0 = fexp2(LOG2E * bflo(lw)) * h0 + bflo(uw); h1 = fexp2(LOG2E * bfhi(lw)) * h1 + bfhi(uw); gp[(size_t)t * (ZLD / 2)] = cvt_pk_bf16(h0 * bflo(gw), h1 * bfhi(gw)); }
        __syncthreads();
    }
}
__device__ __forceinline__ void attn_units(LAS unsigned char* lds, const bf16_t* Q, const bf16_t* KN, const bf16_t* KR, const bf16_t* VT, bf16_t* Z, int G, int blk) {
    const int tid = pg8::tid_opaque(), lane = tid & 63, wid = __builtin_amdgcn_readfirstlane(tid >> 6), i32 = lane & 31, hi = lane >> 5;
    constexpr int KP = 208, VP = 144, KBUF = 64 * KP, VBUF = 64 * VP;
    for (int idx = blk; idx < 1024; idx += G) {
        const int j = idx & 255, rnd = idx >> 8, bh = j >> 1;
        const int qb = (j & 1) ? (rnd == 0 ? 1 : rnd == 1 ? 6 : rnd == 2 ? 3 : 4) : (rnd == 0 ? 0 : rnd == 1 ? 7 : rnd == 2 ? 2 : 5);
        const int b = bh >> 4, h = bh & 15, q0 = qb * 256, NT = q0 / 64 + 4, ntw = (q0 + 32 * wid) / 64 + 1;
        const size_t rowb = (size_t)b * 2048;
        bf16x8 qr[6];
        { const bf16_t* qp = Q + (rowb + q0 + 32 * wid + i32) * 1536 + h * 96 + 8 * hi;
#pragma unroll
          for (int ks = 0; ks < 6; ++ks) qr[ks] = *(const bf16x8*)(qp + 16 * ks); }
        const bf16_t* kns = KN + (rowb + (tid >> 3)) * DM + h * 64 + 8 * (tid & 7);
        const bf16_t* krs = KR + (rowb + (tid >> 2)) * 32 + 8 * (tid & 3);
        const bf16_t* vts = VT + (size_t)(h * 64 + (tid >> 3)) * TC + rowb + 8 * (tid & 7);
        const int kdst = (tid >> 3) * KP + (tid & 7) * 16, krdst = (tid >> 2) * KP + 128 + (tid & 3) * 16, vdst = 2 * KBUF + (tid >> 3) * VP + (tid & 7) * 16;
        u32x4 rk, rr = (u32x4){0u, 0u, 0u, 0u}, rv;
        rk = *(const u32x4*)kns; if (tid < 256) rr = *(const u32x4*)krs; rv = *(const u32x4*)vts;
        *(LAS u32x4*)(lds + kdst) = rk; if (tid < 256) *(LAS u32x4*)(lds + krdst) = rr; *(LAS u32x4*)(lds + vdst) = rv;
        __syncthreads();
        f32x16 o0, o1;
#pragma unroll
        for (int r = 0; r < 16; ++r) { o0[r] = 0.f; o1[r] = 0.f; }
        float mrun = -1e30f, lrun = 0.f;
        for (int t = 0; t < NT; ++t) {
            const int cur = t & 1; const bool more = (t + 1 < NT);
            if (more) { rk = *(const u32x4*)(kns + (size_t)(t + 1) * 64 * DM); if (tid < 256) rr = *(const u32x4*)(krs + (size_t)(t + 1) * 64 * 32); rv = *(const u32x4*)(vts + (size_t)(t + 1) * 64); }
            if (t < ntw) {
                LAS const unsigned char* kb = lds + cur * KBUF; LAS const unsigned char* vb = lds + 2 * KBUF + cur * VBUF;
                f32x16 s0, s1;
#pragma unroll
                for (int r = 0; r < 16; ++r) { s0[r] = 0.f; s1[r] = 0.f; }
#pragma unroll
                for (int ks = 0; ks < 6; ++ks) {
                    const bf16x8 a0 = *(LAS const bf16x8*)(kb + i32 * KP + (16 * ks + 8 * hi) * 2), a1 = *(LAS const bf16x8*)(kb + (32 + i32) * KP + (16 * ks + 8 * hi) * 2);
                    s0 = __builtin_amdgcn_mfma_f32_32x32x16_bf16(a0, qr[ks], s0, 0, 0, 0); s1 = __builtin_amdgcn_mfma_f32_32x32x16_bf16(a1, qr[ks], s1, 0, 0, 0);
                }
                float mx = fmaxf(s0[0], s1[0]);
#pragma unroll
                for (int r = 1; r < 16; ++r) mx = fmaxf(mx, fmaxf(s0[r], s1[r]));
                mx = fmaxf(mx, __shfl_xor(mx, 32));
                const float mn = fmaxf(mrun, mx), alpha = fexp2(mrun - mn); mrun = mn;
                float rs = 0.f;
#pragma unroll
                for (int r = 0; r < 16; ++r) { s0[r] = fexp2(s0[r] - mn); s1[r] = fexp2(s1[r] - mn); rs += s0[r] + s1[r]; }
                lrun = lrun * alpha + rs;
#pragma unroll
                for (int r = 0; r < 16; ++r) { o0[r] *= alpha; o1[r] *= alpha; }
                bf16x8 pf[2][2];
#pragma unroll
                for (int uu = 0; uu < 2; ++uu) {
                    u32x4 w0, w1;
                    w0.x = cvt_pk_bf16(s0[8 * uu + 0], s0[8 * uu + 1]); w0.y = cvt_pk_bf16(s0[8 * uu + 2], s0[8 * uu + 3]); w0.z = cvt_pk_bf16(s0[8 * uu + 4], s0[8 * uu + 5]); w0.w = cvt_pk_bf16(s0[8 * uu + 6], s0[8 * uu + 7]);
                    w1.x = cvt_pk_bf16(s1[8 * uu + 0], s1[8 * uu + 1]); w1.y = cvt_pk_bf16(s1[8 * uu + 2], s1[8 * uu + 3]); w1.z = cvt_pk_bf16(s1[8 * uu + 4], s1[8 * uu + 5]); w1.w = cvt_pk_bf16(s1[8 * uu + 6], s1[8 * uu + 7]);
                    pf[0][uu] = __builtin_bit_cast(bf16x8, w0); pf[1][uu] = __builtin_bit_cast(bf16x8, w1);
                }
#pragma unroll
                for (int tt = 0; tt < 2; ++tt)
#pragma unroll
                    for (int uu = 0; uu < 2; ++uu) {
                        LAS const unsigned char* vp0 = vb + i32 * VP + (32 * tt + 16 * uu + 4 * hi) * 2; LAS const unsigned char* vp1 = vp0 + 32 * VP;
                        const u32x2 a = *(LAS const u32x2*)vp0, bq = *(LAS const u32x2*)(vp0 + 16), c = *(LAS const u32x2*)vp1, d = *(LAS const u32x2*)(vp1 + 16);
                        const bf16x8 vf0 = __builtin_bit_cast(bf16x8, ((u32x4){a.x, a.y, bq.x, bq.y})), vf1 = __builtin_bit_cast(bf16x8, ((u32x4){c.x, c.y, d.x, d.y}));
                        o0 = __builtin_amdgcn_mfma_f32_32x32x16_bf16(vf0, pf[tt][uu], o0, 0, 0, 0); o1 = __builtin_amdgcn_mfma_f32_32x32x16_bf16(vf1, pf[tt][uu], o1, 0, 0, 0);
                    }
            }
            if (more) { const int nb = cur ^ 1; *(LAS u32x4*)(lds + nb * KBUF + kdst) = rk; if (tid < 256) *(LAS u32x4*)(lds + nb * KBUF + krdst) = rr; *(LAS u32x4*)(lds + nb * VBUF + vdst) = rv; }
            __syncthreads();
        }
        lrun += __shfl_xor(lrun, 32); const float inv = frcp(lrun);
        bf16_t* op = Z + (rowb + q0 + 32 * wid + i32) * ZLD + ZC_XA + h * 64 + 4 * hi;
#pragma unroll
        for (int rg = 0; rg < 4; ++rg) {
            u32x2 w; w.x = cvt_pk_bf16(o0[4 * rg] * inv, o0[4 * rg + 1] * inv); w.y = cvt_pk_bf16(o0[4 * rg + 2] * inv, o0[4 * rg + 3] * inv); *(u32x2*)(op + 8 * rg) = w;
            w.x = cvt_pk_bf16(o1[4 * rg] * inv, o1[4 * rg + 1] * inv); w.y = cvt_pk_bf16(o1[4 * rg + 2] * inv, o1[4 * rg + 3] * inv); *(u32x2*)(op + 32 + 8 * rg) = w;
        }
    }
}
__device__ __forceinline__ void sgu_units(LAS unsigned char* lds, const bf16_t* VTS, const float* MEANV, const float* RSTDV, const float* lng, const float* lnb, const bf16_t* WS, const float* bs, bf16_t* Z, int G, int blk) {
    const int tid = pg8::tid_opaque(), lane = tid & 63, wid = __builtin_amdgcn_readfirstlane(tid >> 6), i32 = lane & 31, hi = lane >> 5;
    constexpr int AP = 272;
    for (int idx = blk; idx < 1024; idx += G) {
        const int tb = idx >> 3, g = idx & 7, tok0 = tb * 128;
#pragma unroll
        for (int jj = 0; jj < 4; ++jj) {
            const int id = tid + 512 * jj, c = id >> 4, sc = id & 15; f32x4 x0, x1; unpack8(*(const u32x4*)(VTS + (size_t)(g * 128 + c) * TC + tok0 + 8 * sc), x0, x1);
            const f32x4 m0 = *(const f32x4*)(MEANV + tok0 + 8 * sc), m1 = *(const f32x4*)(MEANV + tok0 + 8 * sc + 4), r0 = *(const f32x4*)(RSTDV + tok0 + 8 * sc), r1 = *(const f32x4*)(RSTDV + tok0 + 8 * sc + 4);
            const float ga = lng[g * 128 + c], be = lnb[g * 128 + c];
            x0 = (x0 - m0) * r0 * ga + be; x1 = (x1 - m1) * r1 * ga + be;
            *(LAS u32x4*)(lds + c * AP + sc * 16) = pack8(x0, x1);
        }
        __syncthreads();
        const int tt = wid & 3; bf16x8 wf[8];
        { const bf16_t* wp = WS + (size_t)(g * 128 + 32 * tt + i32) * 128 + 8 * hi;
#pragma unroll
          for (int ks = 0; ks < 8; ++ks) wf[ks] = *(const bf16x8*)(wp + 16 * ks); }
        const float bsv = bs[g * 128 + 32 * tt + i32];
#pragma unroll
        for (int cc = 0; cc < 2; ++cc) {
            const int ct = 2 * (wid >> 2) + cc; f32x16 acc;
#pragma unroll
            for (int r = 0; r < 16; ++r) acc[r] = 0.f;
#pragma unroll
            for (int ks = 0; ks < 8; ++ks) { const bf16x8 a = *(LAS const bf16x8*)(lds + (32 * ct + i32) * AP + (16 * ks + 8 * hi) * 2); acc = __builtin_amdgcn_mfma_f32_32x32x16_bf16(a, wf[ks], acc, 0, 0, 0); }
            bf16_t* up = Z + (size_t)(tok0 + 32 * tt + i32) * ZLD + ZC_U + g * 128 + 32 * ct + 4 * hi;
#pragma unroll
            for (int rg = 0; rg < 4; ++rg) { const u32x2 uv = *(const u32x2*)(up + 8 * rg); u32x2 w;
                w.x = cvt_pk_bf16((acc[4 * rg] + bsv) * bflo(uv.x), (acc[4 * rg + 1] + bsv) * bfhi(uv.x)); w.y = cvt_pk_bf16((acc[4 * rg + 2] + bsv) * bflo(uv.y), (acc[4 * rg + 3] + bsv) * bfhi(uv.y)); *(u32x2*)(up + 8 * rg) = w; }
        }
        __syncthreads();
    }
}

#ifndef DBG_DUMP
#define DBG_DUMP 0
#define DBG_CH 0
#define DBG_TWICE 0
#define DBG_SKIP56 0
#endif
__device__ __forceinline__ void dbg_add(float* out, const bf16_t* buf, size_t n, bool first, int G, int blk) {
    const size_t gt = (size_t)blk * 512 + pg8::tid_opaque(), NGT = (size_t)G * 512;
    for (size_t i = gt; i < (size_t)T * DM; i += NGT) { float v = 0.f; for (size_t j = i; j < n; j += (size_t)T * DM) v += __uint_as_float((unsigned)buf[j] << 16); out[i] = first ? v : out[i] + v; }
}
__device__ __forceinline__ void dbg_addf(float* out, const float* buf, size_t n, int G, int blk) {
    const size_t gt = (size_t)blk * 512 + pg8::tid_opaque(), NGT = (size_t)G * 512;
    for (size_t i = gt; i < (size_t)T * DM; i += NGT) out[i] += buf[i % n];
}
#define RUN_GEMM(EPI, e, Ap, Bp, M_, N_, K_, lda_, ldb_, apn_) do { int K__ = (K_), blk__ = blk; asm volatile("" : "+s"(K__), "+s"(blk__)); pg8::Gemm gg{(Ap), (Bp), (M_), (N_), K__, (lda_), (ldb_), (apn_)}; pg8::StaticOrder SO; SO.init((M_), (N_), G, blk__); \
    pg8::gemm_phase<decltype(e), pg8::StaticOrder, true, true>(lds, gg, SO, e); } while (0)

constexpr size_t SM_BAR = 1024 * 1024;
__device__ __forceinline__ void grid_barrier(unsigned* bar, unsigned nblk) {
    asm volatile("s_waitcnt vmcnt(0) lgkmcnt(0)" ::: "memory");
    __syncthreads();
    if (threadIdx.x == 0) {
        __builtin_amdgcn_fence(__ATOMIC_RELEASE, "agent");
        asm volatile("s_waitcnt vmcnt(0)" ::: "memory");
        const unsigned gen = __hip_atomic_load(bar + 64, __ATOMIC_RELAXED, __HIP_MEMORY_SCOPE_AGENT);
        const unsigned old = __hip_atomic_fetch_add(bar, 1u, __ATOMIC_RELAXED, __HIP_MEMORY_SCOPE_AGENT);
        if (old == nblk - 1u) { __hip_atomic_store(bar, 0u, __ATOMIC_RELAXED, __HIP_MEMORY_SCOPE_AGENT); asm volatile("s_waitcnt vmcnt(0)" ::: "memory"); __hip_atomic_fetch_add(bar + 64, 1u, __ATOMIC_RELEASE, __HIP_MEMORY_SCOPE_AGENT); }
        else { while (__hip_atomic_load(bar + 64, __ATOMIC_RELAXED, __HIP_MEMORY_SCOPE_AGENT) == gen) __builtin_amdgcn_s_sleep(2); }
        __builtin_amdgcn_fence(__ATOMIC_ACQUIRE, "agent");
        asm volatile("s_waitcnt vmcnt(0)" ::: "memory");
    }
    __syncthreads();
    __builtin_amdgcn_fence(__ATOMIC_ACQUIRE, "agent");
    asm volatile("s_waitcnt vmcnt(0)" ::: "memory");
}
#define GRID_SYNC() grid_barrier(BAR, (unsigned)G)
#define DBG_DUMP_BODY(st) do { \
    dbg_add(X, G3, (size_t)TC * 3072, true, G, blk); } while (0)
__global__ void __launch_bounds__(512, 2) fwd_kernel(Params p) {
    extern __shared__ __attribute__((aligned(16))) unsigned char lds_raw[];
    LAS unsigned char* lds = (LAS unsigned char*)lds_raw;
    cg::grid_group grid = cg::this_grid();
    const int G = gridDim.x, blk = blockIdx.x;
    unsigned char* ws = p.ws;
    unsigned* BAR = (unsigned*)(ws + WS_SMALL + SM_BAR);
    grid.sync();
    bf16_t* wb = (bf16_t*)(ws + WS_W); bf16_t* XB = (bf16_t*)(ws + WS_XB); float* SSQ = (float*)(ws + WS_SSQ); float* X = p.out;
    float* ROPE = (float*)(ws + WS_SMALL + SM_ROPE); float* RSQ = (float*)(ws + WS_SMALL + SM_RSQ); float* RSKV = (float*)(ws + WS_SMALL + SM_RSKV);
    float* MEANV = (float*)(ws + WS_SMALL + SM_MEANV); float* RSTDV = (float*)(ws + WS_SMALL + SM_RSTDV); float* SP8 = (float*)(ws + WS_SMALL + SM_SP8);
    unsigned char* big = ws + WS_BIG;
    bf16_t* H = (bf16_t*)(big + B_H); bf16_t* PB = (bf16_t*)(big + B_PB); bf16_t* GP = (bf16_t*)(big + B_GP);
    bf16_t* Z = (bf16_t*)(big + B_Z); bf16_t* VTS = (bf16_t*)(big + B_VTS); bf16_t* XC = (bf16_t*)(big + B_XC); bf16_t* LA = (bf16_t*)(big + B_LA); bf16_t* U = (bf16_t*)(big + B_U);
    bf16_t* Q = (bf16_t*)(big + B_Q); bf16_t* KN = (bf16_t*)(big + B_KN); bf16_t* VT = (bf16_t*)(big + B_VT); bf16_t* KR = (bf16_t*)(big + B_KR);
    bf16_t* G3 = (bf16_t*)(big + B_G3); bf16_t* MG = (bf16_t*)(big + B_MERGED);

#pragma unroll 1
    for (int L = 0; L < 2; ++L) {
#ifndef NO_P0
        phase0(p, L, lds, G, blk);
#endif
        GRID_SYNC();
        { EpiSwiglu e{H, SSQ}; RUN_GEMM(EpiSwiglu, e, XB, wb + O_WGU1, T, 2 * DFF, 1024, 1024, 1024, 0); }
        GRID_SYNC();
        { EpiResid<false> e{L == 0 ? p.in[0] : X, X, XB, SSQ, nullptr, 0.5f}; RUN_GEMM(EpiResid<false>, e, H, wb + O_WD1, T, 1024, DFF, DFF, DFF, 0); }
        GRID_SYNC();
#if DBG_STOP == 1
        break;
#endif
#pragma unroll 1
        for (int ch = 0; ch < 2; ++ch) {
            const size_t r0 = (size_t)ch * TC;
            { EpiRow<1, 0> e{Z, ZLD, SSQ + r0 * 4, nullptr, 4, 12}; RUN_GEMM((EpiRow<1, 0>), e, XB + r0 * DM, wb + O_WIN, TC, ZLD, 1024, 1024, 1024, 0); }
            { EpiCol<1, 0> e{VTS, TC, SSQ + r0 * 4}; RUN_GEMM((EpiCol<1, 0>), e, wb + O_WINV, XB + r0 * DM, 1024, TC, 1024, 1024, 1024, 0); }
            GRID_SYNC();
#if DBG_DUMP == 3
            if (ch == DBG_CH) { DBG_DUMP_BODY(3); return; }
#endif
#ifndef NO_E1
            e1_rows(p, L, Z, XC, RSQ, RSKV, KR, ROPE, G, blk);
#endif
#ifndef NO_E2
            e2_stats(lds, VTS, MEANV, RSTDV, G, blk);
#endif
            GRID_SYNC();
#if DBG_DUMP == 4
            if (ch == DBG_CH) { DBG_DUMP_BODY(4); return; }
#endif
#if !DBG_SKIP56
            { EpiLru e{XC, LA, U, p.in[10] + L * 1024, p.in[12] + L * 1024, SP8}; RUN_GEMM(EpiLru, e, XC, wb + O_WLRU, TC, 2048, 128, 1024, 128, 128); }
            { EpiQ e{Q, RSQ, ROPE}; RUN_GEMM(EpiQ, e, Z + ZC_CQ, wb + O_WUQ, TC, 1536, 384, ZLD, 384, 0); }
            { EpiRow<0, 1> e{KN, 1024, RSKV, nullptr, 0, 0}; RUN_GEMM((EpiRow<0, 1>), e, Z + ZC_CKV, wb + O_WKVK, TC, 1024, 256, ZLD, 256, 0); }
            { EpiCol<0, 1> e{VT, TC, RSKV}; RUN_GEMM((EpiCol<0, 1>), e, wb + O_WKVV, Z + ZC_CKV, 1024, TC, 256, 256, ZLD, 0); }
            GRID_SYNC();
#if DBG_DUMP == 5
            if (ch == DBG_CH) { DBG_DUMP_BODY(5); return; }
#endif
#if (DBG_BR & 1)
            scan_units(lds, LA, U, Z, G, blk);
#endif
#if (DBG_BR & 2)
            attn_units(lds, Q, KN, KR, VT, Z, G, blk);
#endif
#if (DBG_BR & 4)
            sgu_units(lds, VTS, MEANV, RSTDV, p.in[20] + L * 1024, p.in[21] + L * 1024, wb + O_WSGU, p.in[23] + L * 1024, Z, G, blk);
#endif
            GRID_SYNC();
#if DBG_DUMP == 6
            if (ch == DBG_CH) { DBG_DUMP_BODY(6); return; }
#endif
#endif
            { EpiRow<2, 0> e{G3, 3072, SSQ + r0 * 4, p.in[25] + L * 3072, 0, 0}; RUN_GEMM((EpiRow<2, 0>), e, XB + r0 * DM, wb + O_WING, TC, 3072, 1024, 1024, 1024, 0); }
#if DBG_TWICE
            GRID_SYNC();
            { EpiRow<2, 0> e{G3, 3072, SSQ + r0 * 4, p.in[25] + L * 3072, 0, 0}; RUN_GEMM((EpiRow<2, 0>), e, XB + r0 * DM, wb + O_WING, TC, 3072, 1024, 1024, 1024, 0); }
#endif
            GRID_SYNC();
#if DBG_DUMP == 7
            if (ch == DBG_CH) { DBG_DUMP_BODY(7); return; }
#endif
#if DBG_BR & 1
            { EpiMerge e{G3, MG, 0, 1}; RUN_GEMM(EpiMerge, e, Z + ZC_GA, wb + O_WRA, TC, 1024, 1024, ZLD, 1024, 0); }
#endif
#if DBG_BR & 2
            { EpiMerge e{G3, MG, 1, (DBG_BR & 1) ? 0 : 1}; RUN_GEMM(EpiMerge, e, Z + ZC_XA, wb + O_WRB, TC, 1024, 1024, ZLD, 1024, 0); }
#endif
#if DBG_BR & 4
            { EpiMerge e{G3, MG, 2, (DBG_BR & 3) ? 0 : 1}; RUN_GEMM(EpiMerge, e, Z + ZC_U, wb + O_WRC, TC, 1024, 1024, ZLD, 1024, 0); }
#endif
            GRID_SYNC();
#if DBG_DUMP == 8
            if (ch == DBG_CH) { DBG_DUMP_BODY(8); return; }
#endif
            { EpiResid<false> e{X + r0 * DM, X + r0 * DM, XB + r0 * DM, SSQ + r0 * 4, nullptr, 1.0f}; RUN_GEMM(EpiResid<false>, e, MG, wb + O_WOUT, TC, 1024, 1024, 1024, 1024, 0); }
            GRID_SYNC();
        }
#if DBG_STOP == 2
        break;
#endif
        { EpiSwiglu e{H, SSQ}; RUN_GEMM(EpiSwiglu, e, XB, wb + O_WGU2, T, 2 * DFF, 1024, 1024, 1024, 0); }
        GRID_SYNC();
        { EpiResid<false> e{X, X, XB, SSQ, nullptr, 0.5f}; RUN_GEMM(EpiResid<false>, e, H, wb + O_WD2, T, 1024, DFF, DFF, DFF, 0); }
        GRID_SYNC();
        pb_convert(p, L, G, blk);
        { EpiRow<2, 0> e{GP, 1024, SSQ, nullptr, 0, 0}; RUN_GEMM((EpiRow<2, 0>), e, XB, wb + O_WPG, T, 1024, 1024, 1024, 1024, 0); }
        GRID_SYNC();
        { EpiResid<true> e{X, X, XB, SSQ, GP, 1.0f}; RUN_GEMM(EpiResid<true>, e, PB, wb + O_WPLE, T, 1024, 256, 256, 256, 0); }
        GRID_SYNC();
    }
    {
        const int tid = pg8::tid_opaque(), lane = tid & 63, wave = tid >> 6, gw = blk * 8 + wave, NGW = G * 8; const float* fn = p.in[33];
        for (int m = gw; m < T; m += NGW) {
            f32x4* xr = (f32x4*)(X + (size_t)m * DM) + lane; f32x4 v[4]; float s = 0.f;
#pragma unroll
            for (int j = 0; j < 4; ++j) { v[j] = xr[64 * j]; s += (v[j][0] * v[j][0] + v[j][1] * v[j][1]) + (v[j][2] * v[j][2] + v[j][3] * v[j][3]); }
            const float rstd = __builtin_amdgcn_rsqf(wave_sum(s) * (1.f / 1024.f) + EPS);
#pragma unroll
            for (int j = 0; j < 4; ++j) xr[64 * j] = v[j] * rstd * ((const f32x4*)fn)[lane + 64 * j];
        }
    }
}

extern "C" void kernel_launch(void* const* d_in, const int* in_sizes, int n_in, void* d_out, int out_size, void* d_ws, size_t ws_size, hipStream_t stream) {
    static int grid = 0;
    if (grid == 0) {
        if (n_in != 34 || ws_size < WS_NEED) { fprintf(stderr, "kernel_launch: unexpected n_in %d / ws_size %zu (need %zu)\n", n_in, ws_size, (size_t)WS_NEED); grid = -1; return; }
        int dev = 0, cus = 0, per = 0;
        (void)hipGetDevice(&dev); (void)hipDeviceGetAttribute(&cus, hipDeviceAttributeMultiprocessorCount, dev);
        (void)hipFuncSetAttribute((const void*)fwd_kernel, hipFuncAttributeMaxDynamicSharedMemorySize, LDS_BYTES);
        if (hipOccupancyMaxActiveBlocksPerMultiprocessor(&per, (const void*)fwd_kernel, 512, LDS_BYTES) != hipSuccess || per < 1) per = 1;
        (void)hipGetLastError();
        grid = cus * per;
    }
    if (grid < 0) return;
    (void)hipMemsetAsync((unsigned char*)d_ws + WS_SMALL + SM_BAR, 0, 1024, stream);
    Params prm{};
    for (int i = 0; i < 34; ++i) prm.in[i] = (const float*)d_in[i];
    prm.out = (float*)d_out; prm.ws = (unsigned char*)d_ws;
    void* args[] = {&prm};
    hipError_t e = hipLaunchCooperativeKernel((const void*)fwd_kernel, dim3(grid), dim3(512), args, LDS_BYTES, stream);
    if (e != hipSuccess) fprintf(stderr, "cooperative launch failed: %s (grid %d)\n", hipGetErrorString(e), grid);
}
```

```cpp
#include <hip/hip_runtime.h>
#include <hip/hip_cooperative_groups.h>
#include <cstdio>
#include <cstdint>
namespace cg = cooperative_groups;
namespace pg8 {
#define PG8_LAS __attribute__((address_space(3)))
typedef unsigned short bf16_t;
typedef short bf16x8 __attribute__((ext_vector_type(8)));
typedef float f32x4 __attribute__((ext_vector_type(4)));
typedef unsigned u32x4 __attribute__((ext_vector_type(4)));
typedef unsigned u32x2 __attribute__((ext_vector_type(2)));
constexpr int BM = 256, BK = 64, HALF = 128, HTB = HALF * BK * 2  , STAGE_BYTES = 8 * HTB, NXCD = 8, WGM = 8;

__host__ __device__ __forceinline__ int lds_byte(int r, int c) { const int st = (r >> 4) * 2 + (c >> 5), rr = r & 15, cc = c & 31, ob = rr * 64 + cc * 2; return st * 1024 + (ob ^ (((ob >> 9) & 1) << 5)); }
__host__ __device__ __forceinline__ void stage_rc(int b, int& R, int& C) { const int st = b / 1024, sb = b % 1024, swz = sb ^ (((sb >> 9) & 1) << 5); R = (st >> 1) * 16 + swz / 64; C = (st & 1) * 32 + (swz % 64) / 2; }
__host__ __device__ __forceinline__ int perm32(int rho) { const int n = rho >> 4, i = rho & 15; return 8 * (i >> 2) + 4 * n + (i & 3); }

struct Unit { int pm, pn; };
struct Gemm { const bf16_t* A; const bf16_t* Bt; int M, N, K, lda, ldb, apn, aps; };

struct StaticOrder {
    int nM, nN, nwg, G, c;
    __host__ __device__ void init(int M, int N, int G_, int c_) { nM = M / BM; nN = N / BM; nwg = nM * nN; G = G_; c = c_; }
    __host__ __device__ bool next(int i, Unit& u) const {
        const long L = (long)i * G + c; if (L >= nwg) return false;
        int wgid = (int)L; { const int q = nwg / NXCD, r = nwg % NXCD, xcd = wgid % NXCD, off = wgid / NXCD; wgid = (xcd < r ? xcd * (q + 1) : r * (q + 1) + (xcd - r) * q) + off; }
        const int nig = WGM * nN, gid = wgid / nig, fm = gid * WGM, gsz = (nM - fm) < WGM ? (nM - fm) : WGM;
        u.pm = fm + ((wgid % nig) % gsz); u.pn = (wgid % nig) / gsz; return true;
    }
    __device__ __forceinline__ void a_ready(const Unit&) const {}
    __device__ __forceinline__ void done(const Unit&) const {}
};
__device__ __forceinline__ int tid_opaque() { int t = threadIdx.x; asm volatile("" : "+v"(t)); return t; }
typedef float f32x2_t __attribute__((ext_vector_type(2))); typedef __bf16 bf16x2_t __attribute__((ext_vector_type(2)));
__device__ __forceinline__ unsigned cvt_pk_bf16(float lo, float hi) { const f32x2_t v = {lo, hi}; const bf16x2_t b = __builtin_convertvector(v, bf16x2_t); return __builtin_bit_cast(unsigned, b); }

template <class Epi, class Sched, bool ALIGN_EPI = false, bool SP2 = false>
__device__ __forceinline__ void gemm_phase(PG8_LAS unsigned char* lds, const Gemm g, const Sched& S, const Epi& E) {
    const int tid = pg8::tid_opaque(), wid = __builtin_amdgcn_readfirstlane(tid >> 6), lane = tid & 63, wr = wid >> 2, wc = wid & 3, fr = lane & 15, fq = lane >> 4;
    const int K = g.K, nt = K / BK;
    unsigned voffA[2], voffB[2];
#pragma unroll
    for (int i = 0; i < 2; ++i) { int R, C; stage_rc(tid * 16 + i * 8192, R, C); const int Rb = Epi::PERM ? ((R & ~31) + perm32(R & 31)) : R;
        voffA[i] = (unsigned)(R * g.lda + C) * 2u; voffB[i] = (unsigned)(Rb * g.ldb + C) * 2u; }
    const size_t kstep = (size_t)(BK * 2);
    const size_t hstepA = (size_t)HALF * g.lda * 2, hstepB = (size_t)HALF * g.ldb * 2;
    const size_t tstepA = 2 * hstepA, tstepB = 2 * hstepB; const size_t apn = (size_t)g.apn * 2;
    const unsigned ldsw = (unsigned)wid * 1024u;
    const int aoff = lds_byte(wr * 64 + fr, fq * 8), boff = lds_byte(wc * 32 + fr, fq * 8);
#define PG8_SA(b, h) (((b) * 2 + (h)) * HTB)
#define PG8_SB(b, h) ((4 + (b) * 2 + (h)) * HTB)
#define PG8_STAGE(bufoff, gbase, voff) do { _Pragma("unroll") for (int _i = 0; _i < 2; ++_i) \
        __builtin_amdgcn_global_load_lds((const unsigned*)((const char*)(gbase) + (voff)[_i]), (PG8_LAS unsigned*)(lds + (bufoff) + ldsw + _i * 8192), 16, 0, 0); } while (0)
#define PG8_LDA(dst, b, h) do { _Pragma("unroll") for (int m = 0; m < 4; ++m) _Pragma("unroll") for (int k = 0; k < 2; ++k) dst[m][k] = *(const PG8_LAS bf16x8*)(lds + PG8_SA(b, h) + aoff + m * 2048 + k * 1024); } while (0)
#define PG8_LDB(dst, b, h) do { _Pragma("unroll") for (int n = 0; n < 2; ++n) _Pragma("unroll") for (int k = 0; k < 2; ++k) dst[n][k] = *(const PG8_LAS bf16x8*)(lds + PG8_SB(b, h) + boff + n * 2048 + k * 1024); } while (0)
#define PG8_MMA(ai, bj, At, Bt) do { __builtin_amdgcn_s_setprio(1); _Pragma("unroll") for (int m = 0; m < 4; ++m) _Pragma("unroll") for (int n = 0; n < 2; ++n) _Pragma("unroll") for (int k = 0; k < 2; ++k) \
        acc[ai][bj][m][n] = __builtin_amdgcn_mfma_f32_16x16x32_bf16(Bt[n][k], At[m][k], acc[ai][bj][m][n], 0, 0, 0); __builtin_amdgcn_s_setprio(0); } while (0)
#define PG8_WAIT_V(n) asm volatile("s_waitcnt vmcnt(" #n ")" ::: "memory")
#define PG8_WAIT_L(n) asm volatile("s_waitcnt lgkmcnt(" #n ")" ::: "memory")
#define PG8_BAR __builtin_amdgcn_s_barrier()
#define PG8_SCHED __builtin_amdgcn_sched_barrier(0)
    Unit cur, nxt; int ui = 0;
    if (!S.next(0, cur)) return;
    f32x4 acc[2][2][4][2];
#pragma unroll
    for (int a = 0; a < 2; ++a)
#pragma unroll
        for (int b = 0; b < 2; ++b)
#pragma unroll
            for (int m = 0; m < 4; ++m)
#pragma unroll
                for (int n = 0; n < 2; ++n) acc[a][b][m][n] = (f32x4){0.f, 0.f, 0.f, 0.f};
    bf16x8 At[4][2], B0[2][2], B1[2][2];
    const char* cA = (const char*)g.A + (size_t)cur.pm * tstepA + (size_t)(cur.pn >> g.aps) * apn; const char* cB = (const char*)g.Bt + (size_t)cur.pn * tstepB;
    S.a_ready(cur);
    if constexpr (SP2) {
        PG8_STAGE(PG8_SB(0, 0), cB, voffB); PG8_STAGE(PG8_SB(0, 1), cB + hstepB, voffB); PG8_STAGE(PG8_SA(0, 0), cA, voffA); PG8_STAGE(PG8_SA(0, 1), cA + hstepA, voffA);
        if (wr == 1) PG8_BAR;
        PG8_WAIT_V(2); PG8_BAR;
        PG8_STAGE(PG8_SB(1, 0), cB + kstep, voffB); PG8_STAGE(PG8_SA(1, 0), cA + kstep, voffA); PG8_STAGE(PG8_SB(1, 1), cB + hstepB + kstep, voffB);
        PG8_WAIT_V(6); PG8_BAR;
    } else {
        PG8_STAGE(PG8_SB(0, 0), cB, voffB); PG8_STAGE(PG8_SA(0, 0), cA, voffA); PG8_STAGE(PG8_SB(0, 1), cB + hstepB, voffB); PG8_STAGE(PG8_SA(0, 1), cA + hstepA, voffA);
        if (wr == 1) PG8_BAR;
        PG8_WAIT_V(4); PG8_BAR;
        PG8_STAGE(PG8_SB(1, 0), cB + kstep, voffB); PG8_STAGE(PG8_SA(1, 0), cA + kstep, voffA); PG8_STAGE(PG8_SB(1, 1), cB + hstepB + kstep, voffB);
        PG8_WAIT_V(6); PG8_BAR;
    }
    for (;;) {
        const bool has_next = S.next(ui + 1, nxt);
        const char* nA = has_next ? (const char*)g.A + (size_t)nxt.pm * tstepA + (size_t)(nxt.pn >> g.aps) * apn : cA; const char* nB = has_next ? (const char*)g.Bt + (size_t)nxt.pn * tstepB : cB;
        for (int t = 0; t < nt; t += 2) {
            const bool last = (t == nt - 2);
            const char* a1 = cA + (size_t)(t + 1) * kstep;
            const char* a2 = last ? nA : cA + (size_t)(t + 2) * kstep; const char* b2 = last ? nB : cB + (size_t)(t + 2) * kstep;
            const char* a3 = a2 + kstep; const char* b3 = b2 + kstep;
            if (last && has_next) S.a_ready(nxt);
            if constexpr (SP2) {
            PG8_LDB(B0, 0, 0); PG8_LDB(B1, 0, 1); PG8_SCHED; PG8_LDA(At, 0, 0); PG8_STAGE(PG8_SA(1, 1), a1 + hstepA, voffA);
            PG8_WAIT_V(8); PG8_WAIT_L(0); PG8_BAR; PG8_MMA(0, 0, At, B0); PG8_MMA(0, 1, At, B1); PG8_BAR; PG8_SCHED;
            PG8_LDA(At, 0, 1); PG8_STAGE(PG8_SB(0, 0), b2, voffB); PG8_STAGE(PG8_SB(0, 1), b2 + hstepB, voffB); PG8_STAGE(PG8_SA(0, 0), a2, voffA);
            PG8_WAIT_V(8); PG8_WAIT_L(0); PG8_BAR; PG8_MMA(1, 0, At, B0); PG8_MMA(1, 1, At, B1); PG8_BAR; PG8_SCHED;
            PG8_LDB(B0, 1, 0); PG8_LDB(B1, 1, 1); PG8_SCHED; PG8_LDA(At, 1, 0); PG8_STAGE(PG8_SA(0, 1), a2 + hstepA, voffA);
            PG8_WAIT_V(8); PG8_WAIT_L(0); PG8_BAR; PG8_MMA(0, 0, At, B0); PG8_MMA(0, 1, At, B1); PG8_BAR; PG8_SCHED;
            PG8_LDA(At, 1, 1); PG8_STAGE(PG8_SB(1, 0), b3, voffB); PG8_STAGE(PG8_SB(1, 1), b3 + hstepB, voffB); PG8_STAGE(PG8_SA(1, 0), a3, voffA);
            PG8_WAIT_V(8); PG8_WAIT_L(0); PG8_BAR; PG8_MMA(1, 0, At, B0); PG8_MMA(1, 1, At, B1); PG8_BAR; PG8_SCHED;
            } else {
            PG8_LDB(B0, 0, 0); PG8_SCHED; PG8_LDA(At, 0, 0); PG8_STAGE(PG8_SA(1, 1), a1 + hstepA, voffA);
            PG8_WAIT_L(8); PG8_BAR; PG8_WAIT_L(0); PG8_MMA(0, 0, At, B0); PG8_BAR; PG8_SCHED;
            PG8_LDB(B1, 0, 1); PG8_STAGE(PG8_SB(0, 0), b2, voffB);
            PG8_BAR; PG8_WAIT_L(0); PG8_MMA(0, 1, At, B1); PG8_BAR;
            PG8_LDA(At, 0, 1); PG8_STAGE(PG8_SA(0, 0), a2, voffA);
            PG8_BAR; PG8_WAIT_L(0); PG8_MMA(1, 0, At, B0); PG8_BAR; PG8_SCHED;
            PG8_STAGE(PG8_SB(0, 1), b2 + hstepB, voffB);
            PG8_WAIT_V(6); PG8_BAR; PG8_MMA(1, 1, At, B1); PG8_BAR;
            PG8_LDB(B0, 1, 0); PG8_SCHED; PG8_LDA(At, 1, 0); PG8_STAGE(PG8_SA(0, 1), a2 + hstepA, voffA);
            PG8_WAIT_L(8); PG8_BAR; PG8_WAIT_L(0); PG8_MMA(0, 0, At, B0); PG8_BAR; PG8_SCHED;
            PG8_LDB(B1, 1, 1); PG8_STAGE(PG8_SB(1, 0), b3, voffB);
            PG8_BAR; PG8_WAIT_L(0); PG8_MMA(0, 1, At, B1); PG8_BAR;
            PG8_LDA(At, 1, 1); PG8_STAGE(PG8_SA(1, 0), a3, voffA);
            PG8_BAR; PG8_WAIT_L(0); PG8_MMA(1, 0, At, B0); PG8_BAR; PG8_SCHED;
            PG8_STAGE(PG8_SB(1, 1), b3 + hstepB, voffB);
            PG8_WAIT_V(6); PG8_BAR; PG8_MMA(1, 1, At, B1); PG8_BAR;
            }
        }
        if constexpr (ALIGN_EPI) { if (wr == 0) PG8_BAR; }
        if constexpr (!Epi::AFTER_DRAIN) { E(acc, cur, wr, wc, fr, fq); S.done(cur); }
        if (!has_next) break;
#pragma unroll
        for (int a = 0; a < 2; ++a)
#pragma unroll
            for (int b = 0; b < 2; ++b)
#pragma unroll
                for (int m = 0; m < 4; ++m)
#pragma unroll
                    for (int n = 0; n < 2; ++n) acc[a][b][m][n] = (f32x4){0.f, 0.f, 0.f, 0.f};
        cur = nxt; cA = nA; cB = nB; ++ui;
        if constexpr (ALIGN_EPI) { if (wr == 1) PG8_BAR; }
    }
    PG8_WAIT_V(0);
    if constexpr (!ALIGN_EPI) { if (wr == 0) PG8_BAR; }
    PG8_BAR;
    if constexpr (Epi::AFTER_DRAIN) { E.fused(acc, cur, wr, wc, fr, fq, lds, wid, lane); S.done(cur); }
#undef PG8_SA
#undef PG8_SB
#undef PG8_STAGE
#undef PG8_LDA
#undef PG8_LDB
#undef PG8_MMA
#undef PG8_WAIT_V
#undef PG8_WAIT_L
#undef PG8_BAR
#undef PG8_SCHED
}
}

using pg8::bf16_t; using pg8::bf16x8; using pg8::f32x4; using pg8::u32x4; using pg8::u32x2; using pg8::Unit; using pg8::cvt_pk_bf16;
typedef float f32x16 __attribute__((ext_vector_type(16)));
typedef float f32x2 __attribute__((ext_vector_type(2)));
#define LAS __attribute__((address_space(3)))

constexpr int T = 32768, DM = 1024, TC = 16384, DFF = 2816, ZLD = 3840;
constexpr int ZC_XA = 0, ZC_GA = 1024, ZC_U = 2048, ZC_CKV = 3072, ZC_CQ = 3328, ZC_KR = 3712;
constexpr float EPS = 1e-6f, LOG2E = 1.4426950408889634f;
constexpr float QSCALE = 0.10206207261596577f * 1.4426950408889634f;
constexpr size_t MiB = (size_t)1 << 20;
constexpr size_t WS_W = 0, WS_XB = 64 * MiB, WS_SSQ = 128 * MiB, WS_SMALL = 130 * MiB, WS_BIG = 132 * MiB;
constexpr size_t SM_ROPE = 0, SM_RSQ = 256 * 1024, SM_RSKV = 320 * 1024, SM_MEANV = 384 * 1024, SM_RSTDV = 448 * 1024, SM_SP8 = 512 * 1024;
constexpr size_t B_H = 0, B_PB = 176 * MiB, B_GP = 192 * MiB;
constexpr size_t B_Z = 0, B_VTS = 120 * MiB, B_XC = 152 * MiB, B_LA = 184 * MiB, B_U = 216 * MiB, B_Q = 248 * MiB, B_KN = 296 * MiB, B_VT = 328 * MiB, B_KR = 360 * MiB;
constexpr size_t B_G3 = 248 * MiB, B_MERGED = 184 * MiB;
constexpr size_t WS_NEED = WS_BIG + 361 * MiB;
constexpr size_t O_WGU1 = 0, O_WD1 = O_WGU1 + 5632 * 1024, O_WIN = O_WD1 + 1024 * 2816, O_WINV = O_WIN + 3840 * 1024, O_WING = O_WINV + 1024 * 1024,
                 O_WLRU = O_WING + 3072 * 1024, O_WRA = O_WLRU + 2048 * 128, O_WRB = O_WRA + 1024 * 1024, O_WRC = O_WRB + 1024 * 1024, O_WOUT = O_WRC + 1024 * 1024,
                 O_WPG = O_WOUT + 1024 * 1024, O_WUQ = O_WPG + 1024 * 1024, O_WKVK = O_WUQ + 1536 * 384, O_WKVV = O_WKVK + 1024 * 256, O_WGU2 = O_WKVV + 1024 * 256,
                 O_WD2 = O_WGU2 + 5632 * 1024, O_WPLE = O_WD2 + 1024 * 2816, O_WSGU = O_WPLE + 1024 * 256, O_WEND = O_WSGU + 8 * 128 * 128;
static_assert(O_WEND * 2 <= 64 * MiB, "weights fit");
constexpr int LDS_BYTES = 131072 + 256;
#ifndef DBG_STOP
#define DBG_STOP 0
#endif
#ifndef DBG_BR
#define DBG_BR 7
#endif

struct Params { const float* in[34]; float* out; unsigned char* ws; };

__device__ __forceinline__ float fexp2(float x) { return __builtin_amdgcn_exp2f(x); }
__device__ __forceinline__ float frcp(float x) { return __builtin_amdgcn_rcpf(x); }
__device__ __forceinline__ float sigm(float x) { return frcp(1.f + fexp2(-LOG2E * x)); }
__device__ __forceinline__ float gelu_t(float x) { const float t = x + 0.044715f * x * x * x; return x * frcp(1.f + fexp2(-2.3022081985f * t)); }
__device__ __forceinline__ float bflo(unsigned w) { return __uint_as_float(w << 16); }
__device__ __forceinline__ float bfhi(unsigned w) { return __uint_as_float(w & 0xffff0000u); }
__device__ __forceinline__ bf16_t f2bf(float v) { return (bf16_t)(cvt_pk_bf16(v, 0.f) & 0xffffu); }
__device__ __forceinline__ float wave_sum(float v) {
#pragma unroll
    for (int o = 1; o < 64; o <<= 1) v += __shfl_xor(v, o);
    return v;
}
constexpr size_t SSQ_PLANE = (size_t)T * 4;
__device__ __forceinline__ float rstd16(const float* ssq, size_t row) {
    const float* q = ssq + row * 4; const f32x4 a = *(const f32x4*)q, b = *(const f32x4*)(q + SSQ_PLANE), c = *(const f32x4*)(q + 2 * SSQ_PLANE), d = *(const f32x4*)(q + 3 * SSQ_PLANE);
    const float s = ((a.x + a.y) + (a.z + a.w)) + ((b.x + b.y) + (b.z + b.w)) + ((c.x + c.y) + (c.z + c.w)) + ((d.x + d.y) + (d.z + d.w));
    return __builtin_amdgcn_rsqf(s * (1.0f / 1024.0f) + EPS);
}
__device__ __forceinline__ u32x4 pack8(const f32x4 v0, const f32x4 v1) { u32x4 w; w.x = cvt_pk_bf16(v0[0], v0[1]); w.y = cvt_pk_bf16(v0[2], v0[3]); w.z = cvt_pk_bf16(v1[0], v1[1]); w.w = cvt_pk_bf16(v1[2], v1[3]); return w; }
__device__ __forceinline__ void unpack8(const u32x4 w, f32x4& v0, f32x4& v1) { v0 = (f32x4){bflo(w.x), bfhi(w.x), bflo(w.y), bfhi(w.y)}; v1 = (f32x4){bflo(w.z), bfhi(w.z), bflo(w.w), bfhi(w.w)}; }

template <int ACT, int RS> struct EpiRow {
    static constexpr bool PERM = true, AFTER_DRAIN = false;
    bf16_t* O; int ldc; const float* rs; const float* bias; int t0, t1; int bswap;
    __device__ __forceinline__ void operator()(const f32x4 (&acc)[2][2][4][2], const Unit& u, int wr, int wc, int fr, int fq) const {
        const int row0 = u.pm * 256 + wr * 64 + fr, col0 = u.pn * 256 + wc * 32 + 8 * fq;
        const bool act = (ACT == 1) ? (u.pn >= t0 && u.pn < t1) : true;
        f32x4 bv[2][2];
#pragma unroll
        for (int bj = 0; bj < 2; ++bj)
#pragma unroll
            for (int n = 0; n < 2; ++n) bv[bj][n] = bias ? *(const f32x4*)(bias + col0 + (bswap ? (u.pn < 4 ? 1024 : (u.pn < 8 ? -1024 : 0)) : 0) + bj * 128 + 4 * n) : (f32x4){0.f, 0.f, 0.f, 0.f};
#pragma unroll
        for (int ai = 0; ai < 2; ++ai)
#pragma unroll
            for (int m = 0; m < 4; ++m) {
                const size_t row = (size_t)(row0 + ai * 128 + m * 16); const float s = (RS == 0) ? rstd16(rs, row) : rs[row];
                bf16_t* rowp = O + row * ldc + col0;
#pragma unroll
                for (int bj = 0; bj < 2; ++bj) {
                    f32x4 v0 = acc[ai][bj][m][0] * s + bv[bj][0], v1 = acc[ai][bj][m][1] * s + bv[bj][1];
                    if (ACT == 1) { if (act) {
#pragma unroll
                        for (int e = 0; e < 4; ++e) { v0[e] = gelu_t(v0[e]); v1[e] = gelu_t(v1[e]); } } }
                    if (ACT == 2) {
#pragma unroll
                        for (int e = 0; e < 4; ++e) { v0[e] = sigm(v0[e]); v1[e] = sigm(v1[e]); } }
                    *(u32x4*)(rowp + bj * 128) = pack8(v0, v1);
                }
                asm volatile("" ::: "memory");
            }
    }
};
struct EpiSwiglu {
    static constexpr bool PERM = true, AFTER_DRAIN = false;
    bf16_t* H; const float* ssq;
    __device__ __forceinline__ void operator()(const f32x4 (&acc)[2][2][4][2], const Unit& u, int wr, int wc, int fr, int fq) const {
        const int row0 = u.pm * 256 + wr * 64 + fr, col0 = u.pn * 128 + wc * 32 + 8 * fq;
#pragma unroll
        for (int ai = 0; ai < 2; ++ai)
#pragma unroll
            for (int m = 0; m < 4; ++m) {
                const size_t row = (size_t)(row0 + ai * 128 + m * 16); const float s = rstd16(ssq, row);
                f32x4 h0, h1;
#pragma unroll
                for (int e = 0; e < 4; ++e) { const float g0 = acc[ai][0][m][0][e] * s, g1 = acc[ai][0][m][1][e] * s; h0[e] = g0 * sigm(g0) * (acc[ai][1][m][0][e] * s); h1[e] = g1 * sigm(g1) * (acc[ai][1][m][1][e] * s); }
                *(u32x4*)(H + row * DFF + col0) = pack8(h0, h1);
                asm volatile("" ::: "memory");
            }
    }
};
template <bool GATED> struct EpiResid {
    static constexpr bool PERM = false, AFTER_DRAIN = false;
    const float* Xs; float* Xd; bf16_t* XB; float* ssq; const bf16_t* GP; float alpha;
    __device__ __forceinline__ void operator()(const f32x4 (&acc)[2][2][4][2], const Unit& u, int wr, int wc, int fr, int fq) const {
        const int col0 = u.pn * 256 + wc * 32 + 4 * fq;
#pragma unroll
        for (int ai = 0; ai < 2; ++ai)
#pragma unroll
            for (int m = 0; m < 4; ++m) {
                const size_t row = (size_t)(u.pm * 256 + ai * 128 + wr * 64 + m * 16 + fr); const size_t off = row * DM + col0; float ss = 0.f;
#pragma unroll
                for (int bj = 0; bj < 2; ++bj)
#pragma unroll
                    for (int n = 0; n < 2; ++n) {
                        const size_t o = off + bj * 128 + n * 16; f32x4 a = acc[ai][bj][m][n] * alpha;
                        if (GATED) { const u32x2 g = *(const u32x2*)(GP + o); a[0] *= bflo(g.x); a[1] *= bfhi(g.x); a[2] *= bflo(g.y); a[3] *= bfhi(g.y); }
                        const f32x4 xv = *(const f32x4*)(Xs + o) + a;
                        *(f32x4*)(Xd + o) = xv; u32x2 w; w.x = cvt_pk_bf16(xv[0], xv[1]); w.y = cvt_pk_bf16(xv[2], xv[3]); *(u32x2*)(XB + o) = w;
                        ss += (xv[0] * xv[0] + xv[1] * xv[1]) + (xv[2] * xv[2] + xv[3] * xv[3]);
                    }
                ss += __shfl_xor(ss, 16); ss += __shfl_xor(ss, 32);
                if (fq == 0) ssq[(size_t)u.pn * SSQ_PLANE + row * 4 + wc] = ss;
                asm volatile("" ::: "memory");
            }
    }
};
template <int ACT, int RS> struct EpiCol {
    static constexpr bool PERM = true, AFTER_DRAIN = false;
    bf16_t* O; int ldc; const float* rs;
    __device__ __forceinline__ void operator()(const f32x4 (&acc)[2][2][4][2], const Unit& u, int wr, int wc, int fr, int fq) const {
        const int row0 = u.pm * 256 + wr * 64 + fr, col0 = u.pn * 256 + wc * 32 + 8 * fq;
#pragma unroll
        for (int bj = 0; bj < 2; ++bj) {
            const int col = col0 + bj * 128; f32x4 c0, c1;
            if (RS == 0) {
#pragma unroll
                for (int e = 0; e < 4; ++e) { c0[e] = rstd16(rs, (size_t)(col + e)); asm volatile("" ::: "memory"); c1[e] = rstd16(rs, (size_t)(col + 4 + e)); asm volatile("" ::: "memory"); }
            } else { c0 = *(const f32x4*)(rs + col); c1 = *(const f32x4*)(rs + col + 4); }
#pragma unroll
            for (int ai = 0; ai < 2; ++ai)
#pragma unroll
                for (int m = 0; m < 4; ++m) {
                    f32x4 v0 = acc[ai][bj][m][0] * c0, v1 = acc[ai][bj][m][1] * c1;
                    if (ACT == 1) {
#pragma unroll
                        for (int e = 0; e < 4; ++e) { v0[e] = gelu_t(v0[e]); v1[e] = gelu_t(v1[e]); } }
                    *(u32x4*)(O + (size_t)(row0 + ai * 128 + m * 16) * ldc + col) = pack8(v0, v1);
                    asm volatile("" ::: "memory");
                }
        }
    }
};
struct EpiLru {
    static constexpr bool PERM = true, AFTER_DRAIN = false;
    const bf16_t* XC; bf16_t* LA; bf16_t* U; const float* ba; const float* bx; const float* sp8;
    __device__ __forceinline__ void operator()(const f32x4 (&acc)[2][2][4][2], const Unit& u, int wr, int wc, int fr, int fq) const {
        const int row0 = u.pm * 256 + wr * 64 + fr, ch0 = (u.pn * 256 + wc * 32 + 8 * fq) >> 1;
#pragma unroll
        for (int bj = 0; bj < 2; ++bj) {
            const int ch = ch0 + bj * 64; const f32x4 vba = *(const f32x4*)(ba + ch), vbx = *(const f32x4*)(bx + ch), vsp = *(const f32x4*)(sp8 + ch);
#pragma unroll
            for (int ai = 0; ai < 2; ++ai)
#pragma unroll
                for (int m = 0; m < 4; ++m) {
                    const int row = row0 + ai * 128 + m * 16; const size_t o = (size_t)row * DM + ch; const bool first = (row & 2047) == 0;
                    const u32x2 xw = *(const u32x2*)(XC + o); const float xc[4] = {bflo(xw.x), bfhi(xw.x), bflo(xw.y), bfhi(xw.y)};
                    const f32x4 v0 = acc[ai][bj][m][0], v1 = acc[ai][bj][m][1]; const float ga[4] = {v0[0], v0[2], v1[0], v1[2]}, gx[4] = {v0[1], v0[3], v1[1], v1[3]};
                    float la[4], uu[4];
#pragma unroll
                    for (int e = 0; e < 4; ++e) { const float r = sigm(ga[e] + vba[e]), ig = sigm(gx[e] + vbx[e]); la[e] = -vsp[e] * r;
                        const float a2 = fexp2(2.f * LOG2E * la[e]); const float mult = first ? 1.f : sqrtf(fmaxf(1.f - a2, 0.f)); uu[e] = mult * ig * xc[e]; }
                    u32x2 wl, wu; wl.x = cvt_pk_bf16(la[0], la[1]); wl.y = cvt_pk_bf16(la[2], la[3]); wu.x = cvt_pk_bf16(uu[0], uu[1]); wu.y = cvt_pk_bf16(uu[2], uu[3]);
                    *(u32x2*)(LA + o) = wl; *(u32x2*)(U + o) = wu;
                    asm volatile("" ::: "memory");
                }
        }
    }
};
struct EpiQ {
    static constexpr bool PERM = true, AFTER_DRAIN = false;
    bf16_t* Q; const float* rsq; const float* rope;
    __device__ __forceinline__ void operator()(const f32x4 (&acc)[2][2][4][2], const Unit& u, int wr, int wc, int fr, int fq) const {
        const int row0 = u.pm * 256 + wr * 64 + fr, col0 = u.pn * 256 + wc * 32 + 8 * fq;
#pragma unroll
        for (int ai = 0; ai < 2; ++ai)
#pragma unroll
            for (int m = 0; m < 4; ++m) {
                const int row = row0 + ai * 128 + m * 16; const float s = rsq[row] * QSCALE; const int pos = row & 2047;
#pragma unroll
                for (int bj = 0; bj < 2; ++bj) {
                    const int col = col0 + bj * 128, d = col % 96; f32x4 v0 = acc[ai][bj][m][0] * s, v1 = acc[ai][bj][m][1] * s;
                    if (d >= 64) { const int i0 = (d - 64) >> 1; const f32x4 t0 = *(const f32x4*)(rope + (pos * 16 + i0) * 2), t1 = *(const f32x4*)(rope + (pos * 16 + i0 + 2) * 2);
                        const f32x4 a = v0, b = v1;
                        v0[0] = a[0] * t0[0] - a[1] * t0[1]; v0[1] = a[0] * t0[1] + a[1] * t0[0]; v0[2] = a[2] * t0[2] - a[3] * t0[3]; v0[3] = a[2] * t0[3] + a[3] * t0[2];
                        v1[0] = b[0] * t1[0] - b[1] * t1[1]; v1[1] = b[0] * t1[1] + b[1] * t1[0]; v1[2] = b[2] * t1[2] - b[3] * t1[3]; v1[3] = b[2] * t1[3] + b[3] * t1[2]; }
                    *(u32x4*)(Q + (size_t)row * 1536 + col) = pack8(v0, v1);
                }
                asm volatile("" ::: "memory");
            }
    }
};
struct EpiMerge {
    static constexpr bool PERM = true, AFTER_DRAIN = false;
    const bf16_t* G3; bf16_t* MG;
    __device__ __forceinline__ void operator()(const f32x4 (&acc)[2][2][4][2], const Unit& u, int wr, int wc, int fr, int fq) const {
        const int row0 = u.pm * 256 + wr * 64 + fr, col0 = u.pn * 256 + wc * 32 + 8 * fq, mcol0 = (u.pn & 3) * 256 + wc * 32 + 8 * fq; const bool first = u.pn < 4;
#pragma unroll
        for (int ai = 0; ai < 2; ++ai)
#pragma unroll
            for (int m = 0; m < 4; ++m) {
                const size_t row = (size_t)(row0 + ai * 128 + m * 16);
#pragma unroll
                for (int bj = 0; bj < 2; ++bj) {
                    f32x4 g0, g1; unpack8(*(const u32x4*)(G3 + row * 3072 + col0 + bj * 128), g0, g1);
                    f32x4 v0 = acc[ai][bj][m][0] * g0, v1 = acc[ai][bj][m][1] * g1;
                    if (!first) { f32x4 p0, p1; unpack8(*(const u32x4*)(MG + row * DM + mcol0 + bj * 128), p0, p1); v0 += p0; v1 += p1; }
                    *(u32x4*)(MG + row * DM + mcol0 + bj * 128) = pack8(v0, v1);
                }
                asm volatile("" ::: "memory");
            }
    }
};
enum { MAP_ID = 0, MAP_SWIGLU, MAP_WIN, MAP_UQ, MAP_KVK, MAP_KVV, MAP_GATES };
struct Job { const float* W; const float* gain; bf16_t* dst; int ldw, K, dN, map, off; };
__device__ __forceinline__ int srcmap(int map, int off, int n) {
    switch (map) {
    case MAP_SWIGLU: return (n >> 8) * 128 + (n & 127) + ((n & 128) ? DFF : 0);
    case MAP_WIN: if (n < 2048) return n; if (n < 3072) return 2720 + (n - 2048); if (n < 3328) return 2432 + (n - 3072); if (n < 3712) return 2048 + (n - 3328);
                  if (n < 3744) { const int j = n - 3712, i = j >> 1; return 2688 + ((j & 1) ? 16 + i : i); } return -1;
    case MAP_UQ: { const int h = n / 96, d = n % 96; if (d < 64) return n; const int j = d - 64, i = j >> 1; return h * 96 + 64 + ((j & 1) ? 16 + i : i); }
    case MAP_KVK: return (n >> 6) * 128 + (n & 63);
    case MAP_KVV: return (n >> 6) * 128 + 64 + (n & 63);
    case MAP_GATES: return 4768 + (n < 1024 ? n + 1024 : (n < 2048 ? n - 1024 : n));
    default: return n + off;
    }
}
#define JOB(Wp, GAIN, DST, LDW, KK, DN, MAP, OFF) do { J.W = (Wp); J.gain = (GAIN); J.dst = wb + (DST); J.ldw = (LDW); J.K = (KK); J.dN = (DN); J.map = (MAP); J.off = (OFF); } while (0)
__device__ __forceinline__ void get_job(const Params& p, int L, int j, bf16_t* wb, Job& J) {
    const size_t M1 = 1024 * 1024;
    switch (j) {
    case 0: JOB(p.in[3] + (size_t)L * 1024 * 5632, p.in[2] + L * 1024, O_WGU1, 5632, 1024, 5632, MAP_SWIGLU, 0); break;
    case 1: JOB(p.in[4] + (size_t)L * 2816 * 1024, nullptr, O_WD1, 1024, 2816, 1024, MAP_ID, 0); break;
    case 2: JOB(p.in[6] + (size_t)L * 1024 * 7840, p.in[5] + L * 1024, O_WIN, 7840, 1024, 3840, MAP_WIN, 0); break;
    case 3: JOB(p.in[6] + (size_t)L * 1024 * 7840, p.in[5] + L * 1024, O_WINV, 7840, 1024, 1024, MAP_ID, 3744); break;
    case 4: JOB(p.in[6] + (size_t)L * 1024 * 7840, p.in[5] + L * 1024, O_WING, 7840, 1024, 3072, MAP_GATES, 0); break;
    case 5: JOB(p.in[14] + L * M1, nullptr, O_WRB, 1024, 1024, 1024, MAP_ID, 0); break;
    case 6: JOB(p.in[19] + L * M1, nullptr, O_WRA, 1024, 1024, 1024, MAP_ID, 0); break;
    case 7: JOB(p.in[24] + L * M1, nullptr, O_WRC, 1024, 1024, 1024, MAP_ID, 0); break;
    case 8: JOB(p.in[26] + L * M1, nullptr, O_WOUT, 1024, 1024, 1024, MAP_ID, 0); break;
    case 9: JOB(p.in[31] + L * M1, p.in[30] + L * 1024, O_WPG, 1024, 1024, 1024, MAP_ID, 0); break;
    case 10: JOB(p.in[16] + (size_t)L * 384 * 1536, p.in[15] + L * 384, O_WUQ, 1536, 384, 1536, MAP_UQ, 0); break;
    case 11: JOB(p.in[18] + (size_t)L * 256 * 2048, p.in[17] + L * 256, O_WKVK, 2048, 256, 1024, MAP_KVK, 0); break;
    case 12: JOB(p.in[18] + (size_t)L * 256 * 2048, p.in[17] + L * 256, O_WKVV, 2048, 256, 1024, MAP_KVV, 0); break;
    case 13: JOB(p.in[28] + (size_t)L * 1024 * 5632, p.in[27] + L * 1024, O_WGU2, 5632, 1024, 5632, MAP_SWIGLU, 0); break;
    case 14: JOB(p.in[29] + (size_t)L * 2816 * 1024, nullptr, O_WD2, 1024, 2816, 1024, MAP_ID, 0); break;
    default: JOB(p.in[32] + (size_t)L * 256 * 1024, nullptr, O_WPLE, 1024, 256, 1024, MAP_ID, 0); break;
    }
}
constexpr int NJOBS = 16;
__device__ __forceinline__ void tr_item(const Job& J, int item, LAS float* scr, int lane) {
    const int nblk = J.dN >> 5, kb = item / nblk, nb = item % nblk, k0 = 64 * kb, n0 = 32 * nb;
    const int sc = srcmap(J.map, J.off, n0 + (lane & 31));
#pragma unroll 8
    for (int i = 0; i < 32; ++i) { const int kk = 2 * i + (lane >> 5); float v = (sc >= 0) ? J.W[(size_t)(k0 + kk) * J.ldw + sc] : 0.f; if (J.gain) v *= J.gain[k0 + kk]; scr[kk * 33 + (lane & 31)] = v; }
    asm volatile("s_waitcnt lgkmcnt(0)" ::: "memory");
    const int c = lane & 7;
#pragma unroll
    for (int j = 0; j < 4; ++j) { const int n = (lane >> 3) + 8 * j; const LAS float* s = scr + (8 * c) * 33 + n;
        u32x4 o; o.x = cvt_pk_bf16(s[0 * 33], s[1 * 33]); o.y = cvt_pk_bf16(s[2 * 33], s[3 * 33]); o.z = cvt_pk_bf16(s[4 * 33], s[5 * 33]); o.w = cvt_pk_bf16(s[6 * 33], s[7 * 33]);
        *(u32x4*)(J.dst + (size_t)(n0 + n) * J.K + k0 + 8 * c) = o; }
    asm volatile("s_waitcnt lgkmcnt(0)" ::: "memory");
}
__device__ __forceinline__ void phase0(const Params& p, int L, LAS unsigned char* lds, int G, int blk) {
    const int tid = pg8::tid_opaque(), lane = tid & 63, wave = tid >> 6;
    const int gw = blk * 8 + wave, NGW = G * 8, gt = blk * 512 + tid, NGT = G * 512;
    bf16_t* wb = (bf16_t*)(p.ws + WS_W);
    LAS float* scr = (LAS float*)(lds + wave * 8448);
    int total = 0;
    for (int j = 0; j < NJOBS; ++j) { Job J; get_job(p, L, j, wb, J); total += (J.K >> 6) * (J.dN >> 5); }
    for (int it = gw; it < total; it += NGW) {
        int r = it;
        for (int j = 0; j < NJOBS; ++j) { Job J; get_job(p, L, j, wb, J); const int n = (J.K >> 6) * (J.dN >> 5); if (r < n) { tr_item(J, r, scr, lane); break; } r -= n; }
    }
    { bf16_t* d = wb + O_WLRU; const float* wa = p.in[9] + (size_t)L * 65536; const float* wx = p.in[11] + (size_t)L * 65536;
      for (int i = gt; i < 2048 * 128; i += NGT) { const int n = i >> 7, k = i & 127, ch = n >> 1, nb = ch >> 6, dd = ch & 63;
          float v = 0.f; if ((k >> 6) == (nb & 1)) v = ((n & 1) ? wx : wa)[(size_t)nb * 4096 + (k & 63) * 64 + dd]; d[i] = f2bf(v); } }
    { bf16_t* d = wb + O_WSGU; const float* w = p.in[22] + (size_t)L * 131072;
      for (int i = gt; i < 131072; i += NGT) { const int t = (i >> 7) & 127, s = i & 127; d[i] = f2bf(((s >> 6) <= (t >> 6)) ? w[i] : 0.f); } }
    { float* sp = (float*)(p.ws + WS_SMALL + SM_SP8); const float* lam = p.in[13] + L * 1024;
      for (int i = gt; i < 1024; i += NGT) sp[i] = 8.f * 0.6931471805599453f * __builtin_amdgcn_logf(1.f + fexp2(-LOG2E * lam[i])); }
    if (L == 0) {
        float* rope = (float*)(p.ws + WS_SMALL + SM_ROPE);
        for (int i = gt; i < 2048 * 16; i += NGT) { const int pos = i >> 4, k = i & 15; const float inv = fexp2(-(float)k * (13.287712379549449f / 16.f)); const float ang = (float)pos * inv;
            double rev = (double)ang * 0.15915494309189535; rev -= floor(rev); const float fr = (float)rev; rope[2 * i] = __builtin_amdgcn_cosf(fr); rope[2 * i + 1] = __builtin_amdgcn_sinf(fr); }
        const float* x = p.in[0]; bf16_t* XB = (bf16_t*)(p.ws + WS_XB); float* ssq = (float*)(p.ws + WS_SSQ);
        for (int m = gw; m < T; m += NGW) {
            const f32x4* xr = (const f32x4*)(x + (size_t)m * DM) + lane; u32x2* o8 = (u32x2*)(XB + (size_t)m * DM) + lane; float s = 0.f;
#pragma unroll
            for (int j = 0; j < 4; ++j) { const f32x4 v = xr[64 * j]; s += (v[0] * v[0] + v[1] * v[1]) + (v[2] * v[2] + v[3] * v[3]); u32x2 w; w.x = cvt_pk_bf16(v[0], v[1]); w.y = cvt_pk_bf16(v[2], v[3]); o8[64 * j] = w; }
            s = wave_sum(s);
            if (lane < 16) ssq[(size_t)(lane >> 2) * SSQ_PLANE + (size_t)m * 4 + (lane & 3)] = (lane == 0) ? s : 0.f;
        }
    }
}

__device__ __forceinline__ void pb_convert(const Params& p, int L, int G, int blk) {
    const int tid = pg8::tid_opaque(), gt = blk * 512 + tid, NGT = G * 512;
    const f32x4* src = (const f32x4*)(p.in[1] + (size_t)L * T * 256); u32x2* d = (u32x2*)(p.ws + WS_BIG + B_PB);
    for (int i = gt; i < T * 256 / 4; i += NGT) { const f32x4 v = src[i]; u32x2 w; w.x = cvt_pk_bf16(v[0], v[1]); w.y = cvt_pk_bf16(v[2], v[3]); d[i] = w; }
}
__device__ __forceinline__ void e1_rows(const Params& p, int L, const bf16_t* Z, bf16_t* XC, float* RSQ, float* RSKV, bf16_t* KR, const float* rope, int G, int blk) {
    const int tid = pg8::tid_opaque(), lane = tid & 63, wave = tid >> 6, gw = blk * 8 + wave, NGW = G * 8;
    const float* cw = p.in[7] + (size_t)L * 4096; const float* cb = p.in[8] + L * 1024;
    for (int rb = blk * 64 + wave * 8; rb < TC; rb += G * 64)
    for (int r = rb; r < rb + 8; ++r) {
        const bf16_t* zr = Z + (size_t)r * ZLD; const int pos = r & 2047;
#pragma unroll
        for (int hf = 0; hf < 2; ++hf) {
            const int c0 = hf * 512 + 8 * lane; f32x4 a0 = *(const f32x4*)(cb + c0), a1 = *(const f32x4*)(cb + c0 + 4);
#pragma unroll
            for (int k = 0; k < 4; ++k) { if (pos - 3 + k >= 0) { f32x4 x0, x1; unpack8(*(const u32x4*)(zr + (ptrdiff_t)(k - 3) * ZLD + ZC_XA + c0), x0, x1);
                a0 += *(const f32x4*)(cw + k * 1024 + c0) * x0; a1 += *(const f32x4*)(cw + k * 1024 + c0 + 4) * x1; } }
            *(u32x4*)(XC + (size_t)r * DM + c0) = pack8(a0, a1);
        }
        float sq = 0.f;
        if (lane < 48) { f32x4 x0, x1; unpack8(*(const u32x4*)(zr + ZC_CQ + 8 * lane), x0, x1); sq = (x0[0] * x0[0] + x0[1] * x0[1]) + (x0[2] * x0[2] + x0[3] * x0[3]) + (x1[0] * x1[0] + x1[1] * x1[1]) + (x1[2] * x1[2] + x1[3] * x1[3]); }
        sq = wave_sum(sq);
        float sk; { const u32x2 w = *(const u32x2*)(zr + ZC_CKV + 4 * lane); const float a = bflo(w.x), b = bfhi(w.x), c = bflo(w.y), d = bfhi(w.y); sk = (a * a + b * b) + (c * c + d * d); }
        sk = wave_sum(sk);
        if (lane == 0) { RSQ[r] = __builtin_amdgcn_rsqf(sq * (1.f / 384.f) + EPS); RSKV[r] = __builtin_amdgcn_rsqf(sk * (1.f / 256.f) + EPS); }
        if (lane < 16) { const unsigned w = *(const unsigned*)(zr + ZC_KR + 2 * lane); const float x1 = bflo(w), x2 = bfhi(w); const f32x2 cs = *(const f32x2*)(rope + (pos * 16 + lane) * 2);
            *(unsigned*)(KR + (size_t)r * 32 + 2 * lane) = cvt_pk_bf16(x1 * cs[0] - x2 * cs[1], x1 * cs[1] + x2 * cs[0]); }
    }
}
__device__ __forceinline__ void e2_stats(LAS unsigned char* lds, const bf16_t* VTS, float* MEANV, float* RSTDV, int G, int blk) {
    const int tid = pg8::tid_opaque(), lane = tid & 63, wave = tid >> 6, tg = lane & 7, cr = lane >> 3;
    LAS float* part = (LAS float*)lds;
    for (int unit = blk; unit < TC / 64; unit += G) {
        const int tok0 = unit * 64; float s[8], q[8];
#pragma unroll
        for (int e = 0; e < 8; ++e) { s[e] = 0.f; q[e] = 0.f; }
#pragma unroll 4
        for (int it = 0; it < 16; ++it) { const int c = wave * 128 + it * 8 + cr; f32x4 x0, x1; unpack8(*(const u32x4*)(VTS + (size_t)c * TC + tok0 + 8 * tg), x0, x1);
#pragma unroll
            for (int e = 0; e < 4; ++e) { s[e] += x0[e]; q[e] += x0[e] * x0[e]; s[4 + e] += x1[e]; q[4 + e] += x1[e] * x1[e]; } }
#pragma unroll
        for (int e = 0; e < 8; ++e) { s[e] += __shfl_xor(s[e], 8); s[e] += __shfl_xor(s[e], 16); s[e] += __shfl_xor(s[e], 32); q[e] += __shfl_xor(q[e], 8); q[e] += __shfl_xor(q[e], 16); q[e] += __shfl_xor(q[e], 32); }
        if (cr == 0) {
#pragma unroll
            for (int e = 0; e < 8; ++e) { part[(wave * 64 + 8 * tg + e) * 2] = s[e]; part[(wave * 64 + 8 * tg + e) * 2 + 1] = q[e]; } }
        __syncthreads();
        if (tid < 64) { float ss = 0.f, qq = 0.f;
#pragma unroll
            for (int w = 0; w < 8; ++w) { ss += part[(w * 64 + tid) * 2]; qq += part[(w * 64 + tid) * 2 + 1]; }
            const float mean = ss * (1.f / 1024.f); const float var = fmaxf(qq * (1.f / 1024.f) - mean * mean, 0.f);
            MEANV[tok0 + tid] = mean; RSTDV[tok0 + tid] = __builtin_amdgcn_rsqf(var + EPS); }
        __syncthreads();
    }
}
__device__ __forceinline__ void scan_units(LAS unsigned char* lds, const bf16_t* LA, const bf16_t* U, bf16_t* Z, int G, int blk) {
    const int tid = pg8::tid_opaque(), cp = tid & 15, seg = tid >> 4;
    LAS f32x4* sc = (LAS f32x4*)lds;
    for (int idx = blk; idx < 256; idx += G) {
        const int b = idx >> 5, ch = (idx & 31) * 32 + 2 * cp; const size_t row0 = (size_t)b * 2048 + seg * 64;
        const unsigned* lap = (const unsigned*)(LA + row0 * DM + ch); const unsigned* up = (const unsigned*)(U + row0 * DM + ch);
        float h0 = 0.f, h1 = 0.f, s0 = 0.f, s1 = 0.f;
#pragma unroll 16
        for (int t = 0; t < 64; ++t) { const unsigned lw = lap[(size_t)t * 512], uw = up[(size_t)t * 512]; const float l0 = bflo(lw), l1 = bfhi(lw);
            h0 = fexp2(LOG2E * l0) * h0 + bflo(uw); h1 = fexp2(LOG2E * l1) * h1 + bfhi(uw); s0 += l0; s1 += l1; }
        sc[seg * 16 + cp] = (f32x4){s0, s1, h0, h1};
        __syncthreads();
        float c0 = 0.f, c1 = 0.f;
        for (int j = 0; j < seg; ++j) { const f32x4 v = sc[j * 16 + cp]; c0 = fexp2(LOG2E * v[0]) * c0 + v[2]; c1 = fexp2(LOG2E * v[1]) * c1 + v[3]; }
        h0 = c0; h1 = c1;
        unsigned* gp = (unsigned*)(Z + row0 * ZLD + ZC_GA + ch);
#pragma unroll 16
        for (int t = 0; t < 64; ++t) { const unsigned lw = lap[(size_t)t * 512], uw = up[(size_t)t * 512], gw = gp[(size_t)t * (ZLD / 2)];
            h0 = fexp2(LOG2E * bflo(lw)) * h0 + bflo(uw); h1 = fexp2(LOG2E * bfhi(lw)) * h1 + bfhi(uw); gp[(size_t)t * (ZLD / 2)] = cvt_pk_bf16(h0 * bflo(gw), h1 * bfhi(gw)); }
        __syncthreads();
    }
}
__device__ __forceinline__ void attn_units(LAS unsigned char* lds, const bf16_t* Q, const bf16_t* KN, const bf16_t* KR, const bf16_t* VT, bf16_t* Z, int G, int blk) {
    const int tid = pg8::tid_opaque(), lane = tid & 63, wid = __builtin_amdgcn_readfirstlane(tid >> 6), i32 = lane & 31, hi = lane >> 5;
    constexpr int KP = 208, VP = 144, KBUF = 64 * KP, VBUF = 64 * VP;
    for (int idx = blk; idx < 1024; idx += G) {
        const int j = idx & 255, rnd = idx >> 8, bh = j >> 1;
        const int qb = (j & 1) ? (rnd == 0 ? 1 : rnd == 1 ? 6 : rnd == 2 ? 3 : 4) : (rnd == 0 ? 0 : rnd == 1 ? 7 : rnd == 2 ? 2 : 5);
        const int b = bh >> 4, h = bh & 15, q0 = qb * 256, NT = q0 / 64 + 4, ntw = (q0 + 32 * wid) / 64 + 1;
        const size_t rowb = (size_t)b * 2048;
        bf16x8 qr[6];
        { const bf16_t* qp = Q + (rowb + q0 + 32 * wid + i32) * 1536 + h * 96 + 8 * hi;
#pragma unroll
          for (int ks = 0; ks < 6; ++ks) qr[ks] = *(const bf16x8*)(qp + 16 * ks); }
        const bf16_t* kns = KN + (rowb + (tid >> 3)) * DM + h * 64 + 8 * (tid & 7);
        const bf16_t* krs = KR + (rowb + (tid >> 2)) * 32 + 8 * (tid & 3);
        const bf16_t* vts = VT + (size_t)(h * 64 + (tid >> 3)) * TC + rowb + 8 * (tid & 7);
        const int kdst = (tid >> 3) * KP + (tid & 7) * 16, krdst = (tid >> 2) * KP + 128 + (tid & 3) * 16, vdst = 2 * KBUF + (tid >> 3) * VP + (tid & 7) * 16;
        u32x4 rk, rr = (u32x4){0u, 0u, 0u, 0u}, rv;
        rk = *(const u32x4*)kns; if (tid < 256) rr = *(const u32x4*)krs; rv = *(const u32x4*)vts;
        *(LAS u32x4*)(lds + kdst) = rk; if (tid < 256) *(LAS u32x4*)(lds + krdst) = rr; *(LAS u32x4*)(lds + vdst) = rv;
        __syncthreads();
        f32x16 o0, o1;
#pragma unroll
        for (int r = 0; r < 16; ++r) { o0[r] = 0.f; o1[r] = 0.f; }
        float mrun = -1e30f, lrun = 0.f;
        for (int t = 0; t < NT; ++t) {
            const int cur = t & 1; const bool more = (t + 1 < NT);
            if (more) { rk = *(const u32x4*)(kns + (size_t)(t + 1) * 64 * DM); if (tid < 256) rr = *(const u32x4*)(krs + (size_t)(t + 1) * 64 * 32); rv = *(const u32x4*)(vts + (size_t)(t + 1) * 64); }
            if (t < ntw) {
                LAS const unsigned char* kb = lds + cur * KBUF; LAS const unsigned char* vb = lds + 2 * KBUF + cur * VBUF;
                f32x16 s0, s1;
#pragma unroll
                for (int r = 0; r < 16; ++r) { s0[r] = 0.f; s1[r] = 0.f; }
#pragma unroll
                for (int ks = 0; ks < 6; ++ks) {
                    const bf16x8 a0 = *(LAS const bf16x8*)(kb + i32 * KP + (16 * ks + 8 * hi) * 2), a1 = *(LAS const bf16x8*)(kb + (32 + i32) * KP + (16 * ks + 8 * hi) * 2);
                    s0 = __builtin_amdgcn_mfma_f32_32x32x16_bf16(a0, qr[ks], s0, 0, 0, 0); s1 = __builtin_amdgcn_mfma_f32_32x32x16_bf16(a1, qr[ks], s1, 0, 0, 0);
                }
                float mx = fmaxf(s0[0], s1[0]);
#pragma unroll
                for (int r = 1; r < 16; ++r) mx = fmaxf(mx, fmaxf(s0[r], s1[r]));
                mx = fmaxf(mx, __shfl_xor(mx, 32));
                const float mn = fmaxf(mrun, mx), alpha = fexp2(mrun - mn); mrun = mn;
                float rs = 0.f;
#pragma unroll
                for (int r = 0; r < 16; ++r) { s0[r] = fexp2(s0[r] - mn); s1[r] = fexp2(s1[r] - mn); rs += s0[r] + s1[r]; }
                lrun = lrun * alpha + rs;
#pragma unroll
                for (int r = 0; r < 16; ++r) { o0[r] *= alpha; o1[r] *= alpha; }
                bf16x8 pf[2][2];
#pragma unroll
                for (int uu = 0; uu < 2; ++uu) {
                    u32x4 w0, w1;
                    w0.x = cvt_pk_bf16(s0[8 * uu + 0], s0[8 * uu + 1]); w0.y = cvt_pk_bf16(s0[8 * uu + 2], s0[8 * uu + 3]); w0.z = cvt_pk_bf16(s0[8 * uu + 4], s0[8 * uu + 5]); w0.w = cvt_pk_bf16(s0[8 * uu + 6], s0[8 * uu + 7]);
                    w1.x = cvt_pk_bf16(s1[8 * uu + 0], s1[8 * uu + 1]); w1.y = cvt_pk_bf16(s1[8 * uu + 2], s1[8 * uu + 3]); w1.z = cvt_pk_bf16(s1[8 * uu + 4], s1[8 * uu + 5]); w1.w = cvt_pk_bf16(s1[8 * uu + 6], s1[8 * uu + 7]);
                    pf[0][uu] = __builtin_bit_cast(bf16x8, w0); pf[1][uu] = __builtin_bit_cast(bf16x8, w1);
                }
#pragma unroll
                for (int tt = 0; tt < 2; ++tt)
#pragma unroll
                    for (int uu = 0; uu < 2; ++uu) {
                        LAS const unsigned char* vp0 = vb + i32 * VP + (32 * tt + 16 * uu + 4 * hi) * 2; LAS const unsigned char* vp1 = vp0 + 32 * VP;
                        const u32x2 a = *(LAS const u32x2*)vp0, bq = *(LAS const u32x2*)(vp0 + 16), c = *(LAS const u32x2*)vp1, d = *(LAS const u32x2*)(vp1 + 16);
                        const bf16x8 vf0 = __builtin_bit_cast(bf16x8, ((u32x4){a.x, a.y, bq.x, bq.y})), vf1 = __builtin_bit_cast(bf16x8, ((u32x4){c.x, c.y, d.x, d.y}));
                        o0 = __builtin_amdgcn_mfma_f32_32x32x16_bf16(vf0, pf[tt][uu], o0, 0, 0, 0); o1 = __builtin_amdgcn_mfma_f32_32x32x16_bf16(vf1, pf[tt][uu], o1, 0, 0, 0);
                    }
            }
            if (more) { const int nb = cur ^ 1; *(LAS u32x4*)(lds + nb * KBUF + kdst) = rk; if (tid < 256) *(LAS u32x4*)(lds + nb * KBUF + krdst) = rr; *(LAS u32x4*)(lds + nb * VBUF + vdst) = rv; }
            __syncthreads();
        }
        lrun += __shfl_xor(lrun, 32); const float inv = frcp(lrun);
        bf16_t* op = Z + (rowb + q0 + 32 * wid + i32) * ZLD + ZC_XA + h * 64 + 4 * hi;
#pragma unroll
        for (int rg = 0; rg < 4; ++rg) {
            u32x2 w; w.x = cvt_pk_bf16(o0[4 * rg] * inv, o0[4 * rg + 1] * inv); w.y = cvt_pk_bf16(o0[4 * rg + 2] * inv, o0[4 * rg + 3] * inv); *(u32x2*)(op + 8 * rg) = w;
            w.x = cvt_pk_bf16(o1[4 * rg] * inv, o1[4 * rg + 1] * inv); w.y = cvt_pk_bf16(o1[4 * rg + 2] * inv, o1[4 * rg + 3] * inv); *(u32x2*)(op + 32 + 8 * rg) = w;
        }
    }
}
__device__ __forceinline__ void sgu_units(LAS unsigned char* lds, const bf16_t* VTS, const float* MEANV, const float* RSTDV, const float* lng, const float* lnb, const bf16_t* WS, const float* bs, bf16_t* Z, int G, int blk) {
    const int tid = pg8::tid_opaque(), lane = tid & 63, wid = __builtin_amdgcn_readfirstlane(tid >> 6), i32 = lane & 31, hi = lane >> 5;
    constexpr int AP = 272;
    for (int idx = blk; idx < 1024; idx += G) {
        const int tb = idx >> 3, g = idx & 7, tok0 = tb * 128;
#pragma unroll
        for (int jj = 0; jj < 4; ++jj) {
            const int id = tid + 512 * jj, c = id >> 4, sc = id & 15; f32x4 x0, x1; unpack8(*(const u32x4*)(VTS + (size_t)(g * 128 + c) * TC + tok0 + 8 * sc), x0, x1);
            const f32x4 m0 = *(const f32x4*)(MEANV + tok0 + 8 * sc), m1 = *(const f32x4*)(MEANV + tok0 + 8 * sc + 4), r0 = *(const f32x4*)(RSTDV + tok0 + 8 * sc), r1 = *(const f32x4*)(RSTDV + tok0 + 8 * sc + 4);
            const float ga = lng[g * 128 + c], be = lnb[g * 128 + c];
            x0 = (x0 - m0) * r0 * ga + be; x1 = (x1 - m1) * r1 * ga + be;
            *(LAS u32x4*)(lds + c * AP + sc * 16) = pack8(x0, x1);
        }
        __syncthreads();
        const int tt = wid & 3; bf16x8 wf[8];
        { const bf16_t* wp = WS + (size_t)(g * 128 + 32 * tt + i32) * 128 + 8 * hi;
#pragma unroll
          for (int ks = 0; ks < 8; ++ks) wf[ks] = *(const bf16x8*)(wp + 16 * ks); }
        const float bsv = bs[g * 128 + 32 * tt + i32];
#pragma unroll
        for (int cc = 0; cc < 2; ++cc) {
            const int ct = 2 * (wid >> 2) + cc; f32x16 acc;
#pragma unroll
            for (int r = 0; r < 16; ++r) acc[r] = 0.f;
#pragma unroll
            for (int ks = 0; ks < 8; ++ks) { const bf16x8 a = *(LAS const bf16x8*)(lds + (32 * ct + i32) * AP + (16 * ks + 8 * hi) * 2); acc = __builtin_amdgcn_mfma_f32_32x32x16_bf16(a, wf[ks], acc, 0, 0, 0); }
            bf16_t* up = Z + (size_t)(tok0 + 32 * tt + i32) * ZLD + ZC_U + g * 128 + 32 * ct + 4 * hi;
#pragma unroll
            for (int rg = 0; rg < 4; ++rg) { const u32x2 uv = *(const u32x2*)(up + 8 * rg); u32x2 w;
                w.x = cvt_pk_bf16((acc[4 * rg] + bsv) * bflo(uv.x), (acc[4 * rg + 1] + bsv) * bfhi(uv.x)); w.y = cvt_pk_bf16((acc[4 * rg + 2] + bsv) * bflo(uv.y), (acc[4 * rg + 3] + bsv) * bfhi(uv.y)); *(u32x2*)(up + 8 * rg) = w; }
        }
        __syncthreads();
    }
}

#ifndef DBG_DUMP
#define DBG_DUMP 0
#define DBG_CH 0
#define DBG_TWICE 0
#define DBG_SKIP56 0
#endif
__device__ __forceinline__ void dbg_add(float* out, const bf16_t* buf, size_t n, bool first, int G, int blk) {
    const size_t gt = (size_t)blk * 512 + pg8::tid_opaque(), NGT = (size_t)G * 512;
    for (size_t i = gt; i < (size_t)T * DM; i += NGT) { float v = 0.f; for (size_t j = i; j < n; j += (size_t)T * DM) v += __uint_as_float((unsigned)buf[j] << 16); out[i] = first ? v : out[i] + v; }
}
__device__ __forceinline__ void dbg_addf(float* out, const float* buf, size_t n, int G, int blk) {
    const size_t gt = (size_t)blk * 512 + pg8::tid_opaque(), NGT = (size_t)G * 512;
    for (size_t i = gt; i < (size_t)T * DM; i += NGT) out[i] += buf[i % n];
}
#define APS 0
#define RUN_GEMM(EPI, e, Ap, Bp, M_, N_, K_, lda_, ldb_, apn_) do { int K__ = (K_), blk__ = blk; asm volatile("" : "+s"(K__), "+s"(blk__)); pg8::Gemm gg{(Ap), (Bp), (M_), (N_), K__, (lda_), (ldb_), (apn_), APS}; pg8::StaticOrder SO; SO.init((M_), (N_), G, blk__); \
    pg8::gemm_phase<decltype(e), pg8::StaticOrder, true, true>(lds, gg, SO, e); } while (0)

constexpr size_t SM_BAR = 1024 * 1024;
#define XB_TMO      128
#define XB_XCNT(j)  (256  + 64 * (j))
#define XB_XSUB(j)  (1280 + 64 * (j))
#define XB_XGEN(j)  (2304 + 64 * (j))
#define XB_TOP      3328
#define XB_TOPGEN   3392
#define XCD_BAR_WORDS 3456
#define XB_SPIN_CAP (1u << 18)

__device__ __forceinline__ unsigned xb_ld(unsigned* p)              { return __hip_atomic_load(p, __ATOMIC_RELAXED, __HIP_MEMORY_SCOPE_AGENT); }
__device__ __forceinline__ unsigned xb_add(unsigned* p, unsigned v) { return __hip_atomic_fetch_add(p, v, __ATOMIC_RELAXED, __HIP_MEMORY_SCOPE_AGENT); }
__device__ __forceinline__ unsigned xb_xcc_id() { return (unsigned)__builtin_amdgcn_s_getreg((3 << 11) | 20) & 0xFu; }
#define XB_SPIN(cond, bar) do { unsigned _sp = 0; while (cond) { __builtin_amdgcn_s_sleep(1); \
    if ((++_sp & 255u) == 0u) { if (xb_ld(&(bar)[XB_TMO])) break; if (_sp > XB_SPIN_CAP) { atomicAdd(&(bar)[XB_TMO], 1u); break; } } } } while (0)

struct XcdBarrier {
    unsigned* bar; unsigned x;
    volatile __attribute__((address_space(3))) unsigned* st;
};

__device__ __forceinline__ XcdBarrier xcd_barrier_post(unsigned* bar, volatile __attribute__((address_space(3))) unsigned* st) {
    XcdBarrier b; b.bar = bar; b.x = xb_xcc_id(); b.st = st;
    if (threadIdx.x == 0) (void)xb_add(&bar[XB_XCNT(b.x)], 1u);
    return b;
}
__device__ __forceinline__ void xcd_barrier_complete(unsigned* bar, unsigned x, unsigned& nloc, unsigned& nx) {
    const unsigned G = gridDim.x * gridDim.y * gridDim.z;
    unsigned sum, cnt, mine, sp = 0u;
    for (;;) {
        sum = 0u; cnt = 0u; mine = 0u;
#pragma unroll
        for (unsigned j = 0; j < 16; ++j) { const unsigned c = xb_ld(&bar[XB_XCNT(j)]); sum += c; cnt += (c > 0u) ? 1u : 0u; mine = (j == x) ? c : mine; }
        if (sum == G) break;
        __builtin_amdgcn_s_sleep(1);
        if ((++sp & 255u) == 0u) { if (xb_ld(&bar[XB_TMO])) break; if (sp > XB_SPIN_CAP) { atomicAdd(&bar[XB_TMO], 1u); break; } }
    }
    nloc = mine > 0u ? mine : 1u; nx = cnt > 0u ? cnt : 1u;
}

__device__ __forceinline__ void xcd_barrier(const XcdBarrier& b) {
    asm volatile("s_waitcnt vmcnt(0)" ::: "memory");
    __syncthreads();
    if (threadIdx.x == 0) {
        unsigned* bar = b.bar;
        __builtin_amdgcn_s_waitcnt(0);
        unsigned nloc = b.st[0], nx = b.st[1];
        if (nloc == 0u) { xcd_barrier_complete(bar, b.x, nloc, nx); b.st[0] = nloc; b.st[1] = nx; }
        const unsigned old = xb_add(&bar[XB_XSUB(b.x)], 1u);
        const unsigned gen = old / nloc;
        if (old + 1u == (gen + 1u) * nloc) {
            __builtin_amdgcn_fence(__ATOMIC_RELEASE, "agent");
            asm volatile("s_waitcnt vmcnt(0)" ::: "memory");
            const unsigned og = xb_add(&bar[XB_TOP], 1u);
            const unsigned tg = og / nx;
            if (og + 1u == (tg + 1u) * nx) xb_add(&bar[XB_TOPGEN], 1u);
            else XB_SPIN(xb_ld(&bar[XB_TOPGEN]) == tg, bar);
            __builtin_amdgcn_fence(__ATOMIC_ACQUIRE, "agent");
            xb_add(&bar[XB_XGEN(b.x)], 1u);
            asm volatile("s_waitcnt vmcnt(0)" ::: "memory");
        } else {
            XB_SPIN(xb_ld(&bar[XB_XGEN(b.x)]) == gen, bar);
            __builtin_amdgcn_fence(__ATOMIC_ACQUIRE, "agent");
            asm volatile("s_waitcnt vmcnt(0)" ::: "memory");
        }
    }
    __syncthreads();
}
#define GRID_SYNC() xcd_barrier(xbar)

#define DBG_DUMP_BODY(st) do { \
    dbg_add(X, G3, (size_t)TC * 3072, true, G, blk); } while (0)
__global__ void __launch_bounds__(512, 2) fwd_kernel(Params p) {
    extern __shared__ __attribute__((aligned(16))) unsigned char lds_raw[];
    LAS unsigned char* lds = (LAS unsigned char*)lds_raw;
    cg::grid_group grid = cg::this_grid();
    const int G = gridDim.x, blk = blockIdx.x;
    unsigned char* ws = p.ws;
    { volatile LAS unsigned* st0 = (volatile LAS unsigned*)(lds + 131072); if (threadIdx.x < 64) st0[threadIdx.x] = 0u; }
    __syncthreads();
    const XcdBarrier xbar = xcd_barrier_post((unsigned*)(ws + WS_SMALL + SM_BAR), (volatile LAS unsigned*)(lds + 131072));
    grid.sync();
    bf16_t* wb = (bf16_t*)(ws + WS_W); bf16_t* XB = (bf16_t*)(ws + WS_XB); float* SSQ = (float*)(ws + WS_SSQ); float* X = p.out;
    float* ROPE = (float*)(ws + WS_SMALL + SM_ROPE); float* RSQ = (float*)(ws + WS_SMALL + SM_RSQ); float* RSKV = (float*)(ws + WS_SMALL + SM_RSKV);
    float* MEANV = (float*)(ws + WS_SMALL + SM_MEANV); float* RSTDV = (float*)(ws + WS_SMALL + SM_RSTDV); float* SP8 = (float*)(ws + WS_SMALL + SM_SP8);
    unsigned char* big = ws + WS_BIG;
    bf16_t* H = (bf16_t*)(big + B_H); bf16_t* PB = (bf16_t*)(big + B_PB); bf16_t* GP = (bf16_t*)(big + B_GP);
    bf16_t* Z = (bf16_t*)(big + B_Z); bf16_t* VTS = (bf16_t*)(big + B_VTS); bf16_t* XC = (bf16_t*)(big + B_XC); bf16_t* LA = (bf16_t*)(big + B_LA); bf16_t* U = (bf16_t*)(big + B_U);
    bf16_t* Q = (bf16_t*)(big + B_Q); bf16_t* KN = (bf16_t*)(big + B_KN); bf16_t* VT = (bf16_t*)(big + B_VT); bf16_t* KR = (bf16_t*)(big + B_KR);
    bf16_t* G3 = (bf16_t*)(big + B_G3); bf16_t* MG = (bf16_t*)(big + B_MERGED);

#pragma unroll 1
    for (int L = 0; L < 2; ++L) {
#ifndef NO_P0
        phase0(p, L, lds, G, blk);
#endif
        GRID_SYNC();
        { EpiSwiglu e{H, SSQ}; RUN_GEMM(EpiSwiglu, e, XB, wb + O_WGU1, T, 2 * DFF, 1024, 1024, 1024, 0); }
        GRID_SYNC();
        { EpiResid<false> e{L == 0 ? p.in[0] : X, X, XB, SSQ, nullptr, 0.5f}; RUN_GEMM(EpiResid<false>, e, H, wb + O_WD1, T, 1024, DFF, DFF, DFF, 0); }
        GRID_SYNC();
#if DBG_STOP == 1
        break;
#endif
#pragma unroll 1
        for (int ch = 0; ch < 2; ++ch) {
            const size_t r0 = (size_t)ch * TC;
            { EpiRow<1, 0> e{Z, ZLD, SSQ + r0 * 4, nullptr, 4, 12, 0}; RUN_GEMM((EpiRow<1, 0>), e, XB + r0 * DM, wb + O_WIN, TC, ZLD, 1024, 1024, 1024, 0); }
            { EpiCol<1, 0> e{VTS, TC, SSQ + r0 * 4}; RUN_GEMM((EpiCol<1, 0>), e, wb + O_WINV, XB + r0 * DM, 1024, TC, 1024, 1024, 1024, 0); }
            GRID_SYNC();
#if DBG_DUMP == 3
            if (ch == DBG_CH) { DBG_DUMP_BODY(3); return; }
#endif
#ifndef NO_E1
            e1_rows(p, L, Z, XC, RSQ, RSKV, KR, ROPE, G, blk);
#endif
#ifndef NO_E2
            e2_stats(lds, VTS, MEANV, RSTDV, G, blk);
#endif
            GRID_SYNC();
#if DBG_DUMP == 4
            if (ch == DBG_CH) { DBG_DUMP_BODY(4); return; }
#endif
#if !DBG_SKIP56
            { EpiLru e{XC, LA, U, p.in[10] + L * 1024, p.in[12] + L * 1024, SP8}; RUN_GEMM(EpiLru, e, XC, wb + O_WLRU, TC, 2048, 128, 1024, 128, 128); }
            { EpiQ e{Q, RSQ, ROPE}; RUN_GEMM(EpiQ, e, Z + ZC_CQ, wb + O_WUQ, TC, 1536, 384, ZLD, 384, 0); }
            { EpiRow<0, 1> e{KN, 1024, RSKV, nullptr, 0, 0, 0}; RUN_GEMM((EpiRow<0, 1>), e, Z + ZC_CKV, wb + O_WKVK, TC, 1024, 256, ZLD, 256, 0); }
            { EpiCol<0, 1> e{VT, TC, RSKV}; RUN_GEMM((EpiCol<0, 1>), e, wb + O_WKVV, Z + ZC_CKV, 1024, TC, 256, 256, ZLD, 0); }
            GRID_SYNC();
#if DBG_DUMP == 5
            if (ch == DBG_CH) { DBG_DUMP_BODY(5); return; }
#endif
#if 1
            scan_units(lds, LA, U, Z, G, blk);
#endif
#if 1
            attn_units(lds, Q, KN, KR, VT, Z, G, blk);
#endif
#if 1
            sgu_units(lds, VTS, MEANV, RSTDV, p.in[20] + L * 1024, p.in[21] + L * 1024, wb + O_WSGU, p.in[23] + L * 1024, Z, G, blk);
#endif
            GRID_SYNC();
#if DBG_DUMP == 6
            if (ch == DBG_CH) { DBG_DUMP_BODY(6); return; }
#endif
#endif
            { EpiRow<2, 0> e{G3, 3072, SSQ + r0 * 4, p.in[25] + L * 3072, 0, 0, 1}; RUN_GEMM((EpiRow<2, 0>), e, XB + r0 * DM, wb + O_WING, TC, 3072, 1024, 1024, 1024, 0); }
#if DBG_TWICE
            GRID_SYNC();
            { EpiRow<2, 0> e{G3, 3072, SSQ + r0 * 4, p.in[25] + L * 3072, 0, 0, 1}; RUN_GEMM((EpiRow<2, 0>), e, XB + r0 * DM, wb + O_WING, TC, 3072, 1024, 1024, 1024, 0); }
#endif
            GRID_SYNC();
#if DBG_DUMP == 7
            if (ch == DBG_CH) { DBG_DUMP_BODY(7); return; }
#endif
#undef APS
#define APS 2
            { EpiMerge e{G3, MG}; RUN_GEMM(EpiMerge, e, Z, wb + O_WRA, TC, 3072, 1024, ZLD, 1024, 1024); }
#undef APS
#define APS 0
            GRID_SYNC();
#if DBG_DUMP == 8
            if (ch == DBG_CH) { DBG_DUMP_BODY(8); return; }
#endif
            { EpiResid<false> e{X + r0 * DM, X + r0 * DM, XB + r0 * DM, SSQ + r0 * 4, nullptr, 1.0f}; RUN_GEMM(EpiResid<false>, e, MG, wb + O_WOUT, TC, 1024, 1024, 1024, 1024, 0); }
            GRID_SYNC();
        }
#if DBG_STOP == 2
        break;
#endif
        { EpiSwiglu e{H, SSQ}; RUN_GEMM(EpiSwiglu, e, XB, wb + O_WGU2, T, 2 * DFF, 1024, 1024, 1024, 0); }
        GRID_SYNC();
        { EpiResid<false> e{X, X, XB, SSQ, nullptr, 0.5f}; RUN_GEMM(EpiResid<false>, e, H, wb + O_WD2, T, 1024, DFF, DFF, DFF, 0); }
        GRID_SYNC();
        pb_convert(p, L, G, blk);
        { EpiRow<2, 0> e{GP, 1024, SSQ, nullptr, 0, 0, 0}; RUN_GEMM((EpiRow<2, 0>), e, XB, wb + O_WPG, T, 1024, 1024, 1024, 1024, 0); }
        GRID_SYNC();
        { EpiResid<true> e{X, X, XB, SSQ, GP, 1.0f}; RUN_GEMM(EpiResid<true>, e, PB, wb + O_WPLE, T, 1024, 256, 256, 256, 0); }
        GRID_SYNC();
    }
    {
        const int tid = pg8::tid_opaque(), lane = tid & 63, wave = tid >> 6, gw = blk * 8 + wave, NGW = G * 8; const float* fn = p.in[33];
        for (int m = gw; m < T; m += NGW) {
            f32x4* xr = (f32x4*)(X + (size_t)m * DM) + lane; f32x4 v[4]; float s = 0.f;
#pragma unroll
            for (int j = 0; j < 4; ++j) { v[j] = xr[64 * j]; s += (v[j][0] * v[j][0] + v[j][1] * v[j][1]) + (v[j][2] * v[j][2] + v[j][3] * v[j][3]); }
            const float rstd = __builtin_amdgcn_rsqf(wave_sum(s) * (1.f / 1024.f) + EPS);
#pragma unroll
            for (int j = 0; j < 4; ++j) xr[64 * j] = v[j] * rstd * ((const f32x4*)fn)[lane + 64 * j];
        }
    }
}

extern "C" void kernel_launch(void* const* d_in, const int* in_sizes, int n_in, void* d_out, int out_size, void* d_ws, size_t ws_size, hipStream_t stream) {
    static int grid = 0;
    if (grid == 0) {
        if (n_in != 34 || ws_size < WS_NEED) { fprintf(stderr, "kernel_launch: unexpected n_in %d / ws_size %zu (need %zu)\n", n_in, ws_size, (size_t)WS_NEED); grid = -1; return; }
        int dev = 0, cus = 0, per = 0;
        (void)hipGetDevice(&dev); (void)hipDeviceGetAttribute(&cus, hipDeviceAttributeMultiprocessorCount, dev);
        (void)hipFuncSetAttribute((const void*)fwd_kernel, hipFuncAttributeMaxDynamicSharedMemorySize, LDS_BYTES);
        if (hipOccupancyMaxActiveBlocksPerMultiprocessor(&per, (const void*)fwd_kernel, 512, LDS_BYTES) != hipSuccess || per < 1) per = 1;
        (void)hipGetLastError();
        grid = cus * per;
    }
    if (grid < 0) return;
    (void)hipMemsetAsync((unsigned char*)d_ws + WS_SMALL + SM_BAR, 0, 16384, stream);
    Params prm{};
    for (int i = 0; i < 34; ++i) prm.in[i] = (const float*)d_in[i];
    prm.out = (float*)d_out; prm.ws = (unsigned char*)d_ws;
    void* args[] = {&prm};
    hipError_t e = hipLaunchCooperativeKernel((const void*)fwd_kernel, dim3(grid), dim3(512), args, LDS_BYTES, stream);
    if (e != hipSuccess) fprintf(stderr, "cooperative launch failed: %s (grid %d)\n", hipGetErrorString(e), grid);
}
```

```cpp
#include <hip/hip_runtime.h>
#include <hip/hip_cooperative_groups.h>
#include <cstdio>
#include <cstdint>
namespace cg = cooperative_groups;
namespace pg8 {
#define PG8_LAS __attribute__((address_space(3)))
typedef unsigned short bf16_t;
typedef short bf16x8 __attribute__((ext_vector_type(8)));
typedef float f32x4 __attribute__((ext_vector_type(4)));
typedef unsigned u32x4 __attribute__((ext_vector_type(4)));
typedef unsigned u32x2 __attribute__((ext_vector_type(2)));
constexpr int BM = 256, BK = 64, HALF = 128, HTB = HALF * BK * 2  , STAGE_BYTES = 8 * HTB, NXCD = 8, WGM = 8;

__host__ __device__ __forceinline__ int lds_byte(int r, int c) { const int st = (r >> 4) * 2 + (c >> 5), rr = r & 15, cc = c & 31, ob = rr * 64 + cc * 2; return st * 1024 + (ob ^ (((ob >> 9) & 1) << 5)); }
__host__ __device__ __forceinline__ void stage_rc(int b, int& R, int& C) { const int st = b / 1024, sb = b % 1024, swz = sb ^ (((sb >> 9) & 1) << 5); R = (st >> 1) * 16 + swz / 64; C = (st & 1) * 32 + (swz % 64) / 2; }
__host__ __device__ __forceinline__ int perm32(int rho) { const int n = rho >> 4, i = rho & 15; return 8 * (i >> 2) + 4 * n + (i & 3); }

struct Unit { int pm, pn; };
struct Gemm { const bf16_t* A; const bf16_t* Bt; int M, N, K, lda, ldb, apn, aps; };

struct StaticOrder {
    int nM, nN, nwg, G, c;
    __host__ __device__ void init(int M, int N, int G_, int c_) { nM = M / BM; nN = N / BM; nwg = nM * nN; G = G_; c = c_; }
    __host__ __device__ bool next(int i, Unit& u) const {
        const long L = (long)i * G + c; if (L >= nwg) return false;
        int wgid = (int)L; { const int q = nwg / NXCD, r = nwg % NXCD, xcd = wgid % NXCD, off = wgid / NXCD; wgid = (xcd < r ? xcd * (q + 1) : r * (q + 1) + (xcd - r) * q) + off; }
        const int nig = WGM * nN, gid = wgid / nig, fm = gid * WGM, gsz = (nM - fm) < WGM ? (nM - fm) : WGM;
        u.pm = fm + ((wgid % nig) % gsz); u.pn = (wgid % nig) / gsz; return true;
    }
    __device__ __forceinline__ void a_ready(const Unit&) const {}
    __device__ __forceinline__ void done(const Unit&) const {}
};
__device__ __forceinline__ int tid_opaque() { int t = threadIdx.x; asm volatile("" : "+v"(t)); return t; }
typedef float f32x2_t __attribute__((ext_vector_type(2))); typedef __bf16 bf16x2_t __attribute__((ext_vector_type(2)));
__device__ __forceinline__ unsigned cvt_pk_bf16(float lo, float hi) { const f32x2_t v = {lo, hi}; const bf16x2_t b = __builtin_convertvector(v, bf16x2_t); return __builtin_bit_cast(unsigned, b); }

template <class Epi, class Sched, bool ALIGN_EPI = false, bool SP2 = false>
__device__ __forceinline__ void gemm_phase(PG8_LAS unsigned char* lds, const Gemm g, const Sched& S, const Epi& E) {
    const int tid = pg8::tid_opaque(), wid = __builtin_amdgcn_readfirstlane(tid >> 6), lane = tid & 63, wr = wid >> 2, wc = wid & 3, fr = lane & 15, fq = lane >> 4;
    const int K = g.K, nt = K / BK;
    unsigned voffA[2], voffB[2];
#pragma unroll
    for (int i = 0; i < 2; ++i) { int R, C; stage_rc(tid * 16 + i * 8192, R, C); const int Rb = Epi::PERM ? ((R & ~31) + perm32(R & 31)) : R;
        voffA[i] = (unsigned)(R * g.lda + C) * 2u; voffB[i] = (unsigned)(Rb * g.ldb + C) * 2u; }
    const size_t kstep = (size_t)(BK * 2);
    const size_t hstepA = (size_t)HALF * g.lda * 2, hstepB = (size_t)HALF * g.ldb * 2;
    const size_t tstepA = 2 * hstepA, tstepB = 2 * hstepB; const size_t apn = (size_t)g.apn * 2;
    const unsigned ldsw = (unsigned)wid * 1024u;
    const int aoff = lds_byte(wr * 64 + fr, fq * 8), boff = lds_byte(wc * 32 + fr, fq * 8);
#define PG8_SA(b, h) (((b) * 2 + (h)) * HTB)
#define PG8_SB(b, h) ((4 + (b) * 2 + (h)) * HTB)
#define PG8_STAGE(bufoff, gbase, voff) do { _Pragma("unroll") for (int _i = 0; _i < 2; ++_i) \
        __builtin_amdgcn_global_load_lds((const unsigned*)((const char*)(gbase) + (voff)[_i]), (PG8_LAS unsigned*)(lds + (bufoff) + ldsw + _i * 8192), 16, 0, 0); } while (0)
#define PG8_LDA(dst, b, h) do { _Pragma("unroll") for (int m = 0; m < 4; ++m) _Pragma("unroll") for (int k = 0; k < 2; ++k) dst[m][k] = *(const PG8_LAS bf16x8*)(lds + PG8_SA(b, h) + aoff + m * 2048 + k * 1024); } while (0)
#define PG8_LDB(dst, b, h) do { _Pragma("unroll") for (int n = 0; n < 2; ++n) _Pragma("unroll") for (int k = 0; k < 2; ++k) dst[n][k] = *(const PG8_LAS bf16x8*)(lds + PG8_SB(b, h) + boff + n * 2048 + k * 1024); } while (0)
#define PG8_MMA(ai, bj, At, Bt) do { __builtin_amdgcn_s_setprio(1); _Pragma("unroll") for (int m = 0; m < 4; ++m) _Pragma("unroll") for (int n = 0; n < 2; ++n) _Pragma("unroll") for (int k = 0; k < 2; ++k) \
        acc[ai][bj][m][n] = __builtin_amdgcn_mfma_f32_16x16x32_bf16(Bt[n][k], At[m][k], acc[ai][bj][m][n], 0, 0, 0); __builtin_amdgcn_s_setprio(0); } while (0)
#define PG8_WAIT_V(n) asm volatile("s_waitcnt vmcnt(" #n ")" ::: "memory")
#define PG8_WAIT_L(n) asm volatile("s_waitcnt lgkmcnt(" #n ")" ::: "memory")
#define PG8_BAR __builtin_amdgcn_s_barrier()
#define PG8_SCHED __builtin_amdgcn_sched_barrier(0)
    Unit cur, nxt; int ui = 0;
    if (!S.next(0, cur)) return;
    f32x4 acc[2][2][4][2];
#pragma unroll
    for (int a = 0; a < 2; ++a)
#pragma unroll
        for (int b = 0; b < 2; ++b)
#pragma unroll
            for (int m = 0; m < 4; ++m)
#pragma unroll
                for (int n = 0; n < 2; ++n) acc[a][b][m][n] = (f32x4){0.f, 0.f, 0.f, 0.f};
    bf16x8 At[4][2], B0[2][2], B1[2][2];
    const char* cA = (const char*)g.A + (size_t)cur.pm * tstepA + (size_t)(cur.pn >> g.aps) * apn; const char* cB = (const char*)g.Bt + (size_t)cur.pn * tstepB;
    S.a_ready(cur);
    if constexpr (SP2) {
        PG8_STAGE(PG8_SB(0, 0), cB, voffB); PG8_STAGE(PG8_SB(0, 1), cB + hstepB, voffB); PG8_STAGE(PG8_SA(0, 0), cA, voffA); PG8_STAGE(PG8_SA(0, 1), cA + hstepA, voffA);
        if (wr == 1) PG8_BAR;
        PG8_WAIT_V(2); PG8_BAR;
        PG8_STAGE(PG8_SB(1, 0), cB + kstep, voffB); PG8_STAGE(PG8_SA(1, 0), cA + kstep, voffA); PG8_STAGE(PG8_SB(1, 1), cB + hstepB + kstep, voffB);
        PG8_WAIT_V(6); PG8_BAR;
    } else {
        PG8_STAGE(PG8_SB(0, 0), cB, voffB); PG8_STAGE(PG8_SA(0, 0), cA, voffA); PG8_STAGE(PG8_SB(0, 1), cB + hstepB, voffB); PG8_STAGE(PG8_SA(0, 1), cA + hstepA, voffA);
        if (wr == 1) PG8_BAR;
        PG8_WAIT_V(4); PG8_BAR;
        PG8_STAGE(PG8_SB(1, 0), cB + kstep, voffB); PG8_STAGE(PG8_SA(1, 0), cA + kstep, voffA); PG8_STAGE(PG8_SB(1, 1), cB + hstepB + kstep, voffB);
        PG8_WAIT_V(6); PG8_BAR;
    }
    for (;;) {
        const bool has_next = S.next(ui + 1, nxt);
        const char* nA = has_next ? (const char*)g.A + (size_t)nxt.pm * tstepA + (size_t)(nxt.pn >> g.aps) * apn : cA; const char* nB = has_next ? (const char*)g.Bt + (size_t)nxt.pn * tstepB : cB;
        for (int t = 0; t < nt; t += 2) {
            const bool last = (t == nt - 2);
            const char* a1 = cA + (size_t)(t + 1) * kstep;
            const char* a2 = last ? nA : cA + (size_t)(t + 2) * kstep; const char* b2 = last ? nB : cB + (size_t)(t + 2) * kstep;
            const char* a3 = a2 + kstep; const char* b3 = b2 + kstep;
            if (last && has_next) S.a_ready(nxt);
            if constexpr (SP2) {
            PG8_LDB(B0, 0, 0); PG8_LDB(B1, 0, 1); PG8_SCHED; PG8_LDA(At, 0, 0); PG8_STAGE(PG8_SA(1, 1), a1 + hstepA, voffA);
            PG8_WAIT_V(8); PG8_WAIT_L(0); PG8_BAR; PG8_MMA(0, 0, At, B0); PG8_MMA(0, 1, At, B1); PG8_BAR; PG8_SCHED;
            PG8_LDA(At, 0, 1); PG8_STAGE(PG8_SB(0, 0), b2, voffB); PG8_STAGE(PG8_SB(0, 1), b2 + hstepB, voffB); PG8_STAGE(PG8_SA(0, 0), a2, voffA);
            PG8_WAIT_V(8); PG8_WAIT_L(0); PG8_BAR; PG8_MMA(1, 0, At, B0); PG8_MMA(1, 1, At, B1); PG8_BAR; PG8_SCHED;
            PG8_LDB(B0, 1, 0); PG8_LDB(B1, 1, 1); PG8_SCHED; PG8_LDA(At, 1, 0); PG8_STAGE(PG8_SA(0, 1), a2 + hstepA, voffA);
            PG8_WAIT_V(8); PG8_WAIT_L(0); PG8_BAR; PG8_MMA(0, 0, At, B0); PG8_MMA(0, 1, At, B1); PG8_BAR; PG8_SCHED;
            PG8_LDA(At, 1, 1); PG8_STAGE(PG8_SB(1, 0), b3, voffB); PG8_STAGE(PG8_SB(1, 1), b3 + hstepB, voffB); PG8_STAGE(PG8_SA(1, 0), a3, voffA);
            PG8_WAIT_V(8); PG8_WAIT_L(0); PG8_BAR; PG8_MMA(1, 0, At, B0); PG8_MMA(1, 1, At, B1); PG8_BAR; PG8_SCHED;
            } else {
            PG8_LDB(B0, 0, 0); PG8_SCHED; PG8_LDA(At, 0, 0); PG8_STAGE(PG8_SA(1, 1), a1 + hstepA, voffA);
            PG8_WAIT_L(8); PG8_BAR; PG8_WAIT_L(0); PG8_MMA(0, 0, At, B0); PG8_BAR; PG8_SCHED;
            PG8_LDB(B1, 0, 1); PG8_STAGE(PG8_SB(0, 0), b2, voffB);
            PG8_BAR; PG8_WAIT_L(0); PG8_MMA(0, 1, At, B1); PG8_BAR;
            PG8_LDA(At, 0, 1); PG8_STAGE(PG8_SA(0, 0), a2, voffA);
            PG8_BAR; PG8_WAIT_L(0); PG8_MMA(1, 0, At, B0); PG8_BAR; PG8_SCHED;
            PG8_STAGE(PG8_SB(0, 1), b2 + hstepB, voffB);
            PG8_WAIT_V(6); PG8_BAR; PG8_MMA(1, 1, At, B1); PG8_BAR;
            PG8_LDB(B0, 1, 0); PG8_SCHED; PG8_LDA(At, 1, 0); PG8_STAGE(PG8_SA(0, 1), a2 + hstepA, voffA);
            PG8_WAIT_L(8); PG8_BAR; PG8_WAIT_L(0); PG8_MMA(0, 0, At, B0); PG8_BAR; PG8_SCHED;
            PG8_LDB(B1, 1, 1); PG8_STAGE(PG8_SB(1, 0), b3, voffB);
            PG8_BAR; PG8_WAIT_L(0); PG8_MMA(0, 1, At, B1); PG8_BAR;
            PG8_LDA(At, 1, 1); PG8_STAGE(PG8_SA(1, 0), a3, voffA);
            PG8_BAR; PG8_WAIT_L(0); PG8_MMA(1, 0, At, B0); PG8_BAR; PG8_SCHED;
            PG8_STAGE(PG8_SB(1, 1), b3 + hstepB, voffB);
            PG8_WAIT_V(6); PG8_BAR; PG8_MMA(1, 1, At, B1); PG8_BAR;
            }
        }
        if constexpr (ALIGN_EPI) { if (wr == 0) PG8_BAR; }
        if constexpr (!Epi::AFTER_DRAIN) { E(acc, cur, wr, wc, fr, fq); S.done(cur); }
        if (!has_next) break;
#pragma unroll
        for (int a = 0; a < 2; ++a)
#pragma unroll
            for (int b = 0; b < 2; ++b)
#pragma unroll
                for (int m = 0; m < 4; ++m)
#pragma unroll
                    for (int n = 0; n < 2; ++n) acc[a][b][m][n] = (f32x4){0.f, 0.f, 0.f, 0.f};
        cur = nxt; cA = nA; cB = nB; ++ui;
        if constexpr (ALIGN_EPI) { if (wr == 1) PG8_BAR; }
    }
    PG8_WAIT_V(0);
    if constexpr (!ALIGN_EPI) { if (wr == 0) PG8_BAR; }
    PG8_BAR;
    if constexpr (Epi::AFTER_DRAIN) { E.fused(acc, cur, wr, wc, fr, fq, lds, wid, lane); S.done(cur); }
#undef PG8_SA
#undef PG8_SB
#undef PG8_STAGE
#undef PG8_LDA
#undef PG8_LDB
#undef PG8_MMA
#undef PG8_WAIT_V
#undef PG8_WAIT_L
#undef PG8_BAR
#undef PG8_SCHED
}
}

using pg8::bf16_t; using pg8::bf16x8; using pg8::f32x4; using pg8::u32x4; using pg8::u32x2; using pg8::Unit; using pg8::cvt_pk_bf16;
typedef float f32x16 __attribute__((ext_vector_type(16)));
typedef float f32x2 __attribute__((ext_vector_type(2)));
#define LAS __attribute__((address_space(3)))

constexpr int T = 32768, DM = 1024, TC = 16384, DFF = 2816, ZLD = 3840;
constexpr int ZC_XA = 0, ZC_GA = 1024, ZC_U = 2048, ZC_CKV = 3072, ZC_CQ = 3328, ZC_KR = 3712;
constexpr float EPS = 1e-6f, LOG2E = 1.4426950408889634f;
constexpr float QSCALE = 0.10206207261596577f * 1.4426950408889634f;
constexpr size_t MiB = (size_t)1 << 20;
constexpr size_t WS_W = 0, WS_XB = 64 * MiB, WS_SSQ = 128 * MiB, WS_SMALL = 130 * MiB, WS_BIG = 132 * MiB;
constexpr size_t SM_ROPE = 0, SM_RSQ = 256 * 1024, SM_RSKV = 320 * 1024, SM_MEANV = 384 * 1024, SM_RSTDV = 448 * 1024, SM_SP8 = 512 * 1024;
constexpr size_t B_H = 0, B_PB = 176 * MiB, B_GP = 192 * MiB;
constexpr size_t B_Z = 0, B_VTS = 120 * MiB, B_XC = 152 * MiB, B_LA = 184 * MiB, B_U = 216 * MiB, B_Q = 248 * MiB, B_KN = 296 * MiB, B_VT = 328 * MiB, B_KR = 360 * MiB;
constexpr size_t B_G3 = 248 * MiB, B_MERGED = 184 * MiB;
constexpr size_t WS_NEED = WS_BIG + 361 * MiB;
constexpr size_t O_WGU1 = 0, O_WD1 = O_WGU1 + 5632 * 1024, O_WIN = O_WD1 + 1024 * 2816, O_WINV = O_WIN + 3840 * 1024, O_WING = O_WINV + 1024 * 1024,
                 O_WLRU = O_WING + 3072 * 1024, O_WRA = O_WLRU + 2048 * 128, O_WRB = O_WRA + 1024 * 1024, O_WRC = O_WRB + 1024 * 1024, O_WOUT = O_WRC + 1024 * 1024,
                 O_WPG = O_WOUT + 1024 * 1024, O_WUQ = O_WPG + 1024 * 1024, O_WKVK = O_WUQ + 1536 * 384, O_WKVV = O_WKVK + 1024 * 256, O_WGU2 = O_WKVV + 1024 * 256,
                 O_WD2 = O_WGU2 + 5632 * 1024, O_WPLE = O_WD2 + 1024 * 2816, O_WSGU = O_WPLE + 1024 * 256, O_WEND = O_WSGU + 8 * 128 * 128;
static_assert(O_WEND * 2 <= 64 * MiB, "weights fit");
constexpr int LDS_BYTES = 131072 + 256;
#ifndef DBG_STOP
#define DBG_STOP 0
#endif
#ifndef DBG_BR
#define DBG_BR 7
#endif

struct Params { const float* in[34]; float* out; unsigned char* ws; };

__device__ __forceinline__ float fexp2(float x) { return __builtin_amdgcn_exp2f(x); }
__device__ __forceinline__ float frcp(float x) { return __builtin_amdgcn_rcpf(x); }
__device__ __forceinline__ float sigm(float x) { return frcp(1.f + fexp2(-LOG2E * x)); }
__device__ __forceinline__ float gelu_t(float x) { const float t = x + 0.044715f * x * x * x; return x * frcp(1.f + fexp2(-2.3022081985f * t)); }
__device__ __forceinline__ float bflo(unsigned w) { return __uint_as_float(w << 16); }
__device__ __forceinline__ float bfhi(unsigned w) { return __uint_as_float(w & 0xffff0000u); }
__device__ __forceinline__ bf16_t f2bf(float v) { return (bf16_t)(cvt_pk_bf16(v, 0.f) & 0xffffu); }
__device__ __forceinline__ float wave_sum(float v) {
#pragma unroll
    for (int o = 1; o < 64; o <<= 1) v += __shfl_xor(v, o);
    return v;
}
constexpr size_t SSQ_PLANE = (size_t)T * 4;
__device__ __forceinline__ float rstd16(const float* ssq, size_t row) {
    const float* q = ssq + row * 4; const f32x4 a = *(const f32x4*)q, b = *(const f32x4*)(q + SSQ_PLANE), c = *(const f32x4*)(q + 2 * SSQ_PLANE), d = *(const f32x4*)(q + 3 * SSQ_PLANE);
    const float s = ((a.x + a.y) + (a.z + a.w)) + ((b.x + b.y) + (b.z + b.w)) + ((c.x + c.y) + (c.z + c.w)) + ((d.x + d.y) + (d.z + d.w));
    return __builtin_amdgcn_rsqf(s * (1.0f / 1024.0f) + EPS);
}
__device__ __forceinline__ u32x4 pack8(const f32x4 v0, const f32x4 v1) { u32x4 w; w.x = cvt_pk_bf16(v0[0], v0[1]); w.y = cvt_pk_bf16(v0[2], v0[3]); w.z = cvt_pk_bf16(v1[0], v1[1]); w.w = cvt_pk_bf16(v1[2], v1[3]); return w; }
__device__ __forceinline__ void unpack8(const u32x4 w, f32x4& v0, f32x4& v1) { v0 = (f32x4){bflo(w.x), bfhi(w.x), bflo(w.y), bfhi(w.y)}; v1 = (f32x4){bflo(w.z), bfhi(w.z), bflo(w.w), bfhi(w.w)}; }

template <int ACT, int RS> struct EpiRow {
    static constexpr bool PERM = true, AFTER_DRAIN = false;
    bf16_t* O; int ldc; const float* rs; const float* bias; int t0, t1; int bswap;
    __device__ __forceinline__ void operator()(const f32x4 (&acc)[2][2][4][2], const Unit& u, int wr, int wc, int fr, int fq) const {
        const int row0 = u.pm * 256 + wr * 64 + fr, col0 = u.pn * 256 + wc * 32 + 8 * fq;
        const bool act = (ACT == 1) ? (u.pn >= t0 && u.pn < t1) : true;
        f32x4 bv[2][2];
#pragma unroll
        for (int bj = 0; bj < 2; ++bj)
#pragma unroll
            for (int n = 0; n < 2; ++n) bv[bj][n] = bias ? *(const f32x4*)(bias + col0 + (bswap ? (u.pn < 4 ? 1024 : (u.pn < 8 ? -1024 : 0)) : 0) + bj * 128 + 4 * n) : (f32x4){0.f, 0.f, 0.f, 0.f};
#pragma unroll
        for (int ai = 0; ai < 2; ++ai)
#pragma unroll
            for (int m = 0; m < 4; ++m) {
                const size_t row = (size_t)(row0 + ai * 128 + m * 16); const float s = (RS == 0) ? rstd16(rs, row) : rs[row];
                bf16_t* rowp = O + row * ldc + col0;
#pragma unroll
                for (int bj = 0; bj < 2; ++bj) {
                    f32x4 v0 = acc[ai][bj][m][0] * s + bv[bj][0], v1 = acc[ai][bj][m][1] * s + bv[bj][1];
                    if (ACT == 1) { if (act) {
#pragma unroll
                        for (int e = 0; e < 4; ++e) { v0[e] = gelu_t(v0[e]); v1[e] = gelu_t(v1[e]); } } }
                    if (ACT == 2) {
#pragma unroll
                        for (int e = 0; e < 4; ++e) { v0[e] = sigm(v0[e]); v1[e] = sigm(v1[e]); } }
                    *(u32x4*)(rowp + bj * 128) = pack8(v0, v1);
                }
                asm volatile("" ::: "memory");
            }
    }
};
struct EpiSwiglu {
    static constexpr bool PERM = true, AFTER_DRAIN = false;
    bf16_t* H; const float* ssq;
    __device__ __forceinline__ void operator()(const f32x4 (&acc)[2][2][4][2], const Unit& u, int wr, int wc, int fr, int fq) const {
        const int row0 = u.pm * 256 + wr * 64 + fr, col0 = u.pn * 128 + wc * 32 + 8 * fq;
#pragma unroll
        for (int ai = 0; ai < 2; ++ai)
#pragma unroll
            for (int m = 0; m < 4; ++m) {
                const size_t row = (size_t)(row0 + ai * 128 + m * 16); const float s = rstd16(ssq, row);
                f32x4 h0, h1;
#pragma unroll
                for (int e = 0; e < 4; ++e) { const float g0 = acc[ai][0][m][0][e] * s, g1 = acc[ai][0][m][1][e] * s; h0[e] = g0 * sigm(g0) * (acc[ai][1][m][0][e] * s); h1[e] = g1 * sigm(g1) * (acc[ai][1][m][1][e] * s); }
                *(u32x4*)(H + row * DFF + col0) = pack8(h0, h1);
                asm volatile("" ::: "memory");
            }
    }
};
template <bool GATED> struct EpiResid {
    static constexpr bool PERM = false, AFTER_DRAIN = false;
    const float* X32; bf16_t* XB; float* ssq; const bf16_t* GP; float alpha;
    __device__ __forceinline__ void operator()(const f32x4 (&acc)[2][2][4][2], const Unit& u, int wr, int wc, int fr, int fq) const {
        const int col0 = u.pn * 256 + wc * 32 + 4 * fq;
#pragma unroll
        for (int ai = 0; ai < 2; ++ai)
#pragma unroll
            for (int m = 0; m < 4; ++m) {
                const size_t row = (size_t)(u.pm * 256 + ai * 128 + wr * 64 + m * 16 + fr); const size_t off = row * DM + col0; float ss = 0.f;
#pragma unroll
                for (int bj = 0; bj < 2; ++bj)
#pragma unroll
                    for (int n = 0; n < 2; ++n) {
                        const size_t o = off + bj * 128 + n * 16; f32x4 a = acc[ai][bj][m][n] * alpha;
                        if (GATED) { const u32x2 g = *(const u32x2*)(GP + o); a[0] *= bflo(g.x); a[1] *= bfhi(g.x); a[2] *= bflo(g.y); a[3] *= bfhi(g.y); }
                        f32x4 xs;
                        if (X32) xs = *(const f32x4*)(X32 + o); else { const u32x2 xw = *(const u32x2*)(XB + o); xs = (f32x4){bflo(xw.x), bfhi(xw.x), bflo(xw.y), bfhi(xw.y)}; }
                        const f32x4 xv = xs + a;
                        u32x2 w; w.x = cvt_pk_bf16(xv[0], xv[1]); w.y = cvt_pk_bf16(xv[2], xv[3]); *(u32x2*)(XB + o) = w;
                        ss += (xv[0] * xv[0] + xv[1] * xv[1]) + (xv[2] * xv[2] + xv[3] * xv[3]);
                    }
                ss += __shfl_xor(ss, 16); ss += __shfl_xor(ss, 32);
                if (fq == 0) ssq[(size_t)u.pn * SSQ_PLANE + row * 4 + wc] = ss;
                asm volatile("" ::: "memory");
            }
    }
};
template <int ACT, int RS> struct EpiCol {
    static constexpr bool PERM = true, AFTER_DRAIN = false;
    bf16_t* O; int ldc; const float* rs;
    __device__ __forceinline__ void operator()(const f32x4 (&acc)[2][2][4][2], const Unit& u, int wr, int wc, int fr, int fq) const {
        const int row0 = u.pm * 256 + wr * 64 + fr, col0 = u.pn * 256 + wc * 32 + 8 * fq;
#pragma unroll
        for (int bj = 0; bj < 2; ++bj) {
            const int col = col0 + bj * 128; f32x4 c0, c1;
            if (RS == 0) {
#pragma unroll
                for (int e = 0; e < 4; ++e) { c0[e] = rstd16(rs, (size_t)(col + e)); asm volatile("" ::: "memory"); c1[e] = rstd16(rs, (size_t)(col + 4 + e)); asm volatile("" ::: "memory"); }
            } else { c0 = *(const f32x4*)(rs + col); c1 = *(const f32x4*)(rs + col + 4); }
#pragma unroll
            for (int ai = 0; ai < 2; ++ai)
#pragma unroll
                for (int m = 0; m < 4; ++m) {
                    f32x4 v0 = acc[ai][bj][m][0] * c0, v1 = acc[ai][bj][m][1] * c1;
                    if (ACT == 1) {
#pragma unroll
                        for (int e = 0; e < 4; ++e) { v0[e] = gelu_t(v0[e]); v1[e] = gelu_t(v1[e]); } }
                    *(u32x4*)(O + (size_t)(row0 + ai * 128 + m * 16) * ldc + col) = pack8(v0, v1);
                    asm volatile("" ::: "memory");
                }
        }
    }
};
struct EpiLru {
    static constexpr bool PERM = true, AFTER_DRAIN = false;
    const bf16_t* XC; bf16_t* LA; bf16_t* U; const float* ba; const float* bx; const float* sp8;
    __device__ __forceinline__ void operator()(const f32x4 (&acc)[2][2][4][2], const Unit& u, int wr, int wc, int fr, int fq) const {
        const int row0 = u.pm * 256 + wr * 64 + fr, ch0 = (u.pn * 256 + wc * 32 + 8 * fq) >> 1;
#pragma unroll
        for (int bj = 0; bj < 2; ++bj) {
            const int ch = ch0 + bj * 64; const f32x4 vba = *(const f32x4*)(ba + ch), vbx = *(const f32x4*)(bx + ch), vsp = *(const f32x4*)(sp8 + ch);
#pragma unroll
            for (int ai = 0; ai < 2; ++ai)
#pragma unroll
                for (int m = 0; m < 4; ++m) {
                    const int row = row0 + ai * 128 + m * 16; const size_t o = (size_t)row * DM + ch; const bool first = (row & 2047) == 0;
                    const u32x2 xw = *(const u32x2*)(XC + o); const float xc[4] = {bflo(xw.x), bfhi(xw.x), bflo(xw.y), bfhi(xw.y)};
                    const f32x4 v0 = acc[ai][bj][m][0], v1 = acc[ai][bj][m][1]; const float ga[4] = {v0[0], v0[2], v1[0], v1[2]}, gx[4] = {v0[1], v0[3], v1[1], v1[3]};
                    float la[4], uu[4];
#pragma unroll
                    for (int e = 0; e < 4; ++e) { const float r = sigm(ga[e] + vba[e]), ig = sigm(gx[e] + vbx[e]); la[e] = -vsp[e] * r;
                        const float a2 = fexp2(2.f * LOG2E * la[e]); const float mult = first ? 1.f : sqrtf(fmaxf(1.f - a2, 0.f)); uu[e] = mult * ig * xc[e]; }
                    u32x2 wl, wu; wl.x = cvt_pk_bf16(la[0], la[1]); wl.y = cvt_pk_bf16(la[2], la[3]); wu.x = cvt_pk_bf16(uu[0], uu[1]); wu.y = cvt_pk_bf16(uu[2], uu[3]);
                    *(u32x2*)(LA + o) = wl; *(u32x2*)(U + o) = wu;
                    asm volatile("" ::: "memory");
                }
        }
    }
};
struct EpiQ {
    static constexpr bool PERM = true, AFTER_DRAIN = false;
    bf16_t* Q; const float* rsq; const float* rope;
    __device__ __forceinline__ void operator()(const f32x4 (&acc)[2][2][4][2], const Unit& u, int wr, int wc, int fr, int fq) const {
        const int row0 = u.pm * 256 + wr * 64 + fr, col0 = u.pn * 256 + wc * 32 + 8 * fq;
#pragma unroll
        for (int ai = 0; ai < 2; ++ai)
#pragma unroll
            for (int m = 0; m < 4; ++m) {
                const int row = row0 + ai * 128 + m * 16; const float s = rsq[row] * QSCALE; const int pos = row & 2047;
#pragma unroll
                for (int bj = 0; bj < 2; ++bj) {
                    const int col = col0 + bj * 128, d = col % 96; f32x4 v0 = acc[ai][bj][m][0] * s, v1 = acc[ai][bj][m][1] * s;
                    if (d >= 64) { const int i0 = (d - 64) >> 1; const f32x4 t0 = *(const f32x4*)(rope + (pos * 16 + i0) * 2), t1 = *(const f32x4*)(rope + (pos * 16 + i0 + 2) * 2);
                        const f32x4 a = v0, b = v1;
                        v0[0] = a[0] * t0[0] - a[1] * t0[1]; v0[1] = a[0] * t0[1] + a[1] * t0[0]; v0[2] = a[2] * t0[2] - a[3] * t0[3]; v0[3] = a[2] * t0[3] + a[3] * t0[2];
                        v1[0] = b[0] * t1[0] - b[1] * t1[1]; v1[1] = b[0] * t1[1] + b[1] * t1[0]; v1[2] = b[2] * t1[2] - b[3] * t1[3]; v1[3] = b[2] * t1[3] + b[3] * t1[2]; }
                    *(u32x4*)(Q + (size_t)row * 1536 + col) = pack8(v0, v1);
                }
                asm volatile("" ::: "memory");
            }
    }
};
struct EpiMerge {
    static constexpr bool PERM = true, AFTER_DRAIN = false;
    const bf16_t* G3; bf16_t* MG;
    __device__ __forceinline__ void operator()(const f32x4 (&acc)[2][2][4][2], const Unit& u, int wr, int wc, int fr, int fq) const {
        const int row0 = u.pm * 256 + wr * 64 + fr, col0 = u.pn * 256 + wc * 32 + 8 * fq, mcol0 = (u.pn & 3) * 256 + wc * 32 + 8 * fq; const bool first = u.pn < 4;
#pragma unroll
        for (int ai = 0; ai < 2; ++ai)
#pragma unroll
            for (int m = 0; m < 4; ++m) {
                const size_t row = (size_t)(row0 + ai * 128 + m * 16);
#pragma unroll
                for (int bj = 0; bj < 2; ++bj) {
                    f32x4 g0, g1; unpack8(*(const u32x4*)(G3 + row * 3072 + col0 + bj * 128), g0, g1);
                    f32x4 v0 = acc[ai][bj][m][0] * g0, v1 = acc[ai][bj][m][1] * g1;
                    if (!first) { f32x4 p0, p1; unpack8(*(const u32x4*)(MG + row * DM + mcol0 + bj * 128), p0, p1); v0 += p0; v1 += p1; }
                    *(u32x4*)(MG + row * DM + mcol0 + bj * 128) = pack8(v0, v1);
                }
                asm volatile("" ::: "memory");
            }
    }
};
enum { MAP_ID = 0, MAP_SWIGLU, MAP_WIN, MAP_UQ, MAP_KVK, MAP_KVV, MAP_GATES };
struct Job { const float* W; const float* gain; bf16_t* dst; int ldw, K, dN, map, off; };
__device__ __forceinline__ int srcmap(int map, int off, int n) {
    switch (map) {
    case MAP_SWIGLU: return (n >> 8) * 128 + (n & 127) + ((n & 128) ? DFF : 0);
    case MAP_WIN: if (n < 2048) return n; if (n < 3072) return 2720 + (n - 2048); if (n < 3328) return 2432 + (n - 3072); if (n < 3712) return 2048 + (n - 3328);
                  if (n < 3744) { const int j = n - 3712, i = j >> 1; return 2688 + ((j & 1) ? 16 + i : i); } return -1;
    case MAP_UQ: { const int h = n / 96, d = n % 96; if (d < 64) return n; const int j = d - 64, i = j >> 1; return h * 96 + 64 + ((j & 1) ? 16 + i : i); }
    case MAP_KVK: return (n >> 6) * 128 + (n & 63);
    case MAP_KVV: return (n >> 6) * 128 + 64 + (n & 63);
    case MAP_GATES: return 4768 + (n < 1024 ? n + 1024 : (n < 2048 ? n - 1024 : n));
    default: return n + off;
    }
}
#define JOB(Wp, GAIN, DST, LDW, KK, DN, MAP, OFF) do { J.W = (Wp); J.gain = (GAIN); J.dst = wb + (DST); J.ldw = (LDW); J.K = (KK); J.dN = (DN); J.map = (MAP); J.off = (OFF); } while (0)
__device__ __forceinline__ void get_job(const Params& p, int L, int j, bf16_t* wb, Job& J) {
    const size_t M1 = 1024 * 1024;
    switch (j) {
    case 0: JOB(p.in[3] + (size_t)L * 1024 * 5632, p.in[2] + L * 1024, O_WGU1, 5632, 1024, 5632, MAP_SWIGLU, 0); break;
    case 1: JOB(p.in[4] + (size_t)L * 2816 * 1024, nullptr, O_WD1, 1024, 2816, 1024, MAP_ID, 0); break;
    case 2: JOB(p.in[6] + (size_t)L * 1024 * 7840, p.in[5] + L * 1024, O_WIN, 7840, 1024, 3840, MAP_WIN, 0); break;
    case 3: JOB(p.in[6] + (size_t)L * 1024 * 7840, p.in[5] + L * 1024, O_WINV, 7840, 1024, 1024, MAP_ID, 3744); break;
    case 4: JOB(p.in[6] + (size_t)L * 1024 * 7840, p.in[5] + L * 1024, O_WING, 7840, 1024, 3072, MAP_GATES, 0); break;
    case 5: JOB(p.in[14] + L * M1, nullptr, O_WRB, 1024, 1024, 1024, MAP_ID, 0); break;
    case 6: JOB(p.in[19] + L * M1, nullptr, O_WRA, 1024, 1024, 1024, MAP_ID, 0); break;
    case 7: JOB(p.in[24] + L * M1, nullptr, O_WRC, 1024, 1024, 1024, MAP_ID, 0); break;
    case 8: JOB(p.in[26] + L * M1, nullptr, O_WOUT, 1024, 1024, 1024, MAP_ID, 0); break;
    case 9: JOB(p.in[31] + L * M1, p.in[30] + L * 1024, O_WPG, 1024, 1024, 1024, MAP_ID, 0); break;
    case 10: JOB(p.in[16] + (size_t)L * 384 * 1536, p.in[15] + L * 384, O_WUQ, 1536, 384, 1536, MAP_UQ, 0); break;
    case 11: JOB(p.in[18] + (size_t)L * 256 * 2048, p.in[17] + L * 256, O_WKVK, 2048, 256, 1024, MAP_KVK, 0); break;
    case 12: JOB(p.in[18] + (size_t)L * 256 * 2048, p.in[17] + L * 256, O_WKVV, 2048, 256, 1024, MAP_KVV, 0); break;
    case 13: JOB(p.in[28] + (size_t)L * 1024 * 5632, p.in[27] + L * 1024, O_WGU2, 5632, 1024, 5632, MAP_SWIGLU, 0); break;
    case 14: JOB(p.in[29] + (size_t)L * 2816 * 1024, nullptr, O_WD2, 1024, 2816, 1024, MAP_ID, 0); break;
    default: JOB(p.in[32] + (size_t)L * 256 * 1024, nullptr, O_WPLE, 1024, 256, 1024, MAP_ID, 0); break;
    }
}
constexpr int NJOBS = 16;
__device__ __forceinline__ void tr_item(const Job& J, int item, LAS float* scr, int lane) {
    const int nblk = J.dN >> 5, kb = item / nblk, nb = item % nblk, k0 = 64 * kb, n0 = 32 * nb;
    const int sc = srcmap(J.map, J.off, n0 + (lane & 31));
#pragma unroll 8
    for (int i = 0; i < 32; ++i) { const int kk = 2 * i + (lane >> 5); float v = (sc >= 0) ? J.W[(size_t)(k0 + kk) * J.ldw + sc] : 0.f; if (J.gain) v *= J.gain[k0 + kk]; scr[kk * 33 + (lane & 31)] = v; }
    asm volatile("s_waitcnt lgkmcnt(0)" ::: "memory");
    const int c = lane & 7;
#pragma unroll
    for (int j = 0; j < 4; ++j) { const int n = (lane >> 3) + 8 * j; const LAS float* s = scr + (8 * c) * 33 + n;
        u32x4 o; o.x = cvt_pk_bf16(s[0 * 33], s[1 * 33]); o.y = cvt_pk_bf16(s[2 * 33], s[3 * 33]); o.z = cvt_pk_bf16(s[4 * 33], s[5 * 33]); o.w = cvt_pk_bf16(s[6 * 33], s[7 * 33]);
        *(u32x4*)(J.dst + (size_t)(n0 + n) * J.K + k0 + 8 * c) = o; }
    asm volatile("s_waitcnt lgkmcnt(0)" ::: "memory");
}
__device__ __forceinline__ void phase0(const Params& p, int L, LAS unsigned char* lds, int G, int blk) {
    const int tid = pg8::tid_opaque(), lane = tid & 63, wave = tid >> 6;
    const int gw = blk * 8 + wave, NGW = G * 8, gt = blk * 512 + tid, NGT = G * 512;
    bf16_t* wb = (bf16_t*)(p.ws + WS_W);
    LAS float* scr = (LAS float*)(lds + wave * 8448);
    int total = 0;
    for (int j = 0; j < NJOBS; ++j) { Job J; get_job(p, L, j, wb, J); total += (J.K >> 6) * (J.dN >> 5); }
    for (int it = gw; it < total; it += NGW) {
        int r = it;
        for (int j = 0; j < NJOBS; ++j) { Job J; get_job(p, L, j, wb, J); const int n = (J.K >> 6) * (J.dN >> 5); if (r < n) { tr_item(J, r, scr, lane); break; } r -= n; }
    }
    { bf16_t* d = wb + O_WLRU; const float* wa = p.in[9] + (size_t)L * 65536; const float* wx = p.in[11] + (size_t)L * 65536;
      for (int i = gt; i < 2048 * 128; i += NGT) { const int n = i >> 7, k = i & 127, ch = n >> 1, nb = ch >> 6, dd = ch & 63;
          float v = 0.f; if ((k >> 6) == (nb & 1)) v = ((n & 1) ? wx : wa)[(size_t)nb * 4096 + (k & 63) * 64 + dd]; d[i] = f2bf(v); } }
    { bf16_t* d = wb + O_WSGU; const float* w = p.in[22] + (size_t)L * 131072;
      for (int i = gt; i < 131072; i += NGT) { const int t = (i >> 7) & 127, s = i & 127; d[i] = f2bf(((s >> 6) <= (t >> 6)) ? w[i] : 0.f); } }
    { float* sp = (float*)(p.ws + WS_SMALL + SM_SP8); const float* lam = p.in[13] + L * 1024;
      for (int i = gt; i < 1024; i += NGT) sp[i] = 8.f * 0.6931471805599453f * __builtin_amdgcn_logf(1.f + fexp2(-LOG2E * lam[i])); }
    if (L == 0) {
        float* rope = (float*)(p.ws + WS_SMALL + SM_ROPE);
        for (int i = gt; i < 2048 * 16; i += NGT) { const int pos = i >> 4, k = i & 15; const float inv = fexp2(-(float)k * (13.287712379549449f / 16.f)); const float ang = (float)pos * inv;
            double rev = (double)ang * 0.15915494309189535; rev -= floor(rev); const float fr = (float)rev; rope[2 * i] = __builtin_amdgcn_cosf(fr); rope[2 * i + 1] = __builtin_amdgcn_sinf(fr); }
        const float* x = p.in[0]; bf16_t* XB = (bf16_t*)(p.ws + WS_XB); float* ssq = (float*)(p.ws + WS_SSQ);
        for (int m = gw; m < T; m += NGW) {
            const f32x4* xr = (const f32x4*)(x + (size_t)m * DM) + lane; u32x2* o8 = (u32x2*)(XB + (size_t)m * DM) + lane; float s = 0.f;
#pragma unroll
            for (int j = 0; j < 4; ++j) { const f32x4 v = xr[64 * j]; s += (v[0] * v[0] + v[1] * v[1]) + (v[2] * v[2] + v[3] * v[3]); u32x2 w; w.x = cvt_pk_bf16(v[0], v[1]); w.y = cvt_pk_bf16(v[2], v[3]); o8[64 * j] = w; }
            s = wave_sum(s);
            if (lane < 16) ssq[(size_t)(lane >> 2) * SSQ_PLANE + (size_t)m * 4 + (lane & 3)] = (lane == 0) ? s : 0.f;
        }
    }
}

__device__ __forceinline__ void pb_convert(const Params& p, int L, int G, int blk) {
    const int tid = pg8::tid_opaque(), gt = blk * 512 + tid, NGT = G * 512;
    const f32x4* src = (const f32x4*)(p.in[1] + (size_t)L * T * 256); u32x2* d = (u32x2*)(p.ws + WS_BIG + B_PB);
    for (int i = gt; i < T * 256 / 4; i += NGT) { const f32x4 v = src[i]; u32x2 w; w.x = cvt_pk_bf16(v[0], v[1]); w.y = cvt_pk_bf16(v[2], v[3]); d[i] = w; }
}
__device__ __forceinline__ void e1_rows(const Params& p, int L, const bf16_t* Z, bf16_t* XC, float* RSQ, float* RSKV, bf16_t* KR, const float* rope, int G, int blk) {
    const int tid = pg8::tid_opaque(), lane = tid & 63, wave = tid >> 6, gw = blk * 8 + wave, NGW = G * 8;
    const float* cw = p.in[7] + (size_t)L * 4096; const float* cb = p.in[8] + L * 1024;
    for (int rb = blk * 64 + wave * 8; rb < TC; rb += G * 64)
    for (int r = rb; r < rb + 8; ++r) {
        const bf16_t* zr = Z + (size_t)r * ZLD; const int pos = r & 2047;
#pragma unroll
        for (int hf = 0; hf < 2; ++hf) {
            const int c0 = hf * 512 + 8 * lane; f32x4 a0 = *(const f32x4*)(cb + c0), a1 = *(const f32x4*)(cb + c0 + 4);
#pragma unroll
            for (int k = 0; k < 4; ++k) { if (pos - 3 + k >= 0) { f32x4 x0, x1; unpack8(*(const u32x4*)(zr + (ptrdiff_t)(k - 3) * ZLD + ZC_XA + c0), x0, x1);
                a0 += *(const f32x4*)(cw + k * 1024 + c0) * x0; a1 += *(const f32x4*)(cw + k * 1024 + c0 + 4) * x1; } }
            *(u32x4*)(XC + (size_t)r * DM + c0) = pack8(a0, a1);
        }
        float sq = 0.f;
        if (lane < 48) { f32x4 x0, x1; unpack8(*(const u32x4*)(zr + ZC_CQ + 8 * lane), x0, x1); sq = (x0[0] * x0[0] + x0[1] * x0[1]) + (x0[2] * x0[2] + x0[3] * x0[3]) + (x1[0] * x1[0] + x1[1] * x1[1]) + (x1[2] * x1[2] + x1[3] * x1[3]); }
        sq = wave_sum(sq);
        float sk; { const u32x2 w = *(const u32x2*)(zr + ZC_CKV + 4 * lane); const float a = bflo(w.x), b = bfhi(w.x), c = bflo(w.y), d = bfhi(w.y); sk = (a * a + b * b) + (c * c + d * d); }
        sk = wave_sum(sk);
        if (lane == 0) { RSQ[r] = __builtin_amdgcn_rsqf(sq * (1.f / 384.f) + EPS); RSKV[r] = __builtin_amdgcn_rsqf(sk * (1.f / 256.f) + EPS); }
        if (lane < 16) { const unsigned w = *(const unsigned*)(zr + ZC_KR + 2 * lane); const float x1 = bflo(w), x2 = bfhi(w); const f32x2 cs = *(const f32x2*)(rope + (pos * 16 + lane) * 2);
            *(unsigned*)(KR + (size_t)r * 32 + 2 * lane) = cvt_pk_bf16(x1 * cs[0] - x2 * cs[1], x1 * cs[1] + x2 * cs[0]); }
    }
}
__device__ __forceinline__ void e2_stats(LAS unsigned char* lds, const bf16_t* VTS, float* MEANV, float* RSTDV, int G, int blk) {
    const int tid = pg8::tid_opaque(), lane = tid & 63, wave = tid >> 6, tg = lane & 7, cr = lane >> 3;
    LAS float* part = (LAS float*)lds;
    for (int unit = blk; unit < TC / 64; unit += G) {
        const int tok0 = unit * 64; float s[8], q[8];
#pragma unroll
        for (int e = 0; e < 8; ++e) { s[e] = 0.f; q[e] = 0.f; }
#pragma unroll 4
        for (int it = 0; it < 16; ++it) { const int c = wave * 128 + it * 8 + cr; f32x4 x0, x1; unpack8(*(const u32x4*)(VTS + (size_t)c * TC + tok0 + 8 * tg), x0, x1);
#pragma unroll
            for (int e = 0; e < 4; ++e) { s[e] += x0[e]; q[e] += x0[e] * x0[e]; s[4 + e] += x1[e]; q[4 + e] += x1[e] * x1[e]; } }
#pragma unroll
        for (int e = 0; e < 8; ++e) { s[e] += __shfl_xor(s[e], 8); s[e] += __shfl_xor(s[e], 16); s[e] += __shfl_xor(s[e], 32); q[e] += __shfl_xor(q[e], 8); q[e] += __shfl_xor(q[e], 16); q[e] += __shfl_xor(q[e], 32); }
        if (cr == 0) {
#pragma unroll
            for (int e = 0; e < 8; ++e) { part[(wave * 64 + 8 * tg + e) * 2] = s[e]; part[(wave * 64 + 8 * tg + e) * 2 + 1] = q[e]; } }
        __syncthreads();
        if (tid < 64) { float ss = 0.f, qq = 0.f;
#pragma unroll
            for (int w = 0; w < 8; ++w) { ss += part[(w * 64 + tid) * 2]; qq += part[(w * 64 + tid) * 2 + 1]; }
            const float mean = ss * (1.f / 1024.f); const float var = fmaxf(qq * (1.f / 1024.f) - mean * mean, 0.f);
            MEANV[tok0 + tid] = mean; RSTDV[tok0 + tid] = __builtin_amdgcn_rsqf(var + EPS); }
        __syncthreads();
    }
}
__device__ __forceinline__ void scan_units(LAS unsigned char* lds, const bf16_t* LA, const bf16_t* U, bf16_t* Z, int G, int blk) {
    const int tid = pg8::tid_opaque(), cp = tid & 15, seg = tid >> 4;
    LAS f32x4* sc = (LAS f32x4*)lds;
    for (int idx = blk; idx < 256; idx += G) {
        const int b = idx >> 5, ch = (idx & 31) * 32 + 2 * cp; const size_t row0 = (size_t)b * 2048 + seg * 64;
        const unsigned* lap = (const unsigned*)(LA + row0 * DM + ch); const unsigned* up = (const unsigned*)(U + row0 * DM + ch);
        float h0 = 0.f, h1 = 0.f, s0 = 0.f, s1 = 0.f;
#pragma unroll 16
        for (int t = 0; t < 64; ++t) { const unsigned lw = lap[(size_t)t * 512], uw = up[(size_t)t * 512]; const float l0 = bflo(lw), l1 = bfhi(lw);
            h0 = fexp2(LOG2E * l0) * h0 + bflo(uw); h1 = fexp2(LOG2E * l1) * h1 + bfhi(uw); s0 += l0; s1 += l1; }
        sc[seg * 16 + cp] = (f32x4){s0, s1, h0, h1};
        __syncthreads();
        float c0 = 0.f, c1 = 0.f;
        for (int j = 0; j < seg; ++j) { const f32x4 v = sc[j * 16 + cp]; c0 = fexp2(LOG2E * v[0]) * c0 + v[2]; c1 = fexp2(LOG2E * v[1]) * c1 + v[3]; }
        h0 = c0; h1 = c1;
        unsigned* gp = (unsigned*)(Z + row0 * ZLD + ZC_GA + ch);
#pragma unroll 16
        for (int t = 0; t < 64; ++t) { const unsigned lw = lap[(size_t)t * 512], uw = up[(size_t)t * 512], gw = gp[(size_t)t * (ZLD / 2)];
            h0 = fexp2(LOG2E * bflo(lw)) * h0 + bflo(uw); h1 = fexp2(LOG2E * bfhi(lw)) * h1 + bfhi(uw); gp[(size_t)t * (ZLD / 2)] = cvt_pk_bf16(h0 * bflo(gw), h1 * bfhi(gw)); }
        __syncthreads();
    }
}
__device__ __forceinline__ void attn_units(LAS unsigned char* lds, const bf16_t* Q, const bf16_t* KN, const bf16_t* KR, const bf16_t* VT, bf16_t* Z, int G, int blk) {
    const int tid = pg8::tid_opaque(), lane = tid & 63, wid = __builtin_amdgcn_readfirstlane(tid >> 6), i32 = lane & 31, hi = lane >> 5;
    constexpr int KP = 208, VP = 144, KBUF = 64 * KP, VBUF = 64 * VP;
    for (int idx = blk; idx < 1024; idx += G) {
        const int j = idx & 255, rnd = idx >> 8, bh = j >> 1;
        const int qb = (j & 1) ? (rnd == 0 ? 1 : rnd == 1 ? 6 : rnd == 2 ? 3 : 4) : (rnd == 0 ? 0 : rnd == 1 ? 7 : rnd == 2 ? 2 : 5);
        const int b = bh >> 4, h = bh & 15, q0 = qb * 256, NT = q0 / 64 + 4, ntw = (q0 + 32 * wid) / 64 + 1;
        const size_t rowb = (size_t)b * 2048;
        bf16x8 qr[6];
        { const bf16_t* qp = Q + (rowb + q0 + 32 * wid + i32) * 1536 + h * 96 + 8 * hi;
#pragma unroll
          for (int ks = 0; ks < 6; ++ks) qr[ks] = *(const bf16x8*)(qp + 16 * ks); }
        const bf16_t* kns = KN + (rowb + (tid >> 3)) * DM + h * 64 + 8 * (tid & 7);
        const bf16_t* krs = KR + (rowb + (tid >> 2)) * 32 + 8 * (tid & 3);
        const bf16_t* vts = VT + (size_t)(h * 64 + (tid >> 3)) * TC + rowb + 8 * (tid & 7);
        const int kdst = (tid >> 3) * KP + (tid & 7) * 16, krdst = (tid >> 2) * KP + 128 + (tid & 3) * 16, vdst = 2 * KBUF + (tid >> 3) * VP + (tid & 7) * 16;
        u32x4 rk, rr = (u32x4){0u, 0u, 0u, 0u}, rv;
        rk = *(const u32x4*)kns; if (tid < 256) rr = *(const u32x4*)krs; rv = *(const u32x4*)vts;
        *(LAS u32x4*)(lds + kdst) = rk; if (tid < 256) *(LAS u32x4*)(lds + krdst) = rr; *(LAS u32x4*)(lds + vdst) = rv;
        __syncthreads();
        f32x16 o0, o1;
#pragma unroll
        for (int r = 0; r < 16; ++r) { o0[r] = 0.f; o1[r] = 0.f; }
        float mrun = -1e30f, lrun = 0.f;
        for (int t = 0; t < NT; ++t) {
            const int cur = t & 1; const bool more = (t + 1 < NT);
            if (more) { rk = *(const u32x4*)(kns + (size_t)(t + 1) * 64 * DM); if (tid < 256) rr = *(const u32x4*)(krs + (size_t)(t + 1) * 64 * 32); rv = *(const u32x4*)(vts + (size_t)(t + 1) * 64); }
            if (t < ntw) {
                LAS const unsigned char* kb = lds + cur * KBUF; LAS const unsigned char* vb = lds + 2 * KBUF + cur * VBUF;
                f32x16 s0, s1;
#pragma unroll
                for (int r = 0; r < 16; ++r) { s0[r] = 0.f; s1[r] = 0.f; }
#pragma unroll
                for (int ks = 0; ks < 6; ++ks) {
                    const bf16x8 a0 = *(LAS const bf16x8*)(kb + i32 * KP + (16 * ks + 8 * hi) * 2), a1 = *(LAS const bf16x8*)(kb + (32 + i32) * KP + (16 * ks + 8 * hi) * 2);
                    s0 = __builtin_amdgcn_mfma_f32_32x32x16_bf16(a0, qr[ks], s0, 0, 0, 0); s1 = __builtin_amdgcn_mfma_f32_32x32x16_bf16(a1, qr[ks], s1, 0, 0, 0);
                }
                float mx = fmaxf(s0[0], s1[0]);
#pragma unroll
                for (int r = 1; r < 16; ++r) mx = fmaxf(mx, fmaxf(s0[r], s1[r]));
                mx = fmaxf(mx, __shfl_xor(mx, 32));
                const float mn = fmaxf(mrun, mx), alpha = fexp2(mrun - mn); mrun = mn;
                float rs = 0.f;
#pragma unroll
                for (int r = 0; r < 16; ++r) { s0[r] = fexp2(s0[r] - mn); s1[r] = fexp2(s1[r] - mn); rs += s0[r] + s1[r]; }
                lrun = lrun * alpha + rs;
#pragma unroll
                for (int r = 0; r < 16; ++r) { o0[r] *= alpha; o1[r] *= alpha; }
                bf16x8 pf[2][2];
#pragma unroll
                for (int uu = 0; uu < 2; ++uu) {
                    u32x4 w0, w1;
                    w0.x = cvt_pk_bf16(s0[8 * uu + 0], s0[8 * uu + 1]); w0.y = cvt_pk_bf16(s0[8 * uu + 2], s0[8 * uu + 3]); w0.z = cvt_pk_bf16(s0[8 * uu + 4], s0[8 * uu + 5]); w0.w = cvt_pk_bf16(s0[8 * uu + 6], s0[8 * uu + 7]);
                    w1.x = cvt_pk_bf16(s1[8 * uu + 0], s1[8 * uu + 1]); w1.y = cvt_pk_bf16(s1[8 * uu + 2], s1[8 * uu + 3]); w1.z = cvt_pk_bf16(s1[8 * uu + 4], s1[8 * uu + 5]); w1.w = cvt_pk_bf16(s1[8 * uu + 6], s1[8 * uu + 7]);
                    pf[0][uu] = __builtin_bit_cast(bf16x8, w0); pf[1][uu] = __builtin_bit_cast(bf16x8, w1);
                }
#pragma unroll
                for (int tt = 0; tt < 2; ++tt)
#pragma unroll
                    for (int uu = 0; uu < 2; ++uu) {
                        LAS const unsigned char* vp0 = vb + i32 * VP + (32 * tt + 16 * uu + 4 * hi) * 2; LAS const unsigned char* vp1 = vp0 + 32 * VP;
                        const u32x2 a = *(LAS const u32x2*)vp0, bq = *(LAS const u32x2*)(vp0 + 16), c = *(LAS const u32x2*)vp1, d = *(LAS const u32x2*)(vp1 + 16);
                        const bf16x8 vf0 = __builtin_bit_cast(bf16x8, ((u32x4){a.x, a.y, bq.x, bq.y})), vf1 = __builtin_bit_cast(bf16x8, ((u32x4){c.x, c.y, d.x, d.y}));
                        o0 = __builtin_amdgcn_mfma_f32_32x32x16_bf16(vf0, pf[tt][uu], o0, 0, 0, 0); o1 = __builtin_amdgcn_mfma_f32_32x32x16_bf16(vf1, pf[tt][uu], o1, 0, 0, 0);
                    }
            }
            if (more) { const int nb = cur ^ 1; *(LAS u32x4*)(lds + nb * KBUF + kdst) = rk; if (tid < 256) *(LAS u32x4*)(lds + nb * KBUF + krdst) = rr; *(LAS u32x4*)(lds + nb * VBUF + vdst) = rv; }
            __syncthreads();
        }
        lrun += __shfl_xor(lrun, 32); const float inv = frcp(lrun);
        bf16_t* op = Z + (rowb + q0 + 32 * wid + i32) * ZLD + ZC_XA + h * 64 + 4 * hi;
#pragma unroll
        for (int rg = 0; rg < 4; ++rg) {
            u32x2 w; w.x = cvt_pk_bf16(o0[4 * rg] * inv, o0[4 * rg + 1] * inv); w.y = cvt_pk_bf16(o0[4 * rg + 2] * inv, o0[4 * rg + 3] * inv); *(u32x2*)(op + 8 * rg) = w;
            w.x = cvt_pk_bf16(o1[4 * rg] * inv, o1[4 * rg + 1] * inv); w.y = cvt_pk_bf16(o1[4 * rg + 2] * inv, o1[4 * rg + 3] * inv); *(u32x2*)(op + 32 + 8 * rg) = w;
        }
    }
}
__device__ __forceinline__ void sgu_units(LAS unsigned char* lds, const bf16_t* VTS, const float* MEANV, const float* RSTDV, const float* lng, const float* lnb, const bf16_t* WS, const float* bs, bf16_t* Z, int G, int blk) {
    const int tid = pg8::tid_opaque(), lane = tid & 63, wid = __builtin_amdgcn_readfirstlane(tid >> 6), i32 = lane & 31, hi = lane >> 5;
    constexpr int AP = 272;
    for (int idx = blk; idx < 1024; idx += G) {
        const int tb = idx >> 3, g = idx & 7, tok0 = tb * 128;
#pragma unroll
        for (int jj = 0; jj < 4; ++jj) {
            const int id = tid + 512 * jj, c = id >> 4, sc = id & 15; f32x4 x0, x1; unpack8(*(const u32x4*)(VTS + (size_t)(g * 128 + c) * TC + tok0 + 8 * sc), x0, x1);
            const f32x4 m0 = *(const f32x4*)(MEANV + tok0 + 8 * sc), m1 = *(const f32x4*)(MEANV + tok0 + 8 * sc + 4), r0 = *(const f32x4*)(RSTDV + tok0 + 8 * sc), r1 = *(const f32x4*)(RSTDV + tok0 + 8 * sc + 4);
            const float ga = lng[g * 128 + c], be = lnb[g * 128 + c];
            x0 = (x0 - m0) * r0 * ga + be; x1 = (x1 - m1) * r1 * ga + be;
            *(LAS u32x4*)(lds + c * AP + sc * 16) = pack8(x0, x1);
        }
        __syncthreads();
        const int tt = wid & 3; bf16x8 wf[8];
        { const bf16_t* wp = WS + (size_t)(g * 128 + 32 * tt + i32) * 128 + 8 * hi;
#pragma unroll
          for (int ks = 0; ks < 8; ++ks) wf[ks] = *(const bf16x8*)(wp + 16 * ks); }
        const float bsv = bs[g * 128 + 32 * tt + i32];
#pragma unroll
        for (int cc = 0; cc < 2; ++cc) {
            const int ct = 2 * (wid >> 2) + cc; f32x16 acc;
#pragma unroll
            for (int r = 0; r < 16; ++r) acc[r] = 0.f;
#pragma unroll
            for (int ks = 0; ks < 8; ++ks) { const bf16x8 a = *(LAS const bf16x8*)(lds + (32 * ct + i32) * AP + (16 * ks + 8 * hi) * 2); acc = __builtin_amdgcn_mfma_f32_32x32x16_bf16(a, wf[ks], acc, 0, 0, 0); }
            bf16_t* up = Z + (size_t)(tok0 + 32 * tt + i32) * ZLD + ZC_U + g * 128 + 32 * ct + 4 * hi;
#pragma unroll
            for (int rg = 0; rg < 4; ++rg) { const u32x2 uv = *(const u32x2*)(up + 8 * rg); u32x2 w;
                w.x = cvt_pk_bf16((acc[4 * rg] + bsv) * bflo(uv.x), (acc[4 * rg + 1] + bsv) * bfhi(uv.x)); w.y = cvt_pk_bf16((acc[4 * rg + 2] + bsv) * bflo(uv.y), (acc[4 * rg + 3] + bsv) * bfhi(uv.y)); *(u32x2*)(up + 8 * rg) = w; }
        }
        __syncthreads();
    }
}

#ifndef DBG_DUMP
#define DBG_DUMP 0
#define DBG_CH 0
#define DBG_TWICE 0
#define DBG_SKIP56 0
#endif
__device__ __forceinline__ void dbg_add(float* out, const bf16_t* buf, size_t n, bool first, int G, int blk) {
    const size_t gt = (size_t)blk * 512 + pg8::tid_opaque(), NGT = (size_t)G * 512;
    for (size_t i = gt; i < (size_t)T * DM; i += NGT) { float v = 0.f; for (size_t j = i; j < n; j += (size_t)T * DM) v += __uint_as_float((unsigned)buf[j] << 16); out[i] = first ? v : out[i] + v; }
}
__device__ __forceinline__ void dbg_addf(float* out, const float* buf, size_t n, int G, int blk) {
    const size_t gt = (size_t)blk * 512 + pg8::tid_opaque(), NGT = (size_t)G * 512;
    for (size_t i = gt; i < (size_t)T * DM; i += NGT) out[i] += buf[i % n];
}
#define APS 0
#define RUN_GEMM(EPI, e, Ap, Bp, M_, N_, K_, lda_, ldb_, apn_) do { int K__ = (K_), blk__ = blk; asm volatile("" : "+s"(K__), "+s"(blk__)); pg8::Gemm gg{(Ap), (Bp), (M_), (N_), K__, (lda_), (ldb_), (apn_), APS}; pg8::StaticOrder SO; SO.init((M_), (N_), G, blk__); \
    pg8::gemm_phase<decltype(e), pg8::StaticOrder, true, true>(lds, gg, SO, e); } while (0)

constexpr size_t SM_BAR = 1024 * 1024;
#define XB_TMO      128
#define XB_XCNT(j)  (256  + 64 * (j))
#define XB_XSUB(j)  (1280 + 64 * (j))
#define XB_XGEN(j)  (2304 + 64 * (j))
#define XB_TOP      3328
#define XB_TOPGEN   3392
#define XCD_BAR_WORDS 3456
#define XB_SPIN_CAP (1u << 18)

__device__ __forceinline__ unsigned xb_ld(unsigned* p)              { return __hip_atomic_load(p, __ATOMIC_RELAXED, __HIP_MEMORY_SCOPE_AGENT); }
__device__ __forceinline__ unsigned xb_add(unsigned* p, unsigned v) { return __hip_atomic_fetch_add(p, v, __ATOMIC_RELAXED, __HIP_MEMORY_SCOPE_AGENT); }
__device__ __forceinline__ unsigned xb_xcc_id() { return (unsigned)__builtin_amdgcn_s_getreg((3 << 11) | 20) & 0xFu; }
#define XB_SPIN(cond, bar) do { unsigned _sp = 0; while (cond) { __builtin_amdgcn_s_sleep(1); \
    if ((++_sp & 255u) == 0u) { if (xb_ld(&(bar)[XB_TMO])) break; if (_sp > XB_SPIN_CAP) { atomicAdd(&(bar)[XB_TMO], 1u); break; } } } } while (0)

struct XcdBarrier {
    unsigned* bar; unsigned x;
    volatile __attribute__((address_space(3))) unsigned* st;
};

__device__ __forceinline__ XcdBarrier xcd_barrier_post(unsigned* bar, volatile __attribute__((address_space(3))) unsigned* st) {
    XcdBarrier b; b.bar = bar; b.x = xb_xcc_id(); b.st = st;
    if (threadIdx.x == 0) (void)xb_add(&bar[XB_XCNT(b.x)], 1u);
    return b;
}
__device__ __forceinline__ void xcd_barrier_complete(unsigned* bar, unsigned x, unsigned& nloc, unsigned& nx) {
    const unsigned G = gridDim.x * gridDim.y * gridDim.z;
    unsigned sum, cnt, mine, sp = 0u;
    for (;;) {
        sum = 0u; cnt = 0u; mine = 0u;
#pragma unroll
        for (unsigned j = 0; j < 16; ++j) { const unsigned c = xb_ld(&bar[XB_XCNT(j)]); sum += c; cnt += (c > 0u) ? 1u : 0u; mine = (j == x) ? c : mine; }
        if (sum == G) break;
        __builtin_amdgcn_s_sleep(1);
        if ((++sp & 255u) == 0u) { if (xb_ld(&bar[XB_TMO])) break; if (sp > XB_SPIN_CAP) { atomicAdd(&bar[XB_TMO], 1u); break; } }
    }
    nloc = mine > 0u ? mine : 1u; nx = cnt > 0u ? cnt : 1u;
}

__device__ __forceinline__ void xcd_barrier(const XcdBarrier& b) {
    asm volatile("s_waitcnt vmcnt(0)" ::: "memory");
    __syncthreads();
    if (threadIdx.x == 0) {
        unsigned* bar = b.bar;
        __builtin_amdgcn_s_waitcnt(0);
        unsigned nloc = b.st[0], nx = b.st[1];
        if (nloc == 0u) { xcd_barrier_complete(bar, b.x, nloc, nx); b.st[0] = nloc; b.st[1] = nx; }
        const unsigned old = xb_add(&bar[XB_XSUB(b.x)], 1u);
        const unsigned gen = old / nloc;
        if (old + 1u == (gen + 1u) * nloc) {
            __builtin_amdgcn_fence(__ATOMIC_RELEASE, "agent");
            asm volatile("s_waitcnt vmcnt(0)" ::: "memory");
            const unsigned og = xb_add(&bar[XB_TOP], 1u);
            const unsigned tg = og / nx;
            if (og + 1u == (tg + 1u) * nx) xb_add(&bar[XB_TOPGEN], 1u);
            else XB_SPIN(xb_ld(&bar[XB_TOPGEN]) == tg, bar);
            __builtin_amdgcn_fence(__ATOMIC_ACQUIRE, "agent");
            xb_add(&bar[XB_XGEN(b.x)], 1u);
            asm volatile("s_waitcnt vmcnt(0)" ::: "memory");
        } else {
            XB_SPIN(xb_ld(&bar[XB_XGEN(b.x)]) == gen, bar);
            __builtin_amdgcn_fence(__ATOMIC_ACQUIRE, "agent");
            asm volatile("s_waitcnt vmcnt(0)" ::: "memory");
        }
    }
    __syncthreads();
}
#define GRID_SYNC() xcd_barrier(xbar)

#define DBG_DUMP_BODY(st) do { \
    dbg_add(X, G3, (size_t)TC * 3072, true, G, blk); } while (0)
__global__ void __launch_bounds__(512, 2) fwd_kernel(Params p) {
    extern __shared__ __attribute__((aligned(16))) unsigned char lds_raw[];
    LAS unsigned char* lds = (LAS unsigned char*)lds_raw;
    cg::grid_group grid = cg::this_grid();
    const int G = gridDim.x, blk = blockIdx.x;
    unsigned char* ws = p.ws;
    { volatile LAS unsigned* st0 = (volatile LAS unsigned*)(lds + 131072); if (threadIdx.x < 64) st0[threadIdx.x] = 0u; }
    __syncthreads();
    const XcdBarrier xbar = xcd_barrier_post((unsigned*)(ws + WS_SMALL + SM_BAR), (volatile LAS unsigned*)(lds + 131072));
    grid.sync();
    bf16_t* wb = (bf16_t*)(ws + WS_W); bf16_t* XB = (bf16_t*)(ws + WS_XB); float* SSQ = (float*)(ws + WS_SSQ); float* X = p.out;
    float* ROPE = (float*)(ws + WS_SMALL + SM_ROPE); float* RSQ = (float*)(ws + WS_SMALL + SM_RSQ); float* RSKV = (float*)(ws + WS_SMALL + SM_RSKV);
    float* MEANV = (float*)(ws + WS_SMALL + SM_MEANV); float* RSTDV = (float*)(ws + WS_SMALL + SM_RSTDV); float* SP8 = (float*)(ws + WS_SMALL + SM_SP8);
    unsigned char* big = ws + WS_BIG;
    bf16_t* H = (bf16_t*)(big + B_H); bf16_t* PB = (bf16_t*)(big + B_PB); bf16_t* GP = (bf16_t*)(big + B_GP);
    bf16_t* Z = (bf16_t*)(big + B_Z); bf16_t* VTS = (bf16_t*)(big + B_VTS); bf16_t* XC = (bf16_t*)(big + B_XC); bf16_t* LA = (bf16_t*)(big + B_LA); bf16_t* U = (bf16_t*)(big + B_U);
    bf16_t* Q = (bf16_t*)(big + B_Q); bf16_t* KN = (bf16_t*)(big + B_KN); bf16_t* VT = (bf16_t*)(big + B_VT); bf16_t* KR = (bf16_t*)(big + B_KR);
    bf16_t* G3 = (bf16_t*)(big + B_G3); bf16_t* MG = (bf16_t*)(big + B_MERGED);

#pragma unroll 1
    for (int L = 0; L < 2; ++L) {
        phase0(p, L, lds, G, blk);
        GRID_SYNC();
        { EpiSwiglu e{H, SSQ}; RUN_GEMM(EpiSwiglu, e, XB, wb + O_WGU1, T, 2 * DFF, 1024, 1024, 1024, 0); }
        GRID_SYNC();
        { EpiResid<false> e{L == 0 ? p.in[0] : nullptr, XB, SSQ, nullptr, 0.5f}; RUN_GEMM(EpiResid<false>, e, H, wb + O_WD1, T, 1024, DFF, DFF, DFF, 0); }
        GRID_SYNC();
#pragma unroll 1
        for (int c = 0; c <= 2; ++c) {
            if (c >= 1) { const size_t q0 = (size_t)(c - 1) * TC;
                EpiResid<false> e{nullptr, XB + q0 * DM, SSQ + q0 * 4, nullptr, 1.0f}; RUN_GEMM(EpiResid<false>, e, MG, wb + O_WOUT, TC, 1024, 1024, 1024, 1024, 0); }
            const size_t r0 = (size_t)c * TC;
            if (c <= 1) {
                { EpiRow<1, 0> e{Z, ZLD, SSQ + r0 * 4, nullptr, 4, 12, 0}; RUN_GEMM((EpiRow<1, 0>), e, XB + r0 * DM, wb + O_WIN, TC, ZLD, 1024, 1024, 1024, 0); }
                { EpiCol<1, 0> e{VTS, TC, SSQ + r0 * 4}; RUN_GEMM((EpiCol<1, 0>), e, wb + O_WINV, XB + r0 * DM, 1024, TC, 1024, 1024, 1024, 0); }
            }
            GRID_SYNC();
            if (c > 1) break;
            e1_rows(p, L, Z, XC, RSQ, RSKV, KR, ROPE, G, blk);
            e2_stats(lds, VTS, MEANV, RSTDV, G, blk);
            GRID_SYNC();
            { EpiLru e{XC, LA, U, p.in[10] + L * 1024, p.in[12] + L * 1024, SP8}; RUN_GEMM(EpiLru, e, XC, wb + O_WLRU, TC, 2048, 128, 1024, 128, 128); }
            { EpiQ e{Q, RSQ, ROPE}; RUN_GEMM(EpiQ, e, Z + ZC_CQ, wb + O_WUQ, TC, 1536, 384, ZLD, 384, 0); }
            { EpiRow<0, 1> e{KN, 1024, RSKV, nullptr, 0, 0, 0}; RUN_GEMM((EpiRow<0, 1>), e, Z + ZC_CKV, wb + O_WKVK, TC, 1024, 256, ZLD, 256, 0); }
            { EpiCol<0, 1> e{VT, TC, RSKV}; RUN_GEMM((EpiCol<0, 1>), e, wb + O_WKVV, Z + ZC_CKV, 1024, TC, 256, 256, ZLD, 0); }
            GRID_SYNC();
            scan_units(lds, LA, U, Z, G, blk);
            attn_units(lds, Q, KN, KR, VT, Z, G, blk);
            sgu_units(lds, VTS, MEANV, RSTDV, p.in[20] + L * 1024, p.in[21] + L * 1024, wb + O_WSGU, p.in[23] + L * 1024, Z, G, blk);
            GRID_SYNC();
            { EpiRow<2, 0> e{G3, 3072, SSQ + r0 * 4, p.in[25] + L * 3072, 0, 0, 1}; RUN_GEMM((EpiRow<2, 0>), e, XB + r0 * DM, wb + O_WING, TC, 3072, 1024, 1024, 1024, 0); }
#undef APS
#define APS 2
            { EpiMerge e{G3, MG}; RUN_GEMM(EpiMerge, e, Z, wb + O_WRA, TC, 3072, 1024, ZLD, 1024, 1024); }
#undef APS
#define APS 0
            GRID_SYNC();
        }
        pb_convert(p, L, G, blk);
        { EpiSwiglu e{H, SSQ}; RUN_GEMM(EpiSwiglu, e, XB, wb + O_WGU2, T, 2 * DFF, 1024, 1024, 1024, 0); }
        GRID_SYNC();
        { EpiResid<false> e{nullptr, XB, SSQ, nullptr, 0.5f}; RUN_GEMM(EpiResid<false>, e, H, wb + O_WD2, T, 1024, DFF, DFF, DFF, 0); }
        GRID_SYNC();
        { EpiRow<2, 0> e{GP, 1024, SSQ, nullptr, 0, 0, 0}; RUN_GEMM((EpiRow<2, 0>), e, XB, wb + O_WPG, T, 1024, 1024, 1024, 1024, 0); }
        GRID_SYNC();
        { EpiResid<true> e{nullptr, XB, SSQ, GP, 1.0f}; RUN_GEMM(EpiResid<true>, e, PB, wb + O_WPLE, T, 1024, 256, 256, 256, 0); }
        GRID_SYNC();
    }
    {
        const int tid = pg8::tid_opaque(), lane = tid & 63, wave = tid >> 6, gw = blk * 8 + wave, NGW = G * 8; const float* fn = p.in[33];
        for (int m = gw; m < T; m += NGW) {
            const u32x4* xr = (const u32x4*)(XB + (size_t)m * DM) + lane; f32x4* orow = (f32x4*)(X + (size_t)m * DM); f32x4 v[4]; float s = 0.f;
#pragma unroll
            for (int j = 0; j < 2; ++j) { unpack8(xr[64 * j], v[2 * j], v[2 * j + 1]); }
#pragma unroll
            for (int j = 0; j < 4; ++j) s += (v[j][0] * v[j][0] + v[j][1] * v[j][1]) + (v[j][2] * v[j][2] + v[j][3] * v[j][3]);
            const float rstd = __builtin_amdgcn_rsqf(wave_sum(s) * (1.f / 1024.f) + EPS);
#pragma unroll
            for (int j = 0; j < 2; ++j) { const int c = 512 * j + 8 * lane; orow[c / 4] = v[2 * j] * rstd * *(const f32x4*)(fn + c); orow[c / 4 + 1] = v[2 * j + 1] * rstd * *(const f32x4*)(fn + c + 4); }
        }
    }
}

extern "C" void kernel_launch(void* const* d_in, const int* in_sizes, int n_in, void* d_out, int out_size, void* d_ws, size_t ws_size, hipStream_t stream) {
    static int grid = 0;
    if (grid == 0) {
        if (n_in != 34 || ws_size < WS_NEED) { fprintf(stderr, "kernel_launch: unexpected n_in %d / ws_size %zu (need %zu)\n", n_in, ws_size, (size_t)WS_NEED); grid = -1; return; }
        int dev = 0, cus = 0, per = 0;
        (void)hipGetDevice(&dev); (void)hipDeviceGetAttribute(&cus, hipDeviceAttributeMultiprocessorCount, dev);
        (void)hipFuncSetAttribute((const void*)fwd_kernel, hipFuncAttributeMaxDynamicSharedMemorySize, LDS_BYTES);
        if (hipOccupancyMaxActiveBlocksPerMultiprocessor(&per, (const void*)fwd_kernel, 512, LDS_BYTES) != hipSuccess || per < 1) per = 1;
        (void)hipGetLastError();
        grid = cus * per;
    }
    if (grid < 0) return;
    (void)hipMemsetAsync((unsigned char*)d_ws + WS_SMALL + SM_BAR, 0, 16384, stream);
    Params prm{};
    for (int i = 0; i < 34; ++i) prm.in[i] = (const float*)d_in[i];
    prm.out = (float*)d_out; prm.ws = (unsigned char*)d_ws;
    void* args[] = {&prm};
    hipError_t e = hipLaunchCooperativeKernel((const void*)fwd_kernel, dim3(grid), dim3(512), args, LDS_BYTES, stream);
    if (e != hipSuccess) fprintf(stderr, "cooperative launch failed: %s (grid %d)\n", hipGetErrorString(e), grid);
}
```

```cpp
#include <hip/hip_runtime.h>
#include <hip/hip_cooperative_groups.h>
#include <cstdio>
#include <cstdint>
namespace cg = cooperative_groups;
namespace pg8 {
#define PG8_LAS __attribute__((address_space(3)))
typedef unsigned short bf16_t;
typedef short bf16x8 __attribute__((ext_vector_type(8)));
typedef float f32x4 __attribute__((ext_vector_type(4)));
typedef unsigned u32x4 __attribute__((ext_vector_type(4)));
typedef unsigned u32x2 __attribute__((ext_vector_type(2)));
constexpr int BM = 256, BK = 64, HALF = 128, HTB = HALF * BK * 2  , STAGE_BYTES = 8 * HTB, NXCD = 8, WGM = 8;

__host__ __device__ __forceinline__ int lds_byte(int r, int c) { const int st = (r >> 4) * 2 + (c >> 5), rr = r & 15, cc = c & 31, ob = rr * 64 + cc * 2; return st * 1024 + (ob ^ (((ob >> 9) & 1) << 5)); }
__host__ __device__ __forceinline__ void stage_rc(int b, int& R, int& C) { const int st = b / 1024, sb = b % 1024, swz = sb ^ (((sb >> 9) & 1) << 5); R = (st >> 1) * 16 + swz / 64; C = (st & 1) * 32 + (swz % 64) / 2; }
__host__ __device__ __forceinline__ int perm32(int rho) { const int n = rho >> 4, i = rho & 15; return 8 * (i >> 2) + 4 * n + (i & 3); }

struct Unit { int pm, pn; };
struct Gemm { const bf16_t* A; const bf16_t* Bt; int M, N, K, lda, ldb, apn, aps; };

struct StaticOrder {
    int nM, nN, nwg, G, c;
    __host__ __device__ void init(int M, int N, int G_, int c_) { nM = M / BM; nN = N / BM; nwg = nM * nN; G = G_; c = c_; }
    __host__ __device__ bool next(int i, Unit& u) const {
        const long L = (long)i * G + c; if (L >= nwg) return false;
        int wgid = (int)L; { const int q = nwg / NXCD, r = nwg % NXCD, xcd = wgid % NXCD, off = wgid / NXCD; wgid = (xcd < r ? xcd * (q + 1) : r * (q + 1) + (xcd - r) * q) + off; }
        const int nig = WGM * nN, gid = wgid / nig, fm = gid * WGM, gsz = (nM - fm) < WGM ? (nM - fm) : WGM;
        u.pm = fm + ((wgid % nig) % gsz); u.pn = (wgid % nig) / gsz; return true;
    }
    __device__ __forceinline__ void a_ready(const Unit&) const {}
    __device__ __forceinline__ void done(const Unit&) const {}
};
__device__ __forceinline__ int tid_opaque() { int t = threadIdx.x; asm volatile("" : "+v"(t)); return t; }
typedef float f32x2_t __attribute__((ext_vector_type(2))); typedef __bf16 bf16x2_t __attribute__((ext_vector_type(2)));
__device__ __forceinline__ unsigned cvt_pk_bf16(float lo, float hi) { const f32x2_t v = {lo, hi}; const bf16x2_t b = __builtin_convertvector(v, bf16x2_t); return __builtin_bit_cast(unsigned, b); }

template <class Epi, class Sched, bool ALIGN_EPI = false, bool SP2 = false>
__device__ __forceinline__ void gemm_phase(PG8_LAS unsigned char* lds, const Gemm g, const Sched& S, const Epi& E) {
    const int tid = pg8::tid_opaque(), wid = __builtin_amdgcn_readfirstlane(tid >> 6), lane = tid & 63, wr = wid >> 2, wc = wid & 3, fr = lane & 15, fq = lane >> 4;
    const int K = g.K, nt = K / BK;
    unsigned voffA[2], voffB[2];
#pragma unroll
    for (int i = 0; i < 2; ++i) { int R, C; stage_rc(tid * 16 + i * 8192, R, C); const int Rb = Epi::PERM ? ((R & ~31) + perm32(R & 31)) : R;
        voffA[i] = (unsigned)(R * g.lda + C) * 2u; voffB[i] = (unsigned)(Rb * g.ldb + C) * 2u; }
    const size_t kstep = (size_t)(BK * 2);
    const size_t hstepA = (size_t)HALF * g.lda * 2, hstepB = (size_t)HALF * g.ldb * 2;
    const size_t tstepA = 2 * hstepA, tstepB = 2 * hstepB; const size_t apn = (size_t)g.apn * 2;
    const unsigned ldsw = (unsigned)wid * 1024u;
    const int aoff = lds_byte(wr * 64 + fr, fq * 8), boff = lds_byte(wc * 32 + fr, fq * 8);
#define PG8_SA(b, h) (((b) * 2 + (h)) * HTB)
#define PG8_SB(b, h) ((4 + (b) * 2 + (h)) * HTB)
#define PG8_STAGE(bufoff, gbase, voff) do { _Pragma("unroll") for (int _i = 0; _i < 2; ++_i) \
        __builtin_amdgcn_global_load_lds((const unsigned*)((const char*)(gbase) + (voff)[_i]), (PG8_LAS unsigned*)(lds + (bufoff) + ldsw + _i * 8192), 16, 0, 0); } while (0)
#define PG8_LDA(dst, b, h) do { _Pragma("unroll") for (int m = 0; m < 4; ++m) _Pragma("unroll") for (int k = 0; k < 2; ++k) dst[m][k] = *(const PG8_LAS bf16x8*)(lds + PG8_SA(b, h) + aoff + m * 2048 + k * 1024); } while (0)
#define PG8_LDB(dst, b, h) do { _Pragma("unroll") for (int n = 0; n < 2; ++n) _Pragma("unroll") for (int k = 0; k < 2; ++k) dst[n][k] = *(const PG8_LAS bf16x8*)(lds + PG8_SB(b, h) + boff + n * 2048 + k * 1024); } while (0)
#define PG8_MMA(ai, bj, At, Bt) do { __builtin_amdgcn_s_setprio(1); _Pragma("unroll") for (int m = 0; m < 4; ++m) _Pragma("unroll") for (int n = 0; n < 2; ++n) _Pragma("unroll") for (int k = 0; k < 2; ++k) \
        acc[ai][bj][m][n] = __builtin_amdgcn_mfma_f32_16x16x32_bf16(Bt[n][k], At[m][k], acc[ai][bj][m][n], 0, 0, 0); __builtin_amdgcn_s_setprio(0); } while (0)
#define PG8_WAIT_V(n) asm volatile("s_waitcnt vmcnt(" #n ")" ::: "memory")
#define PG8_WAIT_L(n) asm volatile("s_waitcnt lgkmcnt(" #n ")" ::: "memory")
#define PG8_BAR __builtin_amdgcn_s_barrier()
#define PG8_SCHED __builtin_amdgcn_sched_barrier(0)
    Unit cur, nxt; int ui = 0;
    if (!S.next(0, cur)) return;
    f32x4 acc[2][2][4][2];
#pragma unroll
    for (int a = 0; a < 2; ++a)
#pragma unroll
        for (int b = 0; b < 2; ++b)
#pragma unroll
            for (int m = 0; m < 4; ++m)
#pragma unroll
                for (int n = 0; n < 2; ++n) acc[a][b][m][n] = (f32x4){0.f, 0.f, 0.f, 0.f};
    bf16x8 At[4][2], B0[2][2], B1[2][2];
    const char* cA = (const char*)g.A + (size_t)cur.pm * tstepA + (size_t)(cur.pn >> g.aps) * apn; const char* cB = (const char*)g.Bt + (size_t)cur.pn * tstepB;
    S.a_ready(cur);
    if constexpr (SP2) {
        PG8_STAGE(PG8_SB(0, 0), cB, voffB); PG8_STAGE(PG8_SB(0, 1), cB + hstepB, voffB); PG8_STAGE(PG8_SA(0, 0), cA, voffA); PG8_STAGE(PG8_SA(0, 1), cA + hstepA, voffA);
        if (wr == 1) PG8_BAR;
        PG8_WAIT_V(2); PG8_BAR;
        PG8_STAGE(PG8_SB(1, 0), cB + kstep, voffB); PG8_STAGE(PG8_SA(1, 0), cA + kstep, voffA); PG8_STAGE(PG8_SB(1, 1), cB + hstepB + kstep, voffB);
        PG8_WAIT_V(6); PG8_BAR;
    } else {
        PG8_STAGE(PG8_SB(0, 0), cB, voffB); PG8_STAGE(PG8_SA(0, 0), cA, voffA); PG8_STAGE(PG8_SB(0, 1), cB + hstepB, voffB); PG8_STAGE(PG8_SA(0, 1), cA + hstepA, voffA);
        if (wr == 1) PG8_BAR;
        PG8_WAIT_V(4); PG8_BAR;
        PG8_STAGE(PG8_SB(1, 0), cB + kstep, voffB); PG8_STAGE(PG8_SA(1, 0), cA + kstep, voffA); PG8_STAGE(PG8_SB(1, 1), cB + hstepB + kstep, voffB);
        PG8_WAIT_V(6); PG8_BAR;
    }
    for (;;) {
        const bool has_next = S.next(ui + 1, nxt);
        const char* nA = has_next ? (const char*)g.A + (size_t)nxt.pm * tstepA + (size_t)(nxt.pn >> g.aps) * apn : cA; const char* nB = has_next ? (const char*)g.Bt + (size_t)nxt.pn * tstepB : cB;
        for (int t = 0; t < nt; t += 2) {
            const bool last = (t == nt - 2);
            const char* a1 = cA + (size_t)(t + 1) * kstep;
            const char* a2 = last ? nA : cA + (size_t)(t + 2) * kstep; const char* b2 = last ? nB : cB + (size_t)(t + 2) * kstep;
            const char* a3 = a2 + kstep; const char* b3 = b2 + kstep;
            if (last && has_next) S.a_ready(nxt);
            if constexpr (SP2) {
            PG8_LDB(B0, 0, 0); PG8_LDB(B1, 0, 1); PG8_SCHED; PG8_LDA(At, 0, 0); PG8_STAGE(PG8_SA(1, 1), a1 + hstepA, voffA);
            PG8_WAIT_V(8); PG8_WAIT_L(0); PG8_BAR; PG8_MMA(0, 0, At, B0); PG8_MMA(0, 1, At, B1); PG8_BAR; PG8_SCHED;
            PG8_LDA(At, 0, 1); PG8_STAGE(PG8_SB(0, 0), b2, voffB); PG8_STAGE(PG8_SB(0, 1), b2 + hstepB, voffB); PG8_STAGE(PG8_SA(0, 0), a2, voffA);
            PG8_WAIT_V(8); PG8_WAIT_L(0); PG8_BAR; PG8_MMA(1, 0, At, B0); PG8_MMA(1, 1, At, B1); PG8_BAR; PG8_SCHED;
            PG8_LDB(B0, 1, 0); PG8_LDB(B1, 1, 1); PG8_SCHED; PG8_LDA(At, 1, 0); PG8_STAGE(PG8_SA(0, 1), a2 + hstepA, voffA);
            PG8_WAIT_V(8); PG8_WAIT_L(0); PG8_BAR; PG8_MMA(0, 0, At, B0); PG8_MMA(0, 1, At, B1); PG8_BAR; PG8_SCHED;
            PG8_LDA(At, 1, 1); PG8_STAGE(PG8_SB(1, 0), b3, voffB); PG8_STAGE(PG8_SB(1, 1), b3 + hstepB, voffB); PG8_STAGE(PG8_SA(1, 0), a3, voffA);
            PG8_WAIT_V(8); PG8_WAIT_L(0); PG8_BAR; PG8_MMA(1, 0, At, B0); PG8_MMA(1, 1, At, B1); PG8_BAR; PG8_SCHED;
            } else {
            PG8_LDB(B0, 0, 0); PG8_SCHED; PG8_LDA(At, 0, 0); PG8_STAGE(PG8_SA(1, 1), a1 + hstepA, voffA);
            PG8_WAIT_L(8); PG8_BAR; PG8_WAIT_L(0); PG8_MMA(0, 0, At, B0); PG8_BAR; PG8_SCHED;
            PG8_LDB(B1, 0, 1); PG8_STAGE(PG8_SB(0, 0), b2, voffB);
            PG8_BAR; PG8_WAIT_L(0); PG8_MMA(0, 1, At, B1); PG8_BAR;
            PG8_LDA(At, 0, 1); PG8_STAGE(PG8_SA(0, 0), a2, voffA);
            PG8_BAR; PG8_WAIT_L(0); PG8_MMA(1, 0, At, B0); PG8_BAR; PG8_SCHED;
            PG8_STAGE(PG8_SB(0, 1), b2 + hstepB, voffB);
            PG8_WAIT_V(6); PG8_BAR; PG8_MMA(1, 1, At, B1); PG8_BAR;
            PG8_LDB(B0, 1, 0); PG8_SCHED; PG8_LDA(At, 1, 0); PG8_STAGE(PG8_SA(0, 1), a2 + hstepA, voffA);
            PG8_WAIT_L(8); PG8_BAR; PG8_WAIT_L(0); PG8_MMA(0, 0, At, B0); PG8_BAR; PG8_SCHED;
            PG8_LDB(B1, 1, 1); PG8_STAGE(PG8_SB(1, 0), b3, voffB);
            PG8_BAR; PG8_WAIT_L(0); PG8_MMA(0, 1, At, B1); PG8_BAR;
            PG8_LDA(At, 1, 1); PG8_STAGE(PG8_SA(1, 0), a3, voffA);
            PG8_BAR; PG8_WAIT_L(0); PG8_MMA(1, 0, At, B0); PG8_BAR; PG8_SCHED;
            PG8_STAGE(PG8_SB(1, 1), b3 + hstepB, voffB);
            PG8_WAIT_V(6); PG8_BAR; PG8_MMA(1, 1, At, B1); PG8_BAR;
            }
        }
        if constexpr (ALIGN_EPI) { if (wr == 0) PG8_BAR; }
        if constexpr (!Epi::AFTER_DRAIN) { E(acc, cur, wr, wc, fr, fq); S.done(cur); }
        if (!has_next) break;
#pragma unroll
        for (int a = 0; a < 2; ++a)
#pragma unroll
            for (int b = 0; b < 2; ++b)
#pragma unroll
                for (int m = 0; m < 4; ++m)
#pragma unroll
                    for (int n = 0; n < 2; ++n) acc[a][b][m][n] = (f32x4){0.f, 0.f, 0.f, 0.f};
        cur = nxt; cA = nA; cB = nB; ++ui;
        if constexpr (ALIGN_EPI) { if (wr == 1) PG8_BAR; }
    }
    PG8_WAIT_V(0);
    if constexpr (!ALIGN_EPI) { if (wr == 0) PG8_BAR; }
    PG8_BAR;
    if constexpr (Epi::AFTER_DRAIN) { E.fused(acc, cur, wr, wc, fr, fq, lds, wid, lane); S.done(cur); }
#undef PG8_SA
#undef PG8_SB
#undef PG8_STAGE
#undef PG8_LDA
#undef PG8_LDB
#undef PG8_MMA
#undef PG8_WAIT_V
#undef PG8_WAIT_L
#undef PG8_BAR
#undef PG8_SCHED
}
}

using pg8::bf16_t; using pg8::bf16x8; using pg8::f32x4; using pg8::u32x4; using pg8::u32x2; using pg8::Unit; using pg8::cvt_pk_bf16;
typedef float f32x16 __attribute__((ext_vector_type(16)));
typedef float f32x2 __attribute__((ext_vector_type(2)));
#define LAS __attribute__((address_space(3)))

constexpr int T = 32768, DM = 1024, TC = 16384, DFF = 2816, ZLD = 3840;
constexpr int ZC_XA = 0, ZC_GA = 1024, ZC_U = 2048, ZC_CKV = 3072, ZC_CQ = 3328, ZC_KR = 3712;
constexpr float EPS = 1e-6f, LOG2E = 1.4426950408889634f;
constexpr float QSCALE = 0.10206207261596577f * 1.4426950408889634f;
constexpr size_t MiB = (size_t)1 << 20;
constexpr size_t WS_W = 0, WS_XB = 64 * MiB, WS_SSQ = 128 * MiB, WS_SMALL = 130 * MiB, WS_BIG = 132 * MiB;
constexpr size_t SM_ROPE = 0, SM_RSQ = 256 * 1024, SM_RSKV = 320 * 1024, SM_MEANV = 384 * 1024, SM_RSTDV = 448 * 1024, SM_SP8 = 512 * 1024;
constexpr size_t B_H = 0, B_PB = 176 * MiB, B_GP = 192 * MiB;
constexpr size_t B_Z = 0, B_VTS = 120 * MiB, B_XC = 152 * MiB, B_LA = 184 * MiB, B_U = 216 * MiB, B_Q = 248 * MiB, B_KN = 296 * MiB, B_VT = 328 * MiB, B_KR = 360 * MiB;
constexpr size_t B_G3 = 248 * MiB, B_MERGED = 184 * MiB;
constexpr size_t WS_NEED = WS_BIG + 361 * MiB;
constexpr size_t O_WGU1 = 0, O_WD1 = O_WGU1 + 5632 * 1024, O_WIN = O_WD1 + 1024 * 2816, O_WINV = O_WIN + 3840 * 1024, O_WING = O_WINV + 1024 * 1024,
                 O_WLRU = O_WING + 3072 * 1024, O_WRA = O_WLRU + 2048 * 128, O_WRB = O_WRA + 1024 * 1024, O_WRC = O_WRB + 1024 * 1024, O_WOUT = O_WRC + 1024 * 1024,
                 O_WPG = O_WOUT + 1024 * 1024, O_WUQ = O_WPG + 1024 * 1024, O_WKVK = O_WUQ + 1536 * 384, O_WKVV = O_WKVK + 1024 * 256, O_WGU2 = O_WKVV + 1024 * 256,
                 O_WD2 = O_WGU2 + 5632 * 1024, O_WPLE = O_WD2 + 1024 * 2816, O_WSGU = O_WPLE + 1024 * 256, O_WEND = O_WSGU + 8 * 128 * 128;
static_assert(O_WEND * 2 <= 64 * MiB, "weights fit");
constexpr int LDS_BYTES = 131072 + 256;
#ifndef DBG_STOP
#define DBG_STOP 0
#endif
#ifndef DBG_BR
#define DBG_BR 7
#endif

struct Params { const float* in[34]; float* out; unsigned char* ws; };

__device__ __forceinline__ float fexp2(float x) { return __builtin_amdgcn_exp2f(x); }
__device__ __forceinline__ float frcp(float x) { return __builtin_amdgcn_rcpf(x); }
__device__ __forceinline__ float sigm(float x) { return frcp(1.f + fexp2(-LOG2E * x)); }
__device__ __forceinline__ float gelu_t(float x) { const float t = x + 0.044715f * x * x * x; return x * frcp(1.f + fexp2(-2.3022081985f * t)); }
__device__ __forceinline__ float bflo(unsigned w) { return __uint_as_float(w << 16); }
__device__ __forceinline__ float bfhi(unsigned w) { return __uint_as_float(w & 0xffff0000u); }
__device__ __forceinline__ bf16_t f2bf(float v) { return (bf16_t)(cvt_pk_bf16(v, 0.f) & 0xffffu); }
__device__ __forceinline__ float wave_sum(float v) {
#pragma unroll
    for (int o = 1; o < 64; o <<= 1) v += __shfl_xor(v, o);
    return v;
}
constexpr size_t SSQ_PLANE = (size_t)T * 4;
__device__ __forceinline__ float rstd16(const float* ssq, size_t row) {
    const float* q = ssq + row * 4; const f32x4 a = *(const f32x4*)q, b = *(const f32x4*)(q + SSQ_PLANE), c = *(const f32x4*)(q + 2 * SSQ_PLANE), d = *(const f32x4*)(q + 3 * SSQ_PLANE);
    const float s = ((a.x + a.y) + (a.z + a.w)) + ((b.x + b.y) + (b.z + b.w)) + ((c.x + c.y) + (c.z + c.w)) + ((d.x + d.y) + (d.z + d.w));
    return __builtin_amdgcn_rsqf(s * (1.0f / 1024.0f) + EPS);
}
__device__ __forceinline__ u32x4 pack8(const f32x4 v0, const f32x4 v1) { u32x4 w; w.x = cvt_pk_bf16(v0[0], v0[1]); w.y = cvt_pk_bf16(v0[2], v0[3]); w.z = cvt_pk_bf16(v1[0], v1[1]); w.w = cvt_pk_bf16(v1[2], v1[3]); return w; }
__device__ __forceinline__ void unpack8(const u32x4 w, f32x4& v0, f32x4& v1) { v0 = (f32x4){bflo(w.x), bfhi(w.x), bflo(w.y), bfhi(w.y)}; v1 = (f32x4){bflo(w.z), bfhi(w.z), bflo(w.w), bfhi(w.w)}; }

template <int ACT, int RS> struct EpiRow {
    static constexpr bool PERM = true, AFTER_DRAIN = false;
    bf16_t* O; int ldc; const float* rs; const float* bias; int t0, t1; int bswap;
    __device__ __forceinline__ void operator()(const f32x4 (&acc)[2][2][4][2], const Unit& u, int wr, int wc, int fr, int fq) const {
        const int row0 = u.pm * 256 + wr * 64 + fr, col0 = u.pn * 256 + wc * 32 + 8 * fq;
        const bool act = (ACT == 1) ? (u.pn >= t0 && u.pn < t1) : true;
        f32x4 bv[2][2];
#pragma unroll
        for (int bj = 0; bj < 2; ++bj)
#pragma unroll
            for (int n = 0; n < 2; ++n) bv[bj][n] = bias ? *(const f32x4*)(bias + col0 + (bswap ? (u.pn < 4 ? 1024 : (u.pn < 8 ? -1024 : 0)) : 0) + bj * 128 + 4 * n) : (f32x4){0.f, 0.f, 0.f, 0.f};
#pragma unroll
        for (int ai = 0; ai < 2; ++ai)
#pragma unroll
            for (int m = 0; m < 4; ++m) {
                const size_t row = (size_t)(row0 + ai * 128 + m * 16); const float s = (RS == 0) ? rstd16(rs, row) : rs[row];
                bf16_t* rowp = O + row * ldc + col0;
#pragma unroll
                for (int bj = 0; bj < 2; ++bj) {
                    f32x4 v0 = acc[ai][bj][m][0] * s + bv[bj][0], v1 = acc[ai][bj][m][1] * s + bv[bj][1];
                    if (ACT == 1) { if (act) {
#pragma unroll
                        for (int e = 0; e < 4; ++e) { v0[e] = gelu_t(v0[e]); v1[e] = gelu_t(v1[e]); } } }
                    if (ACT == 2) {
#pragma unroll
                        for (int e = 0; e < 4; ++e) { v0[e] = sigm(v0[e]); v1[e] = sigm(v1[e]); } }
                    *(u32x4*)(rowp + bj * 128) = pack8(v0, v1);
                }
                asm volatile("" ::: "memory");
            }
    }
};
struct EpiSwiglu {
    static constexpr bool PERM = true, AFTER_DRAIN = false;
    bf16_t* H; const float* ssq;
    __device__ __forceinline__ void operator()(const f32x4 (&acc)[2][2][4][2], const Unit& u, int wr, int wc, int fr, int fq) const {
        const int row0 = u.pm * 256 + wr * 64 + fr, col0 = u.pn * 128 + wc * 32 + 8 * fq;
#pragma unroll
        for (int ai = 0; ai < 2; ++ai)
#pragma unroll
            for (int m = 0; m < 4; ++m) {
                const size_t row = (size_t)(row0 + ai * 128 + m * 16); const float s = rstd16(ssq, row);
                f32x4 h0, h1;
#pragma unroll
                for (int e = 0; e < 4; ++e) { const float g0 = acc[ai][0][m][0][e] * s, g1 = acc[ai][0][m][1][e] * s; h0[e] = g0 * sigm(g0) * (acc[ai][1][m][0][e] * s); h1[e] = g1 * sigm(g1) * (acc[ai][1][m][1][e] * s); }
                *(u32x4*)(H + row * DFF + col0) = pack8(h0, h1);
                asm volatile("" ::: "memory");
            }
    }
};
template <bool GATED> struct EpiResid {
    static constexpr bool PERM = false, AFTER_DRAIN = false;
    const float* X32; bf16_t* XB; float* ssq; const bf16_t* GP; float alpha;
    __device__ __forceinline__ void operator()(const f32x4 (&acc)[2][2][4][2], const Unit& u, int wr, int wc, int fr, int fq) const {
        const int col0 = u.pn * 256 + wc * 32 + 4 * fq;
#pragma unroll
        for (int ai = 0; ai < 2; ++ai)
#pragma unroll
            for (int m = 0; m < 4; ++m) {
                const size_t row = (size_t)(u.pm * 256 + ai * 128 + wr * 64 + m * 16 + fr); const size_t off = row * DM + col0; float ss = 0.f;
#pragma unroll
                for (int bj = 0; bj < 2; ++bj)
#pragma unroll
                    for (int n = 0; n < 2; ++n) {
                        const size_t o = off + bj * 128 + n * 16; f32x4 a = acc[ai][bj][m][n] * alpha;
                        if (GATED) { const u32x2 g = *(const u32x2*)(GP + o); a[0] *= bflo(g.x); a[1] *= bfhi(g.x); a[2] *= bflo(g.y); a[3] *= bfhi(g.y); }
                        f32x4 xs;
                        if (X32) xs = *(const f32x4*)(X32 + o); else { const u32x2 xw = *(const u32x2*)(XB + o); xs = (f32x4){bflo(xw.x), bfhi(xw.x), bflo(xw.y), bfhi(xw.y)}; }
                        const f32x4 xv = xs + a;
                        u32x2 w; w.x = cvt_pk_bf16(xv[0], xv[1]); w.y = cvt_pk_bf16(xv[2], xv[3]); *(u32x2*)(XB + o) = w;
                        ss += (xv[0] * xv[0] + xv[1] * xv[1]) + (xv[2] * xv[2] + xv[3] * xv[3]);
                    }
                ss += __shfl_xor(ss, 16); ss += __shfl_xor(ss, 32);
                if (fq == 0) ssq[(size_t)u.pn * SSQ_PLANE + row * 4 + wc] = ss;
                asm volatile("" ::: "memory");
            }
    }
};
template <int ACT, int RS> struct EpiCol {
    static constexpr bool PERM = true, AFTER_DRAIN = false;
    bf16_t* O; int ldc; const float* rs;
    __device__ __forceinline__ void operator()(const f32x4 (&acc)[2][2][4][2], const Unit& u, int wr, int wc, int fr, int fq) const {
        const int row0 = u.pm * 256 + wr * 64 + fr, col0 = u.pn * 256 + wc * 32 + 8 * fq;
#pragma unroll
        for (int bj = 0; bj < 2; ++bj) {
            const int col = col0 + bj * 128; f32x4 c0, c1;
            if (RS == 0) {
#pragma unroll
                for (int e = 0; e < 4; ++e) { c0[e] = rstd16(rs, (size_t)(col + e)); asm volatile("" ::: "memory"); c1[e] = rstd16(rs, (size_t)(col + 4 + e)); asm volatile("" ::: "memory"); }
            } else { c0 = *(const f32x4*)(rs + col); c1 = *(const f32x4*)(rs + col + 4); }
#pragma unroll
            for (int ai = 0; ai < 2; ++ai)
#pragma unroll
                for (int m = 0; m < 4; ++m) {
                    f32x4 v0 = acc[ai][bj][m][0] * c0, v1 = acc[ai][bj][m][1] * c1;
                    if (ACT == 1) {
#pragma unroll
                        for (int e = 0; e < 4; ++e) { v0[e] = gelu_t(v0[e]); v1[e] = gelu_t(v1[e]); } }
                    *(u32x4*)(O + (size_t)(row0 + ai * 128 + m * 16) * ldc + col) = pack8(v0, v1);
                    asm volatile("" ::: "memory");
                }
        }
    }
};
struct EpiLru {
    static constexpr bool PERM = true, AFTER_DRAIN = false;
    const bf16_t* XC; bf16_t* LA; bf16_t* U; const float* ba; const float* bx; const float* sp8;
    __device__ __forceinline__ void operator()(const f32x4 (&acc)[2][2][4][2], const Unit& u, int wr, int wc, int fr, int fq) const {
        const int row0 = u.pm * 256 + wr * 64 + fr, ch0 = (u.pn * 256 + wc * 32 + 8 * fq) >> 1;
#pragma unroll
        for (int bj = 0; bj < 2; ++bj) {
            const int ch = ch0 + bj * 64; const f32x4 vba = *(const f32x4*)(ba + ch), vbx = *(const f32x4*)(bx + ch), vsp = *(const f32x4*)(sp8 + ch);
#pragma unroll
            for (int ai = 0; ai < 2; ++ai)
#pragma unroll
                for (int m = 0; m < 4; ++m) {
                    const int row = row0 + ai * 128 + m * 16; const size_t o = (size_t)row * DM + ch; const bool first = (row & 2047) == 0;
                    const u32x2 xw = *(const u32x2*)(XC + o); const float xc[4] = {bflo(xw.x), bfhi(xw.x), bflo(xw.y), bfhi(xw.y)};
                    const f32x4 v0 = acc[ai][bj][m][0], v1 = acc[ai][bj][m][1]; const float ga[4] = {v0[0], v0[2], v1[0], v1[2]}, gx[4] = {v0[1], v0[3], v1[1], v1[3]};
                    float la[4], uu[4];
#pragma unroll
                    for (int e = 0; e < 4; ++e) { const float r = sigm(ga[e] + vba[e]), ig = sigm(gx[e] + vbx[e]); la[e] = -vsp[e] * r;
                        const float a2 = fexp2(2.f * LOG2E * la[e]); const float mult = first ? 1.f : sqrtf(fmaxf(1.f - a2, 0.f)); uu[e] = mult * ig * xc[e]; }
                    u32x2 wl, wu; wl.x = cvt_pk_bf16(la[0], la[1]); wl.y = cvt_pk_bf16(la[2], la[3]); wu.x = cvt_pk_bf16(uu[0], uu[1]); wu.y = cvt_pk_bf16(uu[2], uu[3]);
                    *(u32x2*)(LA + o) = wl; *(u32x2*)(U + o) = wu;
                    asm volatile("" ::: "memory");
                }
        }
    }
};
struct EpiQ {
    static constexpr bool PERM = true, AFTER_DRAIN = false;
    bf16_t* Q; const float* rsq; const float* rope;
    __device__ __forceinline__ void operator()(const f32x4 (&acc)[2][2][4][2], const Unit& u, int wr, int wc, int fr, int fq) const {
        const int row0 = u.pm * 256 + wr * 64 + fr, col0 = u.pn * 256 + wc * 32 + 8 * fq;
#pragma unroll
        for (int ai = 0; ai < 2; ++ai)
#pragma unroll
            for (int m = 0; m < 4; ++m) {
                const int row = row0 + ai * 128 + m * 16; const float s = rsq[row] * QSCALE; const int pos = row & 2047;
#pragma unroll
                for (int bj = 0; bj < 2; ++bj) {
                    const int col = col0 + bj * 128, d = col % 96; f32x4 v0 = acc[ai][bj][m][0] * s, v1 = acc[ai][bj][m][1] * s;
                    if (d >= 64) { const int i0 = (d - 64) >> 1; const f32x4 t0 = *(const f32x4*)(rope + (pos * 16 + i0) * 2), t1 = *(const f32x4*)(rope + (pos * 16 + i0 + 2) * 2);
                        const f32x4 a = v0, b = v1;
                        v0[0] = a[0] * t0[0] - a[1] * t0[1]; v0[1] = a[0] * t0[1] + a[1] * t0[0]; v0[2] = a[2] * t0[2] - a[3] * t0[3]; v0[3] = a[2] * t0[3] + a[3] * t0[2];
                        v1[0] = b[0] * t1[0] - b[1] * t1[1]; v1[1] = b[0] * t1[1] + b[1] * t1[0]; v1[2] = b[2] * t1[2] - b[3] * t1[3]; v1[3] = b[2] * t1[3] + b[3] * t1[2]; }
                    *(u32x4*)(Q + (size_t)row * 1536 + col) = pack8(v0, v1);
                }
                asm volatile("" ::: "memory");
            }
    }
};
struct EpiMerge {
    static constexpr bool PERM = true, AFTER_DRAIN = false;
    const bf16_t* G3; bf16_t* MG;
    __device__ __forceinline__ void operator()(const f32x4 (&acc)[2][2][4][2], const Unit& u, int wr, int wc, int fr, int fq) const {
        const int row0 = u.pm * 256 + wr * 64 + fr, col0 = u.pn * 256 + wc * 32 + 8 * fq, mcol0 = (u.pn & 3) * 256 + wc * 32 + 8 * fq; const bool first = u.pn < 4;
#pragma unroll
        for (int ai = 0; ai < 2; ++ai)
#pragma unroll
            for (int m = 0; m < 4; ++m) {
                const size_t row = (size_t)(row0 + ai * 128 + m * 16);
#pragma unroll
                for (int bj = 0; bj < 2; ++bj) {
                    f32x4 g0, g1; unpack8(*(const u32x4*)(G3 + row * 3072 + col0 + bj * 128), g0, g1);
                    f32x4 v0 = acc[ai][bj][m][0] * g0, v1 = acc[ai][bj][m][1] * g1;
                    if (!first) { f32x4 p0, p1; unpack8(*(const u32x4*)(MG + row * DM + mcol0 + bj * 128), p0, p1); v0 += p0; v1 += p1; }
                    *(u32x4*)(MG + row * DM + mcol0 + bj * 128) = pack8(v0, v1);
                }
                asm volatile("" ::: "memory");
            }
    }
};
enum { MAP_ID = 0, MAP_SWIGLU, MAP_WIN, MAP_UQ, MAP_KVK, MAP_KVV, MAP_GATES };
struct Job { const float* W; const float* gain; bf16_t* dst; int ldw, K, dN, map, off; };
__device__ __forceinline__ int srcmap(int map, int off, int n) {
    switch (map) {
    case MAP_SWIGLU: return (n >> 8) * 128 + (n & 127) + ((n & 128) ? DFF : 0);
    case MAP_WIN: if (n < 2048) return n; if (n < 3072) return 2720 + (n - 2048); if (n < 3328) return 2432 + (n - 3072); if (n < 3712) return 2048 + (n - 3328);
                  if (n < 3744) { const int j = n - 3712, i = j >> 1; return 2688 + ((j & 1) ? 16 + i : i); } return -1;
    case MAP_UQ: { const int h = n / 96, d = n % 96; if (d < 64) return n; const int j = d - 64, i = j >> 1; return h * 96 + 64 + ((j & 1) ? 16 + i : i); }
    case MAP_KVK: return (n >> 6) * 128 + (n & 63);
    case MAP_KVV: return (n >> 6) * 128 + 64 + (n & 63);
    case MAP_GATES: return 4768 + (n < 1024 ? n + 1024 : (n < 2048 ? n - 1024 : n));
    default: return n + off;
    }
}
#define JOB(Wp, GAIN, DST, LDW, KK, DN, MAP, OFF) do { J.W = (Wp); J.gain = (GAIN); J.dst = wb + (DST); J.ldw = (LDW); J.K = (KK); J.dN = (DN); J.map = (MAP); J.off = (OFF); } while (0)
__device__ __forceinline__ void get_job(const Params& p, int L, int j, bf16_t* wb, Job& J) {
    const size_t M1 = 1024 * 1024;
    switch (j) {
    case 0: JOB(p.in[3] + (size_t)L * 1024 * 5632, p.in[2] + L * 1024, O_WGU1, 5632, 1024, 5632, MAP_SWIGLU, 0); break;
    case 1: JOB(p.in[4] + (size_t)L * 2816 * 1024, nullptr, O_WD1, 1024, 2816, 1024, MAP_ID, 0); break;
    case 2: JOB(p.in[6] + (size_t)L * 1024 * 7840, p.in[5] + L * 1024, O_WIN, 7840, 1024, 3840, MAP_WIN, 0); break;
    case 3: JOB(p.in[6] + (size_t)L * 1024 * 7840, p.in[5] + L * 1024, O_WINV, 7840, 1024, 1024, MAP_ID, 3744); break;
    case 4: JOB(p.in[6] + (size_t)L * 1024 * 7840, p.in[5] + L * 1024, O_WING, 7840, 1024, 3072, MAP_GATES, 0); break;
    case 5: JOB(p.in[14] + L * M1, nullptr, O_WRB, 1024, 1024, 1024, MAP_ID, 0); break;
    case 6: JOB(p.in[19] + L * M1, nullptr, O_WRA, 1024, 1024, 1024, MAP_ID, 0); break;
    case 7: JOB(p.in[24] + L * M1, nullptr, O_WRC, 1024, 1024, 1024, MAP_ID, 0); break;
    case 8: JOB(p.in[26] + L * M1, nullptr, O_WOUT, 1024, 1024, 1024, MAP_ID, 0); break;
    case 9: JOB(p.in[31] + L * M1, p.in[30] + L * 1024, O_WPG, 1024, 1024, 1024, MAP_ID, 0); break;
    case 10: JOB(p.in[16] + (size_t)L * 384 * 1536, p.in[15] + L * 384, O_WUQ, 1536, 384, 1536, MAP_UQ, 0); break;
    case 11: JOB(p.in[18] + (size_t)L * 256 * 2048, p.in[17] + L * 256, O_WKVK, 2048, 256, 1024, MAP_KVK, 0); break;
    case 12: JOB(p.in[18] + (size_t)L * 256 * 2048, p.in[17] + L * 256, O_WKVV, 2048, 256, 1024, MAP_KVV, 0); break;
    case 13: JOB(p.in[28] + (size_t)L * 1024 * 5632, p.in[27] + L * 1024, O_WGU2, 5632, 1024, 5632, MAP_SWIGLU, 0); break;
    case 14: JOB(p.in[29] + (size_t)L * 2816 * 1024, nullptr, O_WD2, 1024, 2816, 1024, MAP_ID, 0); break;
    default: JOB(p.in[32] + (size_t)L * 256 * 1024, nullptr, O_WPLE, 1024, 256, 1024, MAP_ID, 0); break;
    }
}
constexpr int NJOBS = 16;
__device__ __forceinline__ void tr_item(const Job& J, int item, LAS float* scr, int lane) {
    const int nblk = J.dN >> 5, kb = item / nblk, nb = item % nblk, k0 = 64 * kb, n0 = 32 * nb;
    const int sc0 = srcmap(J.map, J.off, n0);
    if (sc0 >= 0 && srcmap(J.map, J.off, n0 + 1) == sc0 + 1 && srcmap(J.map, J.off, n0 + 31) == sc0 + 31) {
        const int kr = lane >> 3, c4 = lane & 7; f32x4 v[8];
#pragma unroll
        for (int i = 0; i < 8; ++i) v[i] = *(const f32x4*)(J.W + (size_t)(k0 + 8 * i + kr) * J.ldw + sc0 + 4 * c4);
#pragma unroll
        for (int i = 0; i < 8; ++i) { const int kk = 8 * i + kr; const float gn = J.gain ? J.gain[k0 + kk] : 1.f;
            scr[kk * 33 + 4 * c4] = v[i][0] * gn; scr[kk * 33 + 4 * c4 + 1] = v[i][1] * gn; scr[kk * 33 + 4 * c4 + 2] = v[i][2] * gn; scr[kk * 33 + 4 * c4 + 3] = v[i][3] * gn; }
    } else {
        const int sc = srcmap(J.map, J.off, n0 + (lane & 31));
#pragma unroll 8
        for (int i = 0; i < 32; ++i) { const int kk = 2 * i + (lane >> 5); float v = (sc >= 0) ? J.W[(size_t)(k0 + kk) * J.ldw + sc] : 0.f; if (J.gain) v *= J.gain[k0 + kk]; scr[kk * 33 + (lane & 31)] = v; }
    }
    asm volatile("s_waitcnt lgkmcnt(0)" ::: "memory");
    const int c = lane & 7;
#pragma unroll
    for (int j = 0; j < 4; ++j) { const int n = (lane >> 3) + 8 * j; const LAS float* s = scr + (8 * c) * 33 + n;
        u32x4 o; o.x = cvt_pk_bf16(s[0 * 33], s[1 * 33]); o.y = cvt_pk_bf16(s[2 * 33], s[3 * 33]); o.z = cvt_pk_bf16(s[4 * 33], s[5 * 33]); o.w = cvt_pk_bf16(s[6 * 33], s[7 * 33]);
        *(u32x4*)(J.dst + (size_t)(n0 + n) * J.K + k0 + 8 * c) = o; }
    asm volatile("s_waitcnt lgkmcnt(0)" ::: "memory");
}
__device__ __forceinline__ void phase0(const Params& p, int L, LAS unsigned char* lds, int G, int blk) {
    const int tid = pg8::tid_opaque(), lane = tid & 63, wave = tid >> 6;
    const int gw = blk * 8 + wave, NGW = G * 8, gt = blk * 512 + tid, NGT = G * 512;
    bf16_t* wb = (bf16_t*)(p.ws + WS_W);
    LAS float* scr = (LAS float*)(lds + wave * 8448);
    int total = 0;
    for (int j = 0; j < NJOBS; ++j) { Job J; get_job(p, L, j, wb, J); total += (J.K >> 6) * (J.dN >> 5); }
    for (int it = gw; it < total; it += NGW) {
        int r = it;
        for (int j = 0; j < NJOBS; ++j) { Job J; get_job(p, L, j, wb, J); const int n = (J.K >> 6) * (J.dN >> 5); if (r < n) { tr_item(J, r, scr, lane); break; } r -= n; }
    }
    { bf16_t* d = wb + O_WLRU; const float* wa = p.in[9] + (size_t)L * 65536; const float* wx = p.in[11] + (size_t)L * 65536;
      for (int i = gt; i < 2048 * 128; i += NGT) { const int n = i >> 7, k = i & 127, ch = n >> 1, nb = ch >> 6, dd = ch & 63;
          float v = 0.f; if ((k >> 6) == (nb & 1)) v = ((n & 1) ? wx : wa)[(size_t)nb * 4096 + (k & 63) * 64 + dd]; d[i] = f2bf(v); } }
    { bf16_t* d = wb + O_WSGU; const float* w = p.in[22] + (size_t)L * 131072;
      for (int i = gt; i < 131072; i += NGT) { const int t = (i >> 7) & 127, s = i & 127; d[i] = f2bf(((s >> 6) <= (t >> 6)) ? w[i] : 0.f); } }
    { float* sp = (float*)(p.ws + WS_SMALL + SM_SP8); const float* lam = p.in[13] + L * 1024;
      for (int i = gt; i < 1024; i += NGT) sp[i] = 8.f * 0.6931471805599453f * __builtin_amdgcn_logf(1.f + fexp2(-LOG2E * lam[i])); }
    if (L == 0) {
        float* rope = (float*)(p.ws + WS_SMALL + SM_ROPE);
        for (int i = gt; i < 2048 * 16; i += NGT) { const int pos = i >> 4, k = i & 15; const float inv = fexp2(-(float)k * (13.287712379549449f / 16.f)); const float ang = (float)pos * inv;
            double rev = (double)ang * 0.15915494309189535; rev -= floor(rev); const float fr = (float)rev; rope[2 * i] = __builtin_amdgcn_cosf(fr); rope[2 * i + 1] = __builtin_amdgcn_sinf(fr); }
        const float* x = p.in[0]; bf16_t* XB = (bf16_t*)(p.ws + WS_XB); float* ssq = (float*)(p.ws + WS_SSQ);
        for (int m = gw; m < T; m += NGW) {
            const f32x4* xr = (const f32x4*)(x + (size_t)m * DM) + lane; u32x2* o8 = (u32x2*)(XB + (size_t)m * DM) + lane; float s = 0.f;
#pragma unroll
            for (int j = 0; j < 4; ++j) { const f32x4 v = xr[64 * j]; s += (v[0] * v[0] + v[1] * v[1]) + (v[2] * v[2] + v[3] * v[3]); u32x2 w; w.x = cvt_pk_bf16(v[0], v[1]); w.y = cvt_pk_bf16(v[2], v[3]); o8[64 * j] = w; }
            s = wave_sum(s);
            if (lane < 16) ssq[(size_t)(lane >> 2) * SSQ_PLANE + (size_t)m * 4 + (lane & 3)] = (lane == 0) ? s : 0.f;
        }
    }
}

__device__ __forceinline__ void pb_convert(const Params& p, int L, int G, int blk) {
    const int tid = pg8::tid_opaque(), gt = blk * 512 + tid, NGT = G * 512;
    const f32x4* src = (const f32x4*)(p.in[1] + (size_t)L * T * 256); u32x2* d = (u32x2*)(p.ws + WS_BIG + B_PB);
    for (int i = gt; i < T * 256 / 4; i += NGT) { const f32x4 v = src[i]; u32x2 w; w.x = cvt_pk_bf16(v[0], v[1]); w.y = cvt_pk_bf16(v[2], v[3]); d[i] = w; }
}
__device__ __forceinline__ void e1_rows(const Params& p, int L, const bf16_t* Z, bf16_t* XC, float* RSQ, float* RSKV, bf16_t* KR, const float* rope, int G, int blk) {
    const int tid = pg8::tid_opaque(), lane = tid & 63, wave = tid >> 6;
    const float* cw = p.in[7] + (size_t)L * 4096; const float* cb = p.in[8] + L * 1024;
    for (int rb = blk * 64 + wave * 8; rb < TC; rb += G * 64) {
        const bool halo = (rb & 2047) != 0;
        u32x4 cqv[8]; u32x2 ckv[8];
#pragma unroll
        for (int r = 0; r < 8; ++r) { const bf16_t* zr = Z + (size_t)(rb + r) * ZLD; cqv[r] = (lane < 48) ? *(const u32x4*)(zr + ZC_CQ + 8 * lane) : (u32x4){0u, 0u, 0u, 0u}; ckv[r] = *(const u32x2*)(zr + ZC_CKV + 4 * lane); }
#pragma unroll
        for (int hf = 0; hf < 2; ++hf) {
            const int c0 = hf * 512 + 8 * lane; u32x4 xr[11];
#pragma unroll
            for (int j = 0; j < 11; ++j) xr[j] = (j >= 3 || halo) ? *(const u32x4*)(Z + (ptrdiff_t)(rb - 3 + j) * ZLD + ZC_XA + c0) : (u32x4){0u, 0u, 0u, 0u};
            f32x4 w0[4], w1[4]; const f32x4 b0 = *(const f32x4*)(cb + c0), b1 = *(const f32x4*)(cb + c0 + 4);
#pragma unroll
            for (int k = 0; k < 4; ++k) { w0[k] = *(const f32x4*)(cw + k * 1024 + c0); w1[k] = *(const f32x4*)(cw + k * 1024 + c0 + 4); }
#pragma unroll
            for (int r = 0; r < 8; ++r) { f32x4 a0 = b0, a1 = b1;
#pragma unroll
                for (int k = 0; k < 4; ++k) { f32x4 x0, x1; unpack8(xr[r + k], x0, x1); a0 += w0[k] * x0; a1 += w1[k] * x1; }
                *(u32x4*)(XC + (size_t)(rb + r) * DM + c0) = pack8(a0, a1); }
        }
        float sq[8], sk[8];
#pragma unroll
        for (int r = 0; r < 8; ++r) { f32x4 x0, x1; unpack8(cqv[r], x0, x1); sq[r] = (x0[0] * x0[0] + x0[1] * x0[1]) + (x0[2] * x0[2] + x0[3] * x0[3]) + (x1[0] * x1[0] + x1[1] * x1[1]) + (x1[2] * x1[2] + x1[3] * x1[3]);
            const float a = bflo(ckv[r].x), b = bfhi(ckv[r].x), c = bflo(ckv[r].y), d = bfhi(ckv[r].y); sk[r] = (a * a + b * b) + (c * c + d * d); }
#pragma unroll
        for (int o = 1; o < 64; o <<= 1)
#pragma unroll
            for (int r = 0; r < 8; ++r) { sq[r] += __shfl_xor(sq[r], o); sk[r] += __shfl_xor(sk[r], o); }
        { float q = sq[0], k = sk[0];
#pragma unroll
          for (int r = 1; r < 8; ++r) { if (lane == r) { q = sq[r]; k = sk[r]; } }
          if (lane < 8) { RSQ[rb + lane] = __builtin_amdgcn_rsqf(q * (1.f / 384.f) + EPS); RSKV[rb + lane] = __builtin_amdgcn_rsqf(k * (1.f / 256.f) + EPS); } }
#pragma unroll
        for (int it = 0; it < 2; ++it) { const int r = rb + it * 4 + (lane >> 4), i = lane & 15, pos = r & 2047;
            const unsigned w = *(const unsigned*)(Z + (size_t)r * ZLD + ZC_KR + 2 * i); const float x1 = bflo(w), x2 = bfhi(w); const f32x2 cs = *(const f32x2*)(rope + (pos * 16 + i) * 2);
            *(unsigned*)(KR + (size_t)r * 32 + 2 * i) = cvt_pk_bf16(x1 * cs[0] - x2 * cs[1], x1 * cs[1] + x2 * cs[0]); }
    }
}
__device__ __forceinline__ void e2_stats(LAS unsigned char* lds, const bf16_t* VTS, float* MEANV, float* RSTDV, int G, int blk) {
    const int tid = pg8::tid_opaque(), lane = tid & 63, wave = tid >> 6, tg = lane & 7, cr = lane >> 3;
    LAS float* part = (LAS float*)lds;
    for (int unit = blk; unit < TC / 64; unit += G) {
        const int tok0 = unit * 64; float s[8], q[8];
#pragma unroll
        for (int e = 0; e < 8; ++e) { s[e] = 0.f; q[e] = 0.f; }
#pragma unroll
        for (int it = 0; it < 16; ++it) { const int c = wave * 128 + it * 8 + cr; f32x4 x0, x1; unpack8(*(const u32x4*)(VTS + (size_t)c * TC + tok0 + 8 * tg), x0, x1);
#pragma unroll
            for (int e = 0; e < 4; ++e) { s[e] += x0[e]; q[e] += x0[e] * x0[e]; s[4 + e] += x1[e]; q[4 + e] += x1[e] * x1[e]; } }
#pragma unroll
        for (int e = 0; e < 8; ++e) { s[e] += __shfl_xor(s[e], 8); s[e] += __shfl_xor(s[e], 16); s[e] += __shfl_xor(s[e], 32); q[e] += __shfl_xor(q[e], 8); q[e] += __shfl_xor(q[e], 16); q[e] += __shfl_xor(q[e], 32); }
        if (cr == 0) {
#pragma unroll
            for (int e = 0; e < 8; ++e) { part[(wave * 64 + 8 * tg + e) * 2] = s[e]; part[(wave * 64 + 8 * tg + e) * 2 + 1] = q[e]; } }
        __syncthreads();
        if (tid < 64) { float ss = 0.f, qq = 0.f;
#pragma unroll
            for (int w = 0; w < 8; ++w) { ss += part[(w * 64 + tid) * 2]; qq += part[(w * 64 + tid) * 2 + 1]; }
            const float mean = ss * (1.f / 1024.f); const float var = fmaxf(qq * (1.f / 1024.f) - mean * mean, 0.f);
            MEANV[tok0 + tid] = mean; RSTDV[tok0 + tid] = __builtin_amdgcn_rsqf(var + EPS); }
        __syncthreads();
    }
}
__device__ __forceinline__ void scan_units(LAS unsigned char* lds, const bf16_t* LA, const bf16_t* U, bf16_t* Z, int G, int blk) {
    const int tid = pg8::tid_opaque(), cp = tid & 15, seg = tid >> 4;
    LAS f32x4* sc = (LAS f32x4*)lds;
    for (int idx = blk; idx < 256; idx += G) {
        const int b = idx >> 5, ch = (idx & 31) * 32 + 2 * cp; const size_t row0 = (size_t)b * 2048 + seg * 64;
        const unsigned* lap = (const unsigned*)(LA + row0 * DM + ch); const unsigned* up = (const unsigned*)(U + row0 * DM + ch);
        float h0 = 0.f, h1 = 0.f, s0 = 0.f, s1 = 0.f;
#pragma unroll 16
        for (int t = 0; t < 64; ++t) { const unsigned lw = lap[(size_t)t * 512], uw = up[(size_t)t * 512]; const float l0 = bflo(lw), l1 = bfhi(lw);
            h0 = fexp2(LOG2E * l0) * h0 + bflo(uw); h1 = fexp2(LOG2E * l1) * h1 + bfhi(uw); s0 += l0; s1 += l1; }
        sc[seg * 16 + cp] = (f32x4){s0, s1, h0, h1};
        __syncthreads();
        float c0 = 0.f, c1 = 0.f;
        for (int j = 0; j < seg; ++j) { const f32x4 v = sc[j * 16 + cp]; c0 = fexp2(LOG2E * v[0]) * c0 + v[2]; c1 = fexp2(LOG2E * v[1]) * c1 + v[3]; }
        h0 = c0; h1 = c1;
        unsigned* gp = (unsigned*)(Z + row0 * ZLD + ZC_GA + ch);
#pragma unroll 16
        for (int t = 0; t < 64; ++t) { const unsigned lw = lap[(size_t)t * 512], uw = up[(size_t)t * 512], gw = gp[(size_t)t * (ZLD / 2)];
            h0 = fexp2(LOG2E * bflo(lw)) * h0 + bflo(uw); h1 = fexp2(LOG2E * bfhi(lw)) * h1 + bfhi(uw); gp[(size_t)t * (ZLD / 2)] = cvt_pk_bf16(h0 * bflo(gw), h1 * bfhi(gw)); }
        __syncthreads();
    }
}
__device__ __forceinline__ void attn_units(LAS unsigned char* lds, const bf16_t* Q, const bf16_t* KN, const bf16_t* KR, const bf16_t* VT, bf16_t* Z, int G, int blk) {
    const int tid = pg8::tid_opaque(), lane = tid & 63, wid = __builtin_amdgcn_readfirstlane(tid >> 6), i32 = lane & 31, hi = lane >> 5;
    constexpr int KP = 208, VP = 144, KBUF = 64 * KP, VBUF = 64 * VP;
    for (int idx = blk; idx < 1024; idx += G) {
        const int j = idx & 255, rnd = idx >> 8, bh = j >> 1;
        const int qb = (j & 1) ? (rnd == 0 ? 1 : rnd == 1 ? 6 : rnd == 2 ? 3 : 4) : (rnd == 0 ? 0 : rnd == 1 ? 7 : rnd == 2 ? 2 : 5);
        const int b = bh >> 4, h = bh & 15, q0 = qb * 256, NT = q0 / 64 + 4, ntw = (q0 + 32 * wid) / 64 + 1;
        const size_t rowb = (size_t)b * 2048;
        bf16x8 qr[6];
        { const bf16_t* qp = Q + (rowb + q0 + 32 * wid + i32) * 1536 + h * 96 + 8 * hi;
#pragma unroll
          for (int ks = 0; ks < 6; ++ks) qr[ks] = *(const bf16x8*)(qp + 16 * ks); }
        const bf16_t* kns = KN + (rowb + (tid >> 3)) * DM + h * 64 + 8 * (tid & 7);
        const bf16_t* krs = KR + (rowb + (tid >> 2)) * 32 + 8 * (tid & 3);
        const bf16_t* vts = VT + (size_t)(h * 64 + (tid >> 3)) * TC + rowb + 8 * (tid & 7);
        const int kdst = (tid >> 3) * KP + (tid & 7) * 16, krdst = (tid >> 2) * KP + 128 + (tid & 3) * 16, vdst = 2 * KBUF + (tid >> 3) * VP + (tid & 7) * 16;
        u32x4 rk, rr = (u32x4){0u, 0u, 0u, 0u}, rv;
        rk = *(const u32x4*)kns; if (tid < 256) rr = *(const u32x4*)krs; rv = *(const u32x4*)vts;
        *(LAS u32x4*)(lds + kdst) = rk; if (tid < 256) *(LAS u32x4*)(lds + krdst) = rr; *(LAS u32x4*)(lds + vdst) = rv;
        __syncthreads();
        f32x16 o0, o1;
#pragma unroll
        for (int r = 0; r < 16; ++r) { o0[r] = 0.f; o1[r] = 0.f; }
        float mrun = -1e30f, lrun = 0.f;
        for (int t = 0; t < NT; ++t) {
            const int cur = t & 1; const bool more = (t + 1 < NT);
            if (more) { rk = *(const u32x4*)(kns + (size_t)(t + 1) * 64 * DM); if (tid < 256) rr = *(const u32x4*)(krs + (size_t)(t + 1) * 64 * 32); rv = *(const u32x4*)(vts + (size_t)(t + 1) * 64); }
            if (t < ntw) {
                LAS const unsigned char* kb = lds + cur * KBUF; LAS const unsigned char* vb = lds + 2 * KBUF + cur * VBUF;
                f32x16 s0, s1;
#pragma unroll
                for (int r = 0; r < 16; ++r) { s0[r] = 0.f; s1[r] = 0.f; }
#pragma unroll
                for (int ks = 0; ks < 6; ++ks) {
                    const bf16x8 a0 = *(LAS const bf16x8*)(kb + i32 * KP + (16 * ks + 8 * hi) * 2), a1 = *(LAS const bf16x8*)(kb + (32 + i32) * KP + (16 * ks + 8 * hi) * 2);
                    s0 = __builtin_amdgcn_mfma_f32_32x32x16_bf16(a0, qr[ks], s0, 0, 0, 0); s1 = __builtin_amdgcn_mfma_f32_32x32x16_bf16(a1, qr[ks], s1, 0, 0, 0);
                }
                float mx = fmaxf(s0[0], s1[0]);
#pragma unroll
                for (int r = 1; r < 16; ++r) mx = fmaxf(mx, fmaxf(s0[r], s1[r]));
                mx = fmaxf(mx, __shfl_xor(mx, 32));
                const float mn = fmaxf(mrun, mx), alpha = fexp2(mrun - mn); mrun = mn;
                float rs = 0.f;
#pragma unroll
                for (int r = 0; r < 16; ++r) { s0[r] = fexp2(s0[r] - mn); s1[r] = fexp2(s1[r] - mn); rs += s0[r] + s1[r]; }
                lrun = lrun * alpha + rs;
#pragma unroll
                for (int r = 0; r < 16; ++r) { o0[r] *= alpha; o1[r] *= alpha; }
                bf16x8 pf[2][2];
#pragma unroll
                for (int uu = 0; uu < 2; ++uu) {
                    u32x4 w0, w1;
                    w0.x = cvt_pk_bf16(s0[8 * uu + 0], s0[8 * uu + 1]); w0.y = cvt_pk_bf16(s0[8 * uu + 2], s0[8 * uu + 3]); w0.z = cvt_pk_bf16(s0[8 * uu + 4], s0[8 * uu + 5]); w0.w = cvt_pk_bf16(s0[8 * uu + 6], s0[8 * uu + 7]);
                    w1.x = cvt_pk_bf16(s1[8 * uu + 0], s1[8 * uu + 1]); w1.y = cvt_pk_bf16(s1[8 * uu + 2], s1[8 * uu + 3]); w1.z = cvt_pk_bf16(s1[8 * uu + 4], s1[8 * uu + 5]); w1.w = cvt_pk_bf16(s1[8 * uu + 6], s1[8 * uu + 7]);
                    pf[0][uu] = __builtin_bit_cast(bf16x8, w0); pf[1][uu] = __builtin_bit_cast(bf16x8, w1);
                }
#pragma unroll
                for (int tt = 0; tt < 2; ++tt)
#pragma unroll
                    for (int uu = 0; uu < 2; ++uu) {
                        LAS const unsigned char* vp0 = vb + i32 * VP + (32 * tt + 16 * uu + 4 * hi) * 2; LAS const unsigned char* vp1 = vp0 + 32 * VP;
                        const u32x2 a = *(LAS const u32x2*)vp0, bq = *(LAS const u32x2*)(vp0 + 16), c = *(LAS const u32x2*)vp1, d = *(LAS const u32x2*)(vp1 + 16);
                        const bf16x8 vf0 = __builtin_bit_cast(bf16x8, ((u32x4){a.x, a.y, bq.x, bq.y})), vf1 = __builtin_bit_cast(bf16x8, ((u32x4){c.x, c.y, d.x, d.y}));
                        o0 = __builtin_amdgcn_mfma_f32_32x32x16_bf16(vf0, pf[tt][uu], o0, 0, 0, 0); o1 = __builtin_amdgcn_mfma_f32_32x32x16_bf16(vf1, pf[tt][uu], o1, 0, 0, 0);
                    }
            }
            if (more) { const int nb = cur ^ 1; *(LAS u32x4*)(lds + nb * KBUF + kdst) = rk; if (tid < 256) *(LAS u32x4*)(lds + nb * KBUF + krdst) = rr; *(LAS u32x4*)(lds + nb * VBUF + vdst) = rv; }
            __syncthreads();
        }
        lrun += __shfl_xor(lrun, 32); const float inv = frcp(lrun);
        bf16_t* op = Z + (rowb + q0 + 32 * wid + i32) * ZLD + ZC_XA + h * 64 + 4 * hi;
#pragma unroll
        for (int rg = 0; rg < 4; ++rg) {
            u32x2 w; w.x = cvt_pk_bf16(o0[4 * rg] * inv, o0[4 * rg + 1] * inv); w.y = cvt_pk_bf16(o0[4 * rg + 2] * inv, o0[4 * rg + 3] * inv); *(u32x2*)(op + 8 * rg) = w;
            w.x = cvt_pk_bf16(o1[4 * rg] * inv, o1[4 * rg + 1] * inv); w.y = cvt_pk_bf16(o1[4 * rg + 2] * inv, o1[4 * rg + 3] * inv); *(u32x2*)(op + 32 + 8 * rg) = w;
        }
    }
}
__device__ __forceinline__ void sgu_units(LAS unsigned char* lds, const bf16_t* VTS, const float* MEANV, const float* RSTDV, const float* lng, const float* lnb, const bf16_t* WS, const float* bs, bf16_t* Z, int G, int blk) {
    const int tid = pg8::tid_opaque(), lane = tid & 63, wid = __builtin_amdgcn_readfirstlane(tid >> 6), i32 = lane & 31, hi = lane >> 5;
    constexpr int AP = 272;
    for (int idx = blk; idx < 1024; idx += G) {
        const int tb = idx >> 3, g = idx & 7, tok0 = tb * 128;
#pragma unroll
        for (int jj = 0; jj < 4; ++jj) {
            const int id = tid + 512 * jj, c = id >> 4, sc = id & 15; f32x4 x0, x1; unpack8(*(const u32x4*)(VTS + (size_t)(g * 128 + c) * TC + tok0 + 8 * sc), x0, x1);
            const f32x4 m0 = *(const f32x4*)(MEANV + tok0 + 8 * sc), m1 = *(const f32x4*)(MEANV + tok0 + 8 * sc + 4), r0 = *(const f32x4*)(RSTDV + tok0 + 8 * sc), r1 = *(const f32x4*)(RSTDV + tok0 + 8 * sc + 4);
            const float ga = lng[g * 128 + c], be = lnb[g * 128 + c];
            x0 = (x0 - m0) * r0 * ga + be; x1 = (x1 - m1) * r1 * ga + be;
            *(LAS u32x4*)(lds + c * AP + sc * 16) = pack8(x0, x1);
        }
        __syncthreads();
        const int tt = wid & 3; bf16x8 wf[8];
        { const bf16_t* wp = WS + (size_t)(g * 128 + 32 * tt + i32) * 128 + 8 * hi;
#pragma unroll
          for (int ks = 0; ks < 8; ++ks) wf[ks] = *(const bf16x8*)(wp + 16 * ks); }
        const float bsv = bs[g * 128 + 32 * tt + i32];
#pragma unroll
        for (int cc = 0; cc < 2; ++cc) {
            const int ct = 2 * (wid >> 2) + cc; f32x16 acc;
#pragma unroll
            for (int r = 0; r < 16; ++r) acc[r] = 0.f;
#pragma unroll
            for (int ks = 0; ks < 8; ++ks) { const bf16x8 a = *(LAS const bf16x8*)(lds + (32 * ct + i32) * AP + (16 * ks + 8 * hi) * 2); acc = __builtin_amdgcn_mfma_f32_32x32x16_bf16(a, wf[ks], acc, 0, 0, 0); }
            bf16_t* up = Z + (size_t)(tok0 + 32 * tt + i32) * ZLD + ZC_U + g * 128 + 32 * ct + 4 * hi;
#pragma unroll
            for (int rg = 0; rg < 4; ++rg) { const u32x2 uv = *(const u32x2*)(up + 8 * rg); u32x2 w;
                w.x = cvt_pk_bf16((acc[4 * rg] + bsv) * bflo(uv.x), (acc[4 * rg + 1] + bsv) * bfhi(uv.x)); w.y = cvt_pk_bf16((acc[4 * rg + 2] + bsv) * bflo(uv.y), (acc[4 * rg + 3] + bsv) * bfhi(uv.y)); *(u32x2*)(up + 8 * rg) = w; }
        }
        __syncthreads();
    }
}

#ifndef DBG_DUMP
#define DBG_DUMP 0
#define DBG_CH 0
#define DBG_TWICE 0
#define DBG_SKIP56 0
#endif
__device__ __forceinline__ void dbg_add(float* out, const bf16_t* buf, size_t n, bool first, int G, int blk) {
    const size_t gt = (size_t)blk * 512 + pg8::tid_opaque(), NGT = (size_t)G * 512;
    for (size_t i = gt; i < (size_t)T * DM; i += NGT) { float v = 0.f; for (size_t j = i; j < n; j += (size_t)T * DM) v += __uint_as_float((unsigned)buf[j] << 16); out[i] = first ? v : out[i] + v; }
}
__device__ __forceinline__ void dbg_addf(float* out, const float* buf, size_t n, int G, int blk) {
    const size_t gt = (size_t)blk * 512 + pg8::tid_opaque(), NGT = (size_t)G * 512;
    for (size_t i = gt; i < (size_t)T * DM; i += NGT) out[i] += buf[i % n];
}
#define APS 0
#define RUN_GEMM(EPI, e, Ap, Bp, M_, N_, K_, lda_, ldb_, apn_) do { int K__ = (K_), blk__ = blk; asm volatile("" : "+s"(K__), "+s"(blk__)); pg8::Gemm gg{(Ap), (Bp), (M_), (N_), K__, (lda_), (ldb_), (apn_), APS}; pg8::StaticOrder SO; SO.init((M_), (N_), G, blk__); \
    pg8::gemm_phase<decltype(e), pg8::StaticOrder, true, true>(lds, gg, SO, e); } while (0)

constexpr size_t SM_BAR = 1024 * 1024;
#define XB_TMO      128
#define XB_XCNT(j)  (256  + 64 * (j))
#define XB_XSUB(j)  (1280 + 64 * (j))
#define XB_XGEN(j)  (2304 + 64 * (j))
#define XB_TOP      3328
#define XB_TOPGEN   3392
#define XCD_BAR_WORDS 3456
#define XB_SPIN_CAP (1u << 18)

__device__ __forceinline__ unsigned xb_ld(unsigned* p)              { return __hip_atomic_load(p, __ATOMIC_RELAXED, __HIP_MEMORY_SCOPE_AGENT); }
__device__ __forceinline__ unsigned xb_add(unsigned* p, unsigned v) { return __hip_atomic_fetch_add(p, v, __ATOMIC_RELAXED, __HIP_MEMORY_SCOPE_AGENT); }
__device__ __forceinline__ unsigned xb_xcc_id() { return (unsigned)__builtin_amdgcn_s_getreg((3 << 11) | 20) & 0xFu; }
#define XB_SPIN(cond, bar) do { unsigned _sp = 0; while (cond) { __builtin_amdgcn_s_sleep(1); \
    if ((++_sp & 255u) == 0u) { if (xb_ld(&(bar)[XB_TMO])) break; if (_sp > XB_SPIN_CAP) { atomicAdd(&(bar)[XB_TMO], 1u); break; } } } } while (0)

struct XcdBarrier {
    unsigned* bar; unsigned x;
    volatile __attribute__((address_space(3))) unsigned* st;
};

__device__ __forceinline__ XcdBarrier xcd_barrier_post(unsigned* bar, volatile __attribute__((address_space(3))) unsigned* st) {
    XcdBarrier b; b.bar = bar; b.x = xb_xcc_id(); b.st = st;
    if (threadIdx.x == 0) (void)xb_add(&bar[XB_XCNT(b.x)], 1u);
    return b;
}
__device__ __forceinline__ void xcd_barrier_complete(unsigned* bar, unsigned x, unsigned& nloc, unsigned& nx) {
    const unsigned G = gridDim.x * gridDim.y * gridDim.z;
    unsigned sum, cnt, mine, sp = 0u;
    for (;;) {
        sum = 0u; cnt = 0u; mine = 0u;
#pragma unroll
        for (unsigned j = 0; j < 16; ++j) { const unsigned c = xb_ld(&bar[XB_XCNT(j)]); sum += c; cnt += (c > 0u) ? 1u : 0u; mine = (j == x) ? c : mine; }
        if (sum == G) break;
        __builtin_amdgcn_s_sleep(1);
        if ((++sp & 255u) == 0u) { if (xb_ld(&bar[XB_TMO])) break; if (sp > XB_SPIN_CAP) { atomicAdd(&bar[XB_TMO], 1u); break; } }
    }
    nloc = mine > 0u ? mine : 1u; nx = cnt > 0u ? cnt : 1u;
}

__device__ __forceinline__ void xcd_barrier(const XcdBarrier& b) {
    asm volatile("s_waitcnt vmcnt(0)" ::: "memory");
    __syncthreads();
    if (threadIdx.x == 0) {
        unsigned* bar = b.bar;
        __builtin_amdgcn_s_waitcnt(0);
        unsigned nloc = b.st[0], nx = b.st[1];
        if (nloc == 0u) { xcd_barrier_complete(bar, b.x, nloc, nx); b.st[0] = nloc; b.st[1] = nx; }
        const unsigned old = xb_add(&bar[XB_XSUB(b.x)], 1u);
        const unsigned gen = old / nloc;
        if (old + 1u == (gen + 1u) * nloc) {
            __builtin_amdgcn_fence(__ATOMIC_RELEASE, "agent");
            asm volatile("s_waitcnt vmcnt(0)" ::: "memory");
            const unsigned og = xb_add(&bar[XB_TOP], 1u);
            const unsigned tg = og / nx;
            if (og + 1u == (tg + 1u) * nx) xb_add(&bar[XB_TOPGEN], 1u);
            else XB_SPIN(xb_ld(&bar[XB_TOPGEN]) == tg, bar);
            __builtin_amdgcn_fence(__ATOMIC_ACQUIRE, "agent");
            xb_add(&bar[XB_XGEN(b.x)], 1u);
            asm volatile("s_waitcnt vmcnt(0)" ::: "memory");
        } else {
            XB_SPIN(xb_ld(&bar[XB_XGEN(b.x)]) == gen, bar);
            __builtin_amdgcn_fence(__ATOMIC_ACQUIRE, "agent");
            asm volatile("s_waitcnt vmcnt(0)" ::: "memory");
        }
    }
    __syncthreads();
}
#define GRID_SYNC() xcd_barrier(xbar)

#define DBG_DUMP_BODY(st) do { \
    dbg_add(X, G3, (size_t)TC * 3072, true, G, blk); } while (0)
__global__ void __launch_bounds__(512, 2) fwd_kernel(Params p) {
    extern __shared__ __attribute__((aligned(16))) unsigned char lds_raw[];
    LAS unsigned char* lds = (LAS unsigned char*)lds_raw;
    cg::grid_group grid = cg::this_grid();
    const int G = gridDim.x, blk = blockIdx.x;
    unsigned char* ws = p.ws;
    { volatile LAS unsigned* st0 = (volatile LAS unsigned*)(lds + 131072); if (threadIdx.x < 64) st0[threadIdx.x] = 0u; }
    __syncthreads();
    const XcdBarrier xbar = xcd_barrier_post((unsigned*)(ws + WS_SMALL + SM_BAR), (volatile LAS unsigned*)(lds + 131072));
    grid.sync();
    bf16_t* wb = (bf16_t*)(ws + WS_W); bf16_t* XB = (bf16_t*)(ws + WS_XB); float* SSQ = (float*)(ws + WS_SSQ); float* X = p.out;
    float* ROPE = (float*)(ws + WS_SMALL + SM_ROPE); float* RSQ = (float*)(ws + WS_SMALL + SM_RSQ); float* RSKV = (float*)(ws + WS_SMALL + SM_RSKV);
    float* MEANV = (float*)(ws + WS_SMALL + SM_MEANV); float* RSTDV = (float*)(ws + WS_SMALL + SM_RSTDV); float* SP8 = (float*)(ws + WS_SMALL + SM_SP8);
    unsigned char* big = ws + WS_BIG;
    bf16_t* H = (bf16_t*)(big + B_H); bf16_t* PB = (bf16_t*)(big + B_PB); bf16_t* GP = (bf16_t*)(big + B_GP);
    bf16_t* Z = (bf16_t*)(big + B_Z); bf16_t* VTS = (bf16_t*)(big + B_VTS); bf16_t* XC = (bf16_t*)(big + B_XC); bf16_t* LA = (bf16_t*)(big + B_LA); bf16_t* U = (bf16_t*)(big + B_U);
    bf16_t* Q = (bf16_t*)(big + B_Q); bf16_t* KN = (bf16_t*)(big + B_KN); bf16_t* VT = (bf16_t*)(big + B_VT); bf16_t* KR = (bf16_t*)(big + B_KR);
    bf16_t* G3 = (bf16_t*)(big + B_G3); bf16_t* MG = (bf16_t*)(big + B_MERGED);

#pragma unroll 1
    for (int L = 0; L < 2; ++L) {
        phase0(p, L, lds, G, blk);
        GRID_SYNC();
        { EpiSwiglu e{H, SSQ}; RUN_GEMM(EpiSwiglu, e, XB, wb + O_WGU1, T, 2 * DFF, 1024, 1024, 1024, 0); }
        GRID_SYNC();
        { EpiResid<false> e{L == 0 ? p.in[0] : nullptr, XB, SSQ, nullptr, 0.5f}; RUN_GEMM(EpiResid<false>, e, H, wb + O_WD1, T, 1024, DFF, DFF, DFF, 0); }
        GRID_SYNC();
#pragma unroll 1
        for (int c = 0; c <= 2; ++c) {
            if (c >= 1) { const size_t q0 = (size_t)(c - 1) * TC;
                EpiResid<false> e{nullptr, XB + q0 * DM, SSQ + q0 * 4, nullptr, 1.0f}; RUN_GEMM(EpiResid<false>, e, MG, wb + O_WOUT, TC, 1024, 1024, 1024, 1024, 0); }
            const size_t r0 = (size_t)c * TC;
            if (c <= 1) {
                { EpiRow<1, 0> e{Z, ZLD, SSQ + r0 * 4, nullptr, 4, 12, 0}; RUN_GEMM((EpiRow<1, 0>), e, XB + r0 * DM, wb + O_WIN, TC, ZLD, 1024, 1024, 1024, 0); }
                { EpiCol<1, 0> e{VTS, TC, SSQ + r0 * 4}; RUN_GEMM((EpiCol<1, 0>), e, wb + O_WINV, XB + r0 * DM, 1024, TC, 1024, 1024, 1024, 0); }
            }
            GRID_SYNC();
            if (c > 1) break;
            e1_rows(p, L, Z, XC, RSQ, RSKV, KR, ROPE, G, blk);
            e2_stats(lds, VTS, MEANV, RSTDV, G, blk);
            GRID_SYNC();
            { EpiLru e{XC, LA, U, p.in[10] + L * 1024, p.in[12] + L * 1024, SP8}; RUN_GEMM(EpiLru, e, XC, wb + O_WLRU, TC, 2048, 128, 1024, 128, 128); }
            { EpiQ e{Q, RSQ, ROPE}; RUN_GEMM(EpiQ, e, Z + ZC_CQ, wb + O_WUQ, TC, 1536, 384, ZLD, 384, 0); }
            { EpiRow<0, 1> e{KN, 1024, RSKV, nullptr, 0, 0, 0}; RUN_GEMM((EpiRow<0, 1>), e, Z + ZC_CKV, wb + O_WKVK, TC, 1024, 256, ZLD, 256, 0); }
            { EpiCol<0, 1> e{VT, TC, RSKV}; RUN_GEMM((EpiCol<0, 1>), e, wb + O_WKVV, Z + ZC_CKV, 1024, TC, 256, 256, ZLD, 0); }
            GRID_SYNC();
            scan_units(lds, LA, U, Z, G, blk);
            attn_units(lds, Q, KN, KR, VT, Z, G, blk);
            sgu_units(lds, VTS, MEANV, RSTDV, p.in[20] + L * 1024, p.in[21] + L * 1024, wb + O_WSGU, p.in[23] + L * 1024, Z, G, blk);
            GRID_SYNC();
            { EpiRow<2, 0> e{G3, 3072, SSQ + r0 * 4, p.in[25] + L * 3072, 0, 0, 1}; RUN_GEMM((EpiRow<2, 0>), e, XB + r0 * DM, wb + O_WING, TC, 3072, 1024, 1024, 1024, 0); }
#undef APS
#define APS 2
            { EpiMerge e{G3, MG}; RUN_GEMM(EpiMerge, e, Z, wb + O_WRA, TC, 3072, 1024, ZLD, 1024, 1024); }
#undef APS
#define APS 0
            GRID_SYNC();
        }
        pb_convert(p, L, G, blk);
        { EpiSwiglu e{H, SSQ}; RUN_GEMM(EpiSwiglu, e, XB, wb + O_WGU2, T, 2 * DFF, 1024, 1024, 1024, 0); }
        GRID_SYNC();
        { EpiResid<false> e{nullptr, XB, SSQ, nullptr, 0.5f}; RUN_GEMM(EpiResid<false>, e, H, wb + O_WD2, T, 1024, DFF, DFF, DFF, 0); }
        GRID_SYNC();
        { EpiRow<2, 0> e{GP, 1024, SSQ, nullptr, 0, 0, 0}; RUN_GEMM((EpiRow<2, 0>), e, XB, wb + O_WPG, T, 1024, 1024, 1024, 1024, 0); }
        GRID_SYNC();
        { EpiResid<true> e{nullptr, XB, SSQ, GP, 1.0f}; RUN_GEMM(EpiResid<true>, e, PB, wb + O_WPLE, T, 1024, 256, 256, 256, 0); }
        GRID_SYNC();
    }
    {
        const int tid = pg8::tid_opaque(), lane = tid & 63, wave = tid >> 6, gw = blk * 8 + wave, NGW = G * 8; const float* fn = p.in[33];
        for (int m = gw; m < T; m += NGW) {
            const u32x4* xr = (const u32x4*)(XB + (size_t)m * DM) + lane; f32x4* orow = (f32x4*)(X + (size_t)m * DM); f32x4 v[4]; float s = 0.f;
#pragma unroll
            for (int j = 0; j < 2; ++j) { unpack8(xr[64 * j], v[2 * j], v[2 * j + 1]); }
#pragma unroll
            for (int j = 0; j < 4; ++j) s += (v[j][0] * v[j][0] + v[j][1] * v[j][1]) + (v[j][2] * v[j][2] + v[j][3] * v[j][3]);
            const float rstd = __builtin_amdgcn_rsqf(wave_sum(s) * (1.f / 1024.f) + EPS);
#pragma unroll
            for (int j = 0; j < 2; ++j) { const int c = 512 * j + 8 * lane; orow[c / 4] = v[2 * j] * rstd * *(const f32x4*)(fn + c); orow[c / 4 + 1] = v[2 * j + 1] * rstd * *(const f32x4*)(fn + c + 4); }
        }
    }
}

extern "C" void kernel_launch(void* const* d_in, const int* in_sizes, int n_in, void* d_out, int out_size, void* d_ws, size_t ws_size, hipStream_t stream) {
    static int grid = 0;
    if (grid == 0) {
        if (n_in != 34 || ws_size < WS_NEED) { fprintf(stderr, "kernel_launch: unexpected n_in %d / ws_size %zu (need %zu)\n", n_in, ws_size, (size_t)WS_NEED); grid = -1; return; }
        int dev = 0, cus = 0, per = 0;
        (void)hipGetDevice(&dev); (void)hipDeviceGetAttribute(&cus, hipDeviceAttributeMultiprocessorCount, dev);
        (void)hipFuncSetAttribute((const void*)fwd_kernel, hipFuncAttributeMaxDynamicSharedMemorySize, LDS_BYTES);
        if (hipOccupancyMaxActiveBlocksPerMultiprocessor(&per, (const void*)fwd_kernel, 512, LDS_BYTES) != hipSuccess || per < 1) per = 1;
        (void)hipGetLastError();
        grid = cus * per;
    }
    if (grid < 0) return;
    (void)hipMemsetAsync((unsigned char*)d_ws + WS_SMALL + SM_BAR, 0, 16384, stream);
    Params prm{};
    for (int i = 0; i < 34; ++i) prm.in[i] = (const float*)d_in[i];
    prm.out = (float*)d_out; prm.ws = (unsigned char*)d_ws;
    void* args[] = {&prm};
    hipError_t e = hipLaunchCooperativeKernel((const void*)fwd_kernel, dim3(grid), dim3(512), args, LDS_BYTES, stream);
    if (e != hipSuccess) fprintf(stderr, "cooperative launch failed: %s (grid %d)\n", hipGetErrorString(e), grid);
}
```

```cpp
#include <hip/hip_runtime.h>
#include <hip/hip_cooperative_groups.h>
#include <cstdio>
#include <cstdint>
namespace cg = cooperative_groups;
namespace pg8 {
#define PG8_LAS __attribute__((address_space(3)))
typedef unsigned short bf16_t;
typedef short bf16x8 __attribute__((ext_vector_type(8)));
typedef float f32x4 __attribute__((ext_vector_type(4)));
typedef unsigned u32x4 __attribute__((ext_vector_type(4)));
typedef unsigned u32x2 __attribute__((ext_vector_type(2)));
constexpr int BM = 256, BK = 64, HALF = 128, HTB = HALF * BK * 2  , STAGE_BYTES = 8 * HTB, NXCD = 8, WGM = 8;

__host__ __device__ __forceinline__ int lds_byte(int r, int c) { const int st = (r >> 4) * 2 + (c >> 5), rr = r & 15, cc = c & 31, ob = rr * 64 + cc * 2; return st * 1024 + (ob ^ (((ob >> 9) & 1) << 5)); }
__host__ __device__ __forceinline__ void stage_rc(int b, int& R, int& C) { const int st = b / 1024, sb = b % 1024, swz = sb ^ (((sb >> 9) & 1) << 5); R = (st >> 1) * 16 + swz / 64; C = (st & 1) * 32 + (swz % 64) / 2; }
__host__ __device__ __forceinline__ int perm32(int rho) { const int n = rho >> 4, i = rho & 15; return 8 * (i >> 2) + 4 * n + (i & 3); }

struct Unit { int pm, pn; };
struct Gemm { const bf16_t* A; const bf16_t* Bt; int M, N, K, lda, ldb, apn, aps; };

struct StaticOrder {
    int nM, nN, nwg, G, c;
    __host__ __device__ void init(int M, int N, int G_, int c_) { nM = M / BM; nN = N / BM; nwg = nM * nN; G = G_; c = c_; }
    __host__ __device__ bool next(int i, Unit& u) const {
        const long L = (long)i * G + c; if (L >= nwg) return false;
        int wgid = (int)L; { const int q = nwg / NXCD, r = nwg % NXCD, xcd = wgid % NXCD, off = wgid / NXCD; wgid = (xcd < r ? xcd * (q + 1) : r * (q + 1) + (xcd - r) * q) + off; }
        const int nig = WGM * nN, gid = wgid / nig, fm = gid * WGM, gsz = (nM - fm) < WGM ? (nM - fm) : WGM;
        u.pm = fm + ((wgid % nig) % gsz); u.pn = (wgid % nig) / gsz; return true;
    }
    __device__ __forceinline__ void a_ready(const Unit&) const {}
    __device__ __forceinline__ void done(const Unit&) const {}
};
__device__ __forceinline__ int tid_opaque() { int t = threadIdx.x; asm volatile("" : "+v"(t)); return t; }
typedef float f32x2_t __attribute__((ext_vector_type(2))); typedef __bf16 bf16x2_t __attribute__((ext_vector_type(2)));
__device__ __forceinline__ unsigned cvt_pk_bf16(float lo, float hi) { const f32x2_t v = {lo, hi}; const bf16x2_t b = __builtin_convertvector(v, bf16x2_t); return __builtin_bit_cast(unsigned, b); }

template <class Epi, class Sched, bool ALIGN_EPI = false, bool SP2 = false>
__device__ __forceinline__ void gemm_phase(PG8_LAS unsigned char* lds, const Gemm g, const Sched& S, const Epi& E) {
    const int tid = pg8::tid_opaque(), wid = __builtin_amdgcn_readfirstlane(tid >> 6), lane = tid & 63, wr = wid >> 2, wc = wid & 3, fr = lane & 15, fq = lane >> 4;
    const int K = g.K, nt = K / BK;
    unsigned voffA[2], voffB[2];
#pragma unroll
    for (int i = 0; i < 2; ++i) { int R, C; stage_rc(tid * 16 + i * 8192, R, C); const int Rb = Epi::PERM ? ((R & ~31) + perm32(R & 31)) : R;
        voffA[i] = (unsigned)(R * g.lda + C) * 2u; voffB[i] = (unsigned)(Rb * g.ldb + C) * 2u; }
    const size_t kstep = (size_t)(BK * 2);
    const size_t hstepA = (size_t)HALF * g.lda * 2, hstepB = (size_t)HALF * g.ldb * 2;
    const size_t tstepA = 2 * hstepA, tstepB = 2 * hstepB; const size_t apn = (size_t)g.apn * 2;
    const unsigned ldsw = (unsigned)wid * 1024u;
    const int aoff = lds_byte(wr * 64 + fr, fq * 8), boff = lds_byte(wc * 32 + fr, fq * 8);
#define PG8_SA(b, h) (((b) * 2 + (h)) * HTB)
#define PG8_SB(b, h) ((4 + (b) * 2 + (h)) * HTB)
#define PG8_STAGE(bufoff, gbase, voff) do { _Pragma("unroll") for (int _i = 0; _i < 2; ++_i) \
        __builtin_amdgcn_global_load_lds((const unsigned*)((const char*)(gbase) + (voff)[_i]), (PG8_LAS unsigned*)(lds + (bufoff) + ldsw + _i * 8192), 16, 0, 0); } while (0)
#define PG8_LDA(dst, b, h) do { _Pragma("unroll") for (int m = 0; m < 4; ++m) _Pragma("unroll") for (int k = 0; k < 2; ++k) dst[m][k] = *(const PG8_LAS bf16x8*)(lds + PG8_SA(b, h) + aoff + m * 2048 + k * 1024); } while (0)
#define PG8_LDB(dst, b, h) do { _Pragma("unroll") for (int n = 0; n < 2; ++n) _Pragma("unroll") for (int k = 0; k < 2; ++k) dst[n][k] = *(const PG8_LAS bf16x8*)(lds + PG8_SB(b, h) + boff + n * 2048 + k * 1024); } while (0)
#define PG8_MMA(ai, bj, At, Bt) do { __builtin_amdgcn_s_setprio(1); _Pragma("unroll") for (int m = 0; m < 4; ++m) _Pragma("unroll") for (int n = 0; n < 2; ++n) _Pragma("unroll") for (int k = 0; k < 2; ++k) \
        acc[ai][bj][m][n] = __builtin_amdgcn_mfma_f32_16x16x32_bf16(Bt[n][k], At[m][k], acc[ai][bj][m][n], 0, 0, 0); __builtin_amdgcn_s_setprio(0); } while (0)
#define PG8_WAIT_V(n) asm volatile("s_waitcnt vmcnt(" #n ")" ::: "memory")
#define PG8_WAIT_L(n) asm volatile("s_waitcnt lgkmcnt(" #n ")" ::: "memory")
#define PG8_BAR __builtin_amdgcn_s_barrier()
#define PG8_SCHED __builtin_amdgcn_sched_barrier(0)
    Unit cur, nxt; int ui = 0;
    if (!S.next(0, cur)) return;
    f32x4 acc[2][2][4][2];
#pragma unroll
    for (int a = 0; a < 2; ++a)
#pragma unroll
        for (int b = 0; b < 2; ++b)
#pragma unroll
            for (int m = 0; m < 4; ++m)
#pragma unroll
                for (int n = 0; n < 2; ++n) acc[a][b][m][n] = (f32x4){0.f, 0.f, 0.f, 0.f};
    bf16x8 At[4][2], B0[2][2], B1[2][2];
    const char* cA = (const char*)g.A + (size_t)cur.pm * tstepA + (size_t)(cur.pn >> g.aps) * apn; const char* cB = (const char*)g.Bt + (size_t)cur.pn * tstepB;
    S.a_ready(cur);
    if constexpr (SP2) {
        PG8_STAGE(PG8_SB(0, 0), cB, voffB); PG8_STAGE(PG8_SB(0, 1), cB + hstepB, voffB); PG8_STAGE(PG8_SA(0, 0), cA, voffA); PG8_STAGE(PG8_SA(0, 1), cA + hstepA, voffA);
        if (wr == 1) PG8_BAR;
        PG8_WAIT_V(2); PG8_BAR;
        PG8_STAGE(PG8_SB(1, 0), cB + kstep, voffB); PG8_STAGE(PG8_SA(1, 0), cA + kstep, voffA); PG8_STAGE(PG8_SB(1, 1), cB + hstepB + kstep, voffB);
        PG8_WAIT_V(6); PG8_BAR;
    } else {
        PG8_STAGE(PG8_SB(0, 0), cB, voffB); PG8_STAGE(PG8_SA(0, 0), cA, voffA); PG8_STAGE(PG8_SB(0, 1), cB + hstepB, voffB); PG8_STAGE(PG8_SA(0, 1), cA + hstepA, voffA);
        if (wr == 1) PG8_BAR;
        PG8_WAIT_V(4); PG8_BAR;
        PG8_STAGE(PG8_SB(1, 0), cB + kstep, voffB); PG8_STAGE(PG8_SA(1, 0), cA + kstep, voffA); PG8_STAGE(PG8_SB(1, 1), cB + hstepB + kstep, voffB);
        PG8_WAIT_V(6); PG8_BAR;
    }
    for (;;) {
        const bool has_next = S.next(ui + 1, nxt);
        const char* nA = has_next ? (const char*)g.A + (size_t)nxt.pm * tstepA + (size_t)(nxt.pn >> g.aps) * apn : cA; const char* nB = has_next ? (const char*)g.Bt + (size_t)nxt.pn * tstepB : cB;
        for (int t = 0; t < nt; t += 2) {
            const bool last = (t == nt - 2);
            const char* a1 = cA + (size_t)(t + 1) * kstep;
            const char* a2 = last ? nA : cA + (size_t)(t + 2) * kstep; const char* b2 = last ? nB : cB + (size_t)(t + 2) * kstep;
            const char* a3 = a2 + kstep; const char* b3 = b2 + kstep;
            if (last && has_next) S.a_ready(nxt);
            if constexpr (SP2) {
            PG8_LDB(B0, 0, 0); PG8_LDB(B1, 0, 1); PG8_SCHED; PG8_LDA(At, 0, 0); PG8_STAGE(PG8_SA(1, 1), a1 + hstepA, voffA);
            PG8_WAIT_V(8); PG8_WAIT_L(0); PG8_BAR; PG8_MMA(0, 0, At, B0); PG8_MMA(0, 1, At, B1); PG8_BAR; PG8_SCHED;
            PG8_LDA(At, 0, 1); PG8_STAGE(PG8_SB(0, 0), b2, voffB); PG8_STAGE(PG8_SB(0, 1), b2 + hstepB, voffB); PG8_STAGE(PG8_SA(0, 0), a2, voffA);
            PG8_WAIT_V(8); PG8_WAIT_L(0); PG8_BAR; PG8_MMA(1, 0, At, B0); PG8_MMA(1, 1, At, B1); PG8_BAR; PG8_SCHED;
            PG8_LDB(B0, 1, 0); PG8_LDB(B1, 1, 1); PG8_SCHED; PG8_LDA(At, 1, 0); PG8_STAGE(PG8_SA(0, 1), a2 + hstepA, voffA);
            PG8_WAIT_V(8); PG8_WAIT_L(0); PG8_BAR; PG8_MMA(0, 0, At, B0); PG8_MMA(0, 1, At, B1); PG8_BAR; PG8_SCHED;
            PG8_LDA(At, 1, 1); PG8_STAGE(PG8_SB(1, 0), b3, voffB); PG8_STAGE(PG8_SB(1, 1), b3 + hstepB, voffB); PG8_STAGE(PG8_SA(1, 0), a3, voffA);
            PG8_WAIT_V(8); PG8_WAIT_L(0); PG8_BAR; PG8_MMA(1, 0, At, B0); PG8_MMA(1, 1, At, B1); PG8_BAR; PG8_SCHED;
            } else {
            PG8_LDB(B0, 0, 0); PG8_SCHED; PG8_LDA(At, 0, 0); PG8_STAGE(PG8_SA(1, 1), a1 + hstepA, voffA);
            PG8_WAIT_L(8); PG8_BAR; PG8_WAIT_L(0); PG8_MMA(0, 0, At, B0); PG8_BAR; PG8_SCHED;
            PG8_LDB(B1, 0, 1); PG8_STAGE(PG8_SB(0, 0), b2, voffB);
            PG8_BAR; PG8_WAIT_L(0); PG8_MMA(0, 1, At, B1); PG8_BAR;
            PG8_LDA(At, 0, 1); PG8_STAGE(PG8_SA(0, 0), a2, voffA);
            PG8_BAR; PG8_WAIT_L(0); PG8_MMA(1, 0, At, B0); PG8_BAR; PG8_SCHED;
            PG8_STAGE(PG8_SB(0, 1), b2 + hstepB, voffB);
            PG8_WAIT_V(6); PG8_BAR; PG8_MMA(1, 1, At, B1); PG8_BAR;
            PG8_LDB(B0, 1, 0); PG8_SCHED; PG8_LDA(At, 1, 0); PG8_STAGE(PG8_SA(0, 1), a2 + hstepA, voffA);
            PG8_WAIT_L(8); PG8_BAR; PG8_WAIT_L(0); PG8_MMA(0, 0, At, B0); PG8_BAR; PG8_SCHED;
            PG8_LDB(B1, 1, 1); PG8_STAGE(PG8_SB(1, 0), b3, voffB);
            PG8_BAR; PG8_WAIT_L(0); PG8_MMA(0, 1, At, B1); PG8_BAR;
            PG8_LDA(At, 1, 1); PG8_STAGE(PG8_SA(1, 0), a3, voffA);
            PG8_BAR; PG8_WAIT_L(0); PG8_MMA(1, 0, At, B0); PG8_BAR; PG8_SCHED;
            PG8_STAGE(PG8_SB(1, 1), b3 + hstepB, voffB);
            PG8_WAIT_V(6); PG8_BAR; PG8_MMA(1, 1, At, B1); PG8_BAR;
            }
        }
        if constexpr (ALIGN_EPI) { if (wr == 0) PG8_BAR; }
        if constexpr (!Epi::AFTER_DRAIN) { E(acc, cur, wr, wc, fr, fq); S.done(cur); }
        if (!has_next) break;
#pragma unroll
        for (int a = 0; a < 2; ++a)
#pragma unroll
            for (int b = 0; b < 2; ++b)
#pragma unroll
                for (int m = 0; m < 4; ++m)
#pragma unroll
                    for (int n = 0; n < 2; ++n) acc[a][b][m][n] = (f32x4){0.f, 0.f, 0.f, 0.f};
        cur = nxt; cA = nA; cB = nB; ++ui;
        if constexpr (ALIGN_EPI) { if (wr == 1) PG8_BAR; }
    }
    PG8_WAIT_V(0);
    if constexpr (!ALIGN_EPI) { if (wr == 0) PG8_BAR; }
    PG8_BAR;
    if constexpr (Epi::AFTER_DRAIN) { E.fused(acc, cur, wr, wc, fr, fq, lds, wid, lane); S.done(cur); }
#undef PG8_SA
#undef PG8_SB
#undef PG8_STAGE
#undef PG8_LDA
#undef PG8_LDB
#undef PG8_MMA
#undef PG8_WAIT_V
#undef PG8_WAIT_L
#undef PG8_BAR
#undef PG8_SCHED
}
}

using pg8::bf16_t; using pg8::bf16x8; using pg8::f32x4; using pg8::u32x4; using pg8::u32x2; using pg8::Unit; using pg8::cvt_pk_bf16;
typedef float f32x16 __attribute__((ext_vector_type(16)));
typedef float f32x2 __attribute__((ext_vector_type(2)));
#define LAS __attribute__((address_space(3)))

constexpr int T = 32768, DM = 1024, TC = 16384, DFF = 2816, ZLD = 3840;
constexpr int ZC_XA = 0, ZC_GA = 1024, ZC_U = 2048, ZC_CKV = 3072, ZC_CQ = 3328, ZC_KR = 3712;
constexpr float EPS = 1e-6f, LOG2E = 1.4426950408889634f;
constexpr float QSCALE = 0.10206207261596577f * 1.4426950408889634f;
constexpr size_t MiB = (size_t)1 << 20;
constexpr size_t WS_W = 0, WS_XB = 64 * MiB, WS_SSQ = 128 * MiB, WS_SMALL = 130 * MiB, WS_BIG = 132 * MiB;
constexpr size_t SM_ROPE = 0, SM_RSQ = 256 * 1024, SM_RSKV = 320 * 1024, SM_MEANV = 384 * 1024, SM_RSTDV = 448 * 1024, SM_SP8 = 512 * 1024;
constexpr size_t B_H = 0, B_PB = 176 * MiB, B_GP = 192 * MiB;
constexpr size_t B_Z = 0, B_VTS = 120 * MiB, B_XC = 152 * MiB, B_LA = 184 * MiB, B_U = 216 * MiB, B_Q = 248 * MiB, B_KN = 296 * MiB, B_VT = 328 * MiB, B_KR = 360 * MiB;
constexpr size_t B_G3 = 248 * MiB, B_MERGED = 184 * MiB;
constexpr size_t WS_NEED = WS_BIG + 361 * MiB;
constexpr size_t O_WGU1 = 0, O_WD1 = O_WGU1 + 5632 * 1024, O_WIN = O_WD1 + 1024 * 2816, O_WINV = O_WIN + 3840 * 1024, O_WING = O_WINV + 1024 * 1024,
                 O_WLRU = O_WING + 3072 * 1024, O_WRA = O_WLRU + 2048 * 128, O_WRB = O_WRA + 1024 * 1024, O_WRC = O_WRB + 1024 * 1024, O_WOUT = O_WRC + 1024 * 1024,
                 O_WPG = O_WOUT + 1024 * 1024, O_WUQ = O_WPG + 1024 * 1024, O_WKVK = O_WUQ + 1536 * 384, O_WKVV = O_WKVK + 1024 * 256, O_WGU2 = O_WKVV + 1024 * 256,
                 O_WD2 = O_WGU2 + 5632 * 1024, O_WPLE = O_WD2 + 1024 * 2816, O_WSGU = O_WPLE + 1024 * 256, O_WEND = O_WSGU + 8 * 128 * 128;
static_assert(O_WEND * 2 <= 64 * MiB, "weights fit");
constexpr int LDS_BYTES = 131072 + 256;
#ifndef DBG_STOP
#define DBG_STOP 0
#endif
#ifndef DBG_BR
#define DBG_BR 7
#endif

struct Params { const float* in[34]; float* out; unsigned char* ws; };

__device__ __forceinline__ float fexp2(float x) { return __builtin_amdgcn_exp2f(x); }
__device__ __forceinline__ float frcp(float x) { return __builtin_amdgcn_rcpf(x); }
__device__ __forceinline__ float sigm(float x) { return frcp(1.f + fexp2(-LOG2E * x)); }
__device__ __forceinline__ float gelu_t(float x) { const float t = x + 0.044715f * x * x * x; return x * frcp(1.f + fexp2(-2.3022081985f * t)); }
__device__ __forceinline__ float bflo(unsigned w) { return __uint_as_float(w << 16); }
__device__ __forceinline__ float bfhi(unsigned w) { return __uint_as_float(w & 0xffff0000u); }
__device__ __forceinline__ bf16_t f2bf(float v) { return (bf16_t)(cvt_pk_bf16(v, 0.f) & 0xffffu); }
__device__ __forceinline__ float wave_sum(float v) {
#pragma unroll
    for (int o = 1; o < 64; o <<= 1) v += __shfl_xor(v, o);
    return v;
}
constexpr size_t SSQ_PLANE = (size_t)T * 4;
__device__ __forceinline__ float rstd16(const float* ssq, size_t row) {
    const float* q = ssq + row * 4; const f32x4 a = *(const f32x4*)q, b = *(const f32x4*)(q + SSQ_PLANE), c = *(const f32x4*)(q + 2 * SSQ_PLANE), d = *(const f32x4*)(q + 3 * SSQ_PLANE);
    const float s = ((a.x + a.y) + (a.z + a.w)) + ((b.x + b.y) + (b.z + b.w)) + ((c.x + c.y) + (c.z + c.w)) + ((d.x + d.y) + (d.z + d.w));
    return __builtin_amdgcn_rsqf(s * (1.0f / 1024.0f) + EPS);
}
__device__ __forceinline__ u32x4 pack8(const f32x4 v0, const f32x4 v1) { u32x4 w; w.x = cvt_pk_bf16(v0[0], v0[1]); w.y = cvt_pk_bf16(v0[2], v0[3]); w.z = cvt_pk_bf16(v1[0], v1[1]); w.w = cvt_pk_bf16(v1[2], v1[3]); return w; }
__device__ __forceinline__ void unpack8(const u32x4 w, f32x4& v0, f32x4& v1) { v0 = (f32x4){bflo(w.x), bfhi(w.x), bflo(w.y), bfhi(w.y)}; v1 = (f32x4){bflo(w.z), bfhi(w.z), bflo(w.w), bfhi(w.w)}; }

template <int ACT, int RS> struct EpiRow {
    static constexpr bool PERM = true, AFTER_DRAIN = false;
    bf16_t* O; int ldc; const float* rs; const float* bias; int t0, t1; int bswap;
    __device__ __forceinline__ void operator()(const f32x4 (&acc)[2][2][4][2], const Unit& u, int wr, int wc, int fr, int fq) const {
        const int row0 = u.pm * 256 + wr * 64 + fr, col0 = u.pn * 256 + wc * 32 + 8 * fq;
        const bool act = (ACT == 1) ? (u.pn >= t0 && u.pn < t1) : true;
        f32x4 bv[2][2];
#pragma unroll
        for (int bj = 0; bj < 2; ++bj)
#pragma unroll
            for (int n = 0; n < 2; ++n) bv[bj][n] = bias ? *(const f32x4*)(bias + col0 + (bswap ? (u.pn < 4 ? 1024 : (u.pn < 8 ? -1024 : 0)) : 0) + bj * 128 + 4 * n) : (f32x4){0.f, 0.f, 0.f, 0.f};
#pragma unroll
        for (int ai = 0; ai < 2; ++ai)
#pragma unroll
            for (int m = 0; m < 4; ++m) {
                const size_t row = (size_t)(row0 + ai * 128 + m * 16); const float s = (RS == 0) ? rstd16(rs, row) : rs[row];
                bf16_t* rowp = O + row * ldc + col0;
#pragma unroll
                for (int bj = 0; bj < 2; ++bj) {
                    f32x4 v0 = acc[ai][bj][m][0] * s + bv[bj][0], v1 = acc[ai][bj][m][1] * s + bv[bj][1];
                    if (ACT == 1) { if (act) {
#pragma unroll
                        for (int e = 0; e < 4; ++e) { v0[e] = gelu_t(v0[e]); v1[e] = gelu_t(v1[e]); } } }
                    if (ACT == 2) {
#pragma unroll
                        for (int e = 0; e < 4; ++e) { v0[e] = sigm(v0[e]); v1[e] = sigm(v1[e]); } }
                    *(u32x4*)(rowp + bj * 128) = pack8(v0, v1);
                }
                asm volatile("" ::: "memory");
            }
    }
};
struct EpiSwiglu {
    static constexpr bool PERM = true, AFTER_DRAIN = false;
    bf16_t* H; const float* ssq;
    __device__ __forceinline__ void operator()(const f32x4 (&acc)[2][2][4][2], const Unit& u, int wr, int wc, int fr, int fq) const {
        const int row0 = u.pm * 256 + wr * 64 + fr, col0 = u.pn * 128 + wc * 32 + 8 * fq;
#pragma unroll
        for (int ai = 0; ai < 2; ++ai)
#pragma unroll
            for (int m = 0; m < 4; ++m) {
                const size_t row = (size_t)(row0 + ai * 128 + m * 16); const float s = rstd16(ssq, row);
                f32x4 h0, h1;
#pragma unroll
                for (int e = 0; e < 4; ++e) { const float g0 = acc[ai][0][m][0][e] * s, g1 = acc[ai][0][m][1][e] * s; h0[e] = g0 * sigm(g0) * (acc[ai][1][m][0][e] * s); h1[e] = g1 * sigm(g1) * (acc[ai][1][m][1][e] * s); }
                *(u32x4*)(H + row * DFF + col0) = pack8(h0, h1);
                asm volatile("" ::: "memory");
            }
    }
};
template <bool GATED> struct EpiResid {
    static constexpr bool PERM = false, AFTER_DRAIN = false;
    const float* X32; bf16_t* XB; float* ssq; const bf16_t* GP; float alpha;
    __device__ __forceinline__ void operator()(const f32x4 (&acc)[2][2][4][2], const Unit& u, int wr, int wc, int fr, int fq) const {
        const int col0 = u.pn * 256 + wc * 32 + 4 * fq;
#pragma unroll
        for (int ai = 0; ai < 2; ++ai)
#pragma unroll
            for (int m = 0; m < 4; ++m) {
                const size_t row = (size_t)(u.pm * 256 + ai * 128 + wr * 64 + m * 16 + fr); const size_t off = row * DM + col0; float ss = 0.f;
#pragma unroll
                for (int bj = 0; bj < 2; ++bj)
#pragma unroll
                    for (int n = 0; n < 2; ++n) {
                        const size_t o = off + bj * 128 + n * 16; f32x4 a = acc[ai][bj][m][n] * alpha;
                        if (GATED) { const u32x2 g = *(const u32x2*)(GP + o); a[0] *= bflo(g.x); a[1] *= bfhi(g.x); a[2] *= bflo(g.y); a[3] *= bfhi(g.y); }
                        f32x4 xs;
                        if (X32) xs = *(const f32x4*)(X32 + o); else { const u32x2 xw = *(const u32x2*)(XB + o); xs = (f32x4){bflo(xw.x), bfhi(xw.x), bflo(xw.y), bfhi(xw.y)}; }
                        const f32x4 xv = xs + a;
                        u32x2 w; w.x = cvt_pk_bf16(xv[0], xv[1]); w.y = cvt_pk_bf16(xv[2], xv[3]); *(u32x2*)(XB + o) = w;
                        ss += (xv[0] * xv[0] + xv[1] * xv[1]) + (xv[2] * xv[2] + xv[3] * xv[3]);
                    }
                ss += __shfl_xor(ss, 16); ss += __shfl_xor(ss, 32);
                if (fq == 0) ssq[(size_t)u.pn * SSQ_PLANE + row * 4 + wc] = ss;
                asm volatile("" ::: "memory");
            }
    }
};
template <int ACT, int RS> struct EpiCol {
    static constexpr bool PERM = true, AFTER_DRAIN = false;
    bf16_t* O; int ldc; const float* rs;
    __device__ __forceinline__ void operator()(const f32x4 (&acc)[2][2][4][2], const Unit& u, int wr, int wc, int fr, int fq) const {
        const int row0 = u.pm * 256 + wr * 64 + fr, col0 = u.pn * 256 + wc * 32 + 8 * fq;
#pragma unroll
        for (int bj = 0; bj < 2; ++bj) {
            const int col = col0 + bj * 128; f32x4 c0, c1;
            if (RS == 0) {
#pragma unroll
                for (int e = 0; e < 4; ++e) { c0[e] = rstd16(rs, (size_t)(col + e)); asm volatile("" ::: "memory"); c1[e] = rstd16(rs, (size_t)(col + 4 + e)); asm volatile("" ::: "memory"); }
            } else { c0 = *(const f32x4*)(rs + col); c1 = *(const f32x4*)(rs + col + 4); }
#pragma unroll
            for (int ai = 0; ai < 2; ++ai)
#pragma unroll
                for (int m = 0; m < 4; ++m) {
                    f32x4 v0 = acc[ai][bj][m][0] * c0, v1 = acc[ai][bj][m][1] * c1;
                    if (ACT == 1) {
#pragma unroll
                        for (int e = 0; e < 4; ++e) { v0[e] = gelu_t(v0[e]); v1[e] = gelu_t(v1[e]); } }
                    *(u32x4*)(O + (size_t)(row0 + ai * 128 + m * 16) * ldc + col) = pack8(v0, v1);
                    asm volatile("" ::: "memory");
                }
        }
    }
};
struct EpiLru {
    static constexpr bool PERM = true, AFTER_DRAIN = false;
    const bf16_t* XC; bf16_t* LA; bf16_t* U; const float* ba; const float* bx; const float* sp8;
    __device__ __forceinline__ void operator()(const f32x4 (&acc)[2][2][4][2], const Unit& u, int wr, int wc, int fr, int fq) const {
        const int row0 = u.pm * 256 + wr * 64 + fr, ch0 = (u.pn * 256 + wc * 32 + 8 * fq) >> 1;
#pragma unroll
        for (int bj = 0; bj < 2; ++bj) {
            const int ch = ch0 + bj * 64; const f32x4 vba = *(const f32x4*)(ba + ch), vbx = *(const f32x4*)(bx + ch), vsp = *(const f32x4*)(sp8 + ch);
#pragma unroll
            for (int ai = 0; ai < 2; ++ai)
#pragma unroll
                for (int m = 0; m < 4; ++m) {
                    const int row = row0 + ai * 128 + m * 16; const size_t o = (size_t)row * DM + ch; const bool first = (row & 2047) == 0;
                    const u32x2 xw = *(const u32x2*)(XC + o); const float xc[4] = {bflo(xw.x), bfhi(xw.x), bflo(xw.y), bfhi(xw.y)};
                    const f32x4 v0 = acc[ai][bj][m][0], v1 = acc[ai][bj][m][1]; const float ga[4] = {v0[0], v0[2], v1[0], v1[2]}, gx[4] = {v0[1], v0[3], v1[1], v1[3]};
                    float la[4], uu[4];
#pragma unroll
                    for (int e = 0; e < 4; ++e) { const float r = sigm(ga[e] + vba[e]), ig = sigm(gx[e] + vbx[e]); la[e] = -vsp[e] * r;
                        const float a2 = fexp2(2.f * LOG2E * la[e]); const float mult = first ? 1.f : sqrtf(fmaxf(1.f - a2, 0.f)); uu[e] = mult * ig * xc[e]; }
                    u32x2 wl, wu; wl.x = cvt_pk_bf16(la[0], la[1]); wl.y = cvt_pk_bf16(la[2], la[3]); wu.x = cvt_pk_bf16(uu[0], uu[1]); wu.y = cvt_pk_bf16(uu[2], uu[3]);
                    *(u32x2*)(LA + o) = wl; *(u32x2*)(U + o) = wu;
                    asm volatile("" ::: "memory");
                }
        }
    }
};
struct EpiQ {
    static constexpr bool PERM = true, AFTER_DRAIN = false;
    bf16_t* Q; const float* rsq; const float* rope;
    __device__ __forceinline__ void operator()(const f32x4 (&acc)[2][2][4][2], const Unit& u, int wr, int wc, int fr, int fq) const {
        const int row0 = u.pm * 256 + wr * 64 + fr, col0 = u.pn * 256 + wc * 32 + 8 * fq;
#pragma unroll
        for (int ai = 0; ai < 2; ++ai)
#pragma unroll
            for (int m = 0; m < 4; ++m) {
                const int row = row0 + ai * 128 + m * 16; const float s = rsq[row] * QSCALE; const int pos = row & 2047;
#pragma unroll
                for (int bj = 0; bj < 2; ++bj) {
                    const int col = col0 + bj * 128, d = col % 96; f32x4 v0 = acc[ai][bj][m][0] * s, v1 = acc[ai][bj][m][1] * s;
                    if (d >= 64) { const int i0 = (d - 64) >> 1; const f32x4 t0 = *(const f32x4*)(rope + (pos * 16 + i0) * 2), t1 = *(const f32x4*)(rope + (pos * 16 + i0 + 2) * 2);
                        const f32x4 a = v0, b = v1;
                        v0[0] = a[0] * t0[0] - a[1] * t0[1]; v0[1] = a[0] * t0[1] + a[1] * t0[0]; v0[2] = a[2] * t0[2] - a[3] * t0[3]; v0[3] = a[2] * t0[3] + a[3] * t0[2];
                        v1[0] = b[0] * t1[0] - b[1] * t1[1]; v1[1] = b[0] * t1[1] + b[1] * t1[0]; v1[2] = b[2] * t1[2] - b[3] * t1[3]; v1[3] = b[2] * t1[3] + b[3] * t1[2]; }
                    *(u32x4*)(Q + (size_t)row * 1536 + col) = pack8(v0, v1);
                }
                asm volatile("" ::: "memory");
            }
    }
};
struct EpiMerge {
    static constexpr bool PERM = true, AFTER_DRAIN = false;
    const bf16_t* G3; bf16_t* MG;
    __device__ __forceinline__ void operator()(const f32x4 (&acc)[2][2][4][2], const Unit& u, int wr, int wc, int fr, int fq) const {
        const int row0 = u.pm * 256 + wr * 64 + fr, col0 = u.pn * 256 + wc * 32 + 8 * fq, mcol0 = (u.pn & 3) * 256 + wc * 32 + 8 * fq; const bool first = u.pn < 4;
#pragma unroll
        for (int ai = 0; ai < 2; ++ai)
#pragma unroll
            for (int m = 0; m < 4; ++m) {
                const size_t row = (size_t)(row0 + ai * 128 + m * 16);
#pragma unroll
                for (int bj = 0; bj < 2; ++bj) {
                    f32x4 g0, g1; unpack8(*(const u32x4*)(G3 + row * 3072 + col0 + bj * 128), g0, g1);
                    f32x4 v0 = acc[ai][bj][m][0] * g0, v1 = acc[ai][bj][m][1] * g1;
                    if (!first) { f32x4 p0, p1; unpack8(*(const u32x4*)(MG + row * DM + mcol0 + bj * 128), p0, p1); v0 += p0; v1 += p1; }
                    *(u32x4*)(MG + row * DM + mcol0 + bj * 128) = pack8(v0, v1);
                }
                asm volatile("" ::: "memory");
            }
    }
};
enum { MAP_ID = 0, MAP_SWIGLU, MAP_WIN, MAP_UQ, MAP_KVK, MAP_KVV, MAP_GATES };
struct Job { const float* W; const float* gain; bf16_t* dst; int ldw, K, dN, map, off; };
__device__ __forceinline__ int srcmap(int map, int off, int n) {
    switch (map) {
    case MAP_SWIGLU: return (n >> 8) * 128 + (n & 127) + ((n & 128) ? DFF : 0);
    case MAP_WIN: if (n < 2048) return n; if (n < 3072) return 2720 + (n - 2048); if (n < 3328) return 2432 + (n - 3072); if (n < 3712) return 2048 + (n - 3328);
                  if (n < 3744) { const int j = n - 3712, i = j >> 1; return 2688 + ((j & 1) ? 16 + i : i); } return -1;
    case MAP_UQ: { const int h = n / 96, d = n % 96; if (d < 64) return n; const int j = d - 64, i = j >> 1; return h * 96 + 64 + ((j & 1) ? 16 + i : i); }
    case MAP_KVK: return (n >> 6) * 128 + (n & 63);
    case MAP_KVV: return (n >> 6) * 128 + 64 + (n & 63);
    case MAP_GATES: return 4768 + (n < 1024 ? n + 1024 : (n < 2048 ? n - 1024 : n));
    default: return n + off;
    }
}
#define JOB(Wp, GAIN, DST, LDW, KK, DN, MAP, OFF) do { J.W = (Wp); J.gain = (GAIN); J.dst = wb + (DST); J.ldw = (LDW); J.K = (KK); J.dN = (DN); J.map = (MAP); J.off = (OFF); } while (0)
__device__ __forceinline__ void get_job(const Params& p, int L, int j, bf16_t* wb, Job& J) {
    const size_t M1 = 1024 * 1024;
    switch (j) {
    case 0: JOB(p.in[3] + (size_t)L * 1024 * 5632, p.in[2] + L * 1024, O_WGU1, 5632, 1024, 5632, MAP_SWIGLU, 0); break;
    case 1: JOB(p.in[4] + (size_t)L * 2816 * 1024, nullptr, O_WD1, 1024, 2816, 1024, MAP_ID, 0); break;
    case 2: JOB(p.in[6] + (size_t)L * 1024 * 7840, p.in[5] + L * 1024, O_WIN, 7840, 1024, 3840, MAP_WIN, 0); break;
    case 3: JOB(p.in[6] + (size_t)L * 1024 * 7840, p.in[5] + L * 1024, O_WINV, 7840, 1024, 1024, MAP_ID, 3744); break;
    case 4: JOB(p.in[6] + (size_t)L * 1024 * 7840, p.in[5] + L * 1024, O_WING, 7840, 1024, 3072, MAP_GATES, 0); break;
    case 5: JOB(p.in[14] + L * M1, nullptr, O_WRB, 1024, 1024, 1024, MAP_ID, 0); break;
    case 6: JOB(p.in[19] + L * M1, nullptr, O_WRA, 1024, 1024, 1024, MAP_ID, 0); break;
    case 7: JOB(p.in[24] + L * M1, nullptr, O_WRC, 1024, 1024, 1024, MAP_ID, 0); break;
    case 8: JOB(p.in[26] + L * M1, nullptr, O_WOUT, 1024, 1024, 1024, MAP_ID, 0); break;
    case 9: JOB(p.in[31] + L * M1, p.in[30] + L * 1024, O_WPG, 1024, 1024, 1024, MAP_ID, 0); break;
    case 10: JOB(p.in[16] + (size_t)L * 384 * 1536, p.in[15] + L * 384, O_WUQ, 1536, 384, 1536, MAP_UQ, 0); break;
    case 11: JOB(p.in[18] + (size_t)L * 256 * 2048, p.in[17] + L * 256, O_WKVK, 2048, 256, 1024, MAP_KVK, 0); break;
    case 12: JOB(p.in[18] + (size_t)L * 256 * 2048, p.in[17] + L * 256, O_WKVV, 2048, 256, 1024, MAP_KVV, 0); break;
    case 13: JOB(p.in[28] + (size_t)L * 1024 * 5632, p.in[27] + L * 1024, O_WGU2, 5632, 1024, 5632, MAP_SWIGLU, 0); break;
    case 14: JOB(p.in[29] + (size_t)L * 2816 * 1024, nullptr, O_WD2, 1024, 2816, 1024, MAP_ID, 0); break;
    default: JOB(p.in[32] + (size_t)L * 256 * 1024, nullptr, O_WPLE, 1024, 256, 1024, MAP_ID, 0); break;
    }
}
constexpr int NJOBS = 16;
__device__ __forceinline__ void tr_item(const Job& J, int item, LAS float* scr, int lane) {
    const int nblk = J.dN >> 5, kb = item / nblk, nb = item % nblk, k0 = 64 * kb, n0 = 32 * nb;
    const int sc0 = srcmap(J.map, J.off, n0);
    if (sc0 >= 0 && srcmap(J.map, J.off, n0 + 1) == sc0 + 1 && srcmap(J.map, J.off, n0 + 31) == sc0 + 31) {
        const int kr = lane >> 3, c4 = lane & 7; f32x4 v[8];
#pragma unroll
        for (int i = 0; i < 8; ++i) v[i] = *(const f32x4*)(J.W + (size_t)(k0 + 8 * i + kr) * J.ldw + sc0 + 4 * c4);
#pragma unroll
        for (int i = 0; i < 8; ++i) { const int kk = 8 * i + kr; const float gn = J.gain ? J.gain[k0 + kk] : 1.f;
            scr[kk * 33 + 4 * c4] = v[i][0] * gn; scr[kk * 33 + 4 * c4 + 1] = v[i][1] * gn; scr[kk * 33 + 4 * c4 + 2] = v[i][2] * gn; scr[kk * 33 + 4 * c4 + 3] = v[i][3] * gn; }
    } else {
        const int sc = srcmap(J.map, J.off, n0 + (lane & 31));
#pragma unroll 8
        for (int i = 0; i < 32; ++i) { const int kk = 2 * i + (lane >> 5); float v = (sc >= 0) ? J.W[(size_t)(k0 + kk) * J.ldw + sc] : 0.f; if (J.gain) v *= J.gain[k0 + kk]; scr[kk * 33 + (lane & 31)] = v; }
    }
    asm volatile("s_waitcnt lgkmcnt(0)" ::: "memory");
    const int c = lane & 7;
#pragma unroll
    for (int j = 0; j < 4; ++j) { const int n = (lane >> 3) + 8 * j; const LAS float* s = scr + (8 * c) * 33 + n;
        u32x4 o; o.x = cvt_pk_bf16(s[0 * 33], s[1 * 33]); o.y = cvt_pk_bf16(s[2 * 33], s[3 * 33]); o.z = cvt_pk_bf16(s[4 * 33], s[5 * 33]); o.w = cvt_pk_bf16(s[6 * 33], s[7 * 33]);
        *(u32x4*)(J.dst + (size_t)(n0 + n) * J.K + k0 + 8 * c) = o; }
    asm volatile("s_waitcnt lgkmcnt(0)" ::: "memory");
}
__device__ __forceinline__ void phase0(const Params& p, int L, LAS unsigned char* lds, int G, int blk) {
    const int tid = pg8::tid_opaque(), lane = tid & 63, wave = tid >> 6;
    const int gw = blk * 8 + wave, NGW = G * 8, gt = blk * 512 + tid, NGT = G * 512;
    bf16_t* wb = (bf16_t*)(p.ws + WS_W);
    LAS float* scr = (LAS float*)(lds + wave * 8448);
    int total = 0;
    for (int j = 0; j < NJOBS; ++j) { Job J; get_job(p, L, j, wb, J); total += (J.K >> 6) * (J.dN >> 5); }
    for (int it = gw; it < total; it += NGW) {
        int r = it;
        for (int j = 0; j < NJOBS; ++j) { Job J; get_job(p, L, j, wb, J); const int n = (J.K >> 6) * (J.dN >> 5); if (r < n) { tr_item(J, r, scr, lane); break; } r -= n; }
    }
    { bf16_t* d = wb + O_WLRU; const float* wa = p.in[9] + (size_t)L * 65536; const float* wx = p.in[11] + (size_t)L * 65536;
      for (int i = gt; i < 2048 * 128; i += NGT) { const int n = i >> 7, k = i & 127, ch = n >> 1, nb = ch >> 6, dd = ch & 63;
          float v = 0.f; if ((k >> 6) == (nb & 1)) v = ((n & 1) ? wx : wa)[(size_t)nb * 4096 + (k & 63) * 64 + dd]; d[i] = f2bf(v); } }
    { bf16_t* d = wb + O_WSGU; const float* w = p.in[22] + (size_t)L * 131072;
      for (int i = gt; i < 131072; i += NGT) { const int t = (i >> 7) & 127, s = i & 127; d[i] = f2bf(((s >> 6) <= (t >> 6)) ? w[i] : 0.f); } }
    { float* sp = (float*)(p.ws + WS_SMALL + SM_SP8); const float* lam = p.in[13] + L * 1024;
      for (int i = gt; i < 1024; i += NGT) sp[i] = 8.f * 0.6931471805599453f * __builtin_amdgcn_logf(1.f + fexp2(-LOG2E * lam[i])); }
    if (L == 0) {
        float* rope = (float*)(p.ws + WS_SMALL + SM_ROPE);
        for (int i = gt; i < 2048 * 16; i += NGT) { const int pos = i >> 4, k = i & 15; const float inv = fexp2(-(float)k * (13.287712379549449f / 16.f)); const float ang = (float)pos * inv;
            double rev = (double)ang * 0.15915494309189535; rev -= floor(rev); const float fr = (float)rev; rope[2 * i] = __builtin_amdgcn_cosf(fr); rope[2 * i + 1] = __builtin_amdgcn_sinf(fr); }
        const float* x = p.in[0]; bf16_t* XB = (bf16_t*)(p.ws + WS_XB); float* ssq = (float*)(p.ws + WS_SSQ);
        for (int m = gw; m < T; m += NGW) {
            const f32x4* xr = (const f32x4*)(x + (size_t)m * DM) + lane; u32x2* o8 = (u32x2*)(XB + (size_t)m * DM) + lane; float s = 0.f;
#pragma unroll
            for (int j = 0; j < 4; ++j) { const f32x4 v = xr[64 * j]; s += (v[0] * v[0] + v[1] * v[1]) + (v[2] * v[2] + v[3] * v[3]); u32x2 w; w.x = cvt_pk_bf16(v[0], v[1]); w.y = cvt_pk_bf16(v[2], v[3]); o8[64 * j] = w; }
            s = wave_sum(s);
            if (lane < 16) ssq[(size_t)(lane >> 2) * SSQ_PLANE + (size_t)m * 4 + (lane & 3)] = (lane == 0) ? s : 0.f;
        }
    }
}

__device__ __forceinline__ void pb_convert(const Params& p, int L, int G, int blk) {
    const int tid = pg8::tid_opaque(), gt = blk * 512 + tid, NGT = G * 512;
    const f32x4* src = (const f32x4*)(p.in[1] + (size_t)L * T * 256); u32x2* d = (u32x2*)(p.ws + WS_BIG + B_PB);
    for (int i = gt; i < T * 256 / 4; i += NGT) { const f32x4 v = src[i]; u32x2 w; w.x = cvt_pk_bf16(v[0], v[1]); w.y = cvt_pk_bf16(v[2], v[3]); d[i] = w; }
}
__device__ __forceinline__ void e1_rows(const Params& p, int L, const bf16_t* Z, bf16_t* XC, float* RSQ, float* RSKV, bf16_t* KR, const float* rope, int G, int blk) {
    const int tid = pg8::tid_opaque(), lane = tid & 63, wave = tid >> 6;
    const float* cw = p.in[7] + (size_t)L * 4096; const float* cb = p.in[8] + L * 1024;
    for (int rb = blk * 64 + wave * 8; rb < TC; rb += G * 64) {
        const bool halo = (rb & 2047) != 0;
        u32x4 cqv[8]; u32x2 ckv[8];
#pragma unroll
        for (int r = 0; r < 8; ++r) { const bf16_t* zr = Z + (size_t)(rb + r) * ZLD; cqv[r] = (lane < 48) ? *(const u32x4*)(zr + ZC_CQ + 8 * lane) : (u32x4){0u, 0u, 0u, 0u}; ckv[r] = *(const u32x2*)(zr + ZC_CKV + 4 * lane); }
#pragma unroll
        for (int hf = 0; hf < 2; ++hf) {
            const int c0 = hf * 512 + 8 * lane; u32x4 xr[11];
#pragma unroll
            for (int j = 0; j < 11; ++j) xr[j] = (j >= 3 || halo) ? *(const u32x4*)(Z + (ptrdiff_t)(rb - 3 + j) * ZLD + ZC_XA + c0) : (u32x4){0u, 0u, 0u, 0u};
            f32x4 w0[4], w1[4]; const f32x4 b0 = *(const f32x4*)(cb + c0), b1 = *(const f32x4*)(cb + c0 + 4);
#pragma unroll
            for (int k = 0; k < 4; ++k) { w0[k] = *(const f32x4*)(cw + k * 1024 + c0); w1[k] = *(const f32x4*)(cw + k * 1024 + c0 + 4); }
#pragma unroll
            for (int r = 0; r < 8; ++r) { f32x4 a0 = b0, a1 = b1;
#pragma unroll
                for (int k = 0; k < 4; ++k) { f32x4 x0, x1; unpack8(xr[r + k], x0, x1); a0 += w0[k] * x0; a1 += w1[k] * x1; }
                *(u32x4*)(XC + (size_t)(rb + r) * DM + c0) = pack8(a0, a1); }
        }
        float sq[8], sk[8];
#pragma unroll
        for (int r = 0; r < 8; ++r) { f32x4 x0, x1; unpack8(cqv[r], x0, x1); sq[r] = (x0[0] * x0[0] + x0[1] * x0[1]) + (x0[2] * x0[2] + x0[3] * x0[3]) + (x1[0] * x1[0] + x1[1] * x1[1]) + (x1[2] * x1[2] + x1[3] * x1[3]);
            const float a = bflo(ckv[r].x), b = bfhi(ckv[r].x), c = bflo(ckv[r].y), d = bfhi(ckv[r].y); sk[r] = (a * a + b * b) + (c * c + d * d); }
#pragma unroll
        for (int o = 1; o < 64; o <<= 1)
#pragma unroll
            for (int r = 0; r < 8; ++r) { sq[r] += __shfl_xor(sq[r], o); sk[r] += __shfl_xor(sk[r], o); }
        { float q = sq[0], k = sk[0];
#pragma unroll
          for (int r = 1; r < 8; ++r) { if (lane == r) { q = sq[r]; k = sk[r]; } }
          if (lane < 8) { RSQ[rb + lane] = __builtin_amdgcn_rsqf(q * (1.f / 384.f) + EPS); RSKV[rb + lane] = __builtin_amdgcn_rsqf(k * (1.f / 256.f) + EPS); } }
#pragma unroll
        for (int it = 0; it < 2; ++it) { const int r = rb + it * 4 + (lane >> 4), i = lane & 15, pos = r & 2047;
            const unsigned w = *(const unsigned*)(Z + (size_t)r * ZLD + ZC_KR + 2 * i); const float x1 = bflo(w), x2 = bfhi(w); const f32x2 cs = *(const f32x2*)(rope + (pos * 16 + i) * 2);
            *(unsigned*)(KR + (size_t)r * 32 + 2 * i) = cvt_pk_bf16(x1 * cs[0] - x2 * cs[1], x1 * cs[1] + x2 * cs[0]); }
    }
}
__device__ __forceinline__ void e2_stats(LAS unsigned char* lds, const bf16_t* VTS, float* MEANV, float* RSTDV, int G, int blk) {
    const int tid = pg8::tid_opaque(), lane = tid & 63, wave = tid >> 6, tg = lane & 7, cr = lane >> 3;
    LAS float* part = (LAS float*)lds;
    for (int unit = blk; unit < TC / 64; unit += G) {
        const int tok0 = unit * 64; float s[8], q[8];
#pragma unroll
        for (int e = 0; e < 8; ++e) { s[e] = 0.f; q[e] = 0.f; }
#pragma unroll
        for (int it = 0; it < 16; ++it) { const int c = wave * 128 + it * 8 + cr; f32x4 x0, x1; unpack8(*(const u32x4*)(VTS + (size_t)c * TC + tok0 + 8 * tg), x0, x1);
#pragma unroll
            for (int e = 0; e < 4; ++e) { s[e] += x0[e]; q[e] += x0[e] * x0[e]; s[4 + e] += x1[e]; q[4 + e] += x1[e] * x1[e]; } }
#pragma unroll
        for (int e = 0; e < 8; ++e) { s[e] += __shfl_xor(s[e], 8); s[e] += __shfl_xor(s[e], 16); s[e] += __shfl_xor(s[e], 32); q[e] += __shfl_xor(q[e], 8); q[e] += __shfl_xor(q[e], 16); q[e] += __shfl_xor(q[e], 32); }
        if (cr == 0) {
#pragma unroll
            for (int e = 0; e < 8; ++e) { part[(wave * 64 + 8 * tg + e) * 2] = s[e]; part[(wave * 64 + 8 * tg + e) * 2 + 1] = q[e]; } }
        __syncthreads();
        if (tid < 64) { float ss = 0.f, qq = 0.f;
#pragma unroll
            for (int w = 0; w < 8; ++w) { ss += part[(w * 64 + tid) * 2]; qq += part[(w * 64 + tid) * 2 + 1]; }
            const float mean = ss * (1.f / 1024.f); const float var = fmaxf(qq * (1.f / 1024.f) - mean * mean, 0.f);
            MEANV[tok0 + tid] = mean; RSTDV[tok0 + tid] = __builtin_amdgcn_rsqf(var + EPS); }
        __syncthreads();
    }
}
__device__ __forceinline__ void scan_units(LAS unsigned char* lds, const bf16_t* LA, const bf16_t* U, bf16_t* Z, int G, int blk) {
    const int tid = pg8::tid_opaque(), cp = tid & 15, seg = tid >> 4;
    LAS f32x4* sc = (LAS f32x4*)lds;
    for (int idx = blk; idx < 256; idx += G) {
        const int b = idx >> 5, ch = (idx & 31) * 32 + 2 * cp; const size_t row0 = (size_t)b * 2048 + seg * 64;
        const unsigned* lap = (const unsigned*)(LA + row0 * DM + ch); const unsigned* up = (const unsigned*)(U + row0 * DM + ch);
        float h0 = 0.f, h1 = 0.f, s0 = 0.f, s1 = 0.f;
#pragma unroll 16
        for (int t = 0; t < 64; ++t) { const unsigned lw = lap[(size_t)t * 512], uw = up[(size_t)t * 512]; const float l0 = bflo(lw), l1 = bfhi(lw);
            h0 = fexp2(LOG2E * l0) * h0 + bflo(uw); h1 = fexp2(LOG2E * l1) * h1 + bfhi(uw); s0 += l0; s1 += l1; }
        sc[seg * 16 + cp] = (f32x4){s0, s1, h0, h1};
        __syncthreads();
        float c0 = 0.f, c1 = 0.f;
        for (int j = 0; j < seg; ++j) { const f32x4 v = sc[j * 16 + cp]; c0 = fexp2(LOG2E * v[0]) * c0 + v[2]; c1 = fexp2(LOG2E * v[1]) * c1 + v[3]; }
        h0 = c0; h1 = c1;
        unsigned* gp = (unsigned*)(Z + row0 * ZLD + ZC_GA + ch);
#pragma unroll 16
        for (int t = 0; t < 64; ++t) { const unsigned lw = lap[(size_t)t * 512], uw = up[(size_t)t * 512], gw = gp[(size_t)t * (ZLD / 2)];
            h0 = fexp2(LOG2E * bflo(lw)) * h0 + bflo(uw); h1 = fexp2(LOG2E * bfhi(lw)) * h1 + bfhi(uw); gp[(size_t)t * (ZLD / 2)] = cvt_pk_bf16(h0 * bflo(gw), h1 * bfhi(gw)); }
        __syncthreads();
    }
}
__device__ __forceinline__ void attn_units(LAS unsigned char* lds, const bf16_t* Q, const bf16_t* KN, const bf16_t* KR, const bf16_t* VT, bf16_t* Z, int G, int blk) {
    const int tid = pg8::tid_opaque(), lane = tid & 63, wid = __builtin_amdgcn_readfirstlane(tid >> 6), i32 = lane & 31, hi = lane >> 5;
    constexpr int KP = 208, VP = 144, KBUF = 64 * KP, VBUF = 64 * VP;
    for (int idx = blk; idx < 1024; idx += G) {
        const int j = idx & 255, rnd = idx >> 8, bh = j >> 1;
        const int qb = (j & 1) ? (rnd == 0 ? 1 : rnd == 1 ? 6 : rnd == 2 ? 3 : 4) : (rnd == 0 ? 0 : rnd == 1 ? 7 : rnd == 2 ? 2 : 5);
        const int b = bh >> 4, h = bh & 15, q0 = qb * 256, NT = q0 / 64 + 4, ntw = (q0 + 32 * wid) / 64 + 1;
        const size_t rowb = (size_t)b * 2048;
        bf16x8 qr[6];
        { const bf16_t* qp = Q + (rowb + q0 + 32 * wid + i32) * 1536 + h * 96 + 8 * hi;
#pragma unroll
          for (int ks = 0; ks < 6; ++ks) qr[ks] = *(const bf16x8*)(qp + 16 * ks); }
        const bf16_t* kns = KN + (rowb + (tid >> 3)) * DM + h * 64 + 8 * (tid & 7);
        const bf16_t* krs = KR + (rowb + (tid >> 2)) * 32 + 8 * (tid & 3);
        const bf16_t* vts = VT + (size_t)(h * 64 + (tid >> 3)) * TC + rowb + 8 * (tid & 7);
        const int kdst = (tid >> 3) * KP + (tid & 7) * 16, krdst = (tid >> 2) * KP + 128 + (tid & 3) * 16, vdst = 2 * KBUF + (tid >> 3) * VP + (tid & 7) * 16;
        u32x4 rk, rr = (u32x4){0u, 0u, 0u, 0u}, rv;
        rk = *(const u32x4*)kns; if (tid < 256) rr = *(const u32x4*)krs; rv = *(const u32x4*)vts;
        *(LAS u32x4*)(lds + kdst) = rk; if (tid < 256) *(LAS u32x4*)(lds + krdst) = rr; *(LAS u32x4*)(lds + vdst) = rv;
        __syncthreads();
        f32x16 o0, o1;
#pragma unroll
        for (int r = 0; r < 16; ++r) { o0[r] = 0.f; o1[r] = 0.f; }
        float mrun = -1e30f, lrun = 0.f;
        for (int t = 0; t < NT; ++t) {
            const int cur = t & 1; const bool more = (t + 1 < NT);
            if (more) { rk = *(const u32x4*)(kns + (size_t)(t + 1) * 64 * DM); if (tid < 256) rr = *(const u32x4*)(krs + (size_t)(t + 1) * 64 * 32); rv = *(const u32x4*)(vts + (size_t)(t + 1) * 64); }
            if (t < ntw) {
                LAS const unsigned char* kb = lds + cur * KBUF; LAS const unsigned char* vb = lds + 2 * KBUF + cur * VBUF;
                f32x16 s0, s1;
#pragma unroll
                for (int r = 0; r < 16; ++r) { s0[r] = 0.f; s1[r] = 0.f; }
#pragma unroll
                for (int ks = 0; ks < 6; ++ks) {
                    const bf16x8 a0 = *(LAS const bf16x8*)(kb + i32 * KP + (16 * ks + 8 * hi) * 2), a1 = *(LAS const bf16x8*)(kb + (32 + i32) * KP + (16 * ks + 8 * hi) * 2);
                    s0 = __builtin_amdgcn_mfma_f32_32x32x16_bf16(a0, qr[ks], s0, 0, 0, 0); s1 = __builtin_amdgcn_mfma_f32_32x32x16_bf16(a1, qr[ks], s1, 0, 0, 0);
                }
                float mx = fmaxf(s0[0], s1[0]);
#pragma unroll
                for (int r = 1; r < 16; ++r) mx = fmaxf(mx, fmaxf(s0[r], s1[r]));
                mx = fmaxf(mx, __shfl_xor(mx, 32));
                const float mn = fmaxf(mrun, mx), alpha = fexp2(mrun - mn); mrun = mn;
                float rs = 0.f;
#pragma unroll
                for (int r = 0; r < 16; ++r) { s0[r] = fexp2(s0[r] - mn); s1[r] = fexp2(s1[r] - mn); rs += s0[r] + s1[r]; }
                lrun = lrun * alpha + rs;
#pragma unroll
                for (int r = 0; r < 16; ++r) { o0[r] *= alpha; o1[r] *= alpha; }
                bf16x8 pf[2][2];
#pragma unroll
                for (int uu = 0; uu < 2; ++uu) {
                    u32x4 w0, w1;
                    w0.x = cvt_pk_bf16(s0[8 * uu + 0], s0[8 * uu + 1]); w0.y = cvt_pk_bf16(s0[8 * uu + 2], s0[8 * uu + 3]); w0.z = cvt_pk_bf16(s0[8 * uu + 4], s0[8 * uu + 5]); w0.w = cvt_pk_bf16(s0[8 * uu + 6], s0[8 * uu + 7]);
                    w1.x = cvt_pk_bf16(s1[8 * uu + 0], s1[8 * uu + 1]); w1.y = cvt_pk_bf16(s1[8 * uu + 2], s1[8 * uu + 3]); w1.z = cvt_pk_bf16(s1[8 * uu + 4], s1[8 * uu + 5]); w1.w = cvt_pk_bf16(s1[8 * uu + 6], s1[8 * uu + 7]);
                    pf[0][uu] = __builtin_bit_cast(bf16x8, w0); pf[1][uu] = __builtin_bit_cast(bf16x8, w1);
                }
#pragma unroll
                for (int tt = 0; tt < 2; ++tt)
#pragma unroll
                    for (int uu = 0; uu < 2; ++uu) {
                        LAS const unsigned char* vp0 = vb + i32 * VP + (32 * tt + 16 * uu + 4 * hi) * 2; LAS const unsigned char* vp1 = vp0 + 32 * VP;
                        const u32x2 a = *(LAS const u32x2*)vp0, bq = *(LAS const u32x2*)(vp0 + 16), c = *(LAS const u32x2*)vp1, d = *(LAS const u32x2*)(vp1 + 16);
                        const bf16x8 vf0 = __builtin_bit_cast(bf16x8, ((u32x4){a.x, a.y, bq.x, bq.y})), vf1 = __builtin_bit_cast(bf16x8, ((u32x4){c.x, c.y, d.x, d.y}));
                        o0 = __builtin_amdgcn_mfma_f32_32x32x16_bf16(vf0, pf[tt][uu], o0, 0, 0, 0); o1 = __builtin_amdgcn_mfma_f32_32x32x16_bf16(vf1, pf[tt][uu], o1, 0, 0, 0);
                    }
            }
            if (more) { const int nb = cur ^ 1; *(LAS u32x4*)(lds + nb * KBUF + kdst) = rk; if (tid < 256) *(LAS u32x4*)(lds + nb * KBUF + krdst) = rr; *(LAS u32x4*)(lds + nb * VBUF + vdst) = rv; }
            __syncthreads();
        }
        lrun += __shfl_xor(lrun, 32); const float inv = frcp(lrun);
        bf16_t* op = Z + (rowb + q0 + 32 * wid + i32) * ZLD + ZC_XA + h * 64 + 4 * hi;
#pragma unroll
        for (int rg = 0; rg < 4; ++rg) {
            u32x2 w; w.x = cvt_pk_bf16(o0[4 * rg] * inv, o0[4 * rg + 1] * inv); w.y = cvt_pk_bf16(o0[4 * rg + 2] * inv, o0[4 * rg + 3] * inv); *(u32x2*)(op + 8 * rg) = w;
            w.x = cvt_pk_bf16(o1[4 * rg] * inv, o1[4 * rg + 1] * inv); w.y = cvt_pk_bf16(o1[4 * rg + 2] * inv, o1[4 * rg + 3] * inv); *(u32x2*)(op + 32 + 8 * rg) = w;
        }
    }
}
__device__ __forceinline__ void sgu_units(LAS unsigned char* lds, const bf16_t* VTS, const float* MEANV, const float* RSTDV, const float* lng, const float* lnb, const bf16_t* WS, const float* bs, bf16_t* Z, int G, int blk) {
    const int tid = pg8::tid_opaque(), lane = tid & 63, wid = __builtin_amdgcn_readfirstlane(tid >> 6), i32 = lane & 31, hi = lane >> 5;
    constexpr int AP = 272;
    for (int idx = blk; idx < 1024; idx += G) {
        const int tb = idx >> 3, g = idx & 7, tok0 = tb * 128, tt = wid & 3;
        u32x4 xv[4]; f32x4 m0[4], m1[4], r0[4], r1[4]; float ga[4], be[4];
#pragma unroll
        for (int jj = 0; jj < 4; ++jj) {
            const int id = tid + 512 * jj, c = id >> 4, sc = id & 15; xv[jj] = *(const u32x4*)(VTS + (size_t)(g * 128 + c) * TC + tok0 + 8 * sc);
            m0[jj] = *(const f32x4*)(MEANV + tok0 + 8 * sc); m1[jj] = *(const f32x4*)(MEANV + tok0 + 8 * sc + 4); r0[jj] = *(const f32x4*)(RSTDV + tok0 + 8 * sc); r1[jj] = *(const f32x4*)(RSTDV + tok0 + 8 * sc + 4);
            ga[jj] = lng[g * 128 + c]; be[jj] = lnb[g * 128 + c];
        }
        bf16x8 wf[8];
        { const bf16_t* wp = WS + (size_t)(g * 128 + 32 * tt + i32) * 128 + 8 * hi;
#pragma unroll
          for (int ks = 0; ks < 8; ++ks) wf[ks] = *(const bf16x8*)(wp + 16 * ks); }
        const float bsv = bs[g * 128 + 32 * tt + i32];
        bf16_t* up0 = Z + (size_t)(tok0 + 32 * tt + i32) * ZLD + ZC_U + g * 128 + 64 * (wid >> 2) + 4 * hi;
        u32x2 uv[2][4];
#pragma unroll
        for (int cc = 0; cc < 2; ++cc)
#pragma unroll
            for (int rg = 0; rg < 4; ++rg) uv[cc][rg] = *(const u32x2*)(up0 + 32 * cc + 8 * rg);
#pragma unroll
        for (int jj = 0; jj < 4; ++jj) {
            const int id = tid + 512 * jj, c = id >> 4, sc = id & 15; f32x4 x0, x1; unpack8(xv[jj], x0, x1);
            x0 = (x0 - m0[jj]) * r0[jj] * ga[jj] + be[jj]; x1 = (x1 - m1[jj]) * r1[jj] * ga[jj] + be[jj];
            *(LAS u32x4*)(lds + c * AP + sc * 16) = pack8(x0, x1);
        }
        __syncthreads();
#pragma unroll
        for (int cc = 0; cc < 2; ++cc) {
            const int ct = 2 * (wid >> 2) + cc; f32x16 acc;
#pragma unroll
            for (int r = 0; r < 16; ++r) acc[r] = 0.f;
#pragma unroll
            for (int ks = 0; ks < 8; ++ks) { const bf16x8 a = *(LAS const bf16x8*)(lds + (32 * ct + i32) * AP + (16 * ks + 8 * hi) * 2); acc = __builtin_amdgcn_mfma_f32_32x32x16_bf16(a, wf[ks], acc, 0, 0, 0); }
#pragma unroll
            for (int rg = 0; rg < 4; ++rg) { const u32x2 u2 = uv[cc][rg]; u32x2 w;
                w.x = cvt_pk_bf16((acc[4 * rg] + bsv) * bflo(u2.x), (acc[4 * rg + 1] + bsv) * bfhi(u2.x)); w.y = cvt_pk_bf16((acc[4 * rg + 2] + bsv) * bflo(u2.y), (acc[4 * rg + 3] + bsv) * bfhi(u2.y)); *(u32x2*)(up0 + 32 * cc + 8 * rg) = w; }
        }
        __syncthreads();
    }
}

#ifndef DBG_DUMP
#define DBG_DUMP 0
#define DBG_CH 0
#define DBG_TWICE 0
#define DBG_SKIP56 0
#endif
__device__ __forceinline__ void dbg_add(float* out, const bf16_t* buf, size_t n, bool first, int G, int blk) {
    const size_t gt = (size_t)blk * 512 + pg8::tid_opaque(), NGT = (size_t)G * 512;
    for (size_t i = gt; i < (size_t)T * DM; i += NGT) { float v = 0.f; for (size_t j = i; j < n; j += (size_t)T * DM) v += __uint_as_float((unsigned)buf[j] << 16); out[i] = first ? v : out[i] + v; }
}
__device__ __forceinline__ void dbg_addf(float* out, const float* buf, size_t n, int G, int blk) {
    const size_t gt = (size_t)blk * 512 + pg8::tid_opaque(), NGT = (size_t)G * 512;
    for (size_t i = gt; i < (size_t)T * DM; i += NGT) out[i] += buf[i % n];
}
#define APS 0
#define RUN_GEMM(EPI, e, Ap, Bp, M_, N_, K_, lda_, ldb_, apn_) do { int K__ = (K_), blk__ = blk; asm volatile("" : "+s"(K__), "+s"(blk__)); pg8::Gemm gg{(Ap), (Bp), (M_), (N_), K__, (lda_), (ldb_), (apn_), APS}; pg8::StaticOrder SO; SO.init((M_), (N_), G, blk__); \
    pg8::gemm_phase<decltype(e), pg8::StaticOrder, true, true>(lds, gg, SO, e); } while (0)

constexpr size_t SM_BAR = 1024 * 1024;
#define XB_TMO      128
#define XB_XCNT(j)  (256  + 64 * (j))
#define XB_XSUB(j)  (1280 + 64 * (j))
#define XB_XGEN(j)  (2304 + 64 * (j))
#define XB_TOP      3328
#define XB_TOPGEN   3392
#define XCD_BAR_WORDS 3456
#define XB_SPIN_CAP (1u << 18)

__device__ __forceinline__ unsigned xb_ld(unsigned* p)              { return __hip_atomic_load(p, __ATOMIC_RELAXED, __HIP_MEMORY_SCOPE_AGENT); }
__device__ __forceinline__ unsigned xb_add(unsigned* p, unsigned v) { return __hip_atomic_fetch_add(p, v, __ATOMIC_RELAXED, __HIP_MEMORY_SCOPE_AGENT); }
__device__ __forceinline__ unsigned xb_xcc_id() { return (unsigned)__builtin_amdgcn_s_getreg((3 << 11) | 20) & 0xFu; }
#define XB_SPIN(cond, bar) do { unsigned _sp = 0; while (cond) { __builtin_amdgcn_s_sleep(1); \
    if ((++_sp & 255u) == 0u) { if (xb_ld(&(bar)[XB_TMO])) break; if (_sp > XB_SPIN_CAP) { atomicAdd(&(bar)[XB_TMO], 1u); break; } } } } while (0)

struct XcdBarrier {
    unsigned* bar; unsigned x;
    volatile __attribute__((address_space(3))) unsigned* st;
};

__device__ __forceinline__ XcdBarrier xcd_barrier_post(unsigned* bar, volatile __attribute__((address_space(3))) unsigned* st) {
    XcdBarrier b; b.bar = bar; b.x = xb_xcc_id(); b.st = st;
    if (threadIdx.x == 0) (void)xb_add(&bar[XB_XCNT(b.x)], 1u);
    return b;
}
__device__ __forceinline__ void xcd_barrier_complete(unsigned* bar, unsigned x, unsigned& nloc, unsigned& nx) {
    const unsigned G = gridDim.x * gridDim.y * gridDim.z;
    unsigned sum, cnt, mine, sp = 0u;
    for (;;) {
        sum = 0u; cnt = 0u; mine = 0u;
#pragma unroll
        for (unsigned j = 0; j < 16; ++j) { const unsigned c = xb_ld(&bar[XB_XCNT(j)]); sum += c; cnt += (c > 0u) ? 1u : 0u; mine = (j == x) ? c : mine; }
        if (sum == G) break;
        __builtin_amdgcn_s_sleep(1);
        if ((++sp & 255u) == 0u) { if (xb_ld(&bar[XB_TMO])) break; if (sp > XB_SPIN_CAP) { atomicAdd(&bar[XB_TMO], 1u); break; } }
    }
    nloc = mine > 0u ? mine : 1u; nx = cnt > 0u ? cnt : 1u;
}

__device__ __forceinline__ void xcd_barrier(const XcdBarrier& b) {
    asm volatile("s_waitcnt vmcnt(0)" ::: "memory");
    __syncthreads();
    if (threadIdx.x == 0) {
        unsigned* bar = b.bar;
        __builtin_amdgcn_s_waitcnt(0);
        unsigned nloc = b.st[0], nx = b.st[1];
        if (nloc == 0u) { xcd_barrier_complete(bar, b.x, nloc, nx); b.st[0] = nloc; b.st[1] = nx; }
        const unsigned old = xb_add(&bar[XB_XSUB(b.x)], 1u);
        const unsigned gen = old / nloc;
        if (old + 1u == (gen + 1u) * nloc) {
            __builtin_amdgcn_fence(__ATOMIC_RELEASE, "agent");
            asm volatile("s_waitcnt vmcnt(0)" ::: "memory");
            const unsigned og = xb_add(&bar[XB_TOP], 1u);
            const unsigned tg = og / nx;
            if (og + 1u == (tg + 1u) * nx) xb_add(&bar[XB_TOPGEN], 1u);
            else XB_SPIN(xb_ld(&bar[XB_TOPGEN]) == tg, bar);
            __builtin_amdgcn_fence(__ATOMIC_ACQUIRE, "agent");
            xb_add(&bar[XB_XGEN(b.x)], 1u);
            asm volatile("s_waitcnt vmcnt(0)" ::: "memory");
        } else {
            XB_SPIN(xb_ld(&bar[XB_XGEN(b.x)]) == gen, bar);
            __builtin_amdgcn_fence(__ATOMIC_ACQUIRE, "agent");
            asm volatile("s_waitcnt vmcnt(0)" ::: "memory");
        }
    }
    __syncthreads();
}
#define GRID_SYNC() xcd_barrier(xbar)

#define DBG_DUMP_BODY(st) do { \
    dbg_add(X, G3, (size_t)TC * 3072, true, G, blk); } while (0)
__global__ void __launch_bounds__(512, 2) fwd_kernel(Params p) {
    extern __shared__ __attribute__((aligned(16))) unsigned char lds_raw[];
    LAS unsigned char* lds = (LAS unsigned char*)lds_raw;
    cg::grid_group grid = cg::this_grid();
    const int G = gridDim.x, blk = blockIdx.x;
    unsigned char* ws = p.ws;
    { volatile LAS unsigned* st0 = (volatile LAS unsigned*)(lds + 131072); if (threadIdx.x < 64) st0[threadIdx.x] = 0u; }
    __syncthreads();
    const XcdBarrier xbar = xcd_barrier_post((unsigned*)(ws + WS_SMALL + SM_BAR), (volatile LAS unsigned*)(lds + 131072));
    grid.sync();
    bf16_t* wb = (bf16_t*)(ws + WS_W); bf16_t* XB = (bf16_t*)(ws + WS_XB); float* SSQ = (float*)(ws + WS_SSQ); float* X = p.out;
    float* ROPE = (float*)(ws + WS_SMALL + SM_ROPE); float* RSQ = (float*)(ws + WS_SMALL + SM_RSQ); float* RSKV = (float*)(ws + WS_SMALL + SM_RSKV);
    float* MEANV = (float*)(ws + WS_SMALL + SM_MEANV); float* RSTDV = (float*)(ws + WS_SMALL + SM_RSTDV); float* SP8 = (float*)(ws + WS_SMALL + SM_SP8);
    unsigned char* big = ws + WS_BIG;
    bf16_t* H = (bf16_t*)(big + B_H); bf16_t* PB = (bf16_t*)(big + B_PB); bf16_t* GP = (bf16_t*)(big + B_GP);
    bf16_t* Z = (bf16_t*)(big + B_Z); bf16_t* VTS = (bf16_t*)(big + B_VTS); bf16_t* XC = (bf16_t*)(big + B_XC); bf16_t* LA = (bf16_t*)(big + B_LA); bf16_t* U = (bf16_t*)(big + B_U);
    bf16_t* Q = (bf16_t*)(big + B_Q); bf16_t* KN = (bf16_t*)(big + B_KN); bf16_t* VT = (bf16_t*)(big + B_VT); bf16_t* KR = (bf16_t*)(big + B_KR);
    bf16_t* G3 = (bf16_t*)(big + B_G3); bf16_t* MG = (bf16_t*)(big + B_MERGED);

#pragma unroll 1
    for (int L = 0; L < 2; ++L) {
        phase0(p, L, lds, G, blk);
        GRID_SYNC();
        { EpiSwiglu e{H, SSQ}; RUN_GEMM(EpiSwiglu, e, XB, wb + O_WGU1, T, 2 * DFF, 1024, 1024, 1024, 0); }
        GRID_SYNC();
        { EpiResid<false> e{L == 0 ? p.in[0] : nullptr, XB, SSQ, nullptr, 0.5f}; RUN_GEMM(EpiResid<false>, e, H, wb + O_WD1, T, 1024, DFF, DFF, DFF, 0); }
        GRID_SYNC();
#pragma unroll 1
        for (int c = 0; c <= 2; ++c) {
            if (c >= 1) { const size_t q0 = (size_t)(c - 1) * TC;
                EpiResid<false> e{nullptr, XB + q0 * DM, SSQ + q0 * 4, nullptr, 1.0f}; RUN_GEMM(EpiResid<false>, e, MG, wb + O_WOUT, TC, 1024, 1024, 1024, 1024, 0); }
            const size_t r0 = (size_t)c * TC;
            if (c <= 1) {
                { EpiRow<1, 0> e{Z, ZLD, SSQ + r0 * 4, nullptr, 4, 12, 0}; RUN_GEMM((EpiRow<1, 0>), e, XB + r0 * DM, wb + O_WIN, TC, ZLD, 1024, 1024, 1024, 0); }
                { EpiCol<1, 0> e{VTS, TC, SSQ + r0 * 4}; RUN_GEMM((EpiCol<1, 0>), e, wb + O_WINV, XB + r0 * DM, 1024, TC, 1024, 1024, 1024, 0); }
            }
            GRID_SYNC();
            if (c > 1) break;
            e1_rows(p, L, Z, XC, RSQ, RSKV, KR, ROPE, G, blk);
            e2_stats(lds, VTS, MEANV, RSTDV, G, blk);
            GRID_SYNC();
            { EpiLru e{XC, LA, U, p.in[10] + L * 1024, p.in[12] + L * 1024, SP8}; RUN_GEMM(EpiLru, e, XC, wb + O_WLRU, TC, 2048, 128, 1024, 128, 128); }
            { EpiQ e{Q, RSQ, ROPE}; RUN_GEMM(EpiQ, e, Z + ZC_CQ, wb + O_WUQ, TC, 1536, 384, ZLD, 384, 0); }
            { EpiRow<0, 1> e{KN, 1024, RSKV, nullptr, 0, 0, 0}; RUN_GEMM((EpiRow<0, 1>), e, Z + ZC_CKV, wb + O_WKVK, TC, 1024, 256, ZLD, 256, 0); }
            { EpiCol<0, 1> e{VT, TC, RSKV}; RUN_GEMM((EpiCol<0, 1>), e, wb + O_WKVV, Z + ZC_CKV, 1024, TC, 256, 256, ZLD, 0); }
            GRID_SYNC();
            scan_units(lds, LA, U, Z, G, blk);
            attn_units(lds, Q, KN, KR, VT, Z, G, blk);
            sgu_units(lds, VTS, MEANV, RSTDV, p.in[20] + L * 1024, p.in[21] + L * 1024, wb + O_WSGU, p.in[23] + L * 1024, Z, G, blk);
            GRID_SYNC();
            { EpiRow<2, 0> e{G3, 3072, SSQ + r0 * 4, p.in[25] + L * 3072, 0, 0, 1}; RUN_GEMM((EpiRow<2, 0>), e, XB + r0 * DM, wb + O_WING, TC, 3072, 1024, 1024, 1024, 0); }
#undef APS
#define APS 2
            { EpiMerge e{G3, MG}; RUN_GEMM(EpiMerge, e, Z, wb + O_WRA, TC, 3072, 1024, ZLD, 1024, 1024); }
#undef APS
#define APS 0
            GRID_SYNC();
        }
        pb_convert(p, L, G, blk);
        { EpiSwiglu e{H, SSQ}; RUN_GEMM(EpiSwiglu, e, XB, wb + O_WGU2, T, 2 * DFF, 1024, 1024, 1024, 0); }
        GRID_SYNC();
        { EpiResid<false> e{nullptr, XB, SSQ, nullptr, 0.5f}; RUN_GEMM(EpiResid<false>, e, H, wb + O_WD2, T, 1024, DFF, DFF, DFF, 0); }
        GRID_SYNC();
        { EpiRow<2, 0> e{GP, 1024, SSQ, nullptr, 0, 0, 0}; RUN_GEMM((EpiRow<2, 0>), e, XB, wb + O_WPG, T, 1024, 1024, 1024, 1024, 0); }
        GRID_SYNC();
        { EpiResid<true> e{nullptr, XB, SSQ, GP, 1.0f}; RUN_GEMM(EpiResid<true>, e, PB, wb + O_WPLE, T, 1024, 256, 256, 256, 0); }
        GRID_SYNC();
    }
    {
        const int tid = pg8::tid_opaque(), lane = tid & 63, wave = tid >> 6, gw = blk * 8 + wave, NGW = G * 8; const float* fn = p.in[33];
        for (int m = gw; m < T; m += NGW) {
            const u32x4* xr = (const u32x4*)(XB + (size_t)m * DM) + lane; f32x4* orow = (f32x4*)(X + (size_t)m * DM); f32x4 v[4]; float s = 0.f;
#pragma unroll
            for (int j = 0; j < 2; ++j) { unpack8(xr[64 * j], v[2 * j], v[2 * j + 1]); }
#pragma unroll
            for (int j = 0; j < 4; ++j) s += (v[j][0] * v[j][0] + v[j][1] * v[j][1]) + (v[j][2] * v[j][2] + v[j][3] * v[j][3]);
            const float rstd = __builtin_amdgcn_rsqf(wave_sum(s) * (1.f / 1024.f) + EPS);
#pragma unroll
            for (int j = 0; j < 2; ++j) { const int c = 512 * j + 8 * lane; orow[c / 4] = v[2 * j] * rstd * *(const f32x4*)(fn + c); orow[c / 4 + 1] = v[2 * j + 1] * rstd * *(const f32x4*)(fn + c + 4); }
        }
    }
}

extern "C" void kernel_launch(void* const* d_in, const int* in_sizes, int n_in, void* d_out, int out_size, void* d_ws, size_t ws_size, hipStream_t stream) {
    static int grid = 0;
    if (grid == 0) {
        if (n_in != 34 || ws_size < WS_NEED) { fprintf(stderr, "kernel_launch: unexpected n_in %d / ws_size %zu (need %zu)\n", n_in, ws_size, (size_t)WS_NEED); grid = -1; return; }
        int dev = 0, cus = 0, per = 0;
        (void)hipGetDevice(&dev); (void)hipDeviceGetAttribute(&cus, hipDeviceAttributeMultiprocessorCount, dev);
        (void)hipFuncSetAttribute((const void*)fwd_kernel, hipFuncAttributeMaxDynamicSharedMemorySize, LDS_BYTES);
        if (hipOccupancyMaxActiveBlocksPerMultiprocessor(&per, (const void*)fwd_kernel, 512, LDS_BYTES) != hipSuccess || per < 1) per = 1;
        (void)hipGetLastError();
        grid = cus * per;
    }
    if (grid < 0) return;
    (void)hipMemsetAsync((unsigned char*)d_ws + WS_SMALL + SM_BAR, 0, 16384, stream);
    Params prm{};
    for (int i = 0; i < 34; ++i) prm.in[i] = (const float*)d_in[i];
    prm.out = (float*)d_out; prm.ws = (unsigned char*)d_ws;
    void* args[] = {&prm};
    hipError_t e = hipLaunchCooperativeKernel((const void*)fwd_kernel, dim3(grid), dim3(512), args, LDS_BYTES, stream);
    if (e != hipSuccess) fprintf(stderr, "cooperative launch failed: %s (grid %d)\n", hipGetErrorString(e), grid);
}
```

```cpp
#include <hip/hip_runtime.h>
#include <hip/hip_cooperative_groups.h>
#include <cstdio>
#include <cstdint>
namespace cg = cooperative_groups;
namespace pg8 {
#define PG8_LAS __attribute__((address_space(3)))
typedef unsigned short bf16_t;
typedef short bf16x8 __attribute__((ext_vector_type(8)));
typedef float f32x4 __attribute__((ext_vector_type(4)));
typedef unsigned u32x4 __attribute__((ext_vector_type(4)));
typedef unsigned u32x2 __attribute__((ext_vector_type(2)));
constexpr int BM = 256, BK = 64, HALF = 128, HTB = HALF * BK * 2  , STAGE_BYTES = 8 * HTB, NXCD = 8, WGM = 8;

__host__ __device__ __forceinline__ int lds_byte(int r, int c) { const int st = (r >> 4) * 2 + (c >> 5), rr = r & 15, cc = c & 31, ob = rr * 64 + cc * 2; return st * 1024 + (ob ^ (((ob >> 9) & 1) << 5)); }
__host__ __device__ __forceinline__ void stage_rc(int b, int& R, int& C) { const int st = b / 1024, sb = b % 1024, swz = sb ^ (((sb >> 9) & 1) << 5); R = (st >> 1) * 16 + swz / 64; C = (st & 1) * 32 + (swz % 64) / 2; }
__host__ __device__ __forceinline__ int perm32(int rho) { const int n = rho >> 4, i = rho & 15; return 8 * (i >> 2) + 4 * n + (i & 3); }

struct Unit { int pm, pn; };
struct Gemm { const bf16_t* A; const bf16_t* Bt; int M, N, K, lda, ldb, apn, aps; };

struct StaticOrder {
    int nM, nN, nwg, G, c;
    __host__ __device__ void init(int M, int N, int G_, int c_) { nM = M / BM; nN = N / BM; nwg = nM * nN; G = G_; c = c_; }
    __host__ __device__ bool next(int i, Unit& u) const {
        const long L = (long)i * G + c; if (L >= nwg) return false;
        int wgid = (int)L; { const int q = nwg / NXCD, r = nwg % NXCD, xcd = wgid % NXCD, off = wgid / NXCD; wgid = (xcd < r ? xcd * (q + 1) : r * (q + 1) + (xcd - r) * q) + off; }
        const int nig = WGM * nN, gid = wgid / nig, fm = gid * WGM, gsz = (nM - fm) < WGM ? (nM - fm) : WGM;
        u.pm = fm + ((wgid % nig) % gsz); u.pn = (wgid % nig) / gsz; return true;
    }
    __device__ __forceinline__ void a_ready(const Unit&) const {}
    __device__ __forceinline__ void done(const Unit&) const {}
};
__device__ __forceinline__ int tid_opaque() { int t = threadIdx.x; asm volatile("" : "+v"(t)); return t; }
typedef float f32x2_t __attribute__((ext_vector_type(2))); typedef __bf16 bf16x2_t __attribute__((ext_vector_type(2)));
__device__ __forceinline__ unsigned cvt_pk_bf16(float lo, float hi) { const f32x2_t v = {lo, hi}; const bf16x2_t b = __builtin_convertvector(v, bf16x2_t); return __builtin_bit_cast(unsigned, b); }

template <class Epi, class Sched, bool ALIGN_EPI = false, bool SP2 = false>
__device__ __forceinline__ void gemm_phase(PG8_LAS unsigned char* lds, const Gemm g, const Sched& S, const Epi& E) {
    const int tid = pg8::tid_opaque(), wid = __builtin_amdgcn_readfirstlane(tid >> 6), lane = tid & 63, wr = wid >> 2, wc = wid & 3, fr = lane & 15, fq = lane >> 4;
    const int K = g.K, nt = K / BK;
    unsigned voffA[2], voffB[2];
#pragma unroll
    for (int i = 0; i < 2; ++i) { int R, C; stage_rc(tid * 16 + i * 8192, R, C); const int Rb = Epi::PERM ? ((R & ~31) + perm32(R & 31)) : R;
        voffA[i] = (unsigned)(R * g.lda + C) * 2u; voffB[i] = (unsigned)(Rb * g.ldb + C) * 2u; }
    const size_t kstep = (size_t)(BK * 2);
    const size_t hstepA = (size_t)HALF * g.lda * 2, hstepB = (size_t)HALF * g.ldb * 2;
    const size_t tstepA = 2 * hstepA, tstepB = 2 * hstepB; const size_t apn = (size_t)g.apn * 2;
    const unsigned ldsw = (unsigned)wid * 1024u;
    const int aoff = lds_byte(wr * 64 + fr, fq * 8), boff = lds_byte(wc * 32 + fr, fq * 8);
#define PG8_SA(b, h) (((b) * 2 + (h)) * HTB)
#define PG8_SB(b, h) ((4 + (b) * 2 + (h)) * HTB)
#define PG8_STAGE(bufoff, gbase, voff) do { _Pragma("unroll") for (int _i = 0; _i < 2; ++_i) \
        __builtin_amdgcn_global_load_lds((const unsigned*)((const char*)(gbase) + (voff)[_i]), (PG8_LAS unsigned*)(lds + (bufoff) + ldsw + _i * 8192), 16, 0, 0); } while (0)
#define PG8_LDA(dst, b, h) do { _Pragma("unroll") for (int m = 0; m < 4; ++m) _Pragma("unroll") for (int k = 0; k < 2; ++k) dst[m][k] = *(const PG8_LAS bf16x8*)(lds + PG8_SA(b, h) + aoff + m * 2048 + k * 1024); } while (0)
#define PG8_LDB(dst, b, h) do { _Pragma("unroll") for (int n = 0; n < 2; ++n) _Pragma("unroll") for (int k = 0; k < 2; ++k) dst[n][k] = *(const PG8_LAS bf16x8*)(lds + PG8_SB(b, h) + boff + n * 2048 + k * 1024); } while (0)
#define PG8_MMA(ai, bj, At, Bt) do { __builtin_amdgcn_s_setprio(1); _Pragma("unroll") for (int m = 0; m < 4; ++m) _Pragma("unroll") for (int n = 0; n < 2; ++n) _Pragma("unroll") for (int k = 0; k < 2; ++k) \
        acc[ai][bj][m][n] = __builtin_amdgcn_mfma_f32_16x16x32_bf16(Bt[n][k], At[m][k], acc[ai][bj][m][n], 0, 0, 0); __builtin_amdgcn_s_setprio(0); } while (0)
#define PG8_WAIT_V(n) asm volatile("s_waitcnt vmcnt(" #n ")" ::: "memory")
#define PG8_WAIT_L(n) asm volatile("s_waitcnt lgkmcnt(" #n ")" ::: "memory")
#define PG8_BAR __builtin_amdgcn_s_barrier()
#define PG8_SCHED __builtin_amdgcn_sched_barrier(0)
    Unit cur, nxt; int ui = 0;
    if (!S.next(0, cur)) return;
    f32x4 acc[2][2][4][2];
#pragma unroll
    for (int a = 0; a < 2; ++a)
#pragma unroll
        for (int b = 0; b < 2; ++b)
#pragma unroll
            for (int m = 0; m < 4; ++m)
#pragma unroll
                for (int n = 0; n < 2; ++n) acc[a][b][m][n] = (f32x4){0.f, 0.f, 0.f, 0.f};
    bf16x8 At[4][2], B0[2][2], B1[2][2];
    const char* cA = (const char*)g.A + (size_t)cur.pm * tstepA + (size_t)(cur.pn >> g.aps) * apn; const char* cB = (const char*)g.Bt + (size_t)cur.pn * tstepB;
    S.a_ready(cur);
    if constexpr (SP2) {
        PG8_STAGE(PG8_SB(0, 0), cB, voffB); PG8_STAGE(PG8_SB(0, 1), cB + hstepB, voffB); PG8_STAGE(PG8_SA(0, 0), cA, voffA); PG8_STAGE(PG8_SA(0, 1), cA + hstepA, voffA);
        if (wr == 1) PG8_BAR;
        PG8_WAIT_V(2); PG8_BAR;
        PG8_STAGE(PG8_SB(1, 0), cB + kstep, voffB); PG8_STAGE(PG8_SA(1, 0), cA + kstep, voffA); PG8_STAGE(PG8_SB(1, 1), cB + hstepB + kstep, voffB);
        PG8_WAIT_V(6); PG8_BAR;
    } else {
        PG8_STAGE(PG8_SB(0, 0), cB, voffB); PG8_STAGE(PG8_SA(0, 0), cA, voffA); PG8_STAGE(PG8_SB(0, 1), cB + hstepB, voffB); PG8_STAGE(PG8_SA(0, 1), cA + hstepA, voffA);
        if (wr == 1) PG8_BAR;
        PG8_WAIT_V(4); PG8_BAR;
        PG8_STAGE(PG8_SB(1, 0), cB + kstep, voffB); PG8_STAGE(PG8_SA(1, 0), cA + kstep, voffA); PG8_STAGE(PG8_SB(1, 1), cB + hstepB + kstep, voffB);
        PG8_WAIT_V(6); PG8_BAR;
    }
    for (;;) {
        const bool has_next = S.next(ui + 1, nxt);
        const char* nA = has_next ? (const char*)g.A + (size_t)nxt.pm * tstepA + (size_t)(nxt.pn >> g.aps) * apn : cA; const char* nB = has_next ? (const char*)g.Bt + (size_t)nxt.pn * tstepB : cB;
        for (int t = 0; t < nt; t += 2) {
            const bool last = (t == nt - 2);
            const char* a1 = cA + (size_t)(t + 1) * kstep;
            const char* a2 = last ? nA : cA + (size_t)(t + 2) * kstep; const char* b2 = last ? nB : cB + (size_t)(t + 2) * kstep;
            const char* a3 = a2 + kstep; const char* b3 = b2 + kstep;
            if (last && has_next) S.a_ready(nxt);
            if constexpr (SP2) {
            PG8_LDB(B0, 0, 0); PG8_LDB(B1, 0, 1); PG8_SCHED; PG8_LDA(At, 0, 0); PG8_STAGE(PG8_SA(1, 1), a1 + hstepA, voffA);
            PG8_WAIT_V(8); PG8_WAIT_L(0); PG8_BAR; PG8_MMA(0, 0, At, B0); PG8_MMA(0, 1, At, B1); PG8_BAR; PG8_SCHED;
            PG8_LDA(At, 0, 1); PG8_STAGE(PG8_SB(0, 0), b2, voffB); PG8_STAGE(PG8_SB(0, 1), b2 + hstepB, voffB); PG8_STAGE(PG8_SA(0, 0), a2, voffA);
            PG8_WAIT_V(8); PG8_WAIT_L(0); PG8_BAR; PG8_MMA(1, 0, At, B0); PG8_MMA(1, 1, At, B1); PG8_BAR; PG8_SCHED;
            PG8_LDB(B0, 1, 0); PG8_LDB(B1, 1, 1); PG8_SCHED; PG8_LDA(At, 1, 0); PG8_STAGE(PG8_SA(0, 1), a2 + hstepA, voffA);
            PG8_WAIT_V(8); PG8_WAIT_L(0); PG8_BAR; PG8_MMA(0, 0, At, B0); PG8_MMA(0, 1, At, B1); PG8_BAR; PG8_SCHED;
            PG8_LDA(At, 1, 1); PG8_STAGE(PG8_SB(1, 0), b3, voffB); PG8_STAGE(PG8_SB(1, 1), b3 + hstepB, voffB); PG8_STAGE(PG8_SA(1, 0), a3, voffA);
            PG8_WAIT_V(8); PG8_WAIT_L(0); PG8_BAR; PG8_MMA(1, 0, At, B0); PG8_MMA(1, 1, At, B1); PG8_BAR; PG8_SCHED;
            } else {
            PG8_LDB(B0, 0, 0); PG8_SCHED; PG8_LDA(At, 0, 0); PG8_STAGE(PG8_SA(1, 1), a1 + hstepA, voffA);
            PG8_WAIT_L(8); PG8_BAR; PG8_WAIT_L(0); PG8_MMA(0, 0, At, B0); PG8_BAR; PG8_SCHED;
            PG8_LDB(B1, 0, 1); PG8_STAGE(PG8_SB(0, 0), b2, voffB);
            PG8_BAR; PG8_WAIT_L(0); PG8_MMA(0, 1, At, B1); PG8_BAR;
            PG8_LDA(At, 0, 1); PG8_STAGE(PG8_SA(0, 0), a2, voffA);
            PG8_BAR; PG8_WAIT_L(0); PG8_MMA(1, 0, At, B0); PG8_BAR; PG8_SCHED;
            PG8_STAGE(PG8_SB(0, 1), b2 + hstepB, voffB);
            PG8_WAIT_V(6); PG8_BAR; PG8_MMA(1, 1, At, B1); PG8_BAR;
            PG8_LDB(B0, 1, 0); PG8_SCHED; PG8_LDA(At, 1, 0); PG8_STAGE(PG8_SA(0, 1), a2 + hstepA, voffA);
            PG8_WAIT_L(8); PG8_BAR; PG8_WAIT_L(0); PG8_MMA(0, 0, At, B0); PG8_BAR; PG8_SCHED;
            PG8_LDB(B1, 1, 1); PG8_STAGE(PG8_SB(1, 0), b3, voffB);
            PG8_BAR; PG8_WAIT_L(0); PG8_MMA(0, 1, At, B1); PG8_BAR;
            PG8_LDA(At, 1, 1); PG8_STAGE(PG8_SA(1, 0), a3, voffA);
            PG8_BAR; PG8_WAIT_L(0); PG8_MMA(1, 0, At, B0); PG8_BAR; PG8_SCHED;
            PG8_STAGE(PG8_SB(1, 1), b3 + hstepB, voffB);
            PG8_WAIT_V(6); PG8_BAR; PG8_MMA(1, 1, At, B1); PG8_BAR;
            }
        }
        if constexpr (ALIGN_EPI) { if (wr == 0) PG8_BAR; }
        if constexpr (!Epi::AFTER_DRAIN) { E(acc, cur, wr, wc, fr, fq); S.done(cur); }
        if (!has_next) break;
#pragma unroll
        for (int a = 0; a < 2; ++a)
#pragma unroll
            for (int b = 0; b < 2; ++b)
#pragma unroll
                for (int m = 0; m < 4; ++m)
#pragma unroll
                    for (int n = 0; n < 2; ++n) acc[a][b][m][n] = (f32x4){0.f, 0.f, 0.f, 0.f};
        cur = nxt; cA = nA; cB = nB; ++ui;
        if constexpr (ALIGN_EPI) { if (wr == 1) PG8_BAR; }
    }
    PG8_WAIT_V(0);
    if constexpr (!ALIGN_EPI) { if (wr == 0) PG8_BAR; }
    PG8_BAR;
    if constexpr (Epi::AFTER_DRAIN) { E.fused(acc, cur, wr, wc, fr, fq, lds, wid, lane); S.done(cur); }
#undef PG8_SA
#undef PG8_SB
#undef PG8_STAGE
#undef PG8_LDA
#undef PG8_LDB
#undef PG8_MMA
#undef PG8_WAIT_V
#undef PG8_WAIT_L
#undef PG8_BAR
#undef PG8_SCHED
}
}

using pg8::bf16_t; using pg8::bf16x8; using pg8::f32x4; using pg8::u32x4; using pg8::u32x2; using pg8::Unit; using pg8::cvt_pk_bf16;
typedef float f32x16 __attribute__((ext_vector_type(16)));
typedef float f32x2 __attribute__((ext_vector_type(2)));
#define LAS __attribute__((address_space(3)))

constexpr int T = 32768, DM = 1024, TC = 16384, DFF = 2816, ZLD = 3840;
constexpr int ZC_XA = 0, ZC_GA = 1024, ZC_U = 2048, ZC_CKV = 3072, ZC_CQ = 3328, ZC_KR = 3712;
constexpr float EPS = 1e-6f, LOG2E = 1.4426950408889634f;
constexpr float QSCALE = 0.10206207261596577f * 1.4426950408889634f;
constexpr size_t MiB = (size_t)1 << 20;
constexpr size_t WS_W = 0, WS_XB = 64 * MiB, WS_SSQ = 128 * MiB, WS_SMALL = 130 * MiB, WS_BIG = 132 * MiB;
constexpr size_t SM_ROPE = 0, SM_RSQ = 256 * 1024, SM_RSKV = 320 * 1024, SM_MEANV = 384 * 1024, SM_RSTDV = 448 * 1024, SM_SP8 = 512 * 1024;
constexpr size_t B_H = 0, B_PB = 361 * MiB, B_GP = 192 * MiB, B_SSQ2 = 377 * MiB;
constexpr size_t B_Z = 0, B_VTS = 120 * MiB, B_XC = 152 * MiB, B_LA = 184 * MiB, B_U = 216 * MiB, B_Q = 248 * MiB, B_KN = 296 * MiB, B_VT = 328 * MiB, B_KR = 360 * MiB;
constexpr size_t B_G3 = 248 * MiB, B_MERGED = 184 * MiB;
constexpr size_t WS_NEED = WS_BIG + 379 * MiB;
constexpr size_t O_WGU1 = 0, O_WD1 = O_WGU1 + 5632 * 1024, O_WIN = O_WD1 + 1024 * 2816, O_WINV = O_WIN + 3840 * 1024, O_WING = O_WINV + 1024 * 1024,
                 O_WLRU = O_WING + 3072 * 1024, O_WRA = O_WLRU + 2048 * 128, O_WRB = O_WRA + 1024 * 1024, O_WRC = O_WRB + 1024 * 1024, O_WOUT = O_WRC + 1024 * 1024,
                 O_WPG = O_WOUT + 1024 * 1024, O_WUQ = O_WPG + 1024 * 1024, O_WKVK = O_WUQ + 1536 * 384, O_WKVV = O_WKVK + 1024 * 256, O_WGU2 = O_WKVV + 1024 * 256,
                 O_WD2 = O_WGU2 + 5632 * 1024, O_WPLE = O_WD2 + 1024 * 2816, O_WSGU = O_WPLE + 1024 * 256, O_WEND = O_WSGU + 8 * 128 * 128;
static_assert(O_WEND * 2 <= 64 * MiB, "weights fit");
constexpr int LDS_BYTES = 131072 + 256;
#ifndef DBG_STOP
#define DBG_STOP 0
#endif
#ifndef DBG_BR
#define DBG_BR 7
#endif

struct Params { const float* in[34]; float* out; unsigned char* ws; };

__device__ __forceinline__ float fexp2(float x) { return __builtin_amdgcn_exp2f(x); }
__device__ __forceinline__ float frcp(float x) { return __builtin_amdgcn_rcpf(x); }
__device__ __forceinline__ float sigm(float x) { return frcp(1.f + fexp2(-LOG2E * x)); }
__device__ __forceinline__ float gelu_t(float x) { const float t = x + 0.044715f * x * x * x; return x * frcp(1.f + fexp2(-2.3022081985f * t)); }
__device__ __forceinline__ float bflo(unsigned w) { return __uint_as_float(w << 16); }
__device__ __forceinline__ float bfhi(unsigned w) { return __uint_as_float(w & 0xffff0000u); }
__device__ __forceinline__ bf16_t f2bf(float v) { return (bf16_t)(cvt_pk_bf16(v, 0.f) & 0xffffu); }
__device__ __forceinline__ float wave_sum(float v) {
#pragma unroll
    for (int o = 1; o < 64; o <<= 1) v += __shfl_xor(v, o);
    return v;
}
constexpr size_t SSQ_PLANE = (size_t)T * 4;
__device__ __forceinline__ float rstd16(const float* ssq, size_t row) {
    const float* q = ssq + row * 4; const f32x4 a = *(const f32x4*)q, b = *(const f32x4*)(q + SSQ_PLANE), c = *(const f32x4*)(q + 2 * SSQ_PLANE), d = *(const f32x4*)(q + 3 * SSQ_PLANE);
    const float s = ((a.x + a.y) + (a.z + a.w)) + ((b.x + b.y) + (b.z + b.w)) + ((c.x + c.y) + (c.z + c.w)) + ((d.x + d.y) + (d.z + d.w));
    return __builtin_amdgcn_rsqf(s * (1.0f / 1024.0f) + EPS);
}
__device__ __forceinline__ u32x4 pack8(const f32x4 v0, const f32x4 v1) { u32x4 w; w.x = cvt_pk_bf16(v0[0], v0[1]); w.y = cvt_pk_bf16(v0[2], v0[3]); w.z = cvt_pk_bf16(v1[0], v1[1]); w.w = cvt_pk_bf16(v1[2], v1[3]); return w; }
__device__ __forceinline__ void unpack8(const u32x4 w, f32x4& v0, f32x4& v1) { v0 = (f32x4){bflo(w.x), bfhi(w.x), bflo(w.y), bfhi(w.y)}; v1 = (f32x4){bflo(w.z), bfhi(w.z), bflo(w.w), bfhi(w.w)}; }

template <int ACT, int RS> struct EpiRow {
    static constexpr bool PERM = true, AFTER_DRAIN = false;
    bf16_t* O; int ldc; const float* rs; const float* bias; int t0, t1; int bswap;
    __device__ __forceinline__ void operator()(const f32x4 (&acc)[2][2][4][2], const Unit& u, int wr, int wc, int fr, int fq) const {
        const int row0 = u.pm * 256 + wr * 64 + fr, col0 = u.pn * 256 + wc * 32 + 8 * fq;
        const bool act = (ACT == 1) ? (u.pn >= t0 && u.pn < t1) : true;
        f32x4 bv[2][2];
#pragma unroll
        for (int bj = 0; bj < 2; ++bj)
#pragma unroll
            for (int n = 0; n < 2; ++n) bv[bj][n] = bias ? *(const f32x4*)(bias + col0 + (bswap ? (u.pn < 4 ? 1024 : (u.pn < 8 ? -1024 : 0)) : 0) + bj * 128 + 4 * n) : (f32x4){0.f, 0.f, 0.f, 0.f};
#pragma unroll
        for (int ai = 0; ai < 2; ++ai)
#pragma unroll
            for (int m = 0; m < 4; ++m) {
                const size_t row = (size_t)(row0 + ai * 128 + m * 16); const float s = (RS == 0) ? rstd16(rs, row) : (RS == 1 ? rs[row] : 1.f);
                bf16_t* rowp = O + row * ldc + col0;
#pragma unroll
                for (int bj = 0; bj < 2; ++bj) {
                    f32x4 v0 = acc[ai][bj][m][0] * s + bv[bj][0], v1 = acc[ai][bj][m][1] * s + bv[bj][1];
                    if (ACT == 1) { if (act) {
#pragma unroll
                        for (int e = 0; e < 4; ++e) { v0[e] = gelu_t(v0[e]); v1[e] = gelu_t(v1[e]); } } }
                    if (ACT == 2) {
#pragma unroll
                        for (int e = 0; e < 4; ++e) { v0[e] = sigm(v0[e]); v1[e] = sigm(v1[e]); } }
                    *(u32x4*)(rowp + bj * 128) = pack8(v0, v1);
                }
                asm volatile("" ::: "memory");
            }
    }
};
struct EpiSwiglu {
    static constexpr bool PERM = true, AFTER_DRAIN = false;
    bf16_t* H; const float* ssq;
    __device__ __forceinline__ void operator()(const f32x4 (&acc)[2][2][4][2], const Unit& u, int wr, int wc, int fr, int fq) const {
        const int row0 = u.pm * 256 + wr * 64 + fr, col0 = u.pn * 128 + wc * 32 + 8 * fq;
#pragma unroll
        for (int ai = 0; ai < 2; ++ai)
#pragma unroll
            for (int m = 0; m < 4; ++m) {
                const size_t row = (size_t)(row0 + ai * 128 + m * 16); const float s = rstd16(ssq, row);
                f32x4 h0, h1;
#pragma unroll
                for (int e = 0; e < 4; ++e) { const float g0 = acc[ai][0][m][0][e] * s, g1 = acc[ai][0][m][1][e] * s; h0[e] = g0 * sigm(g0) * (acc[ai][1][m][0][e] * s); h1[e] = g1 * sigm(g1) * (acc[ai][1][m][1][e] * s); }
                *(u32x4*)(H + row * DFF + col0) = pack8(h0, h1);
                asm volatile("" ::: "memory");
            }
    }
};
template <bool GATED> struct EpiResid {
    static constexpr bool PERM = false, AFTER_DRAIN = false;
    const float* X32; bf16_t* XB; float* ssq; const bf16_t* GP; float alpha;
    __device__ __forceinline__ void operator()(const f32x4 (&acc)[2][2][4][2], const Unit& u, int wr, int wc, int fr, int fq) const {
        const int col0 = u.pn * 256 + wc * 32 + 4 * fq;
#pragma unroll
        for (int ai = 0; ai < 2; ++ai)
#pragma unroll
            for (int m = 0; m < 4; ++m) {
                const size_t row = (size_t)(u.pm * 256 + ai * 128 + wr * 64 + m * 16 + fr); const size_t off = row * DM + col0; float ss = 0.f;
#pragma unroll
                for (int bj = 0; bj < 2; ++bj)
#pragma unroll
                    for (int n = 0; n < 2; ++n) {
                        const size_t o = off + bj * 128 + n * 16; f32x4 a = acc[ai][bj][m][n] * alpha;
                        if (GATED) { const u32x2 g = *(const u32x2*)(GP + o); a[0] *= bflo(g.x); a[1] *= bfhi(g.x); a[2] *= bflo(g.y); a[3] *= bfhi(g.y); }
                        f32x4 xs;
                        if (X32) xs = *(const f32x4*)(X32 + o); else { const u32x2 xw = *(const u32x2*)(XB + o); xs = (f32x4){bflo(xw.x), bfhi(xw.x), bflo(xw.y), bfhi(xw.y)}; }
                        const f32x4 xv = xs + a;
                        u32x2 w; w.x = cvt_pk_bf16(xv[0], xv[1]); w.y = cvt_pk_bf16(xv[2], xv[3]); *(u32x2*)(XB + o) = w;
                        ss += (xv[0] * xv[0] + xv[1] * xv[1]) + (xv[2] * xv[2] + xv[3] * xv[3]);
                    }
                ss += __shfl_xor(ss, 16); ss += __shfl_xor(ss, 32);
                if (fq == 0) ssq[(size_t)u.pn * SSQ_PLANE + row * 4 + wc] = ss;
                asm volatile("" ::: "memory");
            }
    }
};
struct EpiPle {
    static constexpr bool PERM = true, AFTER_DRAIN = false;
    const bf16_t* XBc; bf16_t* XBn; const bf16_t* PP; const float* ssqc; float* ssqn;
    __device__ __forceinline__ void operator()(const f32x4 (&acc)[2][2][4][2], const Unit& u, int wr, int wc, int fr, int fq) const {
        const int row0 = u.pm * 256 + wr * 64 + fr, col0 = u.pn * 256 + wc * 32 + 8 * fq;
#pragma unroll
        for (int ai = 0; ai < 2; ++ai)
#pragma unroll
            for (int m = 0; m < 4; ++m) {
                const size_t row = (size_t)(row0 + ai * 128 + m * 16); const float s = rstd16(ssqc, row); float ss = 0.f;
#pragma unroll
                for (int bj = 0; bj < 2; ++bj) {
                    const size_t o = row * DM + col0 + bj * 128; f32x4 p0, p1, x0, x1; unpack8(*(const u32x4*)(PP + o), p0, p1); unpack8(*(const u32x4*)(XBc + o), x0, x1);
                    f32x4 v0 = acc[ai][bj][m][0] * s, v1 = acc[ai][bj][m][1] * s;
#pragma unroll
                    for (int e = 0; e < 4; ++e) { x0[e] += p0[e] * sigm(v0[e]); x1[e] += p1[e] * sigm(v1[e]); }
                    *(u32x4*)(XBn + o) = pack8(x0, x1);
                    ss += (x0[0] * x0[0] + x0[1] * x0[1]) + (x0[2] * x0[2] + x0[3] * x0[3]) + (x1[0] * x1[0] + x1[1] * x1[1]) + (x1[2] * x1[2] + x1[3] * x1[3]);
                }
                ss += __shfl_xor(ss, 16); ss += __shfl_xor(ss, 32);
                if (fq == 0) ssqn[(size_t)u.pn * SSQ_PLANE + row * 4 + wc] = ss;
                asm volatile("" ::: "memory");
            }
    }
};
template <int ACT, int RS> struct EpiCol {
    static constexpr bool PERM = true, AFTER_DRAIN = false;
    bf16_t* O; int ldc; const float* rs;
    __device__ __forceinline__ void operator()(const f32x4 (&acc)[2][2][4][2], const Unit& u, int wr, int wc, int fr, int fq) const {
        const int row0 = u.pm * 256 + wr * 64 + fr, col0 = u.pn * 256 + wc * 32 + 8 * fq;
#pragma unroll
        for (int bj = 0; bj < 2; ++bj) {
            const int col = col0 + bj * 128; f32x4 c0, c1;
            if (RS == 0) {
#pragma unroll
                for (int e = 0; e < 4; ++e) { c0[e] = rstd16(rs, (size_t)(col + e)); asm volatile("" ::: "memory"); c1[e] = rstd16(rs, (size_t)(col + 4 + e)); asm volatile("" ::: "memory"); }
            } else { c0 = *(const f32x4*)(rs + col); c1 = *(const f32x4*)(rs + col + 4); }
#pragma unroll
            for (int ai = 0; ai < 2; ++ai)
#pragma unroll
                for (int m = 0; m < 4; ++m) {
                    f32x4 v0 = acc[ai][bj][m][0] * c0, v1 = acc[ai][bj][m][1] * c1;
                    if (ACT == 1) {
#pragma unroll
                        for (int e = 0; e < 4; ++e) { v0[e] = gelu_t(v0[e]); v1[e] = gelu_t(v1[e]); } }
                    *(u32x4*)(O + (size_t)(row0 + ai * 128 + m * 16) * ldc + col) = pack8(v0, v1);
                    asm volatile("" ::: "memory");
                }
        }
    }
};
struct EpiLru {
    static constexpr bool PERM = true, AFTER_DRAIN = false;
    const bf16_t* XC; bf16_t* LA; bf16_t* U; const float* ba; const float* bx; const float* sp8;
    __device__ __forceinline__ void operator()(const f32x4 (&acc)[2][2][4][2], const Unit& u, int wr, int wc, int fr, int fq) const {
        const int row0 = u.pm * 256 + wr * 64 + fr, ch0 = (u.pn * 256 + wc * 32 + 8 * fq) >> 1;
#pragma unroll
        for (int bj = 0; bj < 2; ++bj) {
            const int ch = ch0 + bj * 64; const f32x4 vba = *(const f32x4*)(ba + ch), vbx = *(const f32x4*)(bx + ch), vsp = *(const f32x4*)(sp8 + ch);
#pragma unroll
            for (int ai = 0; ai < 2; ++ai)
#pragma unroll
                for (int m = 0; m < 4; ++m) {
                    const int row = row0 + ai * 128 + m * 16; const size_t o = (size_t)row * DM + ch; const bool first = (row & 2047) == 0;
                    const u32x2 xw = *(const u32x2*)(XC + o); const float xc[4] = {bflo(xw.x), bfhi(xw.x), bflo(xw.y), bfhi(xw.y)};
                    const f32x4 v0 = acc[ai][bj][m][0], v1 = acc[ai][bj][m][1]; const float ga[4] = {v0[0], v0[2], v1[0], v1[2]}, gx[4] = {v0[1], v0[3], v1[1], v1[3]};
                    float la[4], uu[4];
#pragma unroll
                    for (int e = 0; e < 4; ++e) { const float r = sigm(ga[e] + vba[e]), ig = sigm(gx[e] + vbx[e]); la[e] = -vsp[e] * r;
                        const float a2 = fexp2(2.f * LOG2E * la[e]); const float mult = first ? 1.f : sqrtf(fmaxf(1.f - a2, 0.f)); uu[e] = mult * ig * xc[e]; }
                    u32x2 wl, wu; wl.x = cvt_pk_bf16(la[0], la[1]); wl.y = cvt_pk_bf16(la[2], la[3]); wu.x = cvt_pk_bf16(uu[0], uu[1]); wu.y = cvt_pk_bf16(uu[2], uu[3]);
                    *(u32x2*)(LA + o) = wl; *(u32x2*)(U + o) = wu;
                    asm volatile("" ::: "memory");
                }
        }
    }
};
struct EpiQ {
    static constexpr bool PERM = true, AFTER_DRAIN = false;
    bf16_t* Q; const float* rsq; const float* rope;
    __device__ __forceinline__ void operator()(const f32x4 (&acc)[2][2][4][2], const Unit& u, int wr, int wc, int fr, int fq) const {
        const int row0 = u.pm * 256 + wr * 64 + fr, col0 = u.pn * 256 + wc * 32 + 8 * fq;
#pragma unroll
        for (int ai = 0; ai < 2; ++ai)
#pragma unroll
            for (int m = 0; m < 4; ++m) {
                const int row = row0 + ai * 128 + m * 16; const float s = rsq[row] * QSCALE; const int pos = row & 2047;
#pragma unroll
                for (int bj = 0; bj < 2; ++bj) {
                    const int col = col0 + bj * 128, d = col % 96; f32x4 v0 = acc[ai][bj][m][0] * s, v1 = acc[ai][bj][m][1] * s;
                    if (d >= 64) { const int i0 = (d - 64) >> 1; const f32x4 t0 = *(const f32x4*)(rope + (pos * 16 + i0) * 2), t1 = *(const f32x4*)(rope + (pos * 16 + i0 + 2) * 2);
                        const f32x4 a = v0, b = v1;
                        v0[0] = a[0] * t0[0] - a[1] * t0[1]; v0[1] = a[0] * t0[1] + a[1] * t0[0]; v0[2] = a[2] * t0[2] - a[3] * t0[3]; v0[3] = a[2] * t0[3] + a[3] * t0[2];
                        v1[0] = b[0] * t1[0] - b[1] * t1[1]; v1[1] = b[0] * t1[1] + b[1] * t1[0]; v1[2] = b[2] * t1[2] - b[3] * t1[3]; v1[3] = b[2] * t1[3] + b[3] * t1[2]; }
                    *(u32x4*)(Q + (size_t)row * 1536 + col) = pack8(v0, v1);
                }
                asm volatile("" ::: "memory");
            }
    }
};
struct EpiMerge {
    static constexpr bool PERM = true, AFTER_DRAIN = false;
    const bf16_t* G3; bf16_t* MG;
    __device__ __forceinline__ void operator()(const f32x4 (&acc)[2][2][4][2], const Unit& u, int wr, int wc, int fr, int fq) const {
        const int row0 = u.pm * 256 + wr * 64 + fr, col0 = u.pn * 256 + wc * 32 + 8 * fq, mcol0 = (u.pn & 3) * 256 + wc * 32 + 8 * fq; const bool first = u.pn < 4;
#pragma unroll
        for (int ai = 0; ai < 2; ++ai)
#pragma unroll
            for (int m = 0; m < 4; ++m) {
                const size_t row = (size_t)(row0 + ai * 128 + m * 16);
#pragma unroll
                for (int bj = 0; bj < 2; ++bj) {
                    f32x4 g0, g1; unpack8(*(const u32x4*)(G3 + row * 3072 + col0 + bj * 128), g0, g1);
                    f32x4 v0 = acc[ai][bj][m][0] * g0, v1 = acc[ai][bj][m][1] * g1;
                    if (!first) { f32x4 p0, p1; unpack8(*(const u32x4*)(MG + row * DM + mcol0 + bj * 128), p0, p1); v0 += p0; v1 += p1; }
                    *(u32x4*)(MG + row * DM + mcol0 + bj * 128) = pack8(v0, v1);
                }
                asm volatile("" ::: "memory");
            }
    }
};
enum { MAP_ID = 0, MAP_SWIGLU, MAP_WIN, MAP_UQ, MAP_KVK, MAP_KVV, MAP_GATES };
struct Job { const float* W; const float* gain; bf16_t* dst; int ldw, K, dN, map, off; };
__device__ __forceinline__ int srcmap(int map, int off, int n) {
    switch (map) {
    case MAP_SWIGLU: return (n >> 8) * 128 + (n & 127) + ((n & 128) ? DFF : 0);
    case MAP_WIN: if (n < 2048) return n; if (n < 3072) return 2720 + (n - 2048); if (n < 3328) return 2432 + (n - 3072); if (n < 3712) return 2048 + (n - 3328);
                  if (n < 3744) { const int j = n - 3712, i = j >> 1; return 2688 + ((j & 1) ? 16 + i : i); } return -1;
    case MAP_UQ: { const int h = n / 96, d = n % 96; if (d < 64) return n; const int j = d - 64, i = j >> 1; return h * 96 + 64 + ((j & 1) ? 16 + i : i); }
    case MAP_KVK: return (n >> 6) * 128 + (n & 63);
    case MAP_KVV: return (n >> 6) * 128 + 64 + (n & 63);
    case MAP_GATES: return 4768 + (n < 1024 ? n + 1024 : (n < 2048 ? n - 1024 : n));
    default: return n + off;
    }
}
#define JOB(Wp, GAIN, DST, LDW, KK, DN, MAP, OFF) do { J.W = (Wp); J.gain = (GAIN); J.dst = wb + (DST); J.ldw = (LDW); J.K = (KK); J.dN = (DN); J.map = (MAP); J.off = (OFF); } while (0)
__device__ __forceinline__ void get_job(const Params& p, int L, int j, bf16_t* wb, Job& J) {
    const size_t M1 = 1024 * 1024;
    switch (j) {
    case 0: JOB(p.in[3] + (size_t)L * 1024 * 5632, p.in[2] + L * 1024, O_WGU1, 5632, 1024, 5632, MAP_SWIGLU, 0); break;
    case 1: JOB(p.in[4] + (size_t)L * 2816 * 1024, nullptr, O_WD1, 1024, 2816, 1024, MAP_ID, 0); break;
    case 2: JOB(p.in[6] + (size_t)L * 1024 * 7840, p.in[5] + L * 1024, O_WIN, 7840, 1024, 3840, MAP_WIN, 0); break;
    case 3: JOB(p.in[6] + (size_t)L * 1024 * 7840, p.in[5] + L * 1024, O_WINV, 7840, 1024, 1024, MAP_ID, 3744); break;
    case 4: JOB(p.in[6] + (size_t)L * 1024 * 7840, p.in[5] + L * 1024, O_WING, 7840, 1024, 3072, MAP_GATES, 0); break;
    case 5: JOB(p.in[14] + L * M1, nullptr, O_WRB, 1024, 1024, 1024, MAP_ID, 0); break;
    case 6: JOB(p.in[19] + L * M1, nullptr, O_WRA, 1024, 1024, 1024, MAP_ID, 0); break;
    case 7: JOB(p.in[24] + L * M1, nullptr, O_WRC, 1024, 1024, 1024, MAP_ID, 0); break;
    case 8: JOB(p.in[26] + L * M1, nullptr, O_WOUT, 1024, 1024, 1024, MAP_ID, 0); break;
    case 9: JOB(p.in[31] + L * M1, p.in[30] + L * 1024, O_WPG, 1024, 1024, 1024, MAP_ID, 0); break;
    case 10: JOB(p.in[16] + (size_t)L * 384 * 1536, p.in[15] + L * 384, O_WUQ, 1536, 384, 1536, MAP_UQ, 0); break;
    case 11: JOB(p.in[18] + (size_t)L * 256 * 2048, p.in[17] + L * 256, O_WKVK, 2048, 256, 1024, MAP_KVK, 0); break;
    case 12: JOB(p.in[18] + (size_t)L * 256 * 2048, p.in[17] + L * 256, O_WKVV, 2048, 256, 1024, MAP_KVV, 0); break;
    case 13: JOB(p.in[28] + (size_t)L * 1024 * 5632, p.in[27] + L * 1024, O_WGU2, 5632, 1024, 5632, MAP_SWIGLU, 0); break;
    case 14: JOB(p.in[29] + (size_t)L * 2816 * 1024, nullptr, O_WD2, 1024, 2816, 1024, MAP_ID, 0); break;
    default: JOB(p.in[32] + (size_t)L * 256 * 1024, nullptr, O_WPLE, 1024, 256, 1024, MAP_ID, 0); break;
    }
}
constexpr int NJOBS = 16;
__device__ __forceinline__ void tr_item(const Job& J, int item, LAS float* scr, int lane) {
    const int nblk = J.dN >> 5, kb = item / nblk, nb = item % nblk, k0 = 64 * kb, n0 = 32 * nb;
    const int sc0 = srcmap(J.map, J.off, n0);
    if (sc0 >= 0 && srcmap(J.map, J.off, n0 + 1) == sc0 + 1 && srcmap(J.map, J.off, n0 + 31) == sc0 + 31) {
        const int kr = lane >> 3, c4 = lane & 7; f32x4 v[8];
#pragma unroll
        for (int i = 0; i < 8; ++i) v[i] = *(const f32x4*)(J.W + (size_t)(k0 + 8 * i + kr) * J.ldw + sc0 + 4 * c4);
#pragma unroll
        for (int i = 0; i < 8; ++i) { const int kk = 8 * i + kr; const float gn = J.gain ? J.gain[k0 + kk] : 1.f;
            scr[kk * 33 + 4 * c4] = v[i][0] * gn; scr[kk * 33 + 4 * c4 + 1] = v[i][1] * gn; scr[kk * 33 + 4 * c4 + 2] = v[i][2] * gn; scr[kk * 33 + 4 * c4 + 3] = v[i][3] * gn; }
    } else {
        const int sc = srcmap(J.map, J.off, n0 + (lane & 31));
#pragma unroll 8
        for (int i = 0; i < 32; ++i) { const int kk = 2 * i + (lane >> 5); float v = (sc >= 0) ? J.W[(size_t)(k0 + kk) * J.ldw + sc] : 0.f; if (J.gain) v *= J.gain[k0 + kk]; scr[kk * 33 + (lane & 31)] = v; }
    }
    asm volatile("s_waitcnt lgkmcnt(0)" ::: "memory");
    const int c = lane & 7;
#pragma unroll
    for (int j = 0; j < 4; ++j) { const int n = (lane >> 3) + 8 * j; const LAS float* s = scr + (8 * c) * 33 + n;
        u32x4 o; o.x = cvt_pk_bf16(s[0 * 33], s[1 * 33]); o.y = cvt_pk_bf16(s[2 * 33], s[3 * 33]); o.z = cvt_pk_bf16(s[4 * 33], s[5 * 33]); o.w = cvt_pk_bf16(s[6 * 33], s[7 * 33]);
        *(u32x4*)(J.dst + (size_t)(n0 + n) * J.K + k0 + 8 * c) = o; }
    asm volatile("s_waitcnt lgkmcnt(0)" ::: "memory");
}
__device__ __forceinline__ void phase0(const Params& p, int L, LAS unsigned char* lds, int G, int blk) {
    const int tid = pg8::tid_opaque(), lane = tid & 63, wave = tid >> 6;
    const int gw = blk * 8 + wave, NGW = G * 8, gt = blk * 512 + tid, NGT = G * 512;
    bf16_t* wb = (bf16_t*)(p.ws + WS_W);
    LAS float* scr = (LAS float*)(lds + wave * 8448);
    int total = 0;
    for (int j = 0; j < NJOBS; ++j) { Job J; get_job(p, L, j, wb, J); total += (J.K >> 6) * (J.dN >> 5); }
    for (int it = gw; it < total; it += NGW) {
        int r = it;
        for (int j = 0; j < NJOBS; ++j) { Job J; get_job(p, L, j, wb, J); const int n = (J.K >> 6) * (J.dN >> 5); if (r < n) { tr_item(J, r, scr, lane); break; } r -= n; }
    }
    { bf16_t* d = wb + O_WLRU; const float* wa = p.in[9] + (size_t)L * 65536; const float* wx = p.in[11] + (size_t)L * 65536;
      for (int i = gt; i < 2048 * 128; i += NGT) { const int n = i >> 7, k = i & 127, ch = n >> 1, nb = ch >> 6, dd = ch & 63;
          float v = 0.f; if ((k >> 6) == (nb & 1)) v = ((n & 1) ? wx : wa)[(size_t)nb * 4096 + (k & 63) * 64 + dd]; d[i] = f2bf(v); } }
    { bf16_t* d = wb + O_WSGU; const float* w = p.in[22] + (size_t)L * 131072;
      for (int i = gt; i < 131072; i += NGT) { const int t = (i >> 7) & 127, s = i & 127; d[i] = f2bf(((s >> 6) <= (t >> 6)) ? w[i] : 0.f); } }
    { const f32x4* src = (const f32x4*)(p.in[1] + (size_t)L * T * 256); u32x2* d = (u32x2*)(p.ws + WS_BIG + B_PB);
      for (int i = gt; i < T * 256 / 4; i += NGT) { const f32x4 v = src[i]; u32x2 w; w.x = cvt_pk_bf16(v[0], v[1]); w.y = cvt_pk_bf16(v[2], v[3]); d[i] = w; } }
    { float* sp = (float*)(p.ws + WS_SMALL + SM_SP8); const float* lam = p.in[13] + L * 1024;
      for (int i = gt; i < 1024; i += NGT) sp[i] = 8.f * 0.6931471805599453f * __builtin_amdgcn_logf(1.f + fexp2(-LOG2E * lam[i])); }
    if (L == 0) {
        float* rope = (float*)(p.ws + WS_SMALL + SM_ROPE);
        for (int i = gt; i < 2048 * 16; i += NGT) { const int pos = i >> 4, k = i & 15; const float inv = fexp2(-(float)k * (13.287712379549449f / 16.f)); const float ang = (float)pos * inv;
            double rev = (double)ang * 0.15915494309189535; rev -= floor(rev); const float fr = (float)rev; rope[2 * i] = __builtin_amdgcn_cosf(fr); rope[2 * i + 1] = __builtin_amdgcn_sinf(fr); }
        const float* x = p.in[0]; bf16_t* XB = (bf16_t*)(p.ws + WS_XB); float* ssq = (float*)(p.ws + WS_SSQ);
        for (int m = gw; m < T; m += NGW) {
            const f32x4* xr = (const f32x4*)(x + (size_t)m * DM) + lane; u32x2* o8 = (u32x2*)(XB + (size_t)m * DM) + lane; float s = 0.f;
#pragma unroll
            for (int j = 0; j < 4; ++j) { const f32x4 v = xr[64 * j]; s += (v[0] * v[0] + v[1] * v[1]) + (v[2] * v[2] + v[3] * v[3]); u32x2 w; w.x = cvt_pk_bf16(v[0], v[1]); w.y = cvt_pk_bf16(v[2], v[3]); o8[64 * j] = w; }
            s = wave_sum(s);
            if (lane < 16) ssq[(size_t)(lane >> 2) * SSQ_PLANE + (size_t)m * 4 + (lane & 3)] = (lane == 0) ? s : 0.f;
        }
    }
}

__device__ __forceinline__ void pb_convert(const Params& p, int L, int G, int blk) {
    const int tid = pg8::tid_opaque(), gt = blk * 512 + tid, NGT = G * 512;
    const f32x4* src = (const f32x4*)(p.in[1] + (size_t)L * T * 256); u32x2* d = (u32x2*)(p.ws + WS_BIG + B_PB);
    for (int i = gt; i < T * 256 / 4; i += NGT) { const f32x4 v = src[i]; u32x2 w; w.x = cvt_pk_bf16(v[0], v[1]); w.y = cvt_pk_bf16(v[2], v[3]); d[i] = w; }
}
__device__ __forceinline__ void e1_rows(const Params& p, int L, const bf16_t* Z, bf16_t* XC, float* RSQ, float* RSKV, bf16_t* KR, const float* rope, int G, int blk) {
    const int tid = pg8::tid_opaque(), lane = tid & 63, wave = tid >> 6;
    const float* cw = p.in[7] + (size_t)L * 4096; const float* cb = p.in[8] + L * 1024;
    for (int rb = blk * 64 + wave * 8; rb < TC; rb += G * 64) {
        const bool halo = (rb & 2047) != 0;
        u32x4 cqv[8]; u32x2 ckv[8];
#pragma unroll
        for (int r = 0; r < 8; ++r) { const bf16_t* zr = Z + (size_t)(rb + r) * ZLD; cqv[r] = (lane < 48) ? *(const u32x4*)(zr + ZC_CQ + 8 * lane) : (u32x4){0u, 0u, 0u, 0u}; ckv[r] = *(const u32x2*)(zr + ZC_CKV + 4 * lane); }
#pragma unroll
        for (int hf = 0; hf < 2; ++hf) {
            const int c0 = hf * 512 + 8 * lane; u32x4 xr[11];
#pragma unroll
            for (int j = 0; j < 11; ++j) xr[j] = (j >= 3 || halo) ? *(const u32x4*)(Z + (ptrdiff_t)(rb - 3 + j) * ZLD + ZC_XA + c0) : (u32x4){0u, 0u, 0u, 0u};
            f32x4 w0[4], w1[4]; const f32x4 b0 = *(const f32x4*)(cb + c0), b1 = *(const f32x4*)(cb + c0 + 4);
#pragma unroll
            for (int k = 0; k < 4; ++k) { w0[k] = *(const f32x4*)(cw + k * 1024 + c0); w1[k] = *(const f32x4*)(cw + k * 1024 + c0 + 4); }
#pragma unroll
            for (int r = 0; r < 8; ++r) { f32x4 a0 = b0, a1 = b1;
#pragma unroll
                for (int k = 0; k < 4; ++k) { f32x4 x0, x1; unpack8(xr[r + k], x0, x1); a0 += w0[k] * x0; a1 += w1[k] * x1; }
                *(u32x4*)(XC + (size_t)(rb + r) * DM + c0) = pack8(a0, a1); }
        }
        float sq[8], sk[8];
#pragma unroll
        for (int r = 0; r < 8; ++r) { f32x4 x0, x1; unpack8(cqv[r], x0, x1); sq[r] = (x0[0] * x0[0] + x0[1] * x0[1]) + (x0[2] * x0[2] + x0[3] * x0[3]) + (x1[0] * x1[0] + x1[1] * x1[1]) + (x1[2] * x1[2] + x1[3] * x1[3]);
            const float a = bflo(ckv[r].x), b = bfhi(ckv[r].x), c = bflo(ckv[r].y), d = bfhi(ckv[r].y); sk[r] = (a * a + b * b) + (c * c + d * d); }
#pragma unroll
        for (int o = 1; o < 64; o <<= 1)
#pragma unroll
            for (int r = 0; r < 8; ++r) { sq[r] += __shfl_xor(sq[r], o); sk[r] += __shfl_xor(sk[r], o); }
        { float q = sq[0], k = sk[0];
#pragma unroll
          for (int r = 1; r < 8; ++r) { if (lane == r) { q = sq[r]; k = sk[r]; } }
          if (lane < 8) { RSQ[rb + lane] = __builtin_amdgcn_rsqf(q * (1.f / 384.f) + EPS); RSKV[rb + lane] = __builtin_amdgcn_rsqf(k * (1.f / 256.f) + EPS); } }
#pragma unroll
        for (int it = 0; it < 2; ++it) { const int r = rb + it * 4 + (lane >> 4), i = lane & 15, pos = r & 2047;
            const unsigned w = *(const unsigned*)(Z + (size_t)r * ZLD + ZC_KR + 2 * i); const float x1 = bflo(w), x2 = bfhi(w); const f32x2 cs = *(const f32x2*)(rope + (pos * 16 + i) * 2);
            *(unsigned*)(KR + (size_t)r * 32 + 2 * i) = cvt_pk_bf16(x1 * cs[0] - x2 * cs[1], x1 * cs[1] + x2 * cs[0]); }
    }
}
__device__ __forceinline__ void e2_stats(LAS unsigned char* lds, const bf16_t* VTS, float* MEANV, float* RSTDV, int G, int blk) {
    const int tid = pg8::tid_opaque(), lane = tid & 63, wave = tid >> 6, tg = lane & 7, cr = lane >> 3;
    LAS float* part = (LAS float*)lds;
    for (int unit = blk; unit < TC / 64; unit += G) {
        const int tok0 = unit * 64; float s[8], q[8];
#pragma unroll
        for (int e = 0; e < 8; ++e) { s[e] = 0.f; q[e] = 0.f; }
#pragma unroll
        for (int it = 0; it < 16; ++it) { const int c = wave * 128 + it * 8 + cr; f32x4 x0, x1; unpack8(*(const u32x4*)(VTS + (size_t)c * TC + tok0 + 8 * tg), x0, x1);
#pragma unroll
            for (int e = 0; e < 4; ++e) { s[e] += x0[e]; q[e] += x0[e] * x0[e]; s[4 + e] += x1[e]; q[4 + e] += x1[e] * x1[e]; } }
#pragma unroll
        for (int e = 0; e < 8; ++e) { s[e] += __shfl_xor(s[e], 8); s[e] += __shfl_xor(s[e], 16); s[e] += __shfl_xor(s[e], 32); q[e] += __shfl_xor(q[e], 8); q[e] += __shfl_xor(q[e], 16); q[e] += __shfl_xor(q[e], 32); }
        if (cr == 0) {
#pragma unroll
            for (int e = 0; e < 8; ++e) { part[(wave * 64 + 8 * tg + e) * 2] = s[e]; part[(wave * 64 + 8 * tg + e) * 2 + 1] = q[e]; } }
        __syncthreads();
        if (tid < 64) { float ss = 0.f, qq = 0.f;
#pragma unroll
            for (int w = 0; w < 8; ++w) { ss += part[(w * 64 + tid) * 2]; qq += part[(w * 64 + tid) * 2 + 1]; }
            const float mean = ss * (1.f / 1024.f); const float var = fmaxf(qq * (1.f / 1024.f) - mean * mean, 0.f);
            MEANV[tok0 + tid] = mean; RSTDV[tok0 + tid] = __builtin_amdgcn_rsqf(var + EPS); }
        __syncthreads();
    }
}
__device__ __forceinline__ void scan_units(LAS unsigned char* lds, const bf16_t* LA, const bf16_t* U, bf16_t* Z, int G, int blk) {
    const int tid = pg8::tid_opaque(), cp = tid & 15, seg = tid >> 4;
    LAS f32x4* sc = (LAS f32x4*)lds;
    for (int idx = blk; idx < 256; idx += G) {
        const int b = idx >> 5, ch = (idx & 31) * 32 + 2 * cp; const size_t row0 = (size_t)b * 2048 + seg * 64;
        const unsigned* lap = (const unsigned*)(LA + row0 * DM + ch); const unsigned* up = (const unsigned*)(U + row0 * DM + ch);
        float h0 = 0.f, h1 = 0.f, s0 = 0.f, s1 = 0.f;
#pragma unroll 16
        for (int t = 0; t < 64; ++t) { const unsigned lw = lap[(size_t)t * 512], uw = up[(size_t)t * 512]; const float l0 = bflo(lw), l1 = bfhi(lw);
            h0 = fexp2(LOG2E * l0) * h0 + bflo(uw); h1 = fexp2(LOG2E * l1) * h1 + bfhi(uw); s0 += l0; s1 += l1; }
        sc[seg * 16 + cp] = (f32x4){s0, s1, h0, h1};
        __syncthreads();
        float c0 = 0.f, c1 = 0.f;
        for (int j = 0; j < seg; ++j) { const f32x4 v = sc[j * 16 + cp]; c0 = fexp2(LOG2E * v[0]) * c0 + v[2]; c1 = fexp2(LOG2E * v[1]) * c1 + v[3]; }
        h0 = c0; h1 = c1;
        unsigned* gp = (unsigned*)(Z + row0 * ZLD + ZC_GA + ch);
#pragma unroll 16
        for (int t = 0; t < 64; ++t) { const unsigned lw = lap[(size_t)t * 512], uw = up[(size_t)t * 512], gw = gp[(size_t)t * (ZLD / 2)];
            h0 = fexp2(LOG2E * bflo(lw)) * h0 + bflo(uw); h1 = fexp2(LOG2E * bfhi(lw)) * h1 + bfhi(uw); gp[(size_t)t * (ZLD / 2)] = cvt_pk_bf16(h0 * bflo(gw), h1 * bfhi(gw)); }
        __syncthreads();
    }
}
__device__ __forceinline__ void attn_units(LAS unsigned char* lds, const bf16_t* Q, const bf16_t* KN, const bf16_t* KR, const bf16_t* VT, bf16_t* Z, int G, int blk) {
    const int tid = pg8::tid_opaque(), lane = tid & 63, wid = __builtin_amdgcn_readfirstlane(tid >> 6), i32 = lane & 31, hi = lane >> 5;
    constexpr int KP = 208, VP = 144, KBUF = 64 * KP, VBUF = 64 * VP;
    for (int idx = blk; idx < 1024; idx += G) {
        const int j = idx & 255, rnd = idx >> 8, bh = j >> 1;
        const int qb = (j & 1) ? (rnd == 0 ? 1 : rnd == 1 ? 6 : rnd == 2 ? 3 : 4) : (rnd == 0 ? 0 : rnd == 1 ? 7 : rnd == 2 ? 2 : 5);
        const int b = bh >> 4, h = bh & 15, q0 = qb * 256, NT = q0 / 64 + 4, ntw = (q0 + 32 * wid) / 64 + 1;
        const size_t rowb = (size_t)b * 2048;
        bf16x8 qr[6];
        { const bf16_t* qp = Q + (rowb + q0 + 32 * wid + i32) * 1536 + h * 96 + 8 * hi;
#pragma unroll
          for (int ks = 0; ks < 6; ++ks) qr[ks] = *(const bf16x8*)(qp + 16 * ks); }
        const bf16_t* kns = KN + (rowb + (tid >> 3)) * DM + h * 64 + 8 * (tid & 7);
        const bf16_t* krs = KR + (rowb + (tid >> 2)) * 32 + 8 * (tid & 3);
        const bf16_t* vts = VT + (size_t)(h * 64 + (tid >> 3)) * TC + rowb + 8 * (tid & 7);
        const int kdst = (tid >> 3) * KP + (tid & 7) * 16, krdst = (tid >> 2) * KP + 128 + (tid & 3) * 16, vdst = 2 * KBUF + (tid >> 3) * VP + (tid & 7) * 16;
        u32x4 rk, rr = (u32x4){0u, 0u, 0u, 0u}, rv;
        rk = *(const u32x4*)kns; if (tid < 256) rr = *(const u32x4*)krs; rv = *(const u32x4*)vts;
        *(LAS u32x4*)(lds + kdst) = rk; if (tid < 256) *(LAS u32x4*)(lds + krdst) = rr; *(LAS u32x4*)(lds + vdst) = rv;
        __syncthreads();
        f32x16 o0, o1;
#pragma unroll
        for (int r = 0; r < 16; ++r) { o0[r] = 0.f; o1[r] = 0.f; }
        float mrun = -1e30f, lrun = 0.f;
        for (int t = 0; t < NT; ++t) {
            const int cur = t & 1; const bool more = (t + 1 < NT);
            if (more) { rk = *(const u32x4*)(kns + (size_t)(t + 1) * 64 * DM); if (tid < 256) rr = *(const u32x4*)(krs + (size_t)(t + 1) * 64 * 32); rv = *(const u32x4*)(vts + (size_t)(t + 1) * 64); }
            if (t < ntw) {
                LAS const unsigned char* kb = lds + cur * KBUF; LAS const unsigned char* vb = lds + 2 * KBUF + cur * VBUF;
                f32x16 s0, s1;
#pragma unroll
                for (int r = 0; r < 16; ++r) { s0[r] = 0.f; s1[r] = 0.f; }
#pragma unroll
                for (int ks = 0; ks < 6; ++ks) {
                    const bf16x8 a0 = *(LAS const bf16x8*)(kb + i32 * KP + (16 * ks + 8 * hi) * 2), a1 = *(LAS const bf16x8*)(kb + (32 + i32) * KP + (16 * ks + 8 * hi) * 2);
                    s0 = __builtin_amdgcn_mfma_f32_32x32x16_bf16(a0, qr[ks], s0, 0, 0, 0); s1 = __builtin_amdgcn_mfma_f32_32x32x16_bf16(a1, qr[ks], s1, 0, 0, 0);
                }
                float mx = fmaxf(s0[0], s1[0]);
#pragma unroll
                for (int r = 1; r < 16; ++r) mx = fmaxf(mx, fmaxf(s0[r], s1[r]));
                mx = fmaxf(mx, __shfl_xor(mx, 32));
                const float mn = fmaxf(mrun, mx), alpha = fexp2(mrun - mn); mrun = mn;
                float rs = 0.f;
#pragma unroll
                for (int r = 0; r < 16; ++r) { s0[r] = fexp2(s0[r] - mn); s1[r] = fexp2(s1[r] - mn); rs += s0[r] + s1[r]; }
                lrun = lrun * alpha + rs;
#pragma unroll
                for (int r = 0; r < 16; ++r) { o0[r] *= alpha; o1[r] *= alpha; }
                bf16x8 pf[2][2];
#pragma unroll
                for (int uu = 0; uu < 2; ++uu) {
                    u32x4 w0, w1;
                    w0.x = cvt_pk_bf16(s0[8 * uu + 0], s0[8 * uu + 1]); w0.y = cvt_pk_bf16(s0[8 * uu + 2], s0[8 * uu + 3]); w0.z = cvt_pk_bf16(s0[8 * uu + 4], s0[8 * uu + 5]); w0.w = cvt_pk_bf16(s0[8 * uu + 6], s0[8 * uu + 7]);
                    w1.x = cvt_pk_bf16(s1[8 * uu + 0], s1[8 * uu + 1]); w1.y = cvt_pk_bf16(s1[8 * uu + 2], s1[8 * uu + 3]); w1.z = cvt_pk_bf16(s1[8 * uu + 4], s1[8 * uu + 5]); w1.w = cvt_pk_bf16(s1[8 * uu + 6], s1[8 * uu + 7]);
                    pf[0][uu] = __builtin_bit_cast(bf16x8, w0); pf[1][uu] = __builtin_bit_cast(bf16x8, w1);
                }
#pragma unroll
                for (int tt = 0; tt < 2; ++tt)
#pragma unroll
                    for (int uu = 0; uu < 2; ++uu) {
                        LAS const unsigned char* vp0 = vb + i32 * VP + (32 * tt + 16 * uu + 4 * hi) * 2; LAS const unsigned char* vp1 = vp0 + 32 * VP;
                        const u32x2 a = *(LAS const u32x2*)vp0, bq = *(LAS const u32x2*)(vp0 + 16), c = *(LAS const u32x2*)vp1, d = *(LAS const u32x2*)(vp1 + 16);
                        const bf16x8 vf0 = __builtin_bit_cast(bf16x8, ((u32x4){a.x, a.y, bq.x, bq.y})), vf1 = __builtin_bit_cast(bf16x8, ((u32x4){c.x, c.y, d.x, d.y}));
                        o0 = __builtin_amdgcn_mfma_f32_32x32x16_bf16(vf0, pf[tt][uu], o0, 0, 0, 0); o1 = __builtin_amdgcn_mfma_f32_32x32x16_bf16(vf1, pf[tt][uu], o1, 0, 0, 0);
                    }
            }
            if (more) { const int nb = cur ^ 1; *(LAS u32x4*)(lds + nb * KBUF + kdst) = rk; if (tid < 256) *(LAS u32x4*)(lds + nb * KBUF + krdst) = rr; *(LAS u32x4*)(lds + nb * VBUF + vdst) = rv; }
            __syncthreads();
        }
        lrun += __shfl_xor(lrun, 32); const float inv = frcp(lrun);
        bf16_t* op = Z + (rowb + q0 + 32 * wid + i32) * ZLD + ZC_XA + h * 64 + 4 * hi;
#pragma unroll
        for (int rg = 0; rg < 4; ++rg) {
            u32x2 w; w.x = cvt_pk_bf16(o0[4 * rg] * inv, o0[4 * rg + 1] * inv); w.y = cvt_pk_bf16(o0[4 * rg + 2] * inv, o0[4 * rg + 3] * inv); *(u32x2*)(op + 8 * rg) = w;
            w.x = cvt_pk_bf16(o1[4 * rg] * inv, o1[4 * rg + 1] * inv); w.y = cvt_pk_bf16(o1[4 * rg + 2] * inv, o1[4 * rg + 3] * inv); *(u32x2*)(op + 32 + 8 * rg) = w;
        }
    }
}
__device__ __forceinline__ void sgu_units(LAS unsigned char* lds, const bf16_t* VTS, const float* MEANV, const float* RSTDV, const float* lng, const float* lnb, const bf16_t* WS, const float* bs, bf16_t* Z, int G, int blk) {
    const int tid = pg8::tid_opaque(), lane = tid & 63, wid = __builtin_amdgcn_readfirstlane(tid >> 6), i32 = lane & 31, hi = lane >> 5;
    constexpr int AP = 272;
    for (int idx = blk; idx < 1024; idx += G) {
        const int tb = idx >> 3, g = idx & 7, tok0 = tb * 128, tt = wid & 3;
        u32x4 xv[4]; f32x4 m0[4], m1[4], r0[4], r1[4]; float ga[4], be[4];
#pragma unroll
        for (int jj = 0; jj < 4; ++jj) {
            const int id = tid + 512 * jj, c = id >> 4, sc = id & 15; xv[jj] = *(const u32x4*)(VTS + (size_t)(g * 128 + c) * TC + tok0 + 8 * sc);
            m0[jj] = *(const f32x4*)(MEANV + tok0 + 8 * sc); m1[jj] = *(const f32x4*)(MEANV + tok0 + 8 * sc + 4); r0[jj] = *(const f32x4*)(RSTDV + tok0 + 8 * sc); r1[jj] = *(const f32x4*)(RSTDV + tok0 + 8 * sc + 4);
            ga[jj] = lng[g * 128 + c]; be[jj] = lnb[g * 128 + c];
        }
        bf16x8 wf[8];
        { const bf16_t* wp = WS + (size_t)(g * 128 + 32 * tt + i32) * 128 + 8 * hi;
#pragma unroll
          for (int ks = 0; ks < 8; ++ks) wf[ks] = *(const bf16x8*)(wp + 16 * ks); }
        const float bsv = bs[g * 128 + 32 * tt + i32];
        bf16_t* up0 = Z + (size_t)(tok0 + 32 * tt + i32) * ZLD + ZC_U + g * 128 + 64 * (wid >> 2) + 4 * hi;
        u32x2 uv[2][4];
#pragma unroll
        for (int cc = 0; cc < 2; ++cc)
#pragma unroll
            for (int rg = 0; rg < 4; ++rg) uv[cc][rg] = *(const u32x2*)(up0 + 32 * cc + 8 * rg);
#pragma unroll
        for (int jj = 0; jj < 4; ++jj) {
            const int id = tid + 512 * jj, c = id >> 4, sc = id & 15; f32x4 x0, x1; unpack8(xv[jj], x0, x1);
            x0 = (x0 - m0[jj]) * r0[jj] * ga[jj] + be[jj]; x1 = (x1 - m1[jj]) * r1[jj] * ga[jj] + be[jj];
            *(LAS u32x4*)(lds + c * AP + sc * 16) = pack8(x0, x1);
        }
        __syncthreads();
#pragma unroll
        for (int cc = 0; cc < 2; ++cc) {
            const int ct = 2 * (wid >> 2) + cc; f32x16 acc;
#pragma unroll
            for (int r = 0; r < 16; ++r) acc[r] = 0.f;
#pragma unroll
            for (int ks = 0; ks < 8; ++ks) { const bf16x8 a = *(LAS const bf16x8*)(lds + (32 * ct + i32) * AP + (16 * ks + 8 * hi) * 2); acc = __builtin_amdgcn_mfma_f32_32x32x16_bf16(a, wf[ks], acc, 0, 0, 0); }
#pragma unroll
            for (int rg = 0; rg < 4; ++rg) { const u32x2 u2 = uv[cc][rg]; u32x2 w;
                w.x = cvt_pk_bf16((acc[4 * rg] + bsv) * bflo(u2.x), (acc[4 * rg + 1] + bsv) * bfhi(u2.x)); w.y = cvt_pk_bf16((acc[4 * rg + 2] + bsv) * bflo(u2.y), (acc[4 * rg + 3] + bsv) * bfhi(u2.y)); *(u32x2*)(up0 + 32 * cc + 8 * rg) = w; }
        }
        __syncthreads();
    }
}

#ifndef DBG_DUMP
#define DBG_DUMP 0
#define DBG_CH 0
#define DBG_TWICE 0
#define DBG_SKIP56 0
#endif
__device__ __forceinline__ void dbg_add(float* out, const bf16_t* buf, size_t n, bool first, int G, int blk) {
    const size_t gt = (size_t)blk * 512 + pg8::tid_opaque(), NGT = (size_t)G * 512;
    for (size_t i = gt; i < (size_t)T * DM; i += NGT) { float v = 0.f; for (size_t j = i; j < n; j += (size_t)T * DM) v += __uint_as_float((unsigned)buf[j] << 16); out[i] = first ? v : out[i] + v; }
}
__device__ __forceinline__ void dbg_addf(float* out, const float* buf, size_t n, int G, int blk) {
    const size_t gt = (size_t)blk * 512 + pg8::tid_opaque(), NGT = (size_t)G * 512;
    for (size_t i = gt; i < (size_t)T * DM; i += NGT) out[i] += buf[i % n];
}
#define APS 0
#define RUN_GEMM(EPI, e, Ap, Bp, M_, N_, K_, lda_, ldb_, apn_) do { int K__ = (K_), blk__ = blk; asm volatile("" : "+s"(K__), "+s"(blk__)); pg8::Gemm gg{(Ap), (Bp), (M_), (N_), K__, (lda_), (ldb_), (apn_), APS}; pg8::StaticOrder SO; SO.init((M_), (N_), G, blk__); \
    pg8::gemm_phase<decltype(e), pg8::StaticOrder, true, true>(lds, gg, SO, e); } while (0)

constexpr size_t SM_BAR = 1024 * 1024;
#define XB_TMO      128
#define XB_XCNT(j)  (256  + 64 * (j))
#define XB_XSUB(j)  (1280 + 64 * (j))
#define XB_XGEN(j)  (2304 + 64 * (j))
#define XB_TOP      3328
#define XB_TOPGEN   3392
#define XCD_BAR_WORDS 3456
#define XB_SPIN_CAP (1u << 18)

__device__ __forceinline__ unsigned xb_ld(unsigned* p)              { return __hip_atomic_load(p, __ATOMIC_RELAXED, __HIP_MEMORY_SCOPE_AGENT); }
__device__ __forceinline__ unsigned xb_add(unsigned* p, unsigned v) { return __hip_atomic_fetch_add(p, v, __ATOMIC_RELAXED, __HIP_MEMORY_SCOPE_AGENT); }
__device__ __forceinline__ unsigned xb_xcc_id() { return (unsigned)__builtin_amdgcn_s_getreg((3 << 11) | 20) & 0xFu; }
#define XB_SPIN(cond, bar) do { unsigned _sp = 0; while (cond) { __builtin_amdgcn_s_sleep(1); \
    if ((++_sp & 255u) == 0u) { if (xb_ld(&(bar)[XB_TMO])) break; if (_sp > XB_SPIN_CAP) { atomicAdd(&(bar)[XB_TMO], 1u); break; } } } } while (0)

struct XcdBarrier {
    unsigned* bar; unsigned x;
    volatile __attribute__((address_space(3))) unsigned* st;
};

__device__ __forceinline__ XcdBarrier xcd_barrier_post(unsigned* bar, volatile __attribute__((address_space(3))) unsigned* st) {
    XcdBarrier b; b.bar = bar; b.x = xb_xcc_id(); b.st = st;
    if (threadIdx.x == 0) (void)xb_add(&bar[XB_XCNT(b.x)], 1u);
    return b;
}
__device__ __forceinline__ void xcd_barrier_complete(unsigned* bar, unsigned x, unsigned& nloc, unsigned& nx) {
    const unsigned G = gridDim.x * gridDim.y * gridDim.z;
    unsigned sum, cnt, mine, sp = 0u;
    for (;;) {
        sum = 0u; cnt = 0u; mine = 0u;
#pragma unroll
        for (unsigned j = 0; j < 16; ++j) { const unsigned c = xb_ld(&bar[XB_XCNT(j)]); sum += c; cnt += (c > 0u) ? 1u : 0u; mine = (j == x) ? c : mine; }
        if (sum == G) break;
        __builtin_amdgcn_s_sleep(1);
        if ((++sp & 255u) == 0u) { if (xb_ld(&bar[XB_TMO])) break; if (sp > XB_SPIN_CAP) { atomicAdd(&bar[XB_TMO], 1u); break; } }
    }
    nloc = mine > 0u ? mine : 1u; nx = cnt > 0u ? cnt : 1u;
}

__device__ __forceinline__ void xcd_barrier(const XcdBarrier& b) {
    asm volatile("s_waitcnt vmcnt(0)" ::: "memory");
    __syncthreads();
    if (threadIdx.x == 0) {
        unsigned* bar = b.bar;
        __builtin_amdgcn_s_waitcnt(0);
        unsigned nloc = b.st[0], nx = b.st[1];
        if (nloc == 0u) { xcd_barrier_complete(bar, b.x, nloc, nx); b.st[0] = nloc; b.st[1] = nx; }
        const unsigned old = xb_add(&bar[XB_XSUB(b.x)], 1u);
        const unsigned gen = old / nloc;
        if (old + 1u == (gen + 1u) * nloc) {
            __builtin_amdgcn_fence(__ATOMIC_RELEASE, "agent");
            asm volatile("s_waitcnt vmcnt(0)" ::: "memory");
            const unsigned og = xb_add(&bar[XB_TOP], 1u);
            const unsigned tg = og / nx;
            if (og + 1u == (tg + 1u) * nx) xb_add(&bar[XB_TOPGEN], 1u);
            else XB_SPIN(xb_ld(&bar[XB_TOPGEN]) == tg, bar);
            __builtin_amdgcn_fence(__ATOMIC_ACQUIRE, "agent");
            xb_add(&bar[XB_XGEN(b.x)], 1u);
            asm volatile("s_waitcnt vmcnt(0)" ::: "memory");
        } else {
            XB_SPIN(xb_ld(&bar[XB_XGEN(b.x)]) == gen, bar);
            __builtin_amdgcn_fence(__ATOMIC_ACQUIRE, "agent");
            asm volatile("s_waitcnt vmcnt(0)" ::: "memory");
        }
    }
    __syncthreads();
}
#define GRID_SYNC() xcd_barrier(xbar)

#define DBG_DUMP_BODY(st) do { \
    dbg_add(X, G3, (size_t)TC * 3072, true, G, blk); } while (0)
__global__ void __launch_bounds__(512, 2) fwd_kernel(Params p) {
    extern __shared__ __attribute__((aligned(16))) unsigned char lds_raw[];
    LAS unsigned char* lds = (LAS unsigned char*)lds_raw;
    cg::grid_group grid = cg::this_grid();
    const int G = gridDim.x, blk = blockIdx.x;
    unsigned char* ws = p.ws;
    { volatile LAS unsigned* st0 = (volatile LAS unsigned*)(lds + 131072); if (threadIdx.x < 64) st0[threadIdx.x] = 0u; }
    __syncthreads();
    const XcdBarrier xbar = xcd_barrier_post((unsigned*)(ws + WS_SMALL + SM_BAR), (volatile LAS unsigned*)(lds + 131072));
    grid.sync();
    bf16_t* wb = (bf16_t*)(ws + WS_W); bf16_t* XB = (bf16_t*)(ws + WS_XB); float* SSQ = (float*)(ws + WS_SSQ); float* X = p.out;
    bf16_t* XBn = (bf16_t*)p.out; float* SSQn = (float*)(ws + WS_BIG + B_SSQ2);
    float* ROPE = (float*)(ws + WS_SMALL + SM_ROPE); float* RSQ = (float*)(ws + WS_SMALL + SM_RSQ); float* RSKV = (float*)(ws + WS_SMALL + SM_RSKV);
    float* MEANV = (float*)(ws + WS_SMALL + SM_MEANV); float* RSTDV = (float*)(ws + WS_SMALL + SM_RSTDV); float* SP8 = (float*)(ws + WS_SMALL + SM_SP8);
    unsigned char* big = ws + WS_BIG;
    bf16_t* H = (bf16_t*)(big + B_H); bf16_t* PB = (bf16_t*)(big + B_PB); bf16_t* GP = (bf16_t*)(big + B_GP);
    bf16_t* Z = (bf16_t*)(big + B_Z); bf16_t* VTS = (bf16_t*)(big + B_VTS); bf16_t* XC = (bf16_t*)(big + B_XC); bf16_t* LA = (bf16_t*)(big + B_LA); bf16_t* U = (bf16_t*)(big + B_U);
    bf16_t* Q = (bf16_t*)(big + B_Q); bf16_t* KN = (bf16_t*)(big + B_KN); bf16_t* VT = (bf16_t*)(big + B_VT); bf16_t* KR = (bf16_t*)(big + B_KR);
    bf16_t* G3 = (bf16_t*)(big + B_G3); bf16_t* MG = (bf16_t*)(big + B_MERGED);

#pragma unroll 1
    for (int L = 0; L < 2; ++L) {
        phase0(p, L, lds, G, blk);
        GRID_SYNC();
        { EpiSwiglu e{H, SSQ}; RUN_GEMM(EpiSwiglu, e, XB, wb + O_WGU1, T, 2 * DFF, 1024, 1024, 1024, 0); }
        GRID_SYNC();
        { EpiResid<false> e{L == 0 ? p.in[0] : nullptr, XB, SSQ, nullptr, 0.5f}; RUN_GEMM(EpiResid<false>, e, H, wb + O_WD1, T, 1024, DFF, DFF, DFF, 0); }
        GRID_SYNC();
#pragma unroll 1
        for (int c = 0; c <= 2; ++c) {
            if (c >= 1) { const size_t q0 = (size_t)(c - 1) * TC;
                EpiResid<false> e{nullptr, XB + q0 * DM, SSQ + q0 * 4, nullptr, 1.0f}; RUN_GEMM(EpiResid<false>, e, MG, wb + O_WOUT, TC, 1024, 1024, 1024, 1024, 0); }
            const size_t r0 = (size_t)c * TC;
            if (c <= 1) {
                { EpiRow<1, 0> e{Z, ZLD, SSQ + r0 * 4, nullptr, 4, 12, 0}; RUN_GEMM((EpiRow<1, 0>), e, XB + r0 * DM, wb + O_WIN, TC, ZLD, 1024, 1024, 1024, 0); }
                { EpiCol<1, 0> e{VTS, TC, SSQ + r0 * 4}; RUN_GEMM((EpiCol<1, 0>), e, wb + O_WINV, XB + r0 * DM, 1024, TC, 1024, 1024, 1024, 0); }
            }
            GRID_SYNC();
            if (c > 1) break;
            e1_rows(p, L, Z, XC, RSQ, RSKV, KR, ROPE, G, blk);
            e2_stats(lds, VTS, MEANV, RSTDV, G, blk);
            GRID_SYNC();
            { EpiLru e{XC, LA, U, p.in[10] + L * 1024, p.in[12] + L * 1024, SP8}; RUN_GEMM(EpiLru, e, XC, wb + O_WLRU, TC, 2048, 128, 1024, 128, 128); }
            { EpiQ e{Q, RSQ, ROPE}; RUN_GEMM(EpiQ, e, Z + ZC_CQ, wb + O_WUQ, TC, 1536, 384, ZLD, 384, 0); }
            { EpiRow<0, 1> e{KN, 1024, RSKV, nullptr, 0, 0, 0}; RUN_GEMM((EpiRow<0, 1>), e, Z + ZC_CKV, wb + O_WKVK, TC, 1024, 256, ZLD, 256, 0); }
            { EpiCol<0, 1> e{VT, TC, RSKV}; RUN_GEMM((EpiCol<0, 1>), e, wb + O_WKVV, Z + ZC_CKV, 1024, TC, 256, 256, ZLD, 0); }
            GRID_SYNC();
            scan_units(lds, LA, U, Z, G, blk);
            attn_units(lds, Q, KN, KR, VT, Z, G, blk);
            sgu_units(lds, VTS, MEANV, RSTDV, p.in[20] + L * 1024, p.in[21] + L * 1024, wb + O_WSGU, p.in[23] + L * 1024, Z, G, blk);
            GRID_SYNC();
            { EpiRow<2, 0> e{G3, 3072, SSQ + r0 * 4, p.in[25] + L * 3072, 0, 0, 1}; RUN_GEMM((EpiRow<2, 0>), e, XB + r0 * DM, wb + O_WING, TC, 3072, 1024, 1024, 1024, 0); }
#undef APS
#define APS 2
            { EpiMerge e{G3, MG}; RUN_GEMM(EpiMerge, e, Z, wb + O_WRA, TC, 3072, 1024, ZLD, 1024, 1024); }
#undef APS
#define APS 0
            GRID_SYNC();
        }
        { EpiSwiglu e{H, SSQ}; RUN_GEMM(EpiSwiglu, e, XB, wb + O_WGU2, T, 2 * DFF, 1024, 1024, 1024, 0); }
        { EpiRow<0, 2> e{GP, 1024, nullptr, nullptr, 0, 0, 0}; RUN_GEMM((EpiRow<0, 2>), e, PB, wb + O_WPLE, T, 1024, 256, 256, 256, 0); }
        GRID_SYNC();
        { EpiResid<false> e{nullptr, XB, SSQ, nullptr, 0.5f}; RUN_GEMM(EpiResid<false>, e, H, wb + O_WD2, T, 1024, DFF, DFF, DFF, 0); }
        GRID_SYNC();
        { EpiPle e{XB, XBn, GP, SSQ, SSQn}; RUN_GEMM(EpiPle, e, XB, wb + O_WPG, T, 1024, 1024, 1024, 1024, 0); }
        GRID_SYNC();
        { bf16_t* tx = XB; XB = XBn; XBn = tx; float* ts = SSQ; SSQ = SSQn; SSQn = ts; }
    }
    {
        const int tid = pg8::tid_opaque(), lane = tid & 63, wave = tid >> 6, gw = blk * 8 + wave, NGW = G * 8; const float* fn = p.in[33];
        for (int m = gw; m < T; m += NGW) {
            const u32x4* xr = (const u32x4*)(XB + (size_t)m * DM) + lane; f32x4* orow = (f32x4*)(X + (size_t)m * DM); f32x4 v[4]; float s = 0.f;
#pragma unroll
            for (int j = 0; j < 2; ++j) { unpack8(xr[64 * j], v[2 * j], v[2 * j + 1]); }
#pragma unroll
            for (int j = 0; j < 4; ++j) s += (v[j][0] * v[j][0] + v[j][1] * v[j][1]) + (v[j][2] * v[j][2] + v[j][3] * v[j][3]);
            const float rstd = __builtin_amdgcn_rsqf(wave_sum(s) * (1.f / 1024.f) + EPS);
#pragma unroll
            for (int j = 0; j < 2; ++j) { const int c = 512 * j + 8 * lane; orow[c / 4] = v[2 * j] * rstd * *(const f32x4*)(fn + c); orow[c / 4 + 1] = v[2 * j + 1] * rstd * *(const f32x4*)(fn + c + 4); }
        }
    }
}

extern "C" void kernel_launch(void* const* d_in, const int* in_sizes, int n_in, void* d_out, int out_size, void* d_ws, size_t ws_size, hipStream_t stream) {
    static int grid = 0;
    if (grid == 0) {
        if (n_in != 34 || ws_size < WS_NEED) { fprintf(stderr, "kernel_launch: unexpected n_in %d / ws_size %zu (need %zu)\n", n_in, ws_size, (size_t)WS_NEED); grid = -1; return; }
        int dev = 0, cus = 0, per = 0;
        (void)hipGetDevice(&dev); (void)hipDeviceGetAttribute(&cus, hipDeviceAttributeMultiprocessorCount, dev);
        (void)hipFuncSetAttribute((const void*)fwd_kernel, hipFuncAttributeMaxDynamicSharedMemorySize, LDS_BYTES);
        if (hipOccupancyMaxActiveBlocksPerMultiprocessor(&per, (const void*)fwd_kernel, 512, LDS_BYTES) != hipSuccess || per < 1) per = 1;
        (void)hipGetLastError();
        grid = cus * per;
    }
    if (grid < 0) return;
    (void)hipMemsetAsync((unsigned char*)d_ws + WS_SMALL + SM_BAR, 0, 16384, stream);
    Params prm{};
    for (int i = 0; i < 34; ++i) prm.in[i] = (const float*)d_in[i];
    prm.out = (float*)d_out; prm.ws = (unsigned char*)d_ws;
    void* args[] = {&prm};
    hipError_t e = hipLaunchCooperativeKernel((const void*)fwd_kernel, dim3(grid), dim3(512), args, LDS_BYTES, stream);
    if (e != hipSuccess) fprintf(stderr, "cooperative launch failed: %s (grid %d)\n", hipGetErrorString(e), grid);
}
```

```cpp
#include <hip/hip_runtime.h>
#include <hip/hip_cooperative_groups.h>
#include <cstdio>
#include <cstdint>
namespace cg = cooperative_groups;
namespace pg8 {
#define PG8_LAS __attribute__((address_space(3)))
typedef unsigned short bf16_t;
typedef short bf16x8 __attribute__((ext_vector_type(8)));
typedef float f32x4 __attribute__((ext_vector_type(4)));
typedef unsigned u32x4 __attribute__((ext_vector_type(4)));
typedef unsigned u32x2 __attribute__((ext_vector_type(2)));
constexpr int BM = 256, BK = 64, HALF = 128, HTB = HALF * BK * 2  , STAGE_BYTES = 8 * HTB, NXCD = 8, WGM = 8;

__host__ __device__ __forceinline__ int lds_byte(int r, int c) { const int st = (r >> 4) * 2 + (c >> 5), rr = r & 15, cc = c & 31, ob = rr * 64 + cc * 2; return st * 1024 + (ob ^ (((ob >> 9) & 1) << 5)); }
__host__ __device__ __forceinline__ void stage_rc(int b, int& R, int& C) { const int st = b / 1024, sb = b % 1024, swz = sb ^ (((sb >> 9) & 1) << 5); R = (st >> 1) * 16 + swz / 64; C = (st & 1) * 32 + (swz % 64) / 2; }
__host__ __device__ __forceinline__ int perm32(int rho) { const int n = rho >> 4, i = rho & 15; return 8 * (i >> 2) + 4 * n + (i & 3); }

struct Unit { int pm, pn; };
struct Gemm { const bf16_t* A; const bf16_t* Bt; int M, N, K, lda, ldb, apn, aps; };

struct StaticOrder {
    int nM, nN, nwg, G, c;
    __host__ __device__ void init(int M, int N, int G_, int c_) { nM = M / BM; nN = N / BM; nwg = nM * nN; G = G_; c = c_; }
    __host__ __device__ bool next(int i, Unit& u) const {
        const long L = (long)i * G + c; if (L >= nwg) return false;
        int wgid = (int)L; { const int q = nwg / NXCD, r = nwg % NXCD, xcd = wgid % NXCD, off = wgid / NXCD; wgid = (xcd < r ? xcd * (q + 1) : r * (q + 1) + (xcd - r) * q) + off; }
        const int nig = WGM * nN, gid = wgid / nig, fm = gid * WGM, gsz = (nM - fm) < WGM ? (nM - fm) : WGM;
        u.pm = fm + ((wgid % nig) % gsz); u.pn = (wgid % nig) / gsz; return true;
    }
    __device__ __forceinline__ void a_ready(const Unit&) const {}
    __device__ __forceinline__ void done(const Unit&) const {}
};
__device__ __forceinline__ int tid_opaque() { int t = threadIdx.x; asm volatile("" : "+v"(t)); return t; }
typedef float f32x2_t __attribute__((ext_vector_type(2))); typedef __bf16 bf16x2_t __attribute__((ext_vector_type(2)));
__device__ __forceinline__ unsigned cvt_pk_bf16(float lo, float hi) { const f32x2_t v = {lo, hi}; const bf16x2_t b = __builtin_convertvector(v, bf16x2_t); return __builtin_bit_cast(unsigned, b); }

template <class Epi, class Sched, bool ALIGN_EPI = false, bool SP2 = false>
__device__ __forceinline__ void gemm_phase(PG8_LAS unsigned char* lds, const Gemm g, const Sched& S, const Epi& E) {
    const int tid = pg8::tid_opaque(), wid = __builtin_amdgcn_readfirstlane(tid >> 6), lane = tid & 63, wr = wid >> 2, wc = wid & 3, fr = lane & 15, fq = lane >> 4;
    const int K = g.K, nt = K / BK;
    unsigned voffA[2], voffB[2];
#pragma unroll
    for (int i = 0; i < 2; ++i) { int R, C; stage_rc(tid * 16 + i * 8192, R, C); const int Rb = Epi::PERM ? ((R & ~31) + perm32(R & 31)) : R;
        voffA[i] = (unsigned)(R * g.lda + C) * 2u; voffB[i] = (unsigned)(Rb * g.ldb + C) * 2u; }
    const size_t kstep = (size_t)(BK * 2);
    const size_t hstepA = (size_t)HALF * g.lda * 2, hstepB = (size_t)HALF * g.ldb * 2;
    const size_t tstepA = 2 * hstepA, tstepB = 2 * hstepB; const size_t apn = (size_t)g.apn * 2;
    const unsigned ldsw = (unsigned)wid * 1024u;
    const int aoff = lds_byte(wr * 64 + fr, fq * 8), boff = lds_byte(wc * 32 + fr, fq * 8);
#define PG8_SA(b, h) (((b) * 2 + (h)) * HTB)
#define PG8_SB(b, h) ((4 + (b) * 2 + (h)) * HTB)
#define PG8_STAGE(bufoff, gbase, voff) do { _Pragma("unroll") for (int _i = 0; _i < 2; ++_i) \
        __builtin_amdgcn_global_load_lds((const unsigned*)((const char*)(gbase) + (voff)[_i]), (PG8_LAS unsigned*)(lds + (bufoff) + ldsw + _i * 8192), 16, 0, 0); } while (0)
#define PG8_LDA(dst, b, h) do { _Pragma("unroll") for (int m = 0; m < 4; ++m) _Pragma("unroll") for (int k = 0; k < 2; ++k) dst[m][k] = *(const PG8_LAS bf16x8*)(lds + PG8_SA(b, h) + aoff + m * 2048 + k * 1024); } while (0)
#define PG8_LDB(dst, b, h) do { _Pragma("unroll") for (int n = 0; n < 2; ++n) _Pragma("unroll") for (int k = 0; k < 2; ++k) dst[n][k] = *(const PG8_LAS bf16x8*)(lds + PG8_SB(b, h) + boff + n * 2048 + k * 1024); } while (0)
#define PG8_MMA(ai, bj, At, Bt) do { __builtin_amdgcn_s_setprio(1); _Pragma("unroll") for (int m = 0; m < 4; ++m) _Pragma("unroll") for (int n = 0; n < 2; ++n) _Pragma("unroll") for (int k = 0; k < 2; ++k) \
        acc[ai][bj][m][n] = __builtin_amdgcn_mfma_f32_16x16x32_bf16(Bt[n][k], At[m][k], acc[ai][bj][m][n], 0, 0, 0); __builtin_amdgcn_s_setprio(0); } while (0)
#define PG8_WAIT_V(n) asm volatile("s_waitcnt vmcnt(" #n ")" ::: "memory")
#define PG8_WAIT_L(n) asm volatile("s_waitcnt lgkmcnt(" #n ")" ::: "memory")
#define PG8_BAR __builtin_amdgcn_s_barrier()
#define PG8_SCHED __builtin_amdgcn_sched_barrier(0)
    Unit cur, nxt; int ui = 0;
    if (!S.next(0, cur)) return;
    f32x4 acc[2][2][4][2];
#pragma unroll
    for (int a = 0; a < 2; ++a)
#pragma unroll
        for (int b = 0; b < 2; ++b)
#pragma unroll
            for (int m = 0; m < 4; ++m)
#pragma unroll
                for (int n = 0; n < 2; ++n) acc[a][b][m][n] = (f32x4){0.f, 0.f, 0.f, 0.f};
    bf16x8 At[4][2], B0[2][2], B1[2][2];
    const char* cA = (const char*)g.A + (size_t)cur.pm * tstepA + (size_t)(cur.pn >> g.aps) * apn; const char* cB = (const char*)g.Bt + (size_t)cur.pn * tstepB;
    S.a_ready(cur);
    if constexpr (SP2) {
        PG8_STAGE(PG8_SB(0, 0), cB, voffB); PG8_STAGE(PG8_SB(0, 1), cB + hstepB, voffB); PG8_STAGE(PG8_SA(0, 0), cA, voffA); PG8_STAGE(PG8_SA(0, 1), cA + hstepA, voffA);
        if (wr == 1) PG8_BAR;
        PG8_WAIT_V(2); PG8_BAR;
        PG8_STAGE(PG8_SB(1, 0), cB + kstep, voffB); PG8_STAGE(PG8_SA(1, 0), cA + kstep, voffA); PG8_STAGE(PG8_SB(1, 1), cB + hstepB + kstep, voffB);
        PG8_WAIT_V(6); PG8_BAR;
    } else {
        PG8_STAGE(PG8_SB(0, 0), cB, voffB); PG8_STAGE(PG8_SA(0, 0), cA, voffA); PG8_STAGE(PG8_SB(0, 1), cB + hstepB, voffB); PG8_STAGE(PG8_SA(0, 1), cA + hstepA, voffA);
        if (wr == 1) PG8_BAR;
        PG8_WAIT_V(4); PG8_BAR;
        PG8_STAGE(PG8_SB(1, 0), cB + kstep, voffB); PG8_STAGE(PG8_SA(1, 0), cA + kstep, voffA); PG8_STAGE(PG8_SB(1, 1), cB + hstepB + kstep, voffB);
        PG8_WAIT_V(6); PG8_BAR;
    }
    for (;;) {
        const bool has_next = S.next(ui + 1, nxt);
        const char* nA = has_next ? (const char*)g.A + (size_t)nxt.pm * tstepA + (size_t)(nxt.pn >> g.aps) * apn : cA; const char* nB = has_next ? (const char*)g.Bt + (size_t)nxt.pn * tstepB : cB;
        for (int t = 0; t < nt; t += 2) {
            const bool last = (t == nt - 2);
            const char* a1 = cA + (size_t)(t + 1) * kstep;
            const char* a2 = last ? nA : cA + (size_t)(t + 2) * kstep; const char* b2 = last ? nB : cB + (size_t)(t + 2) * kstep;
            const char* a3 = a2 + kstep; const char* b3 = b2 + kstep;
            if (last && has_next) S.a_ready(nxt);
            if constexpr (SP2) {
            PG8_LDB(B0, 0, 0); PG8_LDB(B1, 0, 1); PG8_SCHED; PG8_LDA(At, 0, 0); PG8_STAGE(PG8_SA(1, 1), a1 + hstepA, voffA);
            PG8_WAIT_V(8); PG8_WAIT_L(0); PG8_BAR; PG8_MMA(0, 0, At, B0); PG8_MMA(0, 1, At, B1); PG8_BAR; PG8_SCHED;
            PG8_LDA(At, 0, 1); PG8_STAGE(PG8_SB(0, 0), b2, voffB); PG8_STAGE(PG8_SB(0, 1), b2 + hstepB, voffB); PG8_STAGE(PG8_SA(0, 0), a2, voffA);
            PG8_WAIT_V(8); PG8_WAIT_L(0); PG8_BAR; PG8_MMA(1, 0, At, B0); PG8_MMA(1, 1, At, B1); PG8_BAR; PG8_SCHED;
            PG8_LDB(B0, 1, 0); PG8_LDB(B1, 1, 1); PG8_SCHED; PG8_LDA(At, 1, 0); PG8_STAGE(PG8_SA(0, 1), a2 + hstepA, voffA);
            PG8_WAIT_V(8); PG8_WAIT_L(0); PG8_BAR; PG8_MMA(0, 0, At, B0); PG8_MMA(0, 1, At, B1); PG8_BAR; PG8_SCHED;
            PG8_LDA(At, 1, 1); PG8_STAGE(PG8_SB(1, 0), b3, voffB); PG8_STAGE(PG8_SB(1, 1), b3 + hstepB, voffB); PG8_STAGE(PG8_SA(1, 0), a3, voffA);
            PG8_WAIT_V(8); PG8_WAIT_L(0); PG8_BAR; PG8_MMA(1, 0, At, B0); PG8_MMA(1, 1, At, B1); PG8_BAR; PG8_SCHED;
            } else {
            PG8_LDB(B0, 0, 0); PG8_SCHED; PG8_LDA(At, 0, 0); PG8_STAGE(PG8_SA(1, 1), a1 + hstepA, voffA);
            PG8_WAIT_L(8); PG8_BAR; PG8_WAIT_L(0); PG8_MMA(0, 0, At, B0); PG8_BAR; PG8_SCHED;
            PG8_LDB(B1, 0, 1); PG8_STAGE(PG8_SB(0, 0), b2, voffB);
            PG8_BAR; PG8_WAIT_L(0); PG8_MMA(0, 1, At, B1); PG8_BAR;
            PG8_LDA(At, 0, 1); PG8_STAGE(PG8_SA(0, 0), a2, voffA);
            PG8_BAR; PG8_WAIT_L(0); PG8_MMA(1, 0, At, B0); PG8_BAR; PG8_SCHED;
            PG8_STAGE(PG8_SB(0, 1), b2 + hstepB, voffB);
            PG8_WAIT_V(6); PG8_BAR; PG8_MMA(1, 1, At, B1); PG8_BAR;
            PG8_LDB(B0, 1, 0); PG8_SCHED; PG8_LDA(At, 1, 0); PG8_STAGE(PG8_SA(0, 1), a2 + hstepA, voffA);
            PG8_WAIT_L(8); PG8_BAR; PG8_WAIT_L(0); PG8_MMA(0, 0, At, B0); PG8_BAR; PG8_SCHED;
            PG8_LDB(B1, 1, 1); PG8_STAGE(PG8_SB(1, 0), b3, voffB);
            PG8_BAR; PG8_WAIT_L(0); PG8_MMA(0, 1, At, B1); PG8_BAR;
            PG8_LDA(At, 1, 1); PG8_STAGE(PG8_SA(1, 0), a3, voffA);
            PG8_BAR; PG8_WAIT_L(0); PG8_MMA(1, 0, At, B0); PG8_BAR; PG8_SCHED;
            PG8_STAGE(PG8_SB(1, 1), b3 + hstepB, voffB);
            PG8_WAIT_V(6); PG8_BAR; PG8_MMA(1, 1, At, B1); PG8_BAR;
            }
        }
        if constexpr (ALIGN_EPI) { if (wr == 0) PG8_BAR; }
        if constexpr (!Epi::AFTER_DRAIN) { E(acc, cur, wr, wc, fr, fq); S.done(cur); }
        if (!has_next) break;
#pragma unroll
        for (int a = 0; a < 2; ++a)
#pragma unroll
            for (int b = 0; b < 2; ++b)
#pragma unroll
                for (int m = 0; m < 4; ++m)
#pragma unroll
                    for (int n = 0; n < 2; ++n) acc[a][b][m][n] = (f32x4){0.f, 0.f, 0.f, 0.f};
        cur = nxt; cA = nA; cB = nB; ++ui;
        if constexpr (ALIGN_EPI) { if (wr == 1) PG8_BAR; }
    }
    PG8_WAIT_V(0);
    if constexpr (!ALIGN_EPI) { if (wr == 0) PG8_BAR; }
    PG8_BAR;
    if constexpr (Epi::AFTER_DRAIN) { E.fused(acc, cur, wr, wc, fr, fq, lds, wid, lane); S.done(cur); }
#undef PG8_SA
#undef PG8_SB
#undef PG8_STAGE
#undef PG8_LDA
#undef PG8_LDB
#undef PG8_MMA
#undef PG8_WAIT_V
#undef PG8_WAIT_L
#undef PG8_BAR
#undef PG8_SCHED
}
}

using pg8::bf16_t; using pg8::bf16x8; using pg8::f32x4; using pg8::u32x4; using pg8::u32x2; using pg8::Unit; using pg8::cvt_pk_bf16;
typedef float f32x16 __attribute__((ext_vector_type(16)));
typedef float f32x2 __attribute__((ext_vector_type(2)));
#define LAS __attribute__((address_space(3)))

constexpr int T = 32768, DM = 1024, TC = 16384, DFF = 2816, ZLD = 3840;
constexpr int ZC_XA = 0, ZC_GA = 1024, ZC_U = 2048, ZC_CKV = 3072, ZC_CQ = 3328, ZC_KR = 3712;
constexpr float EPS = 1e-6f, LOG2E = 1.4426950408889634f;
constexpr float QSCALE = 0.10206207261596577f * 1.4426950408889634f;
constexpr size_t MiB = (size_t)1 << 20;
constexpr size_t WS_W = 0, WS_XB = 64 * MiB, WS_SSQ = 128 * MiB, WS_SMALL = 130 * MiB, WS_BIG = 132 * MiB;
constexpr size_t SM_ROPE = 0, SM_RSQ = 256 * 1024, SM_RSKV = 320 * 1024, SM_MEANV = 384 * 1024, SM_RSTDV = 448 * 1024, SM_SP8 = 512 * 1024;
constexpr size_t B_H = 0, B_PB = 361 * MiB, B_GP = 192 * MiB, B_SSQ2 = 377 * MiB;
constexpr size_t B_Z = 0, B_VTS = 120 * MiB, B_XC = 152 * MiB, B_LA = 184 * MiB, B_U = 216 * MiB, B_Q = 248 * MiB, B_KN = 296 * MiB, B_VT = 328 * MiB, B_KR = 360 * MiB;
constexpr size_t B_G3 = 248 * MiB, B_MERGED = 184 * MiB;
constexpr size_t WS_NEED = WS_BIG + 379 * MiB;
constexpr size_t O_WGU1 = 0, O_WD1 = O_WGU1 + 5632 * 1024, O_WIN = O_WD1 + 1024 * 2816, O_WINV = O_WIN + 3840 * 1024, O_WING = O_WINV + 1024 * 1024,
                 O_WLRU = O_WING + 3072 * 1024, O_WRA = O_WLRU + 2048 * 128, O_WRB = O_WRA + 1024 * 1024, O_WRC = O_WRB + 1024 * 1024, O_WOUT = O_WRC + 1024 * 1024,
                 O_WPG = O_WOUT + 1024 * 1024, O_WUQ = O_WPG + 1024 * 1024, O_WKVK = O_WUQ + 1536 * 384, O_WKVV = O_WKVK + 1024 * 256, O_WGU2 = O_WKVV + 1024 * 256,
                 O_WD2 = O_WGU2 + 5632 * 1024, O_WPLE = O_WD2 + 1024 * 2816, O_WSGU = O_WPLE + 1024 * 256, O_WEND = O_WSGU + 8 * 128 * 128;
static_assert(O_WEND * 2 <= 64 * MiB, "weights fit");
constexpr int LDS_BYTES = 131072 + 256;
#ifndef DBG_STOP
#define DBG_STOP 0
#endif
#ifndef DBG_BR
#define DBG_BR 7
#endif

struct Params { const float* in[34]; float* out; unsigned char* ws; };

__device__ __forceinline__ float fexp2(float x) { return __builtin_amdgcn_exp2f(x); }
__device__ __forceinline__ float frcp(float x) { return __builtin_amdgcn_rcpf(x); }
__device__ __forceinline__ float sigm(float x) { return frcp(1.f + fexp2(-LOG2E * x)); }
__device__ __forceinline__ float gelu_t(float x) { const float t = x + 0.044715f * x * x * x; return x * frcp(1.f + fexp2(-2.3022081985f * t)); }
__device__ __forceinline__ float bflo(unsigned w) { return __uint_as_float(w << 16); }
__device__ __forceinline__ float bfhi(unsigned w) { return __uint_as_float(w & 0xffff0000u); }
__device__ __forceinline__ bf16_t f2bf(float v) { return (bf16_t)(cvt_pk_bf16(v, 0.f) & 0xffffu); }
__device__ __forceinline__ float wave_sum(float v) {
#pragma unroll
    for (int o = 1; o < 64; o <<= 1) v += __shfl_xor(v, o);
    return v;
}
constexpr size_t SSQ_PLANE = (size_t)T * 4;
__device__ __forceinline__ float rstd16(const float* ssq, size_t row) {
    const float* q = ssq + row * 4; const f32x4 a = *(const f32x4*)q, b = *(const f32x4*)(q + SSQ_PLANE), c = *(const f32x4*)(q + 2 * SSQ_PLANE), d = *(const f32x4*)(q + 3 * SSQ_PLANE);
    const float s = ((a.x + a.y) + (a.z + a.w)) + ((b.x + b.y) + (b.z + b.w)) + ((c.x + c.y) + (c.z + c.w)) + ((d.x + d.y) + (d.z + d.w));
    return __builtin_amdgcn_rsqf(s * (1.0f / 1024.0f) + EPS);
}
__device__ __forceinline__ u32x4 pack8(const f32x4 v0, const f32x4 v1) { u32x4 w; w.x = cvt_pk_bf16(v0[0], v0[1]); w.y = cvt_pk_bf16(v0[2], v0[3]); w.z = cvt_pk_bf16(v1[0], v1[1]); w.w = cvt_pk_bf16(v1[2], v1[3]); return w; }
__device__ __forceinline__ void unpack8(const u32x4 w, f32x4& v0, f32x4& v1) { v0 = (f32x4){bflo(w.x), bfhi(w.x), bflo(w.y), bfhi(w.y)}; v1 = (f32x4){bflo(w.z), bfhi(w.z), bflo(w.w), bfhi(w.w)}; }

template <int ACT, int RS> struct EpiRow {
    static constexpr bool PERM = true, AFTER_DRAIN = false;
    bf16_t* O; int ldc; const float* rs; const float* bias; int t0, t1; int bswap;
    __device__ __forceinline__ void operator()(const f32x4 (&acc)[2][2][4][2], const Unit& u, int wr, int wc, int fr, int fq) const {
        const int row0 = u.pm * 256 + wr * 64 + fr, col0 = u.pn * 256 + wc * 32 + 8 * fq;
        const bool act = (ACT == 1) ? (u.pn >= t0 && u.pn < t1) : true;
        f32x4 bv[2][2];
#pragma unroll
        for (int bj = 0; bj < 2; ++bj)
#pragma unroll
            for (int n = 0; n < 2; ++n) bv[bj][n] = bias ? *(const f32x4*)(bias + col0 + (bswap ? (u.pn < 4 ? 1024 : (u.pn < 8 ? -1024 : 0)) : 0) + bj * 128 + 4 * n) : (f32x4){0.f, 0.f, 0.f, 0.f};
#pragma unroll
        for (int ai = 0; ai < 2; ++ai)
#pragma unroll
            for (int m = 0; m < 4; ++m) {
                const size_t row = (size_t)(row0 + ai * 128 + m * 16); const float s = (RS == 0) ? rstd16(rs, row) : (RS == 1 ? rs[row] : 1.f);
                bf16_t* rowp = O + row * ldc + col0;
#pragma unroll
                for (int bj = 0; bj < 2; ++bj) {
                    f32x4 v0 = acc[ai][bj][m][0] * s + bv[bj][0], v1 = acc[ai][bj][m][1] * s + bv[bj][1];
                    if (ACT == 1) { if (act) {
#pragma unroll
                        for (int e = 0; e < 4; ++e) { v0[e] = gelu_t(v0[e]); v1[e] = gelu_t(v1[e]); } } }
                    if (ACT == 2) {
#pragma unroll
                        for (int e = 0; e < 4; ++e) { v0[e] = sigm(v0[e]); v1[e] = sigm(v1[e]); } }
                    *(u32x4*)(rowp + bj * 128) = pack8(v0, v1);
                }
                asm volatile("" ::: "memory");
            }
    }
};
struct EpiSwiglu {
    static constexpr bool PERM = true, AFTER_DRAIN = false;
    bf16_t* H; const float* ssq;
    __device__ __forceinline__ void operator()(const f32x4 (&acc)[2][2][4][2], const Unit& u, int wr, int wc, int fr, int fq) const {
        const int row0 = u.pm * 256 + wr * 64 + fr, col0 = u.pn * 128 + wc * 32 + 8 * fq;
#pragma unroll
        for (int ai = 0; ai < 2; ++ai)
#pragma unroll
            for (int m = 0; m < 4; ++m) {
                const size_t row = (size_t)(row0 + ai * 128 + m * 16); const float s = rstd16(ssq, row);
                f32x4 h0, h1;
#pragma unroll
                for (int e = 0; e < 4; ++e) { const float g0 = acc[ai][0][m][0][e] * s, g1 = acc[ai][0][m][1][e] * s; h0[e] = g0 * sigm(g0) * (acc[ai][1][m][0][e] * s); h1[e] = g1 * sigm(g1) * (acc[ai][1][m][1][e] * s); }
                *(u32x4*)(H + row * DFF + col0) = pack8(h0, h1);
                asm volatile("" ::: "memory");
            }
    }
};
template <bool GATED> struct EpiResid {
    static constexpr bool PERM = true, AFTER_DRAIN = false;
    const float* X32; bf16_t* XB; float* ssq; const bf16_t* GP; float alpha;
    __device__ __forceinline__ void operator()(const f32x4 (&acc)[2][2][4][2], const Unit& u, int wr, int wc, int fr, int fq) const {
        const int row0 = u.pm * 256 + wr * 64 + fr, col0 = u.pn * 256 + wc * 32 + 8 * fq;
#pragma unroll
        for (int ai = 0; ai < 2; ++ai)
#pragma unroll
            for (int m = 0; m < 4; ++m) {
                const size_t row = (size_t)(row0 + ai * 128 + m * 16); float ss = 0.f;
#pragma unroll
                for (int bj = 0; bj < 2; ++bj) {
                    const size_t o = row * DM + col0 + bj * 128; f32x4 a0 = acc[ai][bj][m][0] * alpha, a1 = acc[ai][bj][m][1] * alpha;
                    if (GATED) { f32x4 g0, g1; unpack8(*(const u32x4*)(GP + o), g0, g1); a0 *= g0; a1 *= g1; }
                    f32x4 x0, x1;
                    if (X32) { x0 = *(const f32x4*)(X32 + o); x1 = *(const f32x4*)(X32 + o + 4); } else unpack8(*(const u32x4*)(XB + o), x0, x1);
                    x0 += a0; x1 += a1;
                    *(u32x4*)(XB + o) = pack8(x0, x1);
                    ss += (x0[0] * x0[0] + x0[1] * x0[1]) + (x0[2] * x0[2] + x0[3] * x0[3]) + (x1[0] * x1[0] + x1[1] * x1[1]) + (x1[2] * x1[2] + x1[3] * x1[3]);
                }
                ss += __shfl_xor(ss, 16); ss += __shfl_xor(ss, 32);
                if (fq == 0) ssq[(size_t)u.pn * SSQ_PLANE + row * 4 + wc] = ss;
                asm volatile("" ::: "memory");
            }
    }
};
struct EpiPle {
    static constexpr bool PERM = true, AFTER_DRAIN = false;
    const bf16_t* XBc; bf16_t* XBn; const bf16_t* PP; const float* ssqc; float* ssqn;
    __device__ __forceinline__ void operator()(const f32x4 (&acc)[2][2][4][2], const Unit& u, int wr, int wc, int fr, int fq) const {
        const int row0 = u.pm * 256 + wr * 64 + fr, col0 = u.pn * 256 + wc * 32 + 8 * fq;
#pragma unroll
        for (int ai = 0; ai < 2; ++ai)
#pragma unroll
            for (int m = 0; m < 4; ++m) {
                const size_t row = (size_t)(row0 + ai * 128 + m * 16); const float s = rstd16(ssqc, row); float ss = 0.f;
#pragma unroll
                for (int bj = 0; bj < 2; ++bj) {
                    const size_t o = row * DM + col0 + bj * 128; f32x4 p0, p1, x0, x1; unpack8(*(const u32x4*)(PP + o), p0, p1); unpack8(*(const u32x4*)(XBc + o), x0, x1);
                    f32x4 v0 = acc[ai][bj][m][0] * s, v1 = acc[ai][bj][m][1] * s;
#pragma unroll
                    for (int e = 0; e < 4; ++e) { x0[e] += p0[e] * sigm(v0[e]); x1[e] += p1[e] * sigm(v1[e]); }
                    *(u32x4*)(XBn + o) = pack8(x0, x1);
                    ss += (x0[0] * x0[0] + x0[1] * x0[1]) + (x0[2] * x0[2] + x0[3] * x0[3]) + (x1[0] * x1[0] + x1[1] * x1[1]) + (x1[2] * x1[2] + x1[3] * x1[3]);
                }
                ss += __shfl_xor(ss, 16); ss += __shfl_xor(ss, 32);
                if (fq == 0) ssqn[(size_t)u.pn * SSQ_PLANE + row * 4 + wc] = ss;
                asm volatile("" ::: "memory");
            }
    }
};
template <int ACT, int RS> struct EpiCol {
    static constexpr bool PERM = true, AFTER_DRAIN = false;
    bf16_t* O; int ldc; const float* rs;
    __device__ __forceinline__ void operator()(const f32x4 (&acc)[2][2][4][2], const Unit& u, int wr, int wc, int fr, int fq) const {
        const int row0 = u.pm * 256 + wr * 64 + fr, col0 = u.pn * 256 + wc * 32 + 8 * fq;
#pragma unroll
        for (int bj = 0; bj < 2; ++bj) {
            const int col = col0 + bj * 128; f32x4 c0, c1;
            if (RS == 0) {
#pragma unroll
                for (int e = 0; e < 4; ++e) { c0[e] = rstd16(rs, (size_t)(col + e)); asm volatile("" ::: "memory"); c1[e] = rstd16(rs, (size_t)(col + 4 + e)); asm volatile("" ::: "memory"); }
            } else { c0 = *(const f32x4*)(rs + col); c1 = *(const f32x4*)(rs + col + 4); }
#pragma unroll
            for (int ai = 0; ai < 2; ++ai)
#pragma unroll
                for (int m = 0; m < 4; ++m) {
                    f32x4 v0 = acc[ai][bj][m][0] * c0, v1 = acc[ai][bj][m][1] * c1;
                    if (ACT == 1) {
#pragma unroll
                        for (int e = 0; e < 4; ++e) { v0[e] = gelu_t(v0[e]); v1[e] = gelu_t(v1[e]); } }
                    *(u32x4*)(O + (size_t)(row0 + ai * 128 + m * 16) * ldc + col) = pack8(v0, v1);
                    asm volatile("" ::: "memory");
                }
        }
    }
};
struct EpiLru {
    static constexpr bool PERM = true, AFTER_DRAIN = false;
    const bf16_t* XC; bf16_t* LA; bf16_t* U; const float* ba; const float* bx; const float* sp8;
    __device__ __forceinline__ void operator()(const f32x4 (&acc)[2][2][4][2], const Unit& u, int wr, int wc, int fr, int fq) const {
        const int row0 = u.pm * 256 + wr * 64 + fr, ch0 = (u.pn * 256 + wc * 32 + 8 * fq) >> 1;
#pragma unroll
        for (int bj = 0; bj < 2; ++bj) {
            const int ch = ch0 + bj * 64; const f32x4 vba = *(const f32x4*)(ba + ch), vbx = *(const f32x4*)(bx + ch), vsp = *(const f32x4*)(sp8 + ch);
#pragma unroll
            for (int ai = 0; ai < 2; ++ai)
#pragma unroll
                for (int m = 0; m < 4; ++m) {
                    const int row = row0 + ai * 128 + m * 16; const size_t o = (size_t)row * DM + ch; const bool first = (row & 2047) == 0;
                    const u32x2 xw = *(const u32x2*)(XC + o); const float xc[4] = {bflo(xw.x), bfhi(xw.x), bflo(xw.y), bfhi(xw.y)};
                    const f32x4 v0 = acc[ai][bj][m][0], v1 = acc[ai][bj][m][1]; const float ga[4] = {v0[0], v0[2], v1[0], v1[2]}, gx[4] = {v0[1], v0[3], v1[1], v1[3]};
                    float la[4], uu[4];
#pragma unroll
                    for (int e = 0; e < 4; ++e) { const float r = sigm(ga[e] + vba[e]), ig = sigm(gx[e] + vbx[e]); la[e] = -vsp[e] * r;
                        const float a2 = fexp2(2.f * LOG2E * la[e]); const float mult = first ? 1.f : sqrtf(fmaxf(1.f - a2, 0.f)); uu[e] = mult * ig * xc[e]; }
                    u32x2 wl, wu; wl.x = cvt_pk_bf16(la[0], la[1]); wl.y = cvt_pk_bf16(la[2], la[3]); wu.x = cvt_pk_bf16(uu[0], uu[1]); wu.y = cvt_pk_bf16(uu[2], uu[3]);
                    *(u32x2*)(LA + o) = wl; *(u32x2*)(U + o) = wu;
                    asm volatile("" ::: "memory");
                }
        }
    }
};
struct EpiQ {
    static constexpr bool PERM = true, AFTER_DRAIN = false;
    bf16_t* Q; const float* rsq; const float* rope;
    __device__ __forceinline__ void operator()(const f32x4 (&acc)[2][2][4][2], const Unit& u, int wr, int wc, int fr, int fq) const {
        const int row0 = u.pm * 256 + wr * 64 + fr, col0 = u.pn * 256 + wc * 32 + 8 * fq;
#pragma unroll
        for (int ai = 0; ai < 2; ++ai)
#pragma unroll
            for (int m = 0; m < 4; ++m) {
                const int row = row0 + ai * 128 + m * 16; const float s = rsq[row] * QSCALE; const int pos = row & 2047;
#pragma unroll
                for (int bj = 0; bj < 2; ++bj) {
                    const int col = col0 + bj * 128, d = col % 96; f32x4 v0 = acc[ai][bj][m][0] * s, v1 = acc[ai][bj][m][1] * s;
                    if (d >= 64) { const int i0 = (d - 64) >> 1; const f32x4 t0 = *(const f32x4*)(rope + (pos * 16 + i0) * 2), t1 = *(const f32x4*)(rope + (pos * 16 + i0 + 2) * 2);
                        const f32x4 a = v0, b = v1;
                        v0[0] = a[0] * t0[0] - a[1] * t0[1]; v0[1] = a[0] * t0[1] + a[1] * t0[0]; v0[2] = a[2] * t0[2] - a[3] * t0[3]; v0[3] = a[2] * t0[3] + a[3] * t0[2];
                        v1[0] = b[0] * t1[0] - b[1] * t1[1]; v1[1] = b[0] * t1[1] + b[1] * t1[0]; v1[2] = b[2] * t1[2] - b[3] * t1[3]; v1[3] = b[2] * t1[3] + b[3] * t1[2]; }
                    *(u32x4*)(Q + (size_t)row * 1536 + col) = pack8(v0, v1);
                }
                asm volatile("" ::: "memory");
            }
    }
};
struct EpiMerge {
    static constexpr bool PERM = true, AFTER_DRAIN = false;
    const bf16_t* G3; bf16_t* MG;
    __device__ __forceinline__ void operator()(const f32x4 (&acc)[2][2][4][2], const Unit& u, int wr, int wc, int fr, int fq) const {
        const int row0 = u.pm * 256 + wr * 64 + fr, col0 = u.pn * 256 + wc * 32 + 8 * fq, mcol0 = (u.pn & 3) * 256 + wc * 32 + 8 * fq; const bool first = u.pn < 4;
#pragma unroll
        for (int ai = 0; ai < 2; ++ai)
#pragma unroll
            for (int m = 0; m < 4; ++m) {
                const size_t row = (size_t)(row0 + ai * 128 + m * 16);
#pragma unroll
                for (int bj = 0; bj < 2; ++bj) {
                    f32x4 g0, g1; unpack8(*(const u32x4*)(G3 + row * 3072 + col0 + bj * 128), g0, g1);
                    f32x4 v0 = acc[ai][bj][m][0] * g0, v1 = acc[ai][bj][m][1] * g1;
                    if (!first) { f32x4 p0, p1; unpack8(*(const u32x4*)(MG + row * DM + mcol0 + bj * 128), p0, p1); v0 += p0; v1 += p1; }
                    *(u32x4*)(MG + row * DM + mcol0 + bj * 128) = pack8(v0, v1);
                }
                asm volatile("" ::: "memory");
            }
    }
};
enum { MAP_ID = 0, MAP_SWIGLU, MAP_WIN, MAP_UQ, MAP_KVK, MAP_KVV, MAP_GATES };
struct Job { const float* W; const float* gain; bf16_t* dst; int ldw, K, dN, map, off; };
__device__ __forceinline__ int srcmap(int map, int off, int n) {
    switch (map) {
    case MAP_SWIGLU: return (n >> 8) * 128 + (n & 127) + ((n & 128) ? DFF : 0);
    case MAP_WIN: if (n < 2048) return n; if (n < 3072) return 2720 + (n - 2048); if (n < 3328) return 2432 + (n - 3072); if (n < 3712) return 2048 + (n - 3328);
                  if (n < 3744) { const int j = n - 3712, i = j >> 1; return 2688 + ((j & 1) ? 16 + i : i); } return -1;
    case MAP_UQ: { const int h = n / 96, d = n % 96; if (d < 64) return n; const int j = d - 64, i = j >> 1; return h * 96 + 64 + ((j & 1) ? 16 + i : i); }
    case MAP_KVK: return (n >> 6) * 128 + (n & 63);
    case MAP_KVV: return (n >> 6) * 128 + 64 + (n & 63);
    case MAP_GATES: return 4768 + (n < 1024 ? n + 1024 : (n < 2048 ? n - 1024 : n));
    default: return n + off;
    }
}
#define JOB(Wp, GAIN, DST, LDW, KK, DN, MAP, OFF) do { J.W = (Wp); J.gain = (GAIN); J.dst = wb + (DST); J.ldw = (LDW); J.K = (KK); J.dN = (DN); J.map = (MAP); J.off = (OFF); } while (0)
__device__ __forceinline__ void get_job(const Params& p, int L, int j, bf16_t* wb, Job& J) {
    const size_t M1 = 1024 * 1024;
    switch (j) {
    case 0: JOB(p.in[3] + (size_t)L * 1024 * 5632, p.in[2] + L * 1024, O_WGU1, 5632, 1024, 5632, MAP_SWIGLU, 0); break;
    case 1: JOB(p.in[4] + (size_t)L * 2816 * 1024, nullptr, O_WD1, 1024, 2816, 1024, MAP_ID, 0); break;
    case 2: JOB(p.in[6] + (size_t)L * 1024 * 7840, p.in[5] + L * 1024, O_WIN, 7840, 1024, 3840, MAP_WIN, 0); break;
    case 3: JOB(p.in[6] + (size_t)L * 1024 * 7840, p.in[5] + L * 1024, O_WINV, 7840, 1024, 1024, MAP_ID, 3744); break;
    case 4: JOB(p.in[6] + (size_t)L * 1024 * 7840, p.in[5] + L * 1024, O_WING, 7840, 1024, 3072, MAP_GATES, 0); break;
    case 5: JOB(p.in[14] + L * M1, nullptr, O_WRB, 1024, 1024, 1024, MAP_ID, 0); break;
    case 6: JOB(p.in[19] + L * M1, nullptr, O_WRA, 1024, 1024, 1024, MAP_ID, 0); break;
    case 7: JOB(p.in[24] + L * M1, nullptr, O_WRC, 1024, 1024, 1024, MAP_ID, 0); break;
    case 8: JOB(p.in[26] + L * M1, nullptr, O_WOUT, 1024, 1024, 1024, MAP_ID, 0); break;
    case 9: JOB(p.in[31] + L * M1, p.in[30] + L * 1024, O_WPG, 1024, 1024, 1024, MAP_ID, 0); break;
    case 10: JOB(p.in[16] + (size_t)L * 384 * 1536, p.in[15] + L * 384, O_WUQ, 1536, 384, 1536, MAP_UQ, 0); break;
    case 11: JOB(p.in[18] + (size_t)L * 256 * 2048, p.in[17] + L * 256, O_WKVK, 2048, 256, 1024, MAP_KVK, 0); break;
    case 12: JOB(p.in[18] + (size_t)L * 256 * 2048, p.in[17] + L * 256, O_WKVV, 2048, 256, 1024, MAP_KVV, 0); break;
    case 13: JOB(p.in[28] + (size_t)L * 1024 * 5632, p.in[27] + L * 1024, O_WGU2, 5632, 1024, 5632, MAP_SWIGLU, 0); break;
    case 14: JOB(p.in[29] + (size_t)L * 2816 * 1024, nullptr, O_WD2, 1024, 2816, 1024, MAP_ID, 0); break;
    default: JOB(p.in[32] + (size_t)L * 256 * 1024, nullptr, O_WPLE, 1024, 256, 1024, MAP_ID, 0); break;
    }
}
constexpr int NJOBS = 16;
__device__ __forceinline__ void tr_item(const Job& J, int item, LAS float* scr, int lane) {
    const int nblk = J.dN >> 5, kb = item / nblk, nb = item % nblk, k0 = 64 * kb, n0 = 32 * nb;
    const int sc0 = srcmap(J.map, J.off, n0);
    if (sc0 >= 0 && srcmap(J.map, J.off, n0 + 1) == sc0 + 1 && srcmap(J.map, J.off, n0 + 31) == sc0 + 31) {
        const int kr = lane >> 3, c4 = lane & 7; f32x4 v[8];
#pragma unroll
        for (int i = 0; i < 8; ++i) v[i] = *(const f32x4*)(J.W + (size_t)(k0 + 8 * i + kr) * J.ldw + sc0 + 4 * c4);
#pragma unroll
        for (int i = 0; i < 8; ++i) { const int kk = 8 * i + kr; const float gn = J.gain ? J.gain[k0 + kk] : 1.f;
            scr[kk * 33 + 4 * c4] = v[i][0] * gn; scr[kk * 33 + 4 * c4 + 1] = v[i][1] * gn; scr[kk * 33 + 4 * c4 + 2] = v[i][2] * gn; scr[kk * 33 + 4 * c4 + 3] = v[i][3] * gn; }
    } else {
        const int sc = srcmap(J.map, J.off, n0 + (lane & 31));
#pragma unroll 8
        for (int i = 0; i < 32; ++i) { const int kk = 2 * i + (lane >> 5); float v = (sc >= 0) ? J.W[(size_t)(k0 + kk) * J.ldw + sc] : 0.f; if (J.gain) v *= J.gain[k0 + kk]; scr[kk * 33 + (lane & 31)] = v; }
    }
    asm volatile("s_waitcnt lgkmcnt(0)" ::: "memory");
    const int c = lane & 7;
#pragma unroll
    for (int j = 0; j < 4; ++j) { const int n = (lane >> 3) + 8 * j; const LAS float* s = scr + (8 * c) * 33 + n;
        u32x4 o; o.x = cvt_pk_bf16(s[0 * 33], s[1 * 33]); o.y = cvt_pk_bf16(s[2 * 33], s[3 * 33]); o.z = cvt_pk_bf16(s[4 * 33], s[5 * 33]); o.w = cvt_pk_bf16(s[6 * 33], s[7 * 33]);
        *(u32x4*)(J.dst + (size_t)(n0 + n) * J.K + k0 + 8 * c) = o; }
    asm volatile("s_waitcnt lgkmcnt(0)" ::: "memory");
}
__device__ __forceinline__ void phase0(const Params& p, int L, LAS unsigned char* lds, int G, int blk) {
    const int tid = pg8::tid_opaque(), lane = tid & 63, wave = tid >> 6;
    const int gw = blk * 8 + wave, NGW = G * 8, gt = blk * 512 + tid, NGT = G * 512;
    bf16_t* wb = (bf16_t*)(p.ws + WS_W);
    LAS float* scr = (LAS float*)(lds + wave * 8448);
    int total = 0;
    for (int j = 0; j < NJOBS; ++j) { Job J; get_job(p, L, j, wb, J); total += (J.K >> 6) * (J.dN >> 5); }
    for (int it = gw; it < total; it += NGW) {
        int r = it;
        for (int j = 0; j < NJOBS; ++j) { Job J; get_job(p, L, j, wb, J); const int n = (J.K >> 6) * (J.dN >> 5); if (r < n) { tr_item(J, r, scr, lane); break; } r -= n; }
    }
    { bf16_t* d = wb + O_WLRU; const float* wa = p.in[9] + (size_t)L * 65536; const float* wx = p.in[11] + (size_t)L * 65536;
      for (int i = gt; i < 2048 * 128; i += NGT) { const int n = i >> 7, k = i & 127, ch = n >> 1, nb = ch >> 6, dd = ch & 63;
          float v = 0.f; if ((k >> 6) == (nb & 1)) v = ((n & 1) ? wx : wa)[(size_t)nb * 4096 + (k & 63) * 64 + dd]; d[i] = f2bf(v); } }
    { bf16_t* d = wb + O_WSGU; const float* w = p.in[22] + (size_t)L * 131072;
      for (int i = gt; i < 131072; i += NGT) { const int t = (i >> 7) & 127, s = i & 127; d[i] = f2bf(((s >> 6) <= (t >> 6)) ? w[i] : 0.f); } }
    { const f32x4* src = (const f32x4*)(p.in[1] + (size_t)L * T * 256); u32x2* d = (u32x2*)(p.ws + WS_BIG + B_PB);
      for (int i = gt; i < T * 256 / 4; i += NGT) { const f32x4 v = src[i]; u32x2 w; w.x = cvt_pk_bf16(v[0], v[1]); w.y = cvt_pk_bf16(v[2], v[3]); d[i] = w; } }
    { float* sp = (float*)(p.ws + WS_SMALL + SM_SP8); const float* lam = p.in[13] + L * 1024;
      for (int i = gt; i < 1024; i += NGT) sp[i] = 8.f * 0.6931471805599453f * __builtin_amdgcn_logf(1.f + fexp2(-LOG2E * lam[i])); }
    if (L == 0) {
        float* rope = (float*)(p.ws + WS_SMALL + SM_ROPE);
        for (int i = gt; i < 2048 * 16; i += NGT) { const int pos = i >> 4, k = i & 15; const float inv = fexp2(-(float)k * (13.287712379549449f / 16.f)); const float ang = (float)pos * inv;
            double rev = (double)ang * 0.15915494309189535; rev -= floor(rev); const float fr = (float)rev; rope[2 * i] = __builtin_amdgcn_cosf(fr); rope[2 * i + 1] = __builtin_amdgcn_sinf(fr); }
        const float* x = p.in[0]; bf16_t* XB = (bf16_t*)(p.ws + WS_XB); float* ssq = (float*)(p.ws + WS_SSQ);
        for (int m = gw; m < T; m += NGW) {
            const f32x4* xr = (const f32x4*)(x + (size_t)m * DM) + lane; u32x2* o8 = (u32x2*)(XB + (size_t)m * DM) + lane; float s = 0.f;
#pragma unroll
            for (int j = 0; j < 4; ++j) { const f32x4 v = xr[64 * j]; s += (v[0] * v[0] + v[1] * v[1]) + (v[2] * v[2] + v[3] * v[3]); u32x2 w; w.x = cvt_pk_bf16(v[0], v[1]); w.y = cvt_pk_bf16(v[2], v[3]); o8[64 * j] = w; }
            s = wave_sum(s);
            if (lane < 16) ssq[(size_t)(lane >> 2) * SSQ_PLANE + (size_t)m * 4 + (lane & 3)] = (lane == 0) ? s : 0.f;
        }
    }
}

__device__ __forceinline__ void pb_convert(const Params& p, int L, int G, int blk) {
    const int tid = pg8::tid_opaque(), gt = blk * 512 + tid, NGT = G * 512;
    const f32x4* src = (const f32x4*)(p.in[1] + (size_t)L * T * 256); u32x2* d = (u32x2*)(p.ws + WS_BIG + B_PB);
    for (int i = gt; i < T * 256 / 4; i += NGT) { const f32x4 v = src[i]; u32x2 w; w.x = cvt_pk_bf16(v[0], v[1]); w.y = cvt_pk_bf16(v[2], v[3]); d[i] = w; }
}
__device__ __forceinline__ void e1_rows(const Params& p, int L, const bf16_t* Z, bf16_t* XC, float* RSQ, float* RSKV, bf16_t* KR, const float* rope, int G, int blk) {
    const int tid = pg8::tid_opaque(), lane = tid & 63, wave = tid >> 6;
    const float* cw = p.in[7] + (size_t)L * 4096; const float* cb = p.in[8] + L * 1024;
    for (int rb = blk * 64 + wave * 8; rb < TC; rb += G * 64) {
        const bool halo = (rb & 2047) != 0;
        u32x4 cqv[8]; u32x2 ckv[8];
#pragma unroll
        for (int r = 0; r < 8; ++r) { const bf16_t* zr = Z + (size_t)(rb + r) * ZLD; cqv[r] = (lane < 48) ? *(const u32x4*)(zr + ZC_CQ + 8 * lane) : (u32x4){0u, 0u, 0u, 0u}; ckv[r] = *(const u32x2*)(zr + ZC_CKV + 4 * lane); }
#pragma unroll
        for (int hf = 0; hf < 2; ++hf) {
            const int c0 = hf * 512 + 8 * lane; u32x4 xr[11];
#pragma unroll
            for (int j = 0; j < 11; ++j) xr[j] = (j >= 3 || halo) ? *(const u32x4*)(Z + (ptrdiff_t)(rb - 3 + j) * ZLD + ZC_XA + c0) : (u32x4){0u, 0u, 0u, 0u};
            f32x4 w0[4], w1[4]; const f32x4 b0 = *(const f32x4*)(cb + c0), b1 = *(const f32x4*)(cb + c0 + 4);
#pragma unroll
            for (int k = 0; k < 4; ++k) { w0[k] = *(const f32x4*)(cw + k * 1024 + c0); w1[k] = *(const f32x4*)(cw + k * 1024 + c0 + 4); }
#pragma unroll
            for (int r = 0; r < 8; ++r) { f32x4 a0 = b0, a1 = b1;
#pragma unroll
                for (int k = 0; k < 4; ++k) { f32x4 x0, x1; unpack8(xr[r + k], x0, x1); a0 += w0[k] * x0; a1 += w1[k] * x1; }
                *(u32x4*)(XC + (size_t)(rb + r) * DM + c0) = pack8(a0, a1); }
        }
        float sq[8], sk[8];
#pragma unroll
        for (int r = 0; r < 8; ++r) { f32x4 x0, x1; unpack8(cqv[r], x0, x1); sq[r] = (x0[0] * x0[0] + x0[1] * x0[1]) + (x0[2] * x0[2] + x0[3] * x0[3]) + (x1[0] * x1[0] + x1[1] * x1[1]) + (x1[2] * x1[2] + x1[3] * x1[3]);
            const float a = bflo(ckv[r].x), b = bfhi(ckv[r].x), c = bflo(ckv[r].y), d = bfhi(ckv[r].y); sk[r] = (a * a + b * b) + (c * c + d * d); }
#pragma unroll
        for (int o = 1; o < 64; o <<= 1)
#pragma unroll
            for (int r = 0; r < 8; ++r) { sq[r] += __shfl_xor(sq[r], o); sk[r] += __shfl_xor(sk[r], o); }
        { float q = sq[0], k = sk[0];
#pragma unroll
          for (int r = 1; r < 8; ++r) { if (lane == r) { q = sq[r]; k = sk[r]; } }
          if (lane < 8) { RSQ[rb + lane] = __builtin_amdgcn_rsqf(q * (1.f / 384.f) + EPS); RSKV[rb + lane] = __builtin_amdgcn_rsqf(k * (1.f / 256.f) + EPS); } }
#pragma unroll
        for (int it = 0; it < 2; ++it) { const int r = rb + it * 4 + (lane >> 4), i = lane & 15, pos = r & 2047;
            const unsigned w = *(const unsigned*)(Z + (size_t)r * ZLD + ZC_KR + 2 * i); const float x1 = bflo(w), x2 = bfhi(w); const f32x2 cs = *(const f32x2*)(rope + (pos * 16 + i) * 2);
            *(unsigned*)(KR + (size_t)r * 32 + 2 * i) = cvt_pk_bf16(x1 * cs[0] - x2 * cs[1], x1 * cs[1] + x2 * cs[0]); }
    }
}
__device__ __forceinline__ void e2_stats(LAS unsigned char* lds, const bf16_t* VTS, float* MEANV, float* RSTDV, int G, int blk) {
    const int tid = pg8::tid_opaque(), lane = tid & 63, wave = tid >> 6, tg = lane & 7, cr = lane >> 3;
    LAS float* part = (LAS float*)lds;
    for (int unit = blk; unit < TC / 64; unit += G) {
        const int tok0 = unit * 64; float s[8], q[8];
#pragma unroll
        for (int e = 0; e < 8; ++e) { s[e] = 0.f; q[e] = 0.f; }
#pragma unroll
        for (int it = 0; it < 16; ++it) { const int c = wave * 128 + it * 8 + cr; f32x4 x0, x1; unpack8(*(const u32x4*)(VTS + (size_t)c * TC + tok0 + 8 * tg), x0, x1);
#pragma unroll
            for (int e = 0; e < 4; ++e) { s[e] += x0[e]; q[e] += x0[e] * x0[e]; s[4 + e] += x1[e]; q[4 + e] += x1[e] * x1[e]; } }
#pragma unroll
        for (int e = 0; e < 8; ++e) { s[e] += __shfl_xor(s[e], 8); s[e] += __shfl_xor(s[e], 16); s[e] += __shfl_xor(s[e], 32); q[e] += __shfl_xor(q[e], 8); q[e] += __shfl_xor(q[e], 16); q[e] += __shfl_xor(q[e], 32); }
        if (cr == 0) {
#pragma unroll
            for (int e = 0; e < 8; ++e) { part[(wave * 64 + 8 * tg + e) * 2] = s[e]; part[(wave * 64 + 8 * tg + e) * 2 + 1] = q[e]; } }
        __syncthreads();
        if (tid < 64) { float ss = 0.f, qq = 0.f;
#pragma unroll
            for (int w = 0; w < 8; ++w) { ss += part[(w * 64 + tid) * 2]; qq += part[(w * 64 + tid) * 2 + 1]; }
            const float mean = ss * (1.f / 1024.f); const float var = fmaxf(qq * (1.f / 1024.f) - mean * mean, 0.f);
            MEANV[tok0 + tid] = mean; RSTDV[tok0 + tid] = __builtin_amdgcn_rsqf(var + EPS); }
        __syncthreads();
    }
}
__device__ __forceinline__ void scan_units(LAS unsigned char* lds, const bf16_t* LA, const bf16_t* U, bf16_t* Z, int G, int blk) {
    const int tid = pg8::tid_opaque(), cp = tid & 15, seg = tid >> 4;
    LAS f32x4* sc = (LAS f32x4*)lds;
    for (int idx = blk; idx < 256; idx += G) {
        const int b = idx >> 5, ch = (idx & 31) * 32 + 2 * cp; const size_t row0 = (size_t)b * 2048 + seg * 64;
        const unsigned* lap = (const unsigned*)(LA + row0 * DM + ch); const unsigned* up = (const unsigned*)(U + row0 * DM + ch);
        float h0 = 0.f, h1 = 0.f, s0 = 0.f, s1 = 0.f;
#pragma unroll 16
        for (int t = 0; t < 64; ++t) { const unsigned lw = lap[(size_t)t * 512], uw = up[(size_t)t * 512]; const float l0 = bflo(lw), l1 = bfhi(lw);
            h0 = fexp2(LOG2E * l0) * h0 + bflo(uw); h1 = fexp2(LOG2E * l1) * h1 + bfhi(uw); s0 += l0; s1 += l1; }
        sc[seg * 16 + cp] = (f32x4){s0, s1, h0, h1};
        __syncthreads();
        float c0 = 0.f, c1 = 0.f;
        for (int j = 0; j < seg; ++j) { const f32x4 v = sc[j * 16 + cp]; c0 = fexp2(LOG2E * v[0]) * c0 + v[2]; c1 = fexp2(LOG2E * v[1]) * c1 + v[3]; }
        h0 = c0; h1 = c1;
        unsigned* gp = (unsigned*)(Z + row0 * ZLD + ZC_GA + ch);
#pragma unroll 16
        for (int t = 0; t < 64; ++t) { const unsigned lw = lap[(size_t)t * 512], uw = up[(size_t)t * 512], gw = gp[(size_t)t * (ZLD / 2)];
            h0 = fexp2(LOG2E * bflo(lw)) * h0 + bflo(uw); h1 = fexp2(LOG2E * bfhi(lw)) * h1 + bfhi(uw); gp[(size_t)t * (ZLD / 2)] = cvt_pk_bf16(h0 * bflo(gw), h1 * bfhi(gw)); }
        __syncthreads();
    }
}
__device__ __forceinline__ void attn_units(LAS unsigned char* lds, const bf16_t* Q, const bf16_t* KN, const bf16_t* KR, const bf16_t* VT, bf16_t* Z, int G, int blk) {
    const int tid = pg8::tid_opaque(), lane = tid & 63, wid = __builtin_amdgcn_readfirstlane(tid >> 6), i32 = lane & 31, hi = lane >> 5;
    constexpr int KP = 208, VP = 144, KBUF = 64 * KP, VBUF = 64 * VP;
    for (int idx = blk; idx < 1024; idx += G) {
        const int j = idx & 255, rnd = idx >> 8, bh = j >> 1;
        const int qb = (j & 1) ? (rnd == 0 ? 1 : rnd == 1 ? 6 : rnd == 2 ? 3 : 4) : (rnd == 0 ? 0 : rnd == 1 ? 7 : rnd == 2 ? 2 : 5);
        const int b = bh >> 4, h = bh & 15, q0 = qb * 256, NT = q0 / 64 + 4, ntw = (q0 + 32 * wid) / 64 + 1;
        const size_t rowb = (size_t)b * 2048;
        bf16x8 qr[6];
        { const bf16_t* qp = Q + (rowb + q0 + 32 * wid + i32) * 1536 + h * 96 + 8 * hi;
#pragma unroll
          for (int ks = 0; ks < 6; ++ks) qr[ks] = *(const bf16x8*)(qp + 16 * ks); }
        const bf16_t* kns = KN + (rowb + (tid >> 3)) * DM + h * 64 + 8 * (tid & 7);
        const bf16_t* krs = KR + (rowb + (tid >> 2)) * 32 + 8 * (tid & 3);
        const bf16_t* vts = VT + (size_t)(h * 64 + (tid >> 3)) * TC + rowb + 8 * (tid & 7);
        const int kdst = (tid >> 3) * KP + (tid & 7) * 16, krdst = (tid >> 2) * KP + 128 + (tid & 3) * 16, vdst = 2 * KBUF + (tid >> 3) * VP + (tid & 7) * 16;
        u32x4 rk, rr = (u32x4){0u, 0u, 0u, 0u}, rv;
        rk = *(const u32x4*)kns; if (tid < 256) rr = *(const u32x4*)krs; rv = *(const u32x4*)vts;
        *(LAS u32x4*)(lds + kdst) = rk; if (tid < 256) *(LAS u32x4*)(lds + krdst) = rr; *(LAS u32x4*)(lds + vdst) = rv;
        __syncthreads();
        f32x16 o0, o1;
#pragma unroll
        for (int r = 0; r < 16; ++r) { o0[r] = 0.f; o1[r] = 0.f; }
        float mrun = -1e30f, lrun = 0.f;
        for (int t = 0; t < NT; ++t) {
            const int cur = t & 1; const bool more = (t + 1 < NT);
            if (more) { rk = *(const u32x4*)(kns + (size_t)(t + 1) * 64 * DM); if (tid < 256) rr = *(const u32x4*)(krs + (size_t)(t + 1) * 64 * 32); rv = *(const u32x4*)(vts + (size_t)(t + 1) * 64); }
            if (t < ntw) {
                LAS const unsigned char* kb = lds + cur * KBUF; LAS const unsigned char* vb = lds + 2 * KBUF + cur * VBUF;
                f32x16 s0, s1;
#pragma unroll
                for (int r = 0; r < 16; ++r) { s0[r] = 0.f; s1[r] = 0.f; }
#pragma unroll
                for (int ks = 0; ks < 6; ++ks) {
                    const bf16x8 a0 = *(LAS const bf16x8*)(kb + i32 * KP + (16 * ks + 8 * hi) * 2), a1 = *(LAS const bf16x8*)(kb + (32 + i32) * KP + (16 * ks + 8 * hi) * 2);
                    s0 = __builtin_amdgcn_mfma_f32_32x32x16_bf16(a0, qr[ks], s0, 0, 0, 0); s1 = __builtin_amdgcn_mfma_f32_32x32x16_bf16(a1, qr[ks], s1, 0, 0, 0);
                }
                float mx = fmaxf(s0[0], s1[0]);
#pragma unroll
                for (int r = 1; r < 16; ++r) mx = fmaxf(mx, fmaxf(s0[r], s1[r]));
                mx = fmaxf(mx, __shfl_xor(mx, 32));
                const float mn = fmaxf(mrun, mx), alpha = fexp2(mrun - mn); mrun = mn;
                float rs = 0.f;
#pragma unroll
                for (int r = 0; r < 16; ++r) { s0[r] = fexp2(s0[r] - mn); s1[r] = fexp2(s1[r] - mn); rs += s0[r] + s1[r]; }
                lrun = lrun * alpha + rs;
#pragma unroll
                for (int r = 0; r < 16; ++r) { o0[r] *= alpha; o1[r] *= alpha; }
                bf16x8 pf[2][2];
#pragma unroll
                for (int uu = 0; uu < 2; ++uu) {
                    u32x4 w0, w1;
                    w0.x = cvt_pk_bf16(s0[8 * uu + 0], s0[8 * uu + 1]); w0.y = cvt_pk_bf16(s0[8 * uu + 2], s0[8 * uu + 3]); w0.z = cvt_pk_bf16(s0[8 * uu + 4], s0[8 * uu + 5]); w0.w = cvt_pk_bf16(s0[8 * uu + 6], s0[8 * uu + 7]);
                    w1.x = cvt_pk_bf16(s1[8 * uu + 0], s1[8 * uu + 1]); w1.y = cvt_pk_bf16(s1[8 * uu + 2], s1[8 * uu + 3]); w1.z = cvt_pk_bf16(s1[8 * uu + 4], s1[8 * uu + 5]); w1.w = cvt_pk_bf16(s1[8 * uu + 6], s1[8 * uu + 7]);
                    pf[0][uu] = __builtin_bit_cast(bf16x8, w0); pf[1][uu] = __builtin_bit_cast(bf16x8, w1);
                }
#pragma unroll
                for (int tt = 0; tt < 2; ++tt)
#pragma unroll
                    for (int uu = 0; uu < 2; ++uu) {
                        LAS const unsigned char* vp0 = vb + i32 * VP + (32 * tt + 16 * uu + 4 * hi) * 2; LAS const unsigned char* vp1 = vp0 + 32 * VP;
                        const u32x2 a = *(LAS const u32x2*)vp0, bq = *(LAS const u32x2*)(vp0 + 16), c = *(LAS const u32x2*)vp1, d = *(LAS const u32x2*)(vp1 + 16);
                        const bf16x8 vf0 = __builtin_bit_cast(bf16x8, ((u32x4){a.x, a.y, bq.x, bq.y})), vf1 = __builtin_bit_cast(bf16x8, ((u32x4){c.x, c.y, d.x, d.y}));
                        o0 = __builtin_amdgcn_mfma_f32_32x32x16_bf16(vf0, pf[tt][uu], o0, 0, 0, 0); o1 = __builtin_amdgcn_mfma_f32_32x32x16_bf16(vf1, pf[tt][uu], o1, 0, 0, 0);
                    }
            }
            if (more) { const int nb = cur ^ 1; *(LAS u32x4*)(lds + nb * KBUF + kdst) = rk; if (tid < 256) *(LAS u32x4*)(lds + nb * KBUF + krdst) = rr; *(LAS u32x4*)(lds + nb * VBUF + vdst) = rv; }
            __syncthreads();
        }
        lrun += __shfl_xor(lrun, 32); const float inv = frcp(lrun);
        bf16_t* op = Z + (rowb + q0 + 32 * wid + i32) * ZLD + ZC_XA + h * 64 + 4 * hi;
#pragma unroll
        for (int rg = 0; rg < 4; ++rg) {
            u32x2 w; w.x = cvt_pk_bf16(o0[4 * rg] * inv, o0[4 * rg + 1] * inv); w.y = cvt_pk_bf16(o0[4 * rg + 2] * inv, o0[4 * rg + 3] * inv); *(u32x2*)(op + 8 * rg) = w;
            w.x = cvt_pk_bf16(o1[4 * rg] * inv, o1[4 * rg + 1] * inv); w.y = cvt_pk_bf16(o1[4 * rg + 2] * inv, o1[4 * rg + 3] * inv); *(u32x2*)(op + 32 + 8 * rg) = w;
        }
    }
}
__device__ __forceinline__ void sgu_units(LAS unsigned char* lds, const bf16_t* VTS, const float* MEANV, const float* RSTDV, const float* lng, const float* lnb, const bf16_t* WS, const float* bs, bf16_t* Z, int G, int blk) {
    const int tid = pg8::tid_opaque(), lane = tid & 63, wid = __builtin_amdgcn_readfirstlane(tid >> 6), i32 = lane & 31, hi = lane >> 5;
    constexpr int AP = 272;
    for (int idx = blk; idx < 1024; idx += G) {
        const int tb = idx >> 3, g = idx & 7, tok0 = tb * 128, tt = wid & 3;
        u32x4 xv[4]; f32x4 m0[4], m1[4], r0[4], r1[4]; float ga[4], be[4];
#pragma unroll
        for (int jj = 0; jj < 4; ++jj) {
            const int id = tid + 512 * jj, c = id >> 4, sc = id & 15; xv[jj] = *(const u32x4*)(VTS + (size_t)(g * 128 + c) * TC + tok0 + 8 * sc);
            m0[jj] = *(const f32x4*)(MEANV + tok0 + 8 * sc); m1[jj] = *(const f32x4*)(MEANV + tok0 + 8 * sc + 4); r0[jj] = *(const f32x4*)(RSTDV + tok0 + 8 * sc); r1[jj] = *(const f32x4*)(RSTDV + tok0 + 8 * sc + 4);
            ga[jj] = lng[g * 128 + c]; be[jj] = lnb[g * 128 + c];
        }
        bf16x8 wf[8];
        { const bf16_t* wp = WS + (size_t)(g * 128 + 32 * tt + i32) * 128 + 8 * hi;
#pragma unroll
          for (int ks = 0; ks < 8; ++ks) wf[ks] = *(const bf16x8*)(wp + 16 * ks); }
        const float bsv = bs[g * 128 + 32 * tt + i32];
        bf16_t* up0 = Z + (size_t)(tok0 + 32 * tt + i32) * ZLD + ZC_U + g * 128 + 64 * (wid >> 2) + 4 * hi;
        u32x2 uv[2][4];
#pragma unroll
        for (int cc = 0; cc < 2; ++cc)
#pragma unroll
            for (int rg = 0; rg < 4; ++rg) uv[cc][rg] = *(const u32x2*)(up0 + 32 * cc + 8 * rg);
#pragma unroll
        for (int jj = 0; jj < 4; ++jj) {
            const int id = tid + 512 * jj, c = id >> 4, sc = id & 15; f32x4 x0, x1; unpack8(xv[jj], x0, x1);
            x0 = (x0 - m0[jj]) * r0[jj] * ga[jj] + be[jj]; x1 = (x1 - m1[jj]) * r1[jj] * ga[jj] + be[jj];
            *(LAS u32x4*)(lds + c * AP + sc * 16) = pack8(x0, x1);
        }
        __syncthreads();
#pragma unroll
        for (int cc = 0; cc < 2; ++cc) {
            const int ct = 2 * (wid >> 2) + cc; f32x16 acc;
#pragma unroll
            for (int r = 0; r < 16; ++r) acc[r] = 0.f;
#pragma unroll
            for (int ks = 0; ks < 8; ++ks) { const bf16x8 a = *(LAS const bf16x8*)(lds + (32 * ct + i32) * AP + (16 * ks + 8 * hi) * 2); acc = __builtin_amdgcn_mfma_f32_32x32x16_bf16(a, wf[ks], acc, 0, 0, 0); }
#pragma unroll
            for (int rg = 0; rg < 4; ++rg) { const u32x2 u2 = uv[cc][rg]; u32x2 w;
                w.x = cvt_pk_bf16((acc[4 * rg] + bsv) * bflo(u2.x), (acc[4 * rg + 1] + bsv) * bfhi(u2.x)); w.y = cvt_pk_bf16((acc[4 * rg + 2] + bsv) * bflo(u2.y), (acc[4 * rg + 3] + bsv) * bfhi(u2.y)); *(u32x2*)(up0 + 32 * cc + 8 * rg) = w; }
        }
        __syncthreads();
    }
}

#ifndef DBG_DUMP
#define DBG_DUMP 0
#define DBG_CH 0
#define DBG_TWICE 0
#define DBG_SKIP56 0
#endif
__device__ __forceinline__ void dbg_add(float* out, const bf16_t* buf, size_t n, bool first, int G, int blk) {
    const size_t gt = (size_t)blk * 512 + pg8::tid_opaque(), NGT = (size_t)G * 512;
    for (size_t i = gt; i < (size_t)T * DM; i += NGT) { float v = 0.f; for (size_t j = i; j < n; j += (size_t)T * DM) v += __uint_as_float((unsigned)buf[j] << 16); out[i] = first ? v : out[i] + v; }
}
__device__ __forceinline__ void dbg_addf(float* out, const float* buf, size_t n, int G, int blk) {
    const size_t gt = (size_t)blk * 512 + pg8::tid_opaque(), NGT = (size_t)G * 512;
    for (size_t i = gt; i < (size_t)T * DM; i += NGT) out[i] += buf[i % n];
}
#define APS 0
#define RUN_GEMM(EPI, e, Ap, Bp, M_, N_, K_, lda_, ldb_, apn_) do { int K__ = (K_), blk__ = blk; asm volatile("" : "+s"(K__), "+s"(blk__)); pg8::Gemm gg{(Ap), (Bp), (M_), (N_), K__, (lda_), (ldb_), (apn_), APS}; pg8::StaticOrder SO; SO.init((M_), (N_), G, blk__); \
    pg8::gemm_phase<decltype(e), pg8::StaticOrder, true, true>(lds, gg, SO, e); } while (0)

constexpr size_t SM_BAR = 1024 * 1024;
#define XB_TMO      128
#define XB_XCNT(j)  (256  + 64 * (j))
#define XB_XSUB(j)  (1280 + 64 * (j))
#define XB_XGEN(j)  (2304 + 64 * (j))
#define XB_TOP      3328
#define XB_TOPGEN   3392
#define XCD_BAR_WORDS 3456
#define XB_SPIN_CAP (1u << 18)

__device__ __forceinline__ unsigned xb_ld(unsigned* p)              { return __hip_atomic_load(p, __ATOMIC_RELAXED, __HIP_MEMORY_SCOPE_AGENT); }
__device__ __forceinline__ unsigned xb_add(unsigned* p, unsigned v) { return __hip_atomic_fetch_add(p, v, __ATOMIC_RELAXED, __HIP_MEMORY_SCOPE_AGENT); }
__device__ __forceinline__ unsigned xb_xcc_id() { return (unsigned)__builtin_amdgcn_s_getreg((3 << 11) | 20) & 0xFu; }
#define XB_SPIN(cond, bar) do { unsigned _sp = 0; while (cond) { __builtin_amdgcn_s_sleep(1); \
    if ((++_sp & 255u) == 0u) { if (xb_ld(&(bar)[XB_TMO])) break; if (_sp > XB_SPIN_CAP) { atomicAdd(&(bar)[XB_TMO], 1u); break; } } } } while (0)

struct XcdBarrier {
    unsigned* bar; unsigned x;
    volatile __attribute__((address_space(3))) unsigned* st;
};

__device__ __forceinline__ XcdBarrier xcd_barrier_post(unsigned* bar, volatile __attribute__((address_space(3))) unsigned* st) {
    XcdBarrier b; b.bar = bar; b.x = xb_xcc_id(); b.st = st;
    if (threadIdx.x == 0) (void)xb_add(&bar[XB_XCNT(b.x)], 1u);
    return b;
}
__device__ __forceinline__ void xcd_barrier_complete(unsigned* bar, unsigned x, unsigned& nloc, unsigned& nx) {
    const unsigned G = gridDim.x * gridDim.y * gridDim.z;
    unsigned sum, cnt, mine, sp = 0u;
    for (;;) {
        sum = 0u; cnt = 0u; mine = 0u;
#pragma unroll
        for (unsigned j = 0; j < 16; ++j) { const unsigned c = xb_ld(&bar[XB_XCNT(j)]); sum += c; cnt += (c > 0u) ? 1u : 0u; mine = (j == x) ? c : mine; }
        if (sum == G) break;
        __builtin_amdgcn_s_sleep(1);
        if ((++sp & 255u) == 0u) { if (xb_ld(&bar[XB_TMO])) break; if (sp > XB_SPIN_CAP) { atomicAdd(&bar[XB_TMO], 1u); break; } }
    }
    nloc = mine > 0u ? mine : 1u; nx = cnt > 0u ? cnt : 1u;
}

__device__ __forceinline__ void xcd_barrier(const XcdBarrier& b) {
    asm volatile("s_waitcnt vmcnt(0)" ::: "memory");
    __syncthreads();
    if (threadIdx.x == 0) {
        unsigned* bar = b.bar;
        __builtin_amdgcn_s_waitcnt(0);
        unsigned nloc = b.st[0], nx = b.st[1];
        if (nloc == 0u) { xcd_barrier_complete(bar, b.x, nloc, nx); b.st[0] = nloc; b.st[1] = nx; }
        const unsigned old = xb_add(&bar[XB_XSUB(b.x)], 1u);
        const unsigned gen = old / nloc;
        if (old + 1u == (gen + 1u) * nloc) {
            __builtin_amdgcn_fence(__ATOMIC_RELEASE, "agent");
            asm volatile("s_waitcnt vmcnt(0)" ::: "memory");
            const unsigned og = xb_add(&bar[XB_TOP], 1u);
            const unsigned tg = og / nx;
            if (og + 1u == (tg + 1u) * nx) xb_add(&bar[XB_TOPGEN], 1u);
            else XB_SPIN(xb_ld(&bar[XB_TOPGEN]) == tg, bar);
            __builtin_amdgcn_fence(__ATOMIC_ACQUIRE, "agent");
            xb_add(&bar[XB_XGEN(b.x)], 1u);
            asm volatile("s_waitcnt vmcnt(0)" ::: "memory");
        } else {
            XB_SPIN(xb_ld(&bar[XB_XGEN(b.x)]) == gen, bar);
            __builtin_amdgcn_fence(__ATOMIC_ACQUIRE, "agent");
            asm volatile("s_waitcnt vmcnt(0)" ::: "memory");
        }
    }
    __syncthreads();
}
#define GRID_SYNC() xcd_barrier(xbar)

#define DBG_DUMP_BODY(st) do { \
    dbg_add(X, G3, (size_t)TC * 3072, true, G, blk); } while (0)
__global__ void __launch_bounds__(512, 2) fwd_kernel(Params p) {
    extern __shared__ __attribute__((aligned(16))) unsigned char lds_raw[];
    LAS unsigned char* lds = (LAS unsigned char*)lds_raw;
    cg::grid_group grid = cg::this_grid();
    const int G = gridDim.x, blk = blockIdx.x;
    unsigned char* ws = p.ws;
    { volatile LAS unsigned* st0 = (volatile LAS unsigned*)(lds + 131072); if (threadIdx.x < 64) st0[threadIdx.x] = 0u; }
    __syncthreads();
    const XcdBarrier xbar = xcd_barrier_post((unsigned*)(ws + WS_SMALL + SM_BAR), (volatile LAS unsigned*)(lds + 131072));
    grid.sync();
    bf16_t* wb = (bf16_t*)(ws + WS_W); bf16_t* XB = (bf16_t*)(ws + WS_XB); float* SSQ = (float*)(ws + WS_SSQ); float* X = p.out;
    bf16_t* XBn = (bf16_t*)p.out; float* SSQn = (float*)(ws + WS_BIG + B_SSQ2);
    float* ROPE = (float*)(ws + WS_SMALL + SM_ROPE); float* RSQ = (float*)(ws + WS_SMALL + SM_RSQ); float* RSKV = (float*)(ws + WS_SMALL + SM_RSKV);
    float* MEANV = (float*)(ws + WS_SMALL + SM_MEANV); float* RSTDV = (float*)(ws + WS_SMALL + SM_RSTDV); float* SP8 = (float*)(ws + WS_SMALL + SM_SP8);
    unsigned char* big = ws + WS_BIG;
    bf16_t* H = (bf16_t*)(big + B_H); bf16_t* PB = (bf16_t*)(big + B_PB); bf16_t* GP = (bf16_t*)(big + B_GP);
    bf16_t* Z = (bf16_t*)(big + B_Z); bf16_t* VTS = (bf16_t*)(big + B_VTS); bf16_t* XC = (bf16_t*)(big + B_XC); bf16_t* LA = (bf16_t*)(big + B_LA); bf16_t* U = (bf16_t*)(big + B_U);
    bf16_t* Q = (bf16_t*)(big + B_Q); bf16_t* KN = (bf16_t*)(big + B_KN); bf16_t* VT = (bf16_t*)(big + B_VT); bf16_t* KR = (bf16_t*)(big + B_KR);
    bf16_t* G3 = (bf16_t*)(big + B_G3); bf16_t* MG = (bf16_t*)(big + B_MERGED);

#pragma unroll 1
    for (int L = 0; L < 2; ++L) {
        phase0(p, L, lds, G, blk);
        GRID_SYNC();
        { EpiSwiglu e{H, SSQ}; RUN_GEMM(EpiSwiglu, e, XB, wb + O_WGU1, T, 2 * DFF, 1024, 1024, 1024, 0); }
        GRID_SYNC();
        { EpiResid<false> e{L == 0 ? p.in[0] : nullptr, XB, SSQ, nullptr, 0.5f}; RUN_GEMM(EpiResid<false>, e, H, wb + O_WD1, T, 1024, DFF, DFF, DFF, 0); }
        GRID_SYNC();
#pragma unroll 1
        for (int c = 0; c <= 2; ++c) {
            if (c >= 1) { const size_t q0 = (size_t)(c - 1) * TC;
                EpiResid<false> e{nullptr, XB + q0 * DM, SSQ + q0 * 4, nullptr, 1.0f}; RUN_GEMM(EpiResid<false>, e, MG, wb + O_WOUT, TC, 1024, 1024, 1024, 1024, 0); }
            const size_t r0 = (size_t)c * TC;
            if (c <= 1) {
                { EpiRow<1, 0> e{Z, ZLD, SSQ + r0 * 4, nullptr, 4, 12, 0}; RUN_GEMM((EpiRow<1, 0>), e, XB + r0 * DM, wb + O_WIN, TC, ZLD, 1024, 1024, 1024, 0); }
                { EpiCol<1, 0> e{VTS, TC, SSQ + r0 * 4}; RUN_GEMM((EpiCol<1, 0>), e, wb + O_WINV, XB + r0 * DM, 1024, TC, 1024, 1024, 1024, 0); }
            }
            GRID_SYNC();
            if (c > 1) break;
            e1_rows(p, L, Z, XC, RSQ, RSKV, KR, ROPE, G, blk);
            e2_stats(lds, VTS, MEANV, RSTDV, G, blk);
            GRID_SYNC();
            { EpiLru e{XC, LA, U, p.in[10] + L * 1024, p.in[12] + L * 1024, SP8}; RUN_GEMM(EpiLru, e, XC, wb + O_WLRU, TC, 2048, 128, 1024, 128, 128); }
            { EpiQ e{Q, RSQ, ROPE}; RUN_GEMM(EpiQ, e, Z + ZC_CQ, wb + O_WUQ, TC, 1536, 384, ZLD, 384, 0); }
            { EpiRow<0, 1> e{KN, 1024, RSKV, nullptr, 0, 0, 0}; RUN_GEMM((EpiRow<0, 1>), e, Z + ZC_CKV, wb + O_WKVK, TC, 1024, 256, ZLD, 256, 0); }
            { EpiCol<0, 1> e{VT, TC, RSKV}; RUN_GEMM((EpiCol<0, 1>), e, wb + O_WKVV, Z + ZC_CKV, 1024, TC, 256, 256, ZLD, 0); }
            GRID_SYNC();
            scan_units(lds, LA, U, Z, G, blk);
            attn_units(lds, Q, KN, KR, VT, Z, G, blk);
            sgu_units(lds, VTS, MEANV, RSTDV, p.in[20] + L * 1024, p.in[21] + L * 1024, wb + O_WSGU, p.in[23] + L * 1024, Z, G, blk);
            GRID_SYNC();
            { EpiRow<2, 0> e{G3, 3072, SSQ + r0 * 4, p.in[25] + L * 3072, 0, 0, 1}; RUN_GEMM((EpiRow<2, 0>), e, XB + r0 * DM, wb + O_WING, TC, 3072, 1024, 1024, 1024, 0); }
#undef APS
#define APS 2
            { EpiMerge e{G3, MG}; RUN_GEMM(EpiMerge, e, Z, wb + O_WRA, TC, 3072, 1024, ZLD, 1024, 1024); }
#undef APS
#define APS 0
            GRID_SYNC();
        }
        { EpiSwiglu e{H, SSQ}; RUN_GEMM(EpiSwiglu, e, XB, wb + O_WGU2, T, 2 * DFF, 1024, 1024, 1024, 0); }
        { EpiRow<0, 2> e{GP, 1024, nullptr, nullptr, 0, 0, 0}; RUN_GEMM((EpiRow<0, 2>), e, PB, wb + O_WPLE, T, 1024, 256, 256, 256, 0); }
        GRID_SYNC();
        { EpiResid<false> e{nullptr, XB, SSQ, nullptr, 0.5f}; RUN_GEMM(EpiResid<false>, e, H, wb + O_WD2, T, 1024, DFF, DFF, DFF, 0); }
        GRID_SYNC();
        { EpiPle e{XB, XBn, GP, SSQ, SSQn}; RUN_GEMM(EpiPle, e, XB, wb + O_WPG, T, 1024, 1024, 1024, 1024, 0); }
        GRID_SYNC();
        { bf16_t* tx = XB; XB = XBn; XBn = tx; float* ts = SSQ; SSQ = SSQn; SSQn = ts; }
    }
    {
        const int tid = pg8::tid_opaque(), lane = tid & 63, wave = tid >> 6, gw = blk * 8 + wave, NGW = G * 8; const float* fn = p.in[33];
        for (int m = gw; m < T; m += NGW) {
            const u32x4* xr = (const u32x4*)(XB + (size_t)m * DM) + lane; f32x4* orow = (f32x4*)(X + (size_t)m * DM); f32x4 v[4]; float s = 0.f;
#pragma unroll
            for (int j = 0; j < 2; ++j) { unpack8(xr[64 * j], v[2 * j], v[2 * j + 1]); }
#pragma unroll
            for (int j = 0; j < 4; ++j) s += (v[j][0] * v[j][0] + v[j][1] * v[j][1]) + (v[j][2] * v[j][2] + v[j][3] * v[j][3]);
            const float rstd = __builtin_amdgcn_rsqf(wave_sum(s) * (1.f / 1024.f) + EPS);
#pragma unroll
            for (int j = 0; j < 2; ++j) { const int c = 512 * j + 8 * lane; orow[c / 4] = v[2 * j] * rstd * *(const f32x4*)(fn + c); orow[c / 4 + 1] = v[2 * j + 1] * rstd * *(const f32x4*)(fn + c + 4); }
        }
    }
}

extern "C" void kernel_launch(void* const* d_in, const int* in_sizes, int n_in, void* d_out, int out_size, void* d_ws, size_t ws_size, hipStream_t stream) {
    static int grid = 0;
    if (grid == 0) {
        if (n_in != 34 || ws_size < WS_NEED) { fprintf(stderr, "kernel_launch: unexpected n_in %d / ws_size %zu (need %zu)\n", n_in, ws_size, (size_t)WS_NEED); grid = -1; return; }
        int dev = 0, cus = 0, per = 0;
        (void)hipGetDevice(&dev); (void)hipDeviceGetAttribute(&cus, hipDeviceAttributeMultiprocessorCount, dev);
        (void)hipFuncSetAttribute((const void*)fwd_kernel, hipFuncAttributeMaxDynamicSharedMemorySize, LDS_BYTES);
        if (hipOccupancyMaxActiveBlocksPerMultiprocessor(&per, (const void*)fwd_kernel, 512, LDS_BYTES) != hipSuccess || per < 1) per = 1;
        (void)hipGetLastError();
        grid = cus * per;
    }
    if (grid < 0) return;
    (void)hipMemsetAsync((unsigned char*)d_ws + WS_SMALL + SM_BAR, 0, 16384, stream);
    Params prm{};
    for (int i = 0; i < 34; ++i) prm.in[i] = (const float*)d_in[i];
    prm.out = (float*)d_out; prm.ws = (unsigned char*)d_ws;
    void* args[] = {&prm};
    hipError_t e = hipLaunchCooperativeKernel((const void*)fwd_kernel, dim3(grid), dim3(512), args, LDS_BYTES, stream);
    if (e != hipSuccess) fprintf(stderr, "cooperative launch failed: %s (grid %d)\n", hipGetErrorString(e), grid);
}
```

```cpp
#include <hip/hip_runtime.h>
#include <hip/hip_cooperative_groups.h>
#include <cstdio>
#include <cstdint>
namespace cg = cooperative_groups;
namespace pg8 {
#define PG8_LAS __attribute__((address_space(3)))
typedef unsigned short bf16_t;
typedef short bf16x8 __attribute__((ext_vector_type(8)));
typedef float f32x4 __attribute__((ext_vector_type(4)));
typedef unsigned u32x4 __attribute__((ext_vector_type(4)));
typedef unsigned u32x2 __attribute__((ext_vector_type(2)));
constexpr int BM = 256, BK = 64, HALF = 128, HTB = HALF * BK * 2  , STAGE_BYTES = 8 * HTB, NXCD = 8, WGM = 8;

__host__ __device__ __forceinline__ int lds_byte(int r, int c) { const int st = (r >> 4) * 2 + (c >> 5), rr = r & 15, cc = c & 31, ob = rr * 64 + cc * 2; return st * 1024 + (ob ^ (((ob >> 9) & 1) << 5)); }
__host__ __device__ __forceinline__ void stage_rc(int b, int& R, int& C) { const int st = b / 1024, sb = b % 1024, swz = sb ^ (((sb >> 9) & 1) << 5); R = (st >> 1) * 16 + swz / 64; C = (st & 1) * 32 + (swz % 64) / 2; }
__host__ __device__ __forceinline__ int perm32(int rho) { const int n = rho >> 4, i = rho & 15; return 8 * (i >> 2) + 4 * n + (i & 3); }

struct Unit { int pm, pn; };
struct Gemm { const bf16_t* A; const bf16_t* Bt; int M, N, K, lda, ldb, apn, aps; };

struct StaticOrder {
    int nM, nN, nwg, G, c;
    __host__ __device__ void init(int M, int N, int G_, int c_) { nM = M / BM; nN = N / BM; nwg = nM * nN; G = G_; c = c_; }
    __host__ __device__ bool next(int i, Unit& u) const {
        const long L = (long)i * G + c; if (L >= nwg) return false;
        int wgid = (int)L; { const int q = nwg / NXCD, r = nwg % NXCD, xcd = wgid % NXCD, off = wgid / NXCD; wgid = (xcd < r ? xcd * (q + 1) : r * (q + 1) + (xcd - r) * q) + off; }
        const int nig = WGM * nN, gid = wgid / nig, fm = gid * WGM, gsz = (nM - fm) < WGM ? (nM - fm) : WGM;
        u.pm = fm + ((wgid % nig) % gsz); u.pn = (wgid % nig) / gsz; return true;
    }
    __device__ __forceinline__ void a_ready(const Unit&) const {}
    __device__ __forceinline__ void done(const Unit&) const {}
};
__device__ __forceinline__ int tid_opaque() { int t = threadIdx.x; asm volatile("" : "+v"(t)); return t; }
typedef float f32x2_t __attribute__((ext_vector_type(2))); typedef __bf16 bf16x2_t __attribute__((ext_vector_type(2)));
__device__ __forceinline__ unsigned cvt_pk_bf16(float lo, float hi) { const f32x2_t v = {lo, hi}; const bf16x2_t b = __builtin_convertvector(v, bf16x2_t); return __builtin_bit_cast(unsigned, b); }

template <class Epi, class Sched, bool ALIGN_EPI = false, bool SP2 = false>
__device__ __forceinline__ void gemm_phase(PG8_LAS unsigned char* lds, const Gemm g, const Sched& S, const Epi& E) {
    const int tid = pg8::tid_opaque(), wid = __builtin_amdgcn_readfirstlane(tid >> 6), lane = tid & 63, wr = wid >> 2, wc = wid & 3, fr = lane & 15, fq = lane >> 4;
    const int K = g.K, nt = K / BK;
    unsigned voffA[2], voffB[2];
#pragma unroll
    for (int i = 0; i < 2; ++i) { int R, C; stage_rc(tid * 16 + i * 8192, R, C); const int Rb = Epi::PERM ? ((R & ~31) + perm32(R & 31)) : R;
        voffA[i] = (unsigned)(R * g.lda + C) * 2u; voffB[i] = (unsigned)(Rb * g.ldb + C) * 2u; }
    const size_t kstep = (size_t)(BK * 2);
    const size_t hstepA = (size_t)HALF * g.lda * 2, hstepB = (size_t)HALF * g.ldb * 2;
    const size_t tstepA = 2 * hstepA, tstepB = 2 * hstepB; const size_t apn = (size_t)g.apn * 2;
    const unsigned ldsw = (unsigned)wid * 1024u;
    const int aoff = lds_byte(wr * 64 + fr, fq * 8), boff = lds_byte(wc * 32 + fr, fq * 8);
#define PG8_SA(b, h) (((b) * 2 + (h)) * HTB)
#define PG8_SB(b, h) ((4 + (b) * 2 + (h)) * HTB)
#define PG8_STAGE(bufoff, gbase, voff) do { _Pragma("unroll") for (int _i = 0; _i < 2; ++_i) \
        __builtin_amdgcn_global_load_lds((const unsigned*)((const char*)(gbase) + (voff)[_i]), (PG8_LAS unsigned*)(lds + (bufoff) + ldsw + _i * 8192), 16, 0, 0); } while (0)
#define PG8_LDA(dst, b, h) do { _Pragma("unroll") for (int m = 0; m < 4; ++m) _Pragma("unroll") for (int k = 0; k < 2; ++k) dst[m][k] = *(const PG8_LAS bf16x8*)(lds + PG8_SA(b, h) + aoff + m * 2048 + k * 1024); } while (0)
#define PG8_LDB(dst, b, h) do { _Pragma("unroll") for (int n = 0; n < 2; ++n) _Pragma("unroll") for (int k = 0; k < 2; ++k) dst[n][k] = *(const PG8_LAS bf16x8*)(lds + PG8_SB(b, h) + boff + n * 2048 + k * 1024); } while (0)
#define PG8_MMA(ai, bj, At, Bt) do { __builtin_amdgcn_s_setprio(1); _Pragma("unroll") for (int m = 0; m < 4; ++m) _Pragma("unroll") for (int n = 0; n < 2; ++n) _Pragma("unroll") for (int k = 0; k < 2; ++k) \
        acc[ai][bj][m][n] = __builtin_amdgcn_mfma_f32_16x16x32_bf16(Bt[n][k], At[m][k], acc[ai][bj][m][n], 0, 0, 0); __builtin_amdgcn_s_setprio(0); } while (0)
#define PG8_WAIT_V(n) asm volatile("s_waitcnt vmcnt(" #n ")" ::: "memory")
#define PG8_WAIT_L(n) asm volatile("s_waitcnt lgkmcnt(" #n ")" ::: "memory")
#define PG8_BAR __builtin_amdgcn_s_barrier()
#define PG8_SCHED __builtin_amdgcn_sched_barrier(0)
    Unit cur, nxt; int ui = 0;
    if (!S.next(0, cur)) return;
    f32x4 acc[2][2][4][2];
#pragma unroll
    for (int a = 0; a < 2; ++a)
#pragma unroll
        for (int b = 0; b < 2; ++b)
#pragma unroll
            for (int m = 0; m < 4; ++m)
#pragma unroll
                for (int n = 0; n < 2; ++n) acc[a][b][m][n] = (f32x4){0.f, 0.f, 0.f, 0.f};
    bf16x8 At[4][2], B0[2][2], B1[2][2];
    const char* cA = (const char*)g.A + (size_t)cur.pm * tstepA + (size_t)(cur.pn >> g.aps) * apn; const char* cB = (const char*)g.Bt + (size_t)cur.pn * tstepB;
    S.a_ready(cur);
    if constexpr (SP2) {
        PG8_STAGE(PG8_SB(0, 0), cB, voffB); PG8_STAGE(PG8_SB(0, 1), cB + hstepB, voffB); PG8_STAGE(PG8_SA(0, 0), cA, voffA); PG8_STAGE(PG8_SA(0, 1), cA + hstepA, voffA);
        if (wr == 1) PG8_BAR;
        PG8_WAIT_V(2); PG8_BAR;
        PG8_STAGE(PG8_SB(1, 0), cB + kstep, voffB); PG8_STAGE(PG8_SA(1, 0), cA + kstep, voffA); PG8_STAGE(PG8_SB(1, 1), cB + hstepB + kstep, voffB);
        PG8_WAIT_V(6); PG8_BAR;
    } else {
        PG8_STAGE(PG8_SB(0, 0), cB, voffB); PG8_STAGE(PG8_SA(0, 0), cA, voffA); PG8_STAGE(PG8_SB(0, 1), cB + hstepB, voffB); PG8_STAGE(PG8_SA(0, 1), cA + hstepA, voffA);
        if (wr == 1) PG8_BAR;
        PG8_WAIT_V(4); PG8_BAR;
        PG8_STAGE(PG8_SB(1, 0), cB + kstep, voffB); PG8_STAGE(PG8_SA(1, 0), cA + kstep, voffA); PG8_STAGE(PG8_SB(1, 1), cB + hstepB + kstep, voffB);
        PG8_WAIT_V(6); PG8_BAR;
    }
    for (;;) {
        const bool has_next = S.next(ui + 1, nxt);
        const char* nA = has_next ? (const char*)g.A + (size_t)nxt.pm * tstepA + (size_t)(nxt.pn >> g.aps) * apn : cA; const char* nB = has_next ? (const char*)g.Bt + (size_t)nxt.pn * tstepB : cB;
        for (int t = 0; t < nt; t += 2) {
            const bool last = (t == nt - 2);
            const char* a1 = cA + (size_t)(t + 1) * kstep;
            const char* a2 = last ? nA : cA + (size_t)(t + 2) * kstep; const char* b2 = last ? nB : cB + (size_t)(t + 2) * kstep;
            const char* a3 = a2 + kstep; const char* b3 = b2 + kstep;
            if (last && has_next) S.a_ready(nxt);
            if constexpr (SP2) {
            PG8_LDB(B0, 0, 0); PG8_LDB(B1, 0, 1); PG8_SCHED; PG8_LDA(At, 0, 0); PG8_STAGE(PG8_SA(1, 1), a1 + hstepA, voffA);
            PG8_WAIT_V(8); PG8_WAIT_L(0); PG8_BAR; PG8_MMA(0, 0, At, B0); PG8_MMA(0, 1, At, B1); PG8_BAR; PG8_SCHED;
            PG8_LDA(At, 0, 1); PG8_STAGE(PG8_SB(0, 0), b2, voffB); PG8_STAGE(PG8_SB(0, 1), b2 + hstepB, voffB); PG8_STAGE(PG8_SA(0, 0), a2, voffA);
            PG8_WAIT_V(8); PG8_WAIT_L(0); PG8_BAR; PG8_MMA(1, 0, At, B0); PG8_MMA(1, 1, At, B1); PG8_BAR; PG8_SCHED;
            PG8_LDB(B0, 1, 0); PG8_LDB(B1, 1, 1); PG8_SCHED; PG8_LDA(At, 1, 0); PG8_STAGE(PG8_SA(0, 1), a2 + hstepA, voffA);
            PG8_WAIT_V(8); PG8_WAIT_L(0); PG8_BAR; PG8_MMA(0, 0, At, B0); PG8_MMA(0, 1, At, B1); PG8_BAR; PG8_SCHED;
            PG8_LDA(At, 1, 1); PG8_STAGE(PG8_SB(1, 0), b3, voffB); PG8_STAGE(PG8_SB(1, 1), b3 + hstepB, voffB); PG8_STAGE(PG8_SA(1, 0), a3, voffA);
            PG8_WAIT_V(8); PG8_WAIT_L(0); PG8_BAR; PG8_MMA(1, 0, At, B0); PG8_MMA(1, 1, At, B1); PG8_BAR; PG8_SCHED;
            } else {
            PG8_LDB(B0, 0, 0); PG8_SCHED; PG8_LDA(At, 0, 0); PG8_STAGE(PG8_SA(1, 1), a1 + hstepA, voffA);
            PG8_WAIT_L(8); PG8_BAR; PG8_WAIT_L(0); PG8_MMA(0, 0, At, B0); PG8_BAR; PG8_SCHED;
            PG8_LDB(B1, 0, 1); PG8_STAGE(PG8_SB(0, 0), b2, voffB);
            PG8_BAR; PG8_WAIT_L(0); PG8_MMA(0, 1, At, B1); PG8_BAR;
            PG8_LDA(At, 0, 1); PG8_STAGE(PG8_SA(0, 0), a2, voffA);
            PG8_BAR; PG8_WAIT_L(0); PG8_MMA(1, 0, At, B0); PG8_BAR; PG8_SCHED;
            PG8_STAGE(PG8_SB(0, 1), b2 + hstepB, voffB);
            PG8_WAIT_V(6); PG8_BAR; PG8_MMA(1, 1, At, B1); PG8_BAR;
            PG8_LDB(B0, 1, 0); PG8_SCHED; PG8_LDA(At, 1, 0); PG8_STAGE(PG8_SA(0, 1), a2 + hstepA, voffA);
            PG8_WAIT_L(8); PG8_BAR; PG8_WAIT_L(0); PG8_MMA(0, 0, At, B0); PG8_BAR; PG8_SCHED;
            PG8_LDB(B1, 1, 1); PG8_STAGE(PG8_SB(1, 0), b3, voffB);
            PG8_BAR; PG8_WAIT_L(0); PG8_MMA(0, 1, At, B1); PG8_BAR;
            PG8_LDA(At, 1, 1); PG8_STAGE(PG8_SA(1, 0), a3, voffA);
            PG8_BAR; PG8_WAIT_L(0); PG8_MMA(1, 0, At, B0); PG8_BAR; PG8_SCHED;
            PG8_STAGE(PG8_SB(1, 1), b3 + hstepB, voffB);
            PG8_WAIT_V(6); PG8_BAR; PG8_MMA(1, 1, At, B1); PG8_BAR;
            }
        }
        if constexpr (ALIGN_EPI) { if (wr == 0) PG8_BAR; }
        if constexpr (!Epi::AFTER_DRAIN) { E(acc, cur, wr, wc, fr, fq); S.done(cur); }
        if (!has_next) break;
#pragma unroll
        for (int a = 0; a < 2; ++a)
#pragma unroll
            for (int b = 0; b < 2; ++b)
#pragma unroll
                for (int m = 0; m < 4; ++m)
#pragma unroll
                    for (int n = 0; n < 2; ++n) acc[a][b][m][n] = (f32x4){0.f, 0.f, 0.f, 0.f};
        cur = nxt; cA = nA; cB = nB; ++ui;
        if constexpr (ALIGN_EPI) { if (wr == 1) PG8_BAR; }
    }
    PG8_WAIT_V(0);
    if constexpr (!ALIGN_EPI) { if (wr == 0) PG8_BAR; }
    PG8_BAR;
    if constexpr (Epi::AFTER_DRAIN) { E.fused(acc, cur, wr, wc, fr, fq, lds, wid, lane); S.done(cur); }
#undef PG8_SA
#undef PG8_SB
#undef PG8_STAGE
#undef PG8_LDA
#undef PG8_LDB
#undef PG8_MMA
#undef PG8_WAIT_V
#undef PG8_WAIT_L
#undef PG8_BAR
#undef PG8_SCHED
}
}

using pg8::bf16_t; using pg8::bf16x8; using pg8::f32x4; using pg8::u32x4; using pg8::u32x2; using pg8::Unit; using pg8::cvt_pk_bf16;
typedef float f32x16 __attribute__((ext_vector_type(16)));
typedef float f32x2 __attribute__((ext_vector_type(2)));
#define LAS __attribute__((address_space(3)))

constexpr int T = 32768, DM = 1024, TC = 16384, DFF = 2816, ZLD = 3840;
constexpr int ZC_XA = 0, ZC_GA = 1024, ZC_U = 2048, ZC_CKV = 3072, ZC_CQ = 3328, ZC_KR = 3712;
constexpr float EPS = 1e-6f, LOG2E = 1.4426950408889634f;
constexpr float QSCALE = 0.10206207261596577f * 1.4426950408889634f;
constexpr size_t MiB = (size_t)1 << 20;
constexpr size_t WS_W = 0, WS_XB = 64 * MiB, WS_SSQ = 128 * MiB, WS_SMALL = 130 * MiB, WS_BIG = 132 * MiB;
constexpr size_t SM_ROPE = 0, SM_RSQ = 256 * 1024, SM_RSKV = 320 * 1024, SM_MEANV = 384 * 1024, SM_RSTDV = 448 * 1024, SM_SP8 = 512 * 1024;
constexpr size_t B_H = 0, B_PB = 361 * MiB, B_GP = 192 * MiB, B_SSQ2 = 377 * MiB;
constexpr size_t B_Z = 0, B_VTS = 120 * MiB, B_XC = 152 * MiB, B_LA = 184 * MiB, B_U = 216 * MiB, B_Q = 248 * MiB, B_KN = 296 * MiB, B_VT = 328 * MiB, B_KR = 360 * MiB;
constexpr size_t B_G3 = 248 * MiB, B_MERGED = 184 * MiB;
constexpr size_t WS_NEED = WS_BIG + 379 * MiB;
constexpr size_t O_WGU1 = 0, O_WD1 = O_WGU1 + 5632 * 1024, O_WIN = O_WD1 + 1024 * 2816, O_WINV = O_WIN + 3840 * 1024, O_WING = O_WINV + 1024 * 1024,
                 O_WLRU = O_WING + 3072 * 1024, O_WRA = O_WLRU + 2048 * 128, O_WRB = O_WRA + 1024 * 1024, O_WRC = O_WRB + 1024 * 1024, O_WOUT = O_WRC + 1024 * 1024,
                 O_WPG = O_WOUT + 1024 * 1024, O_WUQ = O_WPG + 1024 * 1024, O_WKVK = O_WUQ + 1536 * 384, O_WKVV = O_WKVK + 1024 * 256, O_WGU2 = O_WKVV + 1024 * 256,
                 O_WD2 = O_WGU2 + 5632 * 1024, O_WPLE = O_WD2 + 1024 * 2816, O_WSGU = O_WPLE + 1024 * 256, O_WEND = O_WSGU + 8 * 128 * 128;
static_assert(O_WEND * 2 <= 64 * MiB, "weights fit");
constexpr int LDS_BYTES = 131072 + 256;
#ifndef DBG_STOP
#define DBG_STOP 0
#endif
#ifndef DBG_BR
#define DBG_BR 7
#endif

struct Params { const float* in[34]; float* out; unsigned char* ws; };

__device__ __forceinline__ float fexp2(float x) { return __builtin_amdgcn_exp2f(x); }
__device__ __forceinline__ float frcp(float x) { return __builtin_amdgcn_rcpf(x); }
__device__ __forceinline__ float sigm(float x) { return frcp(1.f + fexp2(-LOG2E * x)); }
__device__ __forceinline__ float gelu_t(float x) { const float t = x + 0.044715f * x * x * x; return x * frcp(1.f + fexp2(-2.3022081985f * t)); }
__device__ __forceinline__ float bflo(unsigned w) { return __uint_as_float(w << 16); }
__device__ __forceinline__ float bfhi(unsigned w) { return __uint_as_float(w & 0xffff0000u); }
__device__ __forceinline__ bf16_t f2bf(float v) { return (bf16_t)(cvt_pk_bf16(v, 0.f) & 0xffffu); }
__device__ __forceinline__ float wave_sum(float v) {
#pragma unroll
    for (int o = 1; o < 64; o <<= 1) v += __shfl_xor(v, o);
    return v;
}
constexpr size_t SSQ_PLANE = (size_t)T * 4;
__device__ __forceinline__ float rstd16(const float* ssq, size_t row) {
    const float* q = ssq + row * 4; const f32x4 a = *(const f32x4*)q, b = *(const f32x4*)(q + SSQ_PLANE), c = *(const f32x4*)(q + 2 * SSQ_PLANE), d = *(const f32x4*)(q + 3 * SSQ_PLANE);
    const float s = ((a.x + a.y) + (a.z + a.w)) + ((b.x + b.y) + (b.z + b.w)) + ((c.x + c.y) + (c.z + c.w)) + ((d.x + d.y) + (d.z + d.w));
    return __builtin_amdgcn_rsqf(s * (1.0f / 1024.0f) + EPS);
}
__device__ __forceinline__ u32x4 pack8(const f32x4 v0, const f32x4 v1) { u32x4 w; w.x = cvt_pk_bf16(v0[0], v0[1]); w.y = cvt_pk_bf16(v0[2], v0[3]); w.z = cvt_pk_bf16(v1[0], v1[1]); w.w = cvt_pk_bf16(v1[2], v1[3]); return w; }
__device__ __forceinline__ void unpack8(const u32x4 w, f32x4& v0, f32x4& v1) { v0 = (f32x4){bflo(w.x), bfhi(w.x), bflo(w.y), bfhi(w.y)}; v1 = (f32x4){bflo(w.z), bfhi(w.z), bflo(w.w), bfhi(w.w)}; }

template <int MODE> __device__ __forceinline__ void row_scales(const float* rs, int pm, int wr, int fr, int fq, float (&sc)[2][4]) {
    if (MODE == 2) {
#pragma unroll
        for (int m = 0; m < 4; ++m) { sc[0][m] = 1.f; sc[1][m] = 1.f; }
        return; }
    const int lane = fq * 16 + fr; const size_t r = (size_t)pm * 256 + wr * 64 + lane;
    const float sA = (MODE == 0) ? rstd16(rs, r) : rs[r], sB = (MODE == 0) ? rstd16(rs, r + 128) : rs[r + 128];
#pragma unroll
    for (int m = 0; m < 4; ++m) { sc[0][m] = __shfl(sA, 16 * m + fr); sc[1][m] = __shfl(sB, 16 * m + fr); }
}
template <int ACT, int RS> struct EpiRow {
    static constexpr bool PERM = true, AFTER_DRAIN = false;
    bf16_t* O; int ldc; const float* rs; const float* bias; int t0, t1; int bswap;
    __device__ __forceinline__ void operator()(const f32x4 (&acc)[2][2][4][2], const Unit& u, int wr, int wc, int fr, int fq) const {
        const int row0 = u.pm * 256 + wr * 64 + fr, col0 = u.pn * 256 + wc * 32 + 8 * fq;
        const bool act = (ACT == 1) ? (u.pn >= t0 && u.pn < t1) : true;
        float scl[2][4]; row_scales<RS>(rs, u.pm, wr, fr, fq, scl);
        f32x4 bv[2][2];
#pragma unroll
        for (int bj = 0; bj < 2; ++bj)
#pragma unroll
            for (int n = 0; n < 2; ++n) bv[bj][n] = bias ? *(const f32x4*)(bias + col0 + (bswap ? (u.pn < 4 ? 1024 : (u.pn < 8 ? -1024 : 0)) : 0) + bj * 128 + 4 * n) : (f32x4){0.f, 0.f, 0.f, 0.f};
#pragma unroll
        for (int ai = 0; ai < 2; ++ai)
#pragma unroll
            for (int m = 0; m < 4; ++m) {
                const size_t row = (size_t)(row0 + ai * 128 + m * 16); const float s = scl[ai][m];
                bf16_t* rowp = O + row * ldc + col0;
#pragma unroll
                for (int bj = 0; bj < 2; ++bj) {
                    f32x4 v0 = acc[ai][bj][m][0] * s + bv[bj][0], v1 = acc[ai][bj][m][1] * s + bv[bj][1];
                    if (ACT == 1) { if (act) {
#pragma unroll
                        for (int e = 0; e < 4; ++e) { v0[e] = gelu_t(v0[e]); v1[e] = gelu_t(v1[e]); } } }
                    if (ACT == 2) {
#pragma unroll
                        for (int e = 0; e < 4; ++e) { v0[e] = sigm(v0[e]); v1[e] = sigm(v1[e]); } }
                    *(u32x4*)(rowp + bj * 128) = pack8(v0, v1);
                }
                asm volatile("" ::: "memory");
            }
    }
};
struct EpiSwiglu {
    static constexpr bool PERM = true, AFTER_DRAIN = false;
    bf16_t* H; const float* ssq;
    __device__ __forceinline__ void operator()(const f32x4 (&acc)[2][2][4][2], const Unit& u, int wr, int wc, int fr, int fq) const {
        const int row0 = u.pm * 256 + wr * 64 + fr, col0 = u.pn * 128 + wc * 32 + 8 * fq;
        float scl[2][4]; row_scales<0>(ssq, u.pm, wr, fr, fq, scl);
#pragma unroll
        for (int ai = 0; ai < 2; ++ai)
#pragma unroll
            for (int m = 0; m < 4; ++m) {
                const size_t row = (size_t)(row0 + ai * 128 + m * 16); const float s = scl[ai][m];
                f32x4 h0, h1;
#pragma unroll
                for (int e = 0; e < 4; ++e) { const float g0 = acc[ai][0][m][0][e] * s, g1 = acc[ai][0][m][1][e] * s; h0[e] = g0 * sigm(g0) * (acc[ai][1][m][0][e] * s); h1[e] = g1 * sigm(g1) * (acc[ai][1][m][1][e] * s); }
                *(u32x4*)(H + row * DFF + col0) = pack8(h0, h1);
                asm volatile("" ::: "memory");
            }
    }
};
template <bool GATED> struct EpiResid {
    static constexpr bool PERM = true, AFTER_DRAIN = false;
    const float* X32; bf16_t* XB; float* ssq; const bf16_t* GP; float alpha;
    __device__ __forceinline__ void ld(size_t o, f32x4 (&x)[2][2]) const {
#pragma unroll
        for (int bj = 0; bj < 2; ++bj) { if (X32) { x[bj][0] = *(const f32x4*)(X32 + o + bj * 128); x[bj][1] = *(const f32x4*)(X32 + o + bj * 128 + 4); } else unpack8(*(const u32x4*)(XB + o + bj * 128), x[bj][0], x[bj][1]); }
    }
    __device__ __forceinline__ void operator()(const f32x4 (&acc)[2][2][4][2], const Unit& u, int wr, int wc, int fr, int fq) const {
        const int row0 = u.pm * 256 + wr * 64 + fr, col0 = u.pn * 256 + wc * 32 + 8 * fq;
        f32x4 xc[2][2], xn[2][2];
        ld((size_t)row0 * DM + col0, xc);
#pragma unroll
        for (int g = 0; g < 8; ++g) {
            const int ai = g >> 2, m = g & 3; const size_t row = (size_t)(row0 + ai * 128 + m * 16); float ss = 0.f;
            if (g < 7) ld((size_t)(row0 + ((g + 1) >> 2) * 128 + ((g + 1) & 3) * 16) * DM + col0, xn);
#pragma unroll
            for (int bj = 0; bj < 2; ++bj) {
                const size_t o = row * DM + col0 + bj * 128; f32x4 a0 = acc[ai][bj][m][0] * alpha, a1 = acc[ai][bj][m][1] * alpha;
                if (GATED) { f32x4 g0, g1; unpack8(*(const u32x4*)(GP + o), g0, g1); a0 *= g0; a1 *= g1; }
                const f32x4 x0 = xc[bj][0] + a0, x1 = xc[bj][1] + a1;
                *(u32x4*)(XB + o) = pack8(x0, x1);
                ss += (x0[0] * x0[0] + x0[1] * x0[1]) + (x0[2] * x0[2] + x0[3] * x0[3]) + (x1[0] * x1[0] + x1[1] * x1[1]) + (x1[2] * x1[2] + x1[3] * x1[3]);
            }
            ss += __shfl_xor(ss, 16); ss += __shfl_xor(ss, 32);
            if (fq == 0) ssq[(size_t)u.pn * SSQ_PLANE + row * 4 + wc] = ss;
#pragma unroll
            for (int bj = 0; bj < 2; ++bj) { xc[bj][0] = xn[bj][0]; xc[bj][1] = xn[bj][1]; }
        }
    }
};
struct EpiPle {
    static constexpr bool PERM = true, AFTER_DRAIN = false;
    const bf16_t* XBc; bf16_t* XBn; const bf16_t* PP; const float* ssqc; float* ssqn;
    __device__ __forceinline__ void ld(size_t o, u32x4 (&w)[2][2]) const {
#pragma unroll
        for (int bj = 0; bj < 2; ++bj) { w[bj][0] = *(const u32x4*)(PP + o + bj * 128); w[bj][1] = *(const u32x4*)(XBc + o + bj * 128); }
    }
    __device__ __forceinline__ void operator()(const f32x4 (&acc)[2][2][4][2], const Unit& u, int wr, int wc, int fr, int fq) const {
        const int row0 = u.pm * 256 + wr * 64 + fr, col0 = u.pn * 256 + wc * 32 + 8 * fq;
        float scl[2][4]; row_scales<0>(ssqc, u.pm, wr, fr, fq, scl);
        u32x4 wc_[2][2], wn_[2][2];
        ld((size_t)row0 * DM + col0, wc_);
#pragma unroll
        for (int g = 0; g < 8; ++g) {
            const int ai = g >> 2, m = g & 3; const size_t row = (size_t)(row0 + ai * 128 + m * 16); const float s = scl[ai][m]; float ss = 0.f;
            if (g < 7) ld((size_t)(row0 + ((g + 1) >> 2) * 128 + ((g + 1) & 3) * 16) * DM + col0, wn_);
#pragma unroll
            for (int bj = 0; bj < 2; ++bj) {
                const size_t o = row * DM + col0 + bj * 128; f32x4 p0, p1, x0, x1; unpack8(wc_[bj][0], p0, p1); unpack8(wc_[bj][1], x0, x1);
                const f32x4 v0 = acc[ai][bj][m][0] * s, v1 = acc[ai][bj][m][1] * s;
#pragma unroll
                for (int e = 0; e < 4; ++e) { x0[e] += p0[e] * sigm(v0[e]); x1[e] += p1[e] * sigm(v1[e]); }
                *(u32x4*)(XBn + o) = pack8(x0, x1);
                ss += (x0[0] * x0[0] + x0[1] * x0[1]) + (x0[2] * x0[2] + x0[3] * x0[3]) + (x1[0] * x1[0] + x1[1] * x1[1]) + (x1[2] * x1[2] + x1[3] * x1[3]);
            }
            ss += __shfl_xor(ss, 16); ss += __shfl_xor(ss, 32);
            if (fq == 0) ssqn[(size_t)u.pn * SSQ_PLANE + row * 4 + wc] = ss;
#pragma unroll
            for (int bj = 0; bj < 2; ++bj) { wc_[bj][0] = wn_[bj][0]; wc_[bj][1] = wn_[bj][1]; }
        }
    }
};
template <int ACT, int RS> struct EpiCol {
    static constexpr bool PERM = true, AFTER_DRAIN = false;
    bf16_t* O; int ldc; const float* rs;
    __device__ __forceinline__ void operator()(const f32x4 (&acc)[2][2][4][2], const Unit& u, int wr, int wc, int fr, int fq) const {
        const int row0 = u.pm * 256 + wr * 64 + fr, col0 = u.pn * 256 + wc * 32 + 8 * fq;
#pragma unroll
        for (int bj = 0; bj < 2; ++bj) {
            const int col = col0 + bj * 128; f32x4 c0, c1;
            if (RS == 0) {
#pragma unroll
                for (int e = 0; e < 4; ++e) { c0[e] = rstd16(rs, (size_t)(col + e)); asm volatile("" ::: "memory"); c1[e] = rstd16(rs, (size_t)(col + 4 + e)); asm volatile("" ::: "memory"); }
            } else { c0 = *(const f32x4*)(rs + col); c1 = *(const f32x4*)(rs + col + 4); }
#pragma unroll
            for (int ai = 0; ai < 2; ++ai)
#pragma unroll
                for (int m = 0; m < 4; ++m) {
                    f32x4 v0 = acc[ai][bj][m][0] * c0, v1 = acc[ai][bj][m][1] * c1;
                    if (ACT == 1) {
#pragma unroll
                        for (int e = 0; e < 4; ++e) { v0[e] = gelu_t(v0[e]); v1[e] = gelu_t(v1[e]); } }
                    *(u32x4*)(O + (size_t)(row0 + ai * 128 + m * 16) * ldc + col) = pack8(v0, v1);
                    asm volatile("" ::: "memory");
                }
        }
    }
};
struct EpiLru {
    static constexpr bool PERM = true, AFTER_DRAIN = false;
    const bf16_t* XC; bf16_t* LA; bf16_t* U; const float* ba; const float* bx; const float* sp8;
    __device__ __forceinline__ void operator()(const f32x4 (&acc)[2][2][4][2], const Unit& u, int wr, int wc, int fr, int fq) const {
        const int row0 = u.pm * 256 + wr * 64 + fr, ch0 = (u.pn * 256 + wc * 32 + 8 * fq) >> 1;
#pragma unroll
        for (int bj = 0; bj < 2; ++bj) {
            const int ch = ch0 + bj * 64; const f32x4 vba = *(const f32x4*)(ba + ch), vbx = *(const f32x4*)(bx + ch), vsp = *(const f32x4*)(sp8 + ch);
#pragma unroll
            for (int ai = 0; ai < 2; ++ai)
#pragma unroll
                for (int m = 0; m < 4; ++m) {
                    const int row = row0 + ai * 128 + m * 16; const size_t o = (size_t)row * DM + ch; const bool first = (row & 2047) == 0;
                    const u32x2 xw = *(const u32x2*)(XC + o); const float xc[4] = {bflo(xw.x), bfhi(xw.x), bflo(xw.y), bfhi(xw.y)};
                    const f32x4 v0 = acc[ai][bj][m][0], v1 = acc[ai][bj][m][1]; const float ga[4] = {v0[0], v0[2], v1[0], v1[2]}, gx[4] = {v0[1], v0[3], v1[1], v1[3]};
                    float la[4], uu[4];
#pragma unroll
                    for (int e = 0; e < 4; ++e) { const float r = sigm(ga[e] + vba[e]), ig = sigm(gx[e] + vbx[e]); la[e] = -vsp[e] * r;
                        const float a2 = fexp2(2.f * LOG2E * la[e]); const float mult = first ? 1.f : sqrtf(fmaxf(1.f - a2, 0.f)); uu[e] = mult * ig * xc[e]; }
                    u32x2 wl, wu; wl.x = cvt_pk_bf16(la[0], la[1]); wl.y = cvt_pk_bf16(la[2], la[3]); wu.x = cvt_pk_bf16(uu[0], uu[1]); wu.y = cvt_pk_bf16(uu[2], uu[3]);
                    *(u32x2*)(LA + o) = wl; *(u32x2*)(U + o) = wu;
                    asm volatile("" ::: "memory");
                }
        }
    }
};
struct EpiQ {
    static constexpr bool PERM = true, AFTER_DRAIN = false;
    bf16_t* Q; const float* rsq; const float* rope;
    __device__ __forceinline__ void operator()(const f32x4 (&acc)[2][2][4][2], const Unit& u, int wr, int wc, int fr, int fq) const {
        const int row0 = u.pm * 256 + wr * 64 + fr, col0 = u.pn * 256 + wc * 32 + 8 * fq;
        float scl[2][4]; row_scales<1>(rsq, u.pm, wr, fr, fq, scl);
#pragma unroll
        for (int ai = 0; ai < 2; ++ai)
#pragma unroll
            for (int m = 0; m < 4; ++m) {
                const int row = row0 + ai * 128 + m * 16; const float s = scl[ai][m] * QSCALE; const int pos = row & 2047;
#pragma unroll
                for (int bj = 0; bj < 2; ++bj) {
                    const int col = col0 + bj * 128, d = col % 96; f32x4 v0 = acc[ai][bj][m][0] * s, v1 = acc[ai][bj][m][1] * s;
                    if (d >= 64) { const int i0 = (d - 64) >> 1; const f32x4 t0 = *(const f32x4*)(rope + (pos * 16 + i0) * 2), t1 = *(const f32x4*)(rope + (pos * 16 + i0 + 2) * 2);
                        const f32x4 a = v0, b = v1;
                        v0[0] = a[0] * t0[0] - a[1] * t0[1]; v0[1] = a[0] * t0[1] + a[1] * t0[0]; v0[2] = a[2] * t0[2] - a[3] * t0[3]; v0[3] = a[2] * t0[3] + a[3] * t0[2];
                        v1[0] = b[0] * t1[0] - b[1] * t1[1]; v1[1] = b[0] * t1[1] + b[1] * t1[0]; v1[2] = b[2] * t1[2] - b[3] * t1[3]; v1[3] = b[2] * t1[3] + b[3] * t1[2]; }
                    *(u32x4*)(Q + (size_t)row * 1536 + col) = pack8(v0, v1);
                }
                asm volatile("" ::: "memory");
            }
    }
};
struct EpiMerge {
    static constexpr bool PERM = true, AFTER_DRAIN = false;
    const bf16_t* G3; bf16_t* MG;
    __device__ __forceinline__ void ld(size_t row, int col0, int mcol0, bool first, u32x4 (&w)[2][2]) const {
#pragma unroll
        for (int bj = 0; bj < 2; ++bj) { w[bj][0] = *(const u32x4*)(G3 + row * 3072 + col0 + bj * 128); w[bj][1] = first ? (u32x4){0u, 0u, 0u, 0u} : *(const u32x4*)(MG + row * DM + mcol0 + bj * 128); }
    }
    __device__ __forceinline__ void operator()(const f32x4 (&acc)[2][2][4][2], const Unit& u, int wr, int wc, int fr, int fq) const {
        const int row0 = u.pm * 256 + wr * 64 + fr, col0 = u.pn * 256 + wc * 32 + 8 * fq, mcol0 = (u.pn & 3) * 256 + wc * 32 + 8 * fq; const bool first = u.pn < 4;
        u32x4 wc_[2][2], wn_[2][2];
        ld((size_t)row0, col0, mcol0, first, wc_);
#pragma unroll
        for (int g = 0; g < 8; ++g) {
            const int ai = g >> 2, m = g & 3; const size_t row = (size_t)(row0 + ai * 128 + m * 16);
            if (g < 7) ld((size_t)(row0 + ((g + 1) >> 2) * 128 + ((g + 1) & 3) * 16), col0, mcol0, first, wn_);
#pragma unroll
            for (int bj = 0; bj < 2; ++bj) {
                f32x4 g0, g1, p0, p1; unpack8(wc_[bj][0], g0, g1); unpack8(wc_[bj][1], p0, p1);
                const f32x4 v0 = acc[ai][bj][m][0] * g0 + p0, v1 = acc[ai][bj][m][1] * g1 + p1;
                *(u32x4*)(MG + row * DM + mcol0 + bj * 128) = pack8(v0, v1);
            }
#pragma unroll
            for (int bj = 0; bj < 2; ++bj) { wc_[bj][0] = wn_[bj][0]; wc_[bj][1] = wn_[bj][1]; }
        }
    }
};
enum { MAP_ID = 0, MAP_SWIGLU, MAP_WIN, MAP_UQ, MAP_KVK, MAP_KVV, MAP_GATES };
struct Job { const float* W; const float* gain; bf16_t* dst; int ldw, K, dN, map, off; };
__device__ __forceinline__ int srcmap(int map, int off, int n) {
    switch (map) {
    case MAP_SWIGLU: return (n >> 8) * 128 + (n & 127) + ((n & 128) ? DFF : 0);
    case MAP_WIN: if (n < 2048) return n; if (n < 3072) return 2720 + (n - 2048); if (n < 3328) return 2432 + (n - 3072); if (n < 3712) return 2048 + (n - 3328);
                  if (n < 3744) { const int j = n - 3712, i = j >> 1; return 2688 + ((j & 1) ? 16 + i : i); } return -1;
    case MAP_UQ: { const int h = n / 96, d = n % 96; if (d < 64) return n; const int j = d - 64, i = j >> 1; return h * 96 + 64 + ((j & 1) ? 16 + i : i); }
    case MAP_KVK: return (n >> 6) * 128 + (n & 63);
    case MAP_KVV: return (n >> 6) * 128 + 64 + (n & 63);
    case MAP_GATES: return 4768 + (n < 1024 ? n + 1024 : (n < 2048 ? n - 1024 : n));
    default: return n + off;
    }
}
#define JOB(Wp, GAIN, DST, LDW, KK, DN, MAP, OFF) do { J.W = (Wp); J.gain = (GAIN); J.dst = wb + (DST); J.ldw = (LDW); J.K = (KK); J.dN = (DN); J.map = (MAP); J.off = (OFF); } while (0)
__device__ __forceinline__ void get_job(const Params& p, int L, int j, bf16_t* wb, Job& J) {
    const size_t M1 = 1024 * 1024;
    switch (j) {
    case 0: JOB(p.in[3] + (size_t)L * 1024 * 5632, p.in[2] + L * 1024, O_WGU1, 5632, 1024, 5632, MAP_SWIGLU, 0); break;
    case 1: JOB(p.in[4] + (size_t)L * 2816 * 1024, nullptr, O_WD1, 1024, 2816, 1024, MAP_ID, 0); break;
    case 2: JOB(p.in[6] + (size_t)L * 1024 * 7840, p.in[5] + L * 1024, O_WIN, 7840, 1024, 3840, MAP_WIN, 0); break;
    case 3: JOB(p.in[6] + (size_t)L * 1024 * 7840, p.in[5] + L * 1024, O_WINV, 7840, 1024, 1024, MAP_ID, 3744); break;
    case 4: JOB(p.in[6] + (size_t)L * 1024 * 7840, p.in[5] + L * 1024, O_WING, 7840, 1024, 3072, MAP_GATES, 0); break;
    case 5: JOB(p.in[14] + L * M1, nullptr, O_WRB, 1024, 1024, 1024, MAP_ID, 0); break;
    case 6: JOB(p.in[19] + L * M1, nullptr, O_WRA, 1024, 1024, 1024, MAP_ID, 0); break;
    case 7: JOB(p.in[24] + L * M1, nullptr, O_WRC, 1024, 1024, 1024, MAP_ID, 0); break;
    case 8: JOB(p.in[26] + L * M1, nullptr, O_WOUT, 1024, 1024, 1024, MAP_ID, 0); break;
    case 9: JOB(p.in[31] + L * M1, p.in[30] + L * 1024, O_WPG, 1024, 1024, 1024, MAP_ID, 0); break;
    case 10: JOB(p.in[16] + (size_t)L * 384 * 1536, p.in[15] + L * 384, O_WUQ, 1536, 384, 1536, MAP_UQ, 0); break;
    case 11: JOB(p.in[18] + (size_t)L * 256 * 2048, p.in[17] + L * 256, O_WKVK, 2048, 256, 1024, MAP_KVK, 0); break;
    case 12: JOB(p.in[18] + (size_t)L * 256 * 2048, p.in[17] + L * 256, O_WKVV, 2048, 256, 1024, MAP_KVV, 0); break;
    case 13: JOB(p.in[28] + (size_t)L * 1024 * 5632, p.in[27] + L * 1024, O_WGU2, 5632, 1024, 5632, MAP_SWIGLU, 0); break;
    case 14: JOB(p.in[29] + (size_t)L * 2816 * 1024, nullptr, O_WD2, 1024, 2816, 1024, MAP_ID, 0); break;
    default: JOB(p.in[32] + (size_t)L * 256 * 1024, nullptr, O_WPLE, 1024, 256, 1024, MAP_ID, 0); break;
    }
}
constexpr int NJOBS = 16;
__device__ __forceinline__ void tr_item(const Job& J, int item, LAS float* scr, int lane) {
    const int nblk = J.dN >> 5, kb = item / nblk, nb = item % nblk, k0 = 64 * kb, n0 = 32 * nb;
    const int sc0 = srcmap(J.map, J.off, n0);
    if (sc0 >= 0 && srcmap(J.map, J.off, n0 + 1) == sc0 + 1 && srcmap(J.map, J.off, n0 + 31) == sc0 + 31) {
        const int kr = lane >> 3, c4 = lane & 7; f32x4 v[8];
#pragma unroll
        for (int i = 0; i < 8; ++i) v[i] = *(const f32x4*)(J.W + (size_t)(k0 + 8 * i + kr) * J.ldw + sc0 + 4 * c4);
#pragma unroll
        for (int i = 0; i < 8; ++i) { const int kk = 8 * i + kr; const float gn = J.gain ? J.gain[k0 + kk] : 1.f;
            scr[kk * 33 + 4 * c4] = v[i][0] * gn; scr[kk * 33 + 4 * c4 + 1] = v[i][1] * gn; scr[kk * 33 + 4 * c4 + 2] = v[i][2] * gn; scr[kk * 33 + 4 * c4 + 3] = v[i][3] * gn; }
    } else {
        const int sc = srcmap(J.map, J.off, n0 + (lane & 31));
#pragma unroll 8
        for (int i = 0; i < 32; ++i) { const int kk = 2 * i + (lane >> 5); float v = (sc >= 0) ? J.W[(size_t)(k0 + kk) * J.ldw + sc] : 0.f; if (J.gain) v *= J.gain[k0 + kk]; scr[kk * 33 + (lane & 31)] = v; }
    }
    asm volatile("s_waitcnt lgkmcnt(0)" ::: "memory");
    const int c = lane & 7;
#pragma unroll
    for (int j = 0; j < 4; ++j) { const int n = (lane >> 3) + 8 * j; const LAS float* s = scr + (8 * c) * 33 + n;
        u32x4 o; o.x = cvt_pk_bf16(s[0 * 33], s[1 * 33]); o.y = cvt_pk_bf16(s[2 * 33], s[3 * 33]); o.z = cvt_pk_bf16(s[4 * 33], s[5 * 33]); o.w = cvt_pk_bf16(s[6 * 33], s[7 * 33]);
        *(u32x4*)(J.dst + (size_t)(n0 + n) * J.K + k0 + 8 * c) = o; }
    asm volatile("s_waitcnt lgkmcnt(0)" ::: "memory");
}
__device__ __forceinline__ void phase0(const Params& p, int L, LAS unsigned char* lds, int G, int blk) {
    const int tid = pg8::tid_opaque(), lane = tid & 63, wave = tid >> 6;
    const int gw = blk * 8 + wave, NGW = G * 8, gt = blk * 512 + tid, NGT = G * 512;
    bf16_t* wb = (bf16_t*)(p.ws + WS_W);
    LAS float* scr = (LAS float*)(lds + wave * 8448);
    int total = 0;
    for (int j = 0; j < NJOBS; ++j) { Job J; get_job(p, L, j, wb, J); total += (J.K >> 6) * (J.dN >> 5); }
    for (int it = gw; it < total; it += NGW) {
        int r = it;
        for (int j = 0; j < NJOBS; ++j) { Job J; get_job(p, L, j, wb, J); const int n = (J.K >> 6) * (J.dN >> 5); if (r < n) { tr_item(J, r, scr, lane); break; } r -= n; }
    }
    { bf16_t* d = wb + O_WLRU; const float* wa = p.in[9] + (size_t)L * 65536; const float* wx = p.in[11] + (size_t)L * 65536;
      for (int i = gt; i < 2048 * 128; i += NGT) { const int n = i >> 7, k = i & 127, ch = n >> 1, nb = ch >> 6, dd = ch & 63;
          float v = 0.f; if ((k >> 6) == (nb & 1)) v = ((n & 1) ? wx : wa)[(size_t)nb * 4096 + (k & 63) * 64 + dd]; d[i] = f2bf(v); } }
    { bf16_t* d = wb + O_WSGU; const float* w = p.in[22] + (size_t)L * 131072;
      for (int i = gt; i < 131072; i += NGT) { const int t = (i >> 7) & 127, s = i & 127; d[i] = f2bf(((s >> 6) <= (t >> 6)) ? w[i] : 0.f); } }
    { const f32x4* src = (const f32x4*)(p.in[1] + (size_t)L * T * 256); u32x2* d = (u32x2*)(p.ws + WS_BIG + B_PB);
      for (int i = gt; i < T * 256 / 4; i += NGT) { const f32x4 v = src[i]; u32x2 w; w.x = cvt_pk_bf16(v[0], v[1]); w.y = cvt_pk_bf16(v[2], v[3]); d[i] = w; } }
    { float* sp = (float*)(p.ws + WS_SMALL + SM_SP8); const float* lam = p.in[13] + L * 1024;
      for (int i = gt; i < 1024; i += NGT) sp[i] = 8.f * 0.6931471805599453f * __builtin_amdgcn_logf(1.f + fexp2(-LOG2E * lam[i])); }
    if (L == 0) {
        float* rope = (float*)(p.ws + WS_SMALL + SM_ROPE);
        for (int i = gt; i < 2048 * 16; i += NGT) { const int pos = i >> 4, k = i & 15; const float inv = fexp2(-(float)k * (13.287712379549449f / 16.f)); const float ang = (float)pos * inv;
            double rev = (double)ang * 0.15915494309189535; rev -= floor(rev); const float fr = (float)rev; rope[2 * i] = __builtin_amdgcn_cosf(fr); rope[2 * i + 1] = __builtin_amdgcn_sinf(fr); }
        const float* x = p.in[0]; bf16_t* XB = (bf16_t*)(p.ws + WS_XB); float* ssq = (float*)(p.ws + WS_SSQ);
        for (int m = gw; m < T; m += NGW) {
            const f32x4* xr = (const f32x4*)(x + (size_t)m * DM) + lane; u32x2* o8 = (u32x2*)(XB + (size_t)m * DM) + lane; float s = 0.f;
#pragma unroll
            for (int j = 0; j < 4; ++j) { const f32x4 v = xr[64 * j]; s += (v[0] * v[0] + v[1] * v[1]) + (v[2] * v[2] + v[3] * v[3]); u32x2 w; w.x = cvt_pk_bf16(v[0], v[1]); w.y = cvt_pk_bf16(v[2], v[3]); o8[64 * j] = w; }
            s = wave_sum(s);
            if (lane < 16) ssq[(size_t)(lane >> 2) * SSQ_PLANE + (size_t)m * 4 + (lane & 3)] = (lane == 0) ? s : 0.f;
        }
    }
}

__device__ __forceinline__ void pb_convert(const Params& p, int L, int G, int blk) {
    const int tid = pg8::tid_opaque(), gt = blk * 512 + tid, NGT = G * 512;
    const f32x4* src = (const f32x4*)(p.in[1] + (size_t)L * T * 256); u32x2* d = (u32x2*)(p.ws + WS_BIG + B_PB);
    for (int i = gt; i < T * 256 / 4; i += NGT) { const f32x4 v = src[i]; u32x2 w; w.x = cvt_pk_bf16(v[0], v[1]); w.y = cvt_pk_bf16(v[2], v[3]); d[i] = w; }
}
__device__ __forceinline__ void e1_rows(const Params& p, int L, const bf16_t* Z, bf16_t* XC, float* RSQ, float* RSKV, bf16_t* KR, const float* rope, int G, int blk) {
    const int tid = pg8::tid_opaque(), lane = tid & 63, wave = tid >> 6;
    const float* cw = p.in[7] + (size_t)L * 4096; const float* cb = p.in[8] + L * 1024;
    for (int rb = blk * 64 + wave * 8; rb < TC; rb += G * 64) {
        const bool halo = (rb & 2047) != 0;
        u32x4 cqv[8]; u32x2 ckv[8];
#pragma unroll
        for (int r = 0; r < 8; ++r) { const bf16_t* zr = Z + (size_t)(rb + r) * ZLD; cqv[r] = (lane < 48) ? *(const u32x4*)(zr + ZC_CQ + 8 * lane) : (u32x4){0u, 0u, 0u, 0u}; ckv[r] = *(const u32x2*)(zr + ZC_CKV + 4 * lane); }
#pragma unroll
        for (int hf = 0; hf < 2; ++hf) {
            const int c0 = hf * 512 + 8 * lane; u32x4 xr[11];
#pragma unroll
            for (int j = 0; j < 11; ++j) xr[j] = (j >= 3 || halo) ? *(const u32x4*)(Z + (ptrdiff_t)(rb - 3 + j) * ZLD + ZC_XA + c0) : (u32x4){0u, 0u, 0u, 0u};
            f32x4 w0[4], w1[4]; const f32x4 b0 = *(const f32x4*)(cb + c0), b1 = *(const f32x4*)(cb + c0 + 4);
#pragma unroll
            for (int k = 0; k < 4; ++k) { w0[k] = *(const f32x4*)(cw + k * 1024 + c0); w1[k] = *(const f32x4*)(cw + k * 1024 + c0 + 4); }
#pragma unroll
            for (int r = 0; r < 8; ++r) { f32x4 a0 = b0, a1 = b1;
#pragma unroll
                for (int k = 0; k < 4; ++k) { f32x4 x0, x1; unpack8(xr[r + k], x0, x1); a0 += w0[k] * x0; a1 += w1[k] * x1; }
                *(u32x4*)(XC + (size_t)(rb + r) * DM + c0) = pack8(a0, a1); }
        }
        float sq[8], sk[8];
#pragma unroll
        for (int r = 0; r < 8; ++r) { f32x4 x0, x1; unpack8(cqv[r], x0, x1); sq[r] = (x0[0] * x0[0] + x0[1] * x0[1]) + (x0[2] * x0[2] + x0[3] * x0[3]) + (x1[0] * x1[0] + x1[1] * x1[1]) + (x1[2] * x1[2] + x1[3] * x1[3]);
            const float a = bflo(ckv[r].x), b = bfhi(ckv[r].x), c = bflo(ckv[r].y), d = bfhi(ckv[r].y); sk[r] = (a * a + b * b) + (c * c + d * d); }
#pragma unroll
        for (int o = 1; o < 64; o <<= 1)
#pragma unroll
            for (int r = 0; r < 8; ++r) { sq[r] += __shfl_xor(sq[r], o); sk[r] += __shfl_xor(sk[r], o); }
        { float q = sq[0], k = sk[0];
#pragma unroll
          for (int r = 1; r < 8; ++r) { if (lane == r) { q = sq[r]; k = sk[r]; } }
          if (lane < 8) { RSQ[rb + lane] = __builtin_amdgcn_rsqf(q * (1.f / 384.f) + EPS); RSKV[rb + lane] = __builtin_amdgcn_rsqf(k * (1.f / 256.f) + EPS); } }
#pragma unroll
        for (int it = 0; it < 2; ++it) { const int r = rb + it * 4 + (lane >> 4), i = lane & 15, pos = r & 2047;
            const unsigned w = *(const unsigned*)(Z + (size_t)r * ZLD + ZC_KR + 2 * i); const float x1 = bflo(w), x2 = bfhi(w); const f32x2 cs = *(const f32x2*)(rope + (pos * 16 + i) * 2);
            *(unsigned*)(KR + (size_t)r * 32 + 2 * i) = cvt_pk_bf16(x1 * cs[0] - x2 * cs[1], x1 * cs[1] + x2 * cs[0]); }
    }
}
__device__ __forceinline__ void e2_stats(LAS unsigned char* lds, const bf16_t* VTS, float* MEANV, float* RSTDV, int G, int blk) {
    const int tid = pg8::tid_opaque(), lane = tid & 63, wave = tid >> 6, tg = lane & 7, cr = lane >> 3;
    LAS float* part = (LAS float*)lds;
    for (int unit = blk; unit < TC / 64; unit += G) {
        const int tok0 = unit * 64; float s[8], q[8];
#pragma unroll
        for (int e = 0; e < 8; ++e) { s[e] = 0.f; q[e] = 0.f; }
#pragma unroll
        for (int it = 0; it < 16; ++it) { const int c = wave * 128 + it * 8 + cr; f32x4 x0, x1; unpack8(*(const u32x4*)(VTS + (size_t)c * TC + tok0 + 8 * tg), x0, x1);
#pragma unroll
            for (int e = 0; e < 4; ++e) { s[e] += x0[e]; q[e] += x0[e] * x0[e]; s[4 + e] += x1[e]; q[4 + e] += x1[e] * x1[e]; } }
#pragma unroll
        for (int e = 0; e < 8; ++e) { s[e] += __shfl_xor(s[e], 8); s[e] += __shfl_xor(s[e], 16); s[e] += __shfl_xor(s[e], 32); q[e] += __shfl_xor(q[e], 8); q[e] += __shfl_xor(q[e], 16); q[e] += __shfl_xor(q[e], 32); }
        if (cr == 0) {
#pragma unroll
            for (int e = 0; e < 8; ++e) { part[(wave * 64 + 8 * tg + e) * 2] = s[e]; part[(wave * 64 + 8 * tg + e) * 2 + 1] = q[e]; } }
        __syncthreads();
        if (tid < 64) { float ss = 0.f, qq = 0.f;
#pragma unroll
            for (int w = 0; w < 8; ++w) { ss += part[(w * 64 + tid) * 2]; qq += part[(w * 64 + tid) * 2 + 1]; }
            const float mean = ss * (1.f / 1024.f); const float var = fmaxf(qq * (1.f / 1024.f) - mean * mean, 0.f);
            MEANV[tok0 + tid] = mean; RSTDV[tok0 + tid] = __builtin_amdgcn_rsqf(var + EPS); }
        __syncthreads();
    }
}
__device__ __forceinline__ void scan_units(LAS unsigned char* lds, const bf16_t* LA, const bf16_t* U, bf16_t* Z, int G, int blk) {
    const int tid = pg8::tid_opaque(), cp = tid & 15, seg = tid >> 4;
    LAS f32x4* sc = (LAS f32x4*)lds;
    for (int idx = blk; idx < 256; idx += G) {
        const int b = idx >> 5, ch = (idx & 31) * 32 + 2 * cp; const size_t row0 = (size_t)b * 2048 + seg * 64;
        const unsigned* lap = (const unsigned*)(LA + row0 * DM + ch); const unsigned* up = (const unsigned*)(U + row0 * DM + ch);
        float h0 = 0.f, h1 = 0.f, s0 = 0.f, s1 = 0.f;
#pragma unroll 16
        for (int t = 0; t < 64; ++t) { const unsigned lw = lap[(size_t)t * 512], uw = up[(size_t)t * 512]; const float l0 = bflo(lw), l1 = bfhi(lw);
            h0 = fexp2(LOG2E * l0) * h0 + bflo(uw); h1 = fexp2(LOG2E * l1) * h1 + bfhi(uw); s0 += l0; s1 += l1; }
        sc[seg * 16 + cp] = (f32x4){s0, s1, h0, h1};
        __syncthreads();
        float c0 = 0.f, c1 = 0.f;
        for (int j = 0; j < seg; ++j) { const f32x4 v = sc[j * 16 + cp]; c0 = fexp2(LOG2E * v[0]) * c0 + v[2]; c1 = fexp2(LOG2E * v[1]) * c1 + v[3]; }
        h0 = c0; h1 = c1;
        unsigned* gp = (unsigned*)(Z + row0 * ZLD + ZC_GA + ch);
#pragma unroll 16
        for (int t = 0; t < 64; ++t) { const unsigned lw = lap[(size_t)t * 512], uw = up[(size_t)t * 512], gw = gp[(size_t)t * (ZLD / 2)];
            h0 = fexp2(LOG2E * bflo(lw)) * h0 + bflo(uw); h1 = fexp2(LOG2E * bfhi(lw)) * h1 + bfhi(uw); gp[(size_t)t * (ZLD / 2)] = cvt_pk_bf16(h0 * bflo(gw), h1 * bfhi(gw)); }
        __syncthreads();
    }
}
__device__ __forceinline__ void attn_units(LAS unsigned char* lds, const bf16_t* Q, const bf16_t* KN, const bf16_t* KR, const bf16_t* VT, bf16_t* Z, int G, int blk) {
    const int tid = pg8::tid_opaque(), lane = tid & 63, wid = __builtin_amdgcn_readfirstlane(tid >> 6), i32 = lane & 31, hi = lane >> 5;
    constexpr int KP = 208, VP = 144, KBUF = 64 * KP, VBUF = 64 * VP;
    for (int idx = blk; idx < 1024; idx += G) {
        const int j = idx & 255, rnd = idx >> 8, bh = j >> 1;
        const int qb = (j & 1) ? (rnd == 0 ? 1 : rnd == 1 ? 6 : rnd == 2 ? 3 : 4) : (rnd == 0 ? 0 : rnd == 1 ? 7 : rnd == 2 ? 2 : 5);
        const int b = bh >> 4, h = bh & 15, q0 = qb * 256, NT = q0 / 64 + 4, ntw = (q0 + 32 * wid) / 64 + 1;
        const size_t rowb = (size_t)b * 2048;
        bf16x8 qr[6];
        { const bf16_t* qp = Q + (rowb + q0 + 32 * wid + i32) * 1536 + h * 96 + 8 * hi;
#pragma unroll
          for (int ks = 0; ks < 6; ++ks) qr[ks] = *(const bf16x8*)(qp + 16 * ks); }
        const bf16_t* kns = KN + (rowb + (tid >> 3)) * DM + h * 64 + 8 * (tid & 7);
        const bf16_t* krs = KR + (rowb + (tid >> 2)) * 32 + 8 * (tid & 3);
        const bf16_t* vts = VT + (size_t)(h * 64 + (tid >> 3)) * TC + rowb + 8 * (tid & 7);
        const int kdst = (tid >> 3) * KP + (tid & 7) * 16, krdst = (tid >> 2) * KP + 128 + (tid & 3) * 16, vdst = 2 * KBUF + (tid >> 3) * VP + (tid & 7) * 16;
        u32x4 rk, rr = (u32x4){0u, 0u, 0u, 0u}, rv;
        rk = *(const u32x4*)kns; if (tid < 256) rr = *(const u32x4*)krs; rv = *(const u32x4*)vts;
        *(LAS u32x4*)(lds + kdst) = rk; if (tid < 256) *(LAS u32x4*)(lds + krdst) = rr; *(LAS u32x4*)(lds + vdst) = rv;
        __syncthreads();
        f32x16 o0, o1;
#pragma unroll
        for (int r = 0; r < 16; ++r) { o0[r] = 0.f; o1[r] = 0.f; }
        float mrun = -1e30f, lrun = 0.f;
        for (int t = 0; t < NT; ++t) {
            const int cur = t & 1; const bool more = (t + 1 < NT);
            if (more) { rk = *(const u32x4*)(kns + (size_t)(t + 1) * 64 * DM); if (tid < 256) rr = *(const u32x4*)(krs + (size_t)(t + 1) * 64 * 32); rv = *(const u32x4*)(vts + (size_t)(t + 1) * 64); }
            if (t < ntw) {
                LAS const unsigned char* kb = lds + cur * KBUF; LAS const unsigned char* vb = lds + 2 * KBUF + cur * VBUF;
                f32x16 s0, s1;
#pragma unroll
                for (int r = 0; r < 16; ++r) { s0[r] = 0.f; s1[r] = 0.f; }
#pragma unroll
                for (int ks = 0; ks < 6; ++ks) {
                    const bf16x8 a0 = *(LAS const bf16x8*)(kb + i32 * KP + (16 * ks + 8 * hi) * 2), a1 = *(LAS const bf16x8*)(kb + (32 + i32) * KP + (16 * ks + 8 * hi) * 2);
                    s0 = __builtin_amdgcn_mfma_f32_32x32x16_bf16(a0, qr[ks], s0, 0, 0, 0); s1 = __builtin_amdgcn_mfma_f32_32x32x16_bf16(a1, qr[ks], s1, 0, 0, 0);
                }
                float mx = fmaxf(s0[0], s1[0]);
#pragma unroll
                for (int r = 1; r < 16; ++r) mx = fmaxf(mx, fmaxf(s0[r], s1[r]));
                mx = fmaxf(mx, __shfl_xor(mx, 32));
                const float mn = fmaxf(mrun, mx), alpha = fexp2(mrun - mn); mrun = mn;
                float rs = 0.f;
#pragma unroll
                for (int r = 0; r < 16; ++r) { s0[r] = fexp2(s0[r] - mn); s1[r] = fexp2(s1[r] - mn); rs += s0[r] + s1[r]; }
                lrun = lrun * alpha + rs;
#pragma unroll
                for (int r = 0; r < 16; ++r) { o0[r] *= alpha; o1[r] *= alpha; }
                bf16x8 pf[2][2];
#pragma unroll
                for (int uu = 0; uu < 2; ++uu) {
                    u32x4 w0, w1;
                    w0.x = cvt_pk_bf16(s0[8 * uu + 0], s0[8 * uu + 1]); w0.y = cvt_pk_bf16(s0[8 * uu + 2], s0[8 * uu + 3]); w0.z = cvt_pk_bf16(s0[8 * uu + 4], s0[8 * uu + 5]); w0.w = cvt_pk_bf16(s0[8 * uu + 6], s0[8 * uu + 7]);
                    w1.x = cvt_pk_bf16(s1[8 * uu + 0], s1[8 * uu + 1]); w1.y = cvt_pk_bf16(s1[8 * uu + 2], s1[8 * uu + 3]); w1.z = cvt_pk_bf16(s1[8 * uu + 4], s1[8 * uu + 5]); w1.w = cvt_pk_bf16(s1[8 * uu + 6], s1[8 * uu + 7]);
                    pf[0][uu] = __builtin_bit_cast(bf16x8, w0); pf[1][uu] = __builtin_bit_cast(bf16x8, w1);
                }
#pragma unroll
                for (int tt = 0; tt < 2; ++tt)
#pragma unroll
                    for (int uu = 0; uu < 2; ++uu) {
                        LAS const unsigned char* vp0 = vb + i32 * VP + (32 * tt + 16 * uu + 4 * hi) * 2; LAS const unsigned char* vp1 = vp0 + 32 * VP;
                        const u32x2 a = *(LAS const u32x2*)vp0, bq = *(LAS const u32x2*)(vp0 + 16), c = *(LAS const u32x2*)vp1, d = *(LAS const u32x2*)(vp1 + 16);
                        const bf16x8 vf0 = __builtin_bit_cast(bf16x8, ((u32x4){a.x, a.y, bq.x, bq.y})), vf1 = __builtin_bit_cast(bf16x8, ((u32x4){c.x, c.y, d.x, d.y}));
                        o0 = __builtin_amdgcn_mfma_f32_32x32x16_bf16(vf0, pf[tt][uu], o0, 0, 0, 0); o1 = __builtin_amdgcn_mfma_f32_32x32x16_bf16(vf1, pf[tt][uu], o1, 0, 0, 0);
                    }
            }
            if (more) { const int nb = cur ^ 1; *(LAS u32x4*)(lds + nb * KBUF + kdst) = rk; if (tid < 256) *(LAS u32x4*)(lds + nb * KBUF + krdst) = rr; *(LAS u32x4*)(lds + nb * VBUF + vdst) = rv; }
            __syncthreads();
        }
        lrun += __shfl_xor(lrun, 32); const float inv = frcp(lrun);
        bf16_t* op = Z + (rowb + q0 + 32 * wid + i32) * ZLD + ZC_XA + h * 64 + 4 * hi;
#pragma unroll
        for (int rg = 0; rg < 4; ++rg) {
            u32x2 w; w.x = cvt_pk_bf16(o0[4 * rg] * inv, o0[4 * rg + 1] * inv); w.y = cvt_pk_bf16(o0[4 * rg + 2] * inv, o0[4 * rg + 3] * inv); *(u32x2*)(op + 8 * rg) = w;
            w.x = cvt_pk_bf16(o1[4 * rg] * inv, o1[4 * rg + 1] * inv); w.y = cvt_pk_bf16(o1[4 * rg + 2] * inv, o1[4 * rg + 3] * inv); *(u32x2*)(op + 32 + 8 * rg) = w;
        }
    }
}
__device__ __forceinline__ void sgu_units(LAS unsigned char* lds, const bf16_t* VTS, const float* MEANV, const float* RSTDV, const float* lng, const float* lnb, const bf16_t* WS, const float* bs, bf16_t* Z, int G, int blk) {
    const int tid = pg8::tid_opaque(), lane = tid & 63, wid = __builtin_amdgcn_readfirstlane(tid >> 6), i32 = lane & 31, hi = lane >> 5;
    constexpr int AP = 272;
    for (int idx = blk; idx < 1024; idx += G) {
        const int tb = idx >> 3, g = idx & 7, tok0 = tb * 128, tt = wid & 3;
        u32x4 xv[4]; f32x4 m0[4], m1[4], r0[4], r1[4]; float ga[4], be[4];
#pragma unroll
        for (int jj = 0; jj < 4; ++jj) {
            const int id = tid + 512 * jj, c = id >> 4, sc = id & 15; xv[jj] = *(const u32x4*)(VTS + (size_t)(g * 128 + c) * TC + tok0 + 8 * sc);
            m0[jj] = *(const f32x4*)(MEANV + tok0 + 8 * sc); m1[jj] = *(const f32x4*)(MEANV + tok0 + 8 * sc + 4); r0[jj] = *(const f32x4*)(RSTDV + tok0 + 8 * sc); r1[jj] = *(const f32x4*)(RSTDV + tok0 + 8 * sc + 4);
            ga[jj] = lng[g * 128 + c]; be[jj] = lnb[g * 128 + c];
        }
        bf16x8 wf[8];
        { const bf16_t* wp = WS + (size_t)(g * 128 + 32 * tt + i32) * 128 + 8 * hi;
#pragma unroll
          for (int ks = 0; ks < 8; ++ks) wf[ks] = *(const bf16x8*)(wp + 16 * ks); }
        const float bsv = bs[g * 128 + 32 * tt + i32];
        bf16_t* up0 = Z + (size_t)(tok0 + 32 * tt + i32) * ZLD + ZC_U + g * 128 + 64 * (wid >> 2) + 4 * hi;
        u32x2 uv[2][4];
#pragma unroll
        for (int cc = 0; cc < 2; ++cc)
#pragma unroll
            for (int rg = 0; rg < 4; ++rg) uv[cc][rg] = *(const u32x2*)(up0 + 32 * cc + 8 * rg);
#pragma unroll
        for (int jj = 0; jj < 4; ++jj) {
            const int id = tid + 512 * jj, c = id >> 4, sc = id & 15; f32x4 x0, x1; unpack8(xv[jj], x0, x1);
            x0 = (x0 - m0[jj]) * r0[jj] * ga[jj] + be[jj]; x1 = (x1 - m1[jj]) * r1[jj] * ga[jj] + be[jj];
            *(LAS u32x4*)(lds + c * AP + sc * 16) = pack8(x0, x1);
        }
        __syncthreads();
#pragma unroll
        for (int cc = 0; cc < 2; ++cc) {
            const int ct = 2 * (wid >> 2) + cc; f32x16 acc;
#pragma unroll
            for (int r = 0; r < 16; ++r) acc[r] = 0.f;
#pragma unroll
            for (int ks = 0; ks < 8; ++ks) { const bf16x8 a = *(LAS const bf16x8*)(lds + (32 * ct + i32) * AP + (16 * ks + 8 * hi) * 2); acc = __builtin_amdgcn_mfma_f32_32x32x16_bf16(a, wf[ks], acc, 0, 0, 0); }
#pragma unroll
            for (int rg = 0; rg < 4; ++rg) { const u32x2 u2 = uv[cc][rg]; u32x2 w;
                w.x = cvt_pk_bf16((acc[4 * rg] + bsv) * bflo(u2.x), (acc[4 * rg + 1] + bsv) * bfhi(u2.x)); w.y = cvt_pk_bf16((acc[4 * rg + 2] + bsv) * bflo(u2.y), (acc[4 * rg + 3] + bsv) * bfhi(u2.y)); *(u32x2*)(up0 + 32 * cc + 8 * rg) = w; }
        }
        __syncthreads();
    }
}

#ifndef DBG_DUMP
#define DBG_DUMP 0
#define DBG_CH 0
#define DBG_TWICE 0
#define DBG_SKIP56 0
#endif
__device__ __forceinline__ void dbg_add(float* out, const bf16_t* buf, size_t n, bool first, int G, int blk) {
    const size_t gt = (size_t)blk * 512 + pg8::tid_opaque(), NGT = (size_t)G * 512;
    for (size_t i = gt; i < (size_t)T * DM; i += NGT) { float v = 0.f; for (size_t j = i; j < n; j += (size_t)T * DM) v += __uint_as_float((unsigned)buf[j] << 16); out[i] = first ? v : out[i] + v; }
}
__device__ __forceinline__ void dbg_addf(float* out, const float* buf, size_t n, int G, int blk) {
    const size_t gt = (size_t)blk * 512 + pg8::tid_opaque(), NGT = (size_t)G * 512;
    for (size_t i = gt; i < (size_t)T * DM; i += NGT) out[i] += buf[i % n];
}
#define APS 0
#define RUN_GEMM(EPI, e, Ap, Bp, M_, N_, K_, lda_, ldb_, apn_) do { int K__ = (K_), blk__ = blk; asm volatile("" : "+s"(K__), "+s"(blk__)); pg8::Gemm gg{(Ap), (Bp), (M_), (N_), K__, (lda_), (ldb_), (apn_), APS}; pg8::StaticOrder SO; SO.init((M_), (N_), G, blk__); \
    pg8::gemm_phase<decltype(e), pg8::StaticOrder, true, true>(lds, gg, SO, e); } while (0)

constexpr size_t SM_BAR = 1024 * 1024;
#define XB_TMO      128
#define XB_XCNT(j)  (256  + 64 * (j))
#define XB_XSUB(j)  (1280 + 64 * (j))
#define XB_XGEN(j)  (2304 + 64 * (j))
#define XB_TOP      3328
#define XB_TOPGEN   3392
#define XCD_BAR_WORDS 3456
#define XB_SPIN_CAP (1u << 18)

__device__ __forceinline__ unsigned xb_ld(unsigned* p)              { return __hip_atomic_load(p, __ATOMIC_RELAXED, __HIP_MEMORY_SCOPE_AGENT); }
__device__ __forceinline__ unsigned xb_add(unsigned* p, unsigned v) { return __hip_atomic_fetch_add(p, v, __ATOMIC_RELAXED, __HIP_MEMORY_SCOPE_AGENT); }
__device__ __forceinline__ unsigned xb_xcc_id() { return (unsigned)__builtin_amdgcn_s_getreg((3 << 11) | 20) & 0xFu; }
#define XB_SPIN(cond, bar) do { unsigned _sp = 0; while (cond) { __builtin_amdgcn_s_sleep(1); \
    if ((++_sp & 255u) == 0u) { if (xb_ld(&(bar)[XB_TMO])) break; if (_sp > XB_SPIN_CAP) { atomicAdd(&(bar)[XB_TMO], 1u); break; } } } } while (0)

struct XcdBarrier {
    unsigned* bar; unsigned x;
    volatile __attribute__((address_space(3))) unsigned* st;
};

__device__ __forceinline__ XcdBarrier xcd_barrier_post(unsigned* bar, volatile __attribute__((address_space(3))) unsigned* st) {
    XcdBarrier b; b.bar = bar; b.x = xb_xcc_id(); b.st = st;
    if (threadIdx.x == 0) (void)xb_add(&bar[XB_XCNT(b.x)], 1u);
    return b;
}
__device__ __forceinline__ void xcd_barrier_complete(unsigned* bar, unsigned x, unsigned& nloc, unsigned& nx) {
    const unsigned G = gridDim.x * gridDim.y * gridDim.z;
    unsigned sum, cnt, mine, sp = 0u;
    for (;;) {
        sum = 0u; cnt = 0u; mine = 0u;
#pragma unroll
        for (unsigned j = 0; j < 16; ++j) { const unsigned c = xb_ld(&bar[XB_XCNT(j)]); sum += c; cnt += (c > 0u) ? 1u : 0u; mine = (j == x) ? c : mine; }
        if (sum == G) break;
        __builtin_amdgcn_s_sleep(1);
        if ((++sp & 255u) == 0u) { if (xb_ld(&bar[XB_TMO])) break; if (sp > XB_SPIN_CAP) { atomicAdd(&bar[XB_TMO], 1u); break; } }
    }
    nloc = mine > 0u ? mine : 1u; nx = cnt > 0u ? cnt : 1u;
}

__device__ __forceinline__ void xcd_barrier(const XcdBarrier& b) {
    asm volatile("s_waitcnt vmcnt(0)" ::: "memory");
    __syncthreads();
    if (threadIdx.x == 0) {
        unsigned* bar = b.bar;
        __builtin_amdgcn_s_waitcnt(0);
        unsigned nloc = b.st[0], nx = b.st[1];
        if (nloc == 0u) { xcd_barrier_complete(bar, b.x, nloc, nx); b.st[0] = nloc; b.st[1] = nx; }
        const unsigned old = xb_add(&bar[XB_XSUB(b.x)], 1u);
        const unsigned gen = old / nloc;
        if (old + 1u == (gen + 1u) * nloc) {
            __builtin_amdgcn_fence(__ATOMIC_RELEASE, "agent");
            asm volatile("s_waitcnt vmcnt(0)" ::: "memory");
            const unsigned og = xb_add(&bar[XB_TOP], 1u);
            const unsigned tg = og / nx;
            if (og + 1u == (tg + 1u) * nx) xb_add(&bar[XB_TOPGEN], 1u);
            else XB_SPIN(xb_ld(&bar[XB_TOPGEN]) == tg, bar);
            __builtin_amdgcn_fence(__ATOMIC_ACQUIRE, "agent");
            xb_add(&bar[XB_XGEN(b.x)], 1u);
            asm volatile("s_waitcnt vmcnt(0)" ::: "memory");
        } else {
            XB_SPIN(xb_ld(&bar[XB_XGEN(b.x)]) == gen, bar);
            __builtin_amdgcn_fence(__ATOMIC_ACQUIRE, "agent");
            asm volatile("s_waitcnt vmcnt(0)" ::: "memory");
        }
    }
    __syncthreads();
}
#define GRID_SYNC() xcd_barrier(xbar)

#define DBG_DUMP_BODY(st) do { \
    dbg_add(X, G3, (size_t)TC * 3072, true, G, blk); } while (0)
__global__ void __launch_bounds__(512, 2) fwd_kernel(Params p) {
    extern __shared__ __attribute__((aligned(16))) unsigned char lds_raw[];
    LAS unsigned char* lds = (LAS unsigned char*)lds_raw;
    cg::grid_group grid = cg::this_grid();
    const int G = gridDim.x, blk = blockIdx.x;
    unsigned char* ws = p.ws;
    { volatile LAS unsigned* st0 = (volatile LAS unsigned*)(lds + 131072); if (threadIdx.x < 64) st0[threadIdx.x] = 0u; }
    __syncthreads();
    const XcdBarrier xbar = xcd_barrier_post((unsigned*)(ws + WS_SMALL + SM_BAR), (volatile LAS unsigned*)(lds + 131072));
    grid.sync();
    bf16_t* wb = (bf16_t*)(ws + WS_W); bf16_t* XB = (bf16_t*)(ws + WS_XB); float* SSQ = (float*)(ws + WS_SSQ); float* X = p.out;
    bf16_t* XBn = (bf16_t*)p.out; float* SSQn = (float*)(ws + WS_BIG + B_SSQ2);
    float* ROPE = (float*)(ws + WS_SMALL + SM_ROPE); float* RSQ = (float*)(ws + WS_SMALL + SM_RSQ); float* RSKV = (float*)(ws + WS_SMALL + SM_RSKV);
    float* MEANV = (float*)(ws + WS_SMALL + SM_MEANV); float* RSTDV = (float*)(ws + WS_SMALL + SM_RSTDV); float* SP8 = (float*)(ws + WS_SMALL + SM_SP8);
    unsigned char* big = ws + WS_BIG;
    bf16_t* H = (bf16_t*)(big + B_H); bf16_t* PB = (bf16_t*)(big + B_PB); bf16_t* GP = (bf16_t*)(big + B_GP);
    bf16_t* Z = (bf16_t*)(big + B_Z); bf16_t* VTS = (bf16_t*)(big + B_VTS); bf16_t* XC = (bf16_t*)(big + B_XC); bf16_t* LA = (bf16_t*)(big + B_LA); bf16_t* U = (bf16_t*)(big + B_U);
    bf16_t* Q = (bf16_t*)(big + B_Q); bf16_t* KN = (bf16_t*)(big + B_KN); bf16_t* VT = (bf16_t*)(big + B_VT); bf16_t* KR = (bf16_t*)(big + B_KR);
    bf16_t* G3 = (bf16_t*)(big + B_G3); bf16_t* MG = (bf16_t*)(big + B_MERGED);

#pragma unroll 1
    for (int L = 0; L < 2; ++L) {
        phase0(p, L, lds, G, blk);
        GRID_SYNC();
        { EpiSwiglu e{H, SSQ}; RUN_GEMM(EpiSwiglu, e, XB, wb + O_WGU1, T, 2 * DFF, 1024, 1024, 1024, 0); }
        GRID_SYNC();
        { EpiResid<false> e{L == 0 ? p.in[0] : nullptr, XB, SSQ, nullptr, 0.5f}; RUN_GEMM(EpiResid<false>, e, H, wb + O_WD1, T, 1024, DFF, DFF, DFF, 0); }
        GRID_SYNC();
#pragma unroll 1
        for (int c = 0; c <= 2; ++c) {
            if (c >= 1) { const size_t q0 = (size_t)(c - 1) * TC;
                EpiResid<false> e{nullptr, XB + q0 * DM, SSQ + q0 * 4, nullptr, 1.0f}; RUN_GEMM(EpiResid<false>, e, MG, wb + O_WOUT, TC, 1024, 1024, 1024, 1024, 0); }
            const size_t r0 = (size_t)c * TC;
            if (c <= 1) {
                { EpiRow<1, 0> e{Z, ZLD, SSQ + r0 * 4, nullptr, 4, 12, 0}; RUN_GEMM((EpiRow<1, 0>), e, XB + r0 * DM, wb + O_WIN, TC, ZLD, 1024, 1024, 1024, 0); }
                { EpiCol<1, 0> e{VTS, TC, SSQ + r0 * 4}; RUN_GEMM((EpiCol<1, 0>), e, wb + O_WINV, XB + r0 * DM, 1024, TC, 1024, 1024, 1024, 0); }
            }
            GRID_SYNC();
            if (c > 1) break;
            e1_rows(p, L, Z, XC, RSQ, RSKV, KR, ROPE, G, blk);
            e2_stats(lds, VTS, MEANV, RSTDV, G, blk);
            GRID_SYNC();
            { EpiLru e{XC, LA, U, p.in[10] + L * 1024, p.in[12] + L * 1024, SP8}; RUN_GEMM(EpiLru, e, XC, wb + O_WLRU, TC, 2048, 128, 1024, 128, 128); }
            { EpiQ e{Q, RSQ, ROPE}; RUN_GEMM(EpiQ, e, Z + ZC_CQ, wb + O_WUQ, TC, 1536, 384, ZLD, 384, 0); }
            { EpiRow<0, 1> e{KN, 1024, RSKV, nullptr, 0, 0, 0}; RUN_GEMM((EpiRow<0, 1>), e, Z + ZC_CKV, wb + O_WKVK, TC, 1024, 256, ZLD, 256, 0); }
            { EpiCol<0, 1> e{VT, TC, RSKV}; RUN_GEMM((EpiCol<0, 1>), e, wb + O_WKVV, Z + ZC_CKV, 1024, TC, 256, 256, ZLD, 0); }
            GRID_SYNC();
            scan_units(lds, LA, U, Z, G, blk);
            attn_units(lds, Q, KN, KR, VT, Z, G, blk);
            sgu_units(lds, VTS, MEANV, RSTDV, p.in[20] + L * 1024, p.in[21] + L * 1024, wb + O_WSGU, p.in[23] + L * 1024, Z, G, blk);
            GRID_SYNC();
            { EpiRow<2, 0> e{G3, 3072, SSQ + r0 * 4, p.in[25] + L * 3072, 0, 0, 1}; RUN_GEMM((EpiRow<2, 0>), e, XB + r0 * DM, wb + O_WING, TC, 3072, 1024, 1024, 1024, 0); }
#undef APS
#define APS 2
            { EpiMerge e{G3, MG}; RUN_GEMM(EpiMerge, e, Z, wb + O_WRA, TC, 3072, 1024, ZLD, 1024, 1024); }
#undef APS
#define APS 0
            GRID_SYNC();
        }
        { EpiSwiglu e{H, SSQ}; RUN_GEMM(EpiSwiglu, e, XB, wb + O_WGU2, T, 2 * DFF, 1024, 1024, 1024, 0); }
        { EpiRow<0, 2> e{GP, 1024, nullptr, nullptr, 0, 0, 0}; RUN_GEMM((EpiRow<0, 2>), e, PB, wb + O_WPLE, T, 1024, 256, 256, 256, 0); }
        GRID_SYNC();
        { EpiResid<false> e{nullptr, XB, SSQ, nullptr, 0.5f}; RUN_GEMM(EpiResid<false>, e, H, wb + O_WD2, T, 1024, DFF, DFF, DFF, 0); }
        GRID_SYNC();
        { EpiPle e{XB, XBn, GP, SSQ, SSQn}; RUN_GEMM(EpiPle, e, XB, wb + O_WPG, T, 1024, 1024, 1024, 1024, 0); }
        GRID_SYNC();
        { bf16_t* tx = XB; XB = XBn; XBn = tx; float* ts = SSQ; SSQ = SSQn; SSQn = ts; }
    }
    {
        const int tid = pg8::tid_opaque(), lane = tid & 63, wave = tid >> 6, gw = blk * 8 + wave, NGW = G * 8; const float* fn = p.in[33];
        for (int m = gw; m < T; m += NGW) {
            const u32x4* xr = (const u32x4*)(XB + (size_t)m * DM) + lane; f32x4* orow = (f32x4*)(X + (size_t)m * DM); f32x4 v[4]; float s = 0.f;
#pragma unroll
            for (int j = 0; j < 2; ++j) { unpack8(xr[64 * j], v[2 * j], v[2 * j + 1]); }
#pragma unroll
            for (int j = 0; j < 4; ++j) s += (v[j][0] * v[j][0] + v[j][1] * v[j][1]) + (v[j][2] * v[j][2] + v[j][3] * v[j][3]);
            const float rstd = __builtin_amdgcn_rsqf(wave_sum(s) * (1.f / 1024.f) + EPS);
#pragma unroll
            for (int j = 0; j < 2; ++j) { const int c = 512 * j + 8 * lane; orow[c / 4] = v[2 * j] * rstd * *(const f32x4*)(fn + c); orow[c / 4 + 1] = v[2 * j + 1] * rstd * *(const f32x4*)(fn + c + 4); }
        }
    }
}

extern "C" void kernel_launch(void* const* d_in, const int* in_sizes, int n_in, void* d_out, int out_size, void* d_ws, size_t ws_size, hipStream_t stream) {
    static int grid = 0;
    if (grid == 0) {
        if (n_in != 34 || ws_size < WS_NEED) { fprintf(stderr, "kernel_launch: unexpected n_in %d / ws_size %zu (need %zu)\n", n_in, ws_size, (size_t)WS_NEED); grid = -1; return; }
        int dev = 0, cus = 0, per = 0;
        (void)hipGetDevice(&dev); (void)hipDeviceGetAttribute(&cus, hipDeviceAttributeMultiprocessorCount, dev);
        (void)hipFuncSetAttribute((const void*)fwd_kernel, hipFuncAttributeMaxDynamicSharedMemorySize, LDS_BYTES);
        if (hipOccupancyMaxActiveBlocksPerMultiprocessor(&per, (const void*)fwd_kernel, 512, LDS_BYTES) != hipSuccess || per < 1) per = 1;
        (void)hipGetLastError();
        grid = cus * per;
    }
    if (grid < 0) return;
    (void)hipMemsetAsync((unsigned char*)d_ws + WS_SMALL + SM_BAR, 0, 16384, stream);
    Params prm{};
    for (int i = 0; i < 34; ++i) prm.in[i] = (const float*)d_in[i];
    prm.out = (float*)d_out; prm.ws = (unsigned char*)d_ws;
    void* args[] = {&prm};
    hipError_t e = hipLaunchCooperativeKernel((const void*)fwd_kernel, dim3(grid), dim3(512), args, LDS_BYTES, stream);
    if (e != hipSuccess) fprintf(stderr, "cooperative launch failed: %s (grid %d)\n", hipGetErrorString(e), grid);
}
```

```cpp
#include <hip/hip_runtime.h>
#include <hip/hip_cooperative_groups.h>
#include <cstdio>
#include <cstdint>
namespace cg = cooperative_groups;
namespace pg8 {
#define PG8_LAS __attribute__((address_space(3)))
typedef unsigned short bf16_t;
typedef short bf16x8 __attribute__((ext_vector_type(8)));
typedef float f32x4 __attribute__((ext_vector_type(4)));
typedef unsigned u32x4 __attribute__((ext_vector_type(4)));
typedef unsigned u32x2 __attribute__((ext_vector_type(2)));
constexpr int BM = 256, BK = 64, HALF = 128, HTB = HALF * BK * 2  , STAGE_BYTES = 8 * HTB, NXCD = 8, WGM = 8;

__host__ __device__ __forceinline__ int lds_byte(int r, int c) { const int st = (r >> 4) * 2 + (c >> 5), rr = r & 15, cc = c & 31, ob = rr * 64 + cc * 2; return st * 1024 + (ob ^ (((ob >> 9) & 1) << 5)); }
__host__ __device__ __forceinline__ void stage_rc(int b, int& R, int& C) { const int st = b / 1024, sb = b % 1024, swz = sb ^ (((sb >> 9) & 1) << 5); R = (st >> 1) * 16 + swz / 64; C = (st & 1) * 32 + (swz % 64) / 2; }
__host__ __device__ __forceinline__ int perm32(int rho) { const int n = rho >> 4, i = rho & 15; return 8 * (i >> 2) + 4 * n + (i & 3); }

struct Unit { int pm, pn; };
struct Gemm { const bf16_t* A; const bf16_t* Bt; int M, N, K, lda, ldb, apn, aps; };

struct StaticOrder {
    int nM, nN, nwg, G, c;
    __host__ __device__ void init(int M, int N, int G_, int c_) { nM = M / BM; nN = N / BM; nwg = nM * nN; G = G_; c = c_; }
    __host__ __device__ bool next(int i, Unit& u) const {
        const long L = (long)i * G + c; if (L >= nwg) return false;
        int wgid = (int)L; { const int q = nwg / NXCD, r = nwg % NXCD, xcd = wgid % NXCD, off = wgid / NXCD; wgid = (xcd < r ? xcd * (q + 1) : r * (q + 1) + (xcd - r) * q) + off; }
        const int nig = WGM * nN, gid = wgid / nig, fm = gid * WGM, gsz = (nM - fm) < WGM ? (nM - fm) : WGM;
        u.pm = fm + ((wgid % nig) % gsz); u.pn = (wgid % nig) / gsz; return true;
    }
    __device__ __forceinline__ void a_ready(const Unit&) const {}
    __device__ __forceinline__ void done(const Unit&) const {}
};
__device__ __forceinline__ int tid_opaque() { int t = threadIdx.x; asm volatile("" : "+v"(t)); return t; }
typedef float f32x2_t __attribute__((ext_vector_type(2))); typedef __bf16 bf16x2_t __attribute__((ext_vector_type(2)));
__device__ __forceinline__ unsigned cvt_pk_bf16(float lo, float hi) { const f32x2_t v = {lo, hi}; const bf16x2_t b = __builtin_convertvector(v, bf16x2_t); return __builtin_bit_cast(unsigned, b); }

template <class Epi, class Sched, bool ALIGN_EPI = false, bool SP2 = false>
__device__ __forceinline__ void gemm_phase(PG8_LAS unsigned char* lds, const Gemm g, const Sched& S, const Epi& E) {
    const int tid = pg8::tid_opaque(), wid = __builtin_amdgcn_readfirstlane(tid >> 6), lane = tid & 63, wr = wid >> 2, wc = wid & 3, fr = lane & 15, fq = lane >> 4;
    const int K = g.K, nt = K / BK;
    unsigned voffA[2], voffB[2];
#pragma unroll
    for (int i = 0; i < 2; ++i) { int R, C; stage_rc(tid * 16 + i * 8192, R, C); const int Rb = Epi::PERM ? ((R & ~31) + perm32(R & 31)) : R;
        voffA[i] = (unsigned)(R * g.lda + C) * 2u; voffB[i] = (unsigned)(Rb * g.ldb + C) * 2u; }
    const size_t kstep = (size_t)(BK * 2);
    const size_t hstepA = (size_t)HALF * g.lda * 2, hstepB = (size_t)HALF * g.ldb * 2;
    const size_t tstepA = 2 * hstepA, tstepB = 2 * hstepB; const size_t apn = (size_t)g.apn * 2;
    const unsigned ldsw = (unsigned)wid * 1024u;
    const int aoff = lds_byte(wr * 64 + fr, fq * 8), boff = lds_byte(wc * 32 + fr, fq * 8);
#define PG8_SA(b, h) (((b) * 2 + (h)) * HTB)
#define PG8_SB(b, h) ((4 + (b) * 2 + (h)) * HTB)
#define PG8_STAGE(bufoff, gbase, voff) do { _Pragma("unroll") for (int _i = 0; _i < 2; ++_i) \
        __builtin_amdgcn_global_load_lds((const unsigned*)((const char*)(gbase) + (voff)[_i]), (PG8_LAS unsigned*)(lds + (bufoff) + ldsw + _i * 8192), 16, 0, 0); } while (0)
#define PG8_LDA(dst, b, h) do { _Pragma("unroll") for (int m = 0; m < 4; ++m) _Pragma("unroll") for (int k = 0; k < 2; ++k) dst[m][k] = *(const PG8_LAS bf16x8*)(lds + PG8_SA(b, h) + aoff + m * 2048 + k * 1024); } while (0)
#define PG8_LDB(dst, b, h) do { _Pragma("unroll") for (int n = 0; n < 2; ++n) _Pragma("unroll") for (int k = 0; k < 2; ++k) dst[n][k] = *(const PG8_LAS bf16x8*)(lds + PG8_SB(b, h) + boff + n * 2048 + k * 1024); } while (0)
#define PG8_MMA(ai, bj, At, Bt) do { __builtin_amdgcn_s_setprio(1); _Pragma("unroll") for (int m = 0; m < 4; ++m) _Pragma("unroll") for (int n = 0; n < 2; ++n) _Pragma("unroll") for (int k = 0; k < 2; ++k) \
        acc[ai][bj][m][n] = __builtin_amdgcn_mfma_f32_16x16x32_bf16(Bt[n][k], At[m][k], acc[ai][bj][m][n], 0, 0, 0); __builtin_amdgcn_s_setprio(0); } while (0)
#define PG8_WAIT_V(n) asm volatile("s_waitcnt vmcnt(" #n ")" ::: "memory")
#define PG8_WAIT_L(n) asm volatile("s_waitcnt lgkmcnt(" #n ")" ::: "memory")
#define PG8_BAR __builtin_amdgcn_s_barrier()
#define PG8_SCHED __builtin_amdgcn_sched_barrier(0)
    Unit cur, nxt; int ui = 0;
    if (!S.next(0, cur)) return;
    f32x4 acc[2][2][4][2];
#pragma unroll
    for (int a = 0; a < 2; ++a)
#pragma unroll
        for (int b = 0; b < 2; ++b)
#pragma unroll
            for (int m = 0; m < 4; ++m)
#pragma unroll
                for (int n = 0; n < 2; ++n) acc[a][b][m][n] = (f32x4){0.f, 0.f, 0.f, 0.f};
    bf16x8 At[4][2], B0[2][2], B1[2][2];
    const char* cA = (const char*)g.A + (size_t)cur.pm * tstepA + (size_t)(cur.pn >> g.aps) * apn; const char* cB = (const char*)g.Bt + (size_t)cur.pn * tstepB;
    S.a_ready(cur);
    if constexpr (SP2) {
        PG8_STAGE(PG8_SB(0, 0), cB, voffB); PG8_STAGE(PG8_SB(0, 1), cB + hstepB, voffB); PG8_STAGE(PG8_SA(0, 0), cA, voffA); PG8_STAGE(PG8_SA(0, 1), cA + hstepA, voffA);
        if (wr == 1) PG8_BAR;
        PG8_WAIT_V(2); PG8_BAR;
        PG8_STAGE(PG8_SB(1, 0), cB + kstep, voffB); PG8_STAGE(PG8_SA(1, 0), cA + kstep, voffA); PG8_STAGE(PG8_SB(1, 1), cB + hstepB + kstep, voffB);
        PG8_WAIT_V(6); PG8_BAR;
    } else {
        PG8_STAGE(PG8_SB(0, 0), cB, voffB); PG8_STAGE(PG8_SA(0, 0), cA, voffA); PG8_STAGE(PG8_SB(0, 1), cB + hstepB, voffB); PG8_STAGE(PG8_SA(0, 1), cA + hstepA, voffA);
        if (wr == 1) PG8_BAR;
        PG8_WAIT_V(4); PG8_BAR;
        PG8_STAGE(PG8_SB(1, 0), cB + kstep, voffB); PG8_STAGE(PG8_SA(1, 0), cA + kstep, voffA); PG8_STAGE(PG8_SB(1, 1), cB + hstepB + kstep, voffB);
        PG8_WAIT_V(6); PG8_BAR;
    }
    for (;;) {
        const bool has_next = S.next(ui + 1, nxt);
        const char* nA = has_next ? (const char*)g.A + (size_t)nxt.pm * tstepA + (size_t)(nxt.pn >> g.aps) * apn : cA; const char* nB = has_next ? (const char*)g.Bt + (size_t)nxt.pn * tstepB : cB;
        for (int t = 0; t < nt; t += 2) {
            const bool last = (t == nt - 2);
            const char* a1 = cA + (size_t)(t + 1) * kstep;
            const char* a2 = last ? nA : cA + (size_t)(t + 2) * kstep; const char* b2 = last ? nB : cB + (size_t)(t + 2) * kstep;
            const char* a3 = a2 + kstep; const char* b3 = b2 + kstep;
            if (last && has_next) S.a_ready(nxt);
            if constexpr (SP2) {
            PG8_LDB(B0, 0, 0); PG8_LDB(B1, 0, 1); PG8_SCHED; PG8_LDA(At, 0, 0); PG8_STAGE(PG8_SA(1, 1), a1 + hstepA, voffA);
            PG8_WAIT_V(8); PG8_WAIT_L(0); PG8_BAR; PG8_MMA(0, 0, At, B0); PG8_MMA(0, 1, At, B1); PG8_BAR; PG8_SCHED;
            PG8_LDA(At, 0, 1); PG8_STAGE(PG8_SB(0, 0), b2, voffB); PG8_STAGE(PG8_SB(0, 1), b2 + hstepB, voffB); PG8_STAGE(PG8_SA(0, 0), a2, voffA);
            PG8_WAIT_V(8); PG8_WAIT_L(0); PG8_BAR; PG8_MMA(1, 0, At, B0); PG8_MMA(1, 1, At, B1); PG8_BAR; PG8_SCHED;
            PG8_LDB(B0, 1, 0); PG8_LDB(B1, 1, 1); PG8_SCHED; PG8_LDA(At, 1, 0); PG8_STAGE(PG8_SA(0, 1), a2 + hstepA, voffA);
            PG8_WAIT_V(8); PG8_WAIT_L(0); PG8_BAR; PG8_MMA(0, 0, At, B0); PG8_MMA(0, 1, At, B1); PG8_BAR; PG8_SCHED;
            PG8_LDA(At, 1, 1); PG8_STAGE(PG8_SB(1, 0), b3, voffB); PG8_STAGE(PG8_SB(1, 1), b3 + hstepB, voffB); PG8_STAGE(PG8_SA(1, 0), a3, voffA);
            PG8_WAIT_V(8); PG8_WAIT_L(0); PG8_BAR; PG8_MMA(1, 0, At, B0); PG8_MMA(1, 1, At, B1); PG8_BAR; PG8_SCHED;
            } else {
            PG8_LDB(B0, 0, 0); PG8_SCHED; PG8_LDA(At, 0, 0); PG8_STAGE(PG8_SA(1, 1), a1 + hstepA, voffA);
            PG8_WAIT_L(8); PG8_BAR; PG8_WAIT_L(0); PG8_MMA(0, 0, At, B0); PG8_BAR; PG8_SCHED;
            PG8_LDB(B1, 0, 1); PG8_STAGE(PG8_SB(0, 0), b2, voffB);
            PG8_BAR; PG8_WAIT_L(0); PG8_MMA(0, 1, At, B1); PG8_BAR;
            PG8_LDA(At, 0, 1); PG8_STAGE(PG8_SA(0, 0), a2, voffA);
            PG8_BAR; PG8_WAIT_L(0); PG8_MMA(1, 0, At, B0); PG8_BAR; PG8_SCHED;
            PG8_STAGE(PG8_SB(0, 1), b2 + hstepB, voffB);
            PG8_WAIT_V(6); PG8_BAR; PG8_MMA(1, 1, At, B1); PG8_BAR;
            PG8_LDB(B0, 1, 0); PG8_SCHED; PG8_LDA(At, 1, 0); PG8_STAGE(PG8_SA(0, 1), a2 + hstepA, voffA);
            PG8_WAIT_L(8); PG8_BAR; PG8_WAIT_L(0); PG8_MMA(0, 0, At, B0); PG8_BAR; PG8_SCHED;
            PG8_LDB(B1, 1, 1); PG8_STAGE(PG8_SB(1, 0), b3, voffB);
            PG8_BAR; PG8_WAIT_L(0); PG8_MMA(0, 1, At, B1); PG8_BAR;
            PG8_LDA(At, 1, 1); PG8_STAGE(PG8_SA(1, 0), a3, voffA);
            PG8_BAR; PG8_WAIT_L(0); PG8_MMA(1, 0, At, B0); PG8_BAR; PG8_SCHED;
            PG8_STAGE(PG8_SB(1, 1), b3 + hstepB, voffB);
            PG8_WAIT_V(6); PG8_BAR; PG8_MMA(1, 1, At, B1); PG8_BAR;
            }
        }
        if constexpr (ALIGN_EPI) { if (wr == 0) PG8_BAR; }
        if constexpr (!Epi::AFTER_DRAIN) { E(acc, cur, wr, wc, fr, fq); S.done(cur); }
        if (!has_next) break;
#pragma unroll
        for (int a = 0; a < 2; ++a)
#pragma unroll
            for (int b = 0; b < 2; ++b)
#pragma unroll
                for (int m = 0; m < 4; ++m)
#pragma unroll
                    for (int n = 0; n < 2; ++n) acc[a][b][m][n] = (f32x4){0.f, 0.f, 0.f, 0.f};
        cur = nxt; cA = nA; cB = nB; ++ui;
        if constexpr (ALIGN_EPI) { if (wr == 1) PG8_BAR; }
    }
    PG8_WAIT_V(0);
    if constexpr (!ALIGN_EPI) { if (wr == 0) PG8_BAR; }
    PG8_BAR;
    if constexpr (Epi::AFTER_DRAIN) { E.fused(acc, cur, wr, wc, fr, fq, lds, wid, lane); S.done(cur); }
#undef PG8_SA
#undef PG8_SB
#undef PG8_STAGE
#undef PG8_LDA
#undef PG8_LDB
#undef PG8_MMA
#undef PG8_WAIT_V
#undef PG8_WAIT_L
#undef PG8_BAR
#undef PG8_SCHED
}
}

using pg8::bf16_t; using pg8::bf16x8; using pg8::f32x4; using pg8::u32x4; using pg8::u32x2; using pg8::Unit; using pg8::cvt_pk_bf16;
typedef float f32x16 __attribute__((ext_vector_type(16)));
typedef float f32x2 __attribute__((ext_vector_type(2)));
#define LAS __attribute__((address_space(3)))

constexpr int T = 32768, DM = 1024, TC = 16384, DFF = 2816, ZLD = 3840;
constexpr int ZC_XA = 0, ZC_GA = 1024, ZC_U = 2048, ZC_CKV = 3072, ZC_CQ = 3328, ZC_KR = 3712;
constexpr float EPS = 1e-6f, LOG2E = 1.4426950408889634f;
constexpr float QSCALE = 0.10206207261596577f * 1.4426950408889634f;
constexpr size_t MiB = (size_t)1 << 20;
constexpr size_t WS_W = 0, WS_XB = 64 * MiB, WS_SSQ = 128 * MiB, WS_SMALL = 130 * MiB, WS_BIG = 132 * MiB;
constexpr size_t SM_ROPE = 0, SM_RSQ = 256 * 1024, SM_RSKV = 320 * 1024, SM_MEANV = 384 * 1024, SM_RSTDV = 448 * 1024, SM_SP8 = 512 * 1024;
constexpr size_t B_H = 0, B_PB = 361 * MiB, B_GP = 192 * MiB, B_SSQ2 = 377 * MiB;
constexpr size_t B_Z = 0, B_VTS = 120 * MiB, B_XC = 152 * MiB, B_LA = 184 * MiB, B_U = 216 * MiB, B_Q = 248 * MiB, B_KN = 296 * MiB, B_VT = 328 * MiB, B_KR = 360 * MiB;
constexpr size_t B_G3 = 248 * MiB, B_MERGED = 184 * MiB;
constexpr size_t WS_NEED = WS_BIG + 379 * MiB;
constexpr size_t O_WGU1 = 0, O_WD1 = O_WGU1 + 5632 * 1024, O_WIN = O_WD1 + 1024 * 2816, O_WINV = O_WIN + 3840 * 1024, O_WING = O_WINV + 1024 * 1024,
                 O_WLRU = O_WING + 3072 * 1024, O_WRA = O_WLRU + 2048 * 128, O_WRB = O_WRA + 1024 * 1024, O_WRC = O_WRB + 1024 * 1024, O_WOUT = O_WRC + 1024 * 1024,
                 O_WPG = O_WOUT + 1024 * 1024, O_WUQ = O_WPG + 1024 * 1024, O_WKVK = O_WUQ + 1536 * 384, O_WKVV = O_WKVK + 1024 * 256, O_WGU2 = O_WKVV + 1024 * 256,
                 O_WD2 = O_WGU2 + 5632 * 1024, O_WPLE = O_WD2 + 1024 * 2816, O_WSGU = O_WPLE + 1024 * 256, O_WEND = O_WSGU + 8 * 128 * 128;
static_assert(O_WEND * 2 <= 64 * MiB, "weights fit");
constexpr int LDS_BYTES = 131072 + 256;
#ifndef DBG_STOP
#define DBG_STOP 0
#endif
#ifndef DBG_BR
#define DBG_BR 7
#endif

struct Params { const float* in[34]; float* out; unsigned char* ws; };

__device__ __forceinline__ float fexp2(float x) { return __builtin_amdgcn_exp2f(x); }
__device__ __forceinline__ float frcp(float x) { return __builtin_amdgcn_rcpf(x); }
__device__ __forceinline__ float sigm(float x) { return frcp(1.f + fexp2(-LOG2E * x)); }
__device__ __forceinline__ float gelu_t(float x) { const float t = x + 0.044715f * x * x * x; return x * frcp(1.f + fexp2(-2.3022081985f * t)); }
__device__ __forceinline__ float bflo(unsigned w) { return __uint_as_float(w << 16); }
__device__ __forceinline__ float bfhi(unsigned w) { return __uint_as_float(w & 0xffff0000u); }
__device__ __forceinline__ bf16_t f2bf(float v) { return (bf16_t)(cvt_pk_bf16(v, 0.f) & 0xffffu); }
__device__ __forceinline__ float wave_sum(float v) {
#pragma unroll
    for (int o = 1; o < 64; o <<= 1) v += __shfl_xor(v, o);
    return v;
}
constexpr size_t SSQ_PLANE = (size_t)T * 4;
__device__ __forceinline__ float rstd16(const float* ssq, size_t row) {
    const float* q = ssq + row * 4; const f32x4 a = *(const f32x4*)q, b = *(const f32x4*)(q + SSQ_PLANE), c = *(const f32x4*)(q + 2 * SSQ_PLANE), d = *(const f32x4*)(q + 3 * SSQ_PLANE);
    const float s = ((a.x + a.y) + (a.z + a.w)) + ((b.x + b.y) + (b.z + b.w)) + ((c.x + c.y) + (c.z + c.w)) + ((d.x + d.y) + (d.z + d.w));
    return __builtin_amdgcn_rsqf(s * (1.0f / 1024.0f) + EPS);
}
__device__ __forceinline__ u32x4 pack8(const f32x4 v0, const f32x4 v1) { u32x4 w; w.x = cvt_pk_bf16(v0[0], v0[1]); w.y = cvt_pk_bf16(v0[2], v0[3]); w.z = cvt_pk_bf16(v1[0], v1[1]); w.w = cvt_pk_bf16(v1[2], v1[3]); return w; }
__device__ __forceinline__ void unpack8(const u32x4 w, f32x4& v0, f32x4& v1) { v0 = (f32x4){bflo(w.x), bfhi(w.x), bflo(w.y), bfhi(w.y)}; v1 = (f32x4){bflo(w.z), bfhi(w.z), bflo(w.w), bfhi(w.w)}; }

template <int MODE> __device__ __forceinline__ void row_scales(const float* rs, int pm, int wr, int fr, int fq, float (&sc)[2][4]) {
    if (MODE == 2) {
#pragma unroll
        for (int m = 0; m < 4; ++m) { sc[0][m] = 1.f; sc[1][m] = 1.f; }
        return; }
    const int lane = fq * 16 + fr; const size_t r = (size_t)pm * 256 + wr * 64 + lane;
    const float sA = (MODE == 0) ? rstd16(rs, r) : rs[r], sB = (MODE == 0) ? rstd16(rs, r + 128) : rs[r + 128];
#pragma unroll
    for (int m = 0; m < 4; ++m) { sc[0][m] = __shfl(sA, 16 * m + fr); sc[1][m] = __shfl(sB, 16 * m + fr); }
}
template <int ACT, int RS> struct EpiRow {
    static constexpr bool PERM = true, AFTER_DRAIN = false;
    bf16_t* O; int ldc; const float* rs; const float* bias; int t0, t1; int bswap;
    __device__ __forceinline__ void operator()(const f32x4 (&acc)[2][2][4][2], const Unit& u, int wr, int wc, int fr, int fq) const {
        const int row0 = u.pm * 256 + wr * 64 + fr, col0 = u.pn * 256 + wc * 32 + 8 * fq;
        const bool act = (ACT == 1) ? (u.pn >= t0 && u.pn < t1) : true;
        float scl[2][4]; row_scales<RS>(rs, u.pm, wr, fr, fq, scl);
        f32x4 bv[2][2];
#pragma unroll
        for (int bj = 0; bj < 2; ++bj)
#pragma unroll
            for (int n = 0; n < 2; ++n) bv[bj][n] = bias ? *(const f32x4*)(bias + col0 + (bswap ? (u.pn < 4 ? 1024 : (u.pn < 8 ? -1024 : 0)) : 0) + bj * 128 + 4 * n) : (f32x4){0.f, 0.f, 0.f, 0.f};
#pragma unroll
        for (int ai = 0; ai < 2; ++ai)
#pragma unroll
            for (int m = 0; m < 4; ++m) {
                const size_t row = (size_t)(row0 + ai * 128 + m * 16); const float s = scl[ai][m];
                bf16_t* rowp = O + row * ldc + col0;
#pragma unroll
                for (int bj = 0; bj < 2; ++bj) {
                    f32x4 v0 = acc[ai][bj][m][0] * s + bv[bj][0], v1 = acc[ai][bj][m][1] * s + bv[bj][1];
                    if (ACT == 1) { if (act) {
#pragma unroll
                        for (int e = 0; e < 4; ++e) { v0[e] = gelu_t(v0[e]); v1[e] = gelu_t(v1[e]); } } }
                    if (ACT == 2) {
#pragma unroll
                        for (int e = 0; e < 4; ++e) { v0[e] = sigm(v0[e]); v1[e] = sigm(v1[e]); } }
                    *(u32x4*)(rowp + bj * 128) = pack8(v0, v1);
                }
                asm volatile("" ::: "memory");
            }
    }
};
struct EpiSwiglu {
    static constexpr bool PERM = true, AFTER_DRAIN = false;
    bf16_t* H; const float* ssq;
    __device__ __forceinline__ void operator()(const f32x4 (&acc)[2][2][4][2], const Unit& u, int wr, int wc, int fr, int fq) const {
        const int row0 = u.pm * 256 + wr * 64 + fr, col0 = u.pn * 128 + wc * 32 + 8 * fq;
        float scl[2][4]; row_scales<0>(ssq, u.pm, wr, fr, fq, scl);
#pragma unroll
        for (int ai = 0; ai < 2; ++ai)
#pragma unroll
            for (int m = 0; m < 4; ++m) {
                const size_t row = (size_t)(row0 + ai * 128 + m * 16); const float s = scl[ai][m];
                f32x4 h0, h1;
#pragma unroll
                for (int e = 0; e < 4; ++e) { const float g0 = acc[ai][0][m][0][e] * s, g1 = acc[ai][0][m][1][e] * s; h0[e] = g0 * sigm(g0) * (acc[ai][1][m][0][e] * s); h1[e] = g1 * sigm(g1) * (acc[ai][1][m][1][e] * s); }
                *(u32x4*)(H + row * DFF + col0) = pack8(h0, h1);
                asm volatile("" ::: "memory");
            }
    }
};
template <bool GATED> struct EpiResid {
    static constexpr bool PERM = true, AFTER_DRAIN = false;
    const float* X32; bf16_t* XB; float* ssq; const bf16_t* GP; float alpha;
    __device__ __forceinline__ void ld(size_t o, f32x4 (&x)[2][2]) const {
#pragma unroll
        for (int bj = 0; bj < 2; ++bj) { if (X32) { x[bj][0] = *(const f32x4*)(X32 + o + bj * 128); x[bj][1] = *(const f32x4*)(X32 + o + bj * 128 + 4); } else unpack8(*(const u32x4*)(XB + o + bj * 128), x[bj][0], x[bj][1]); }
    }
    __device__ __forceinline__ void operator()(const f32x4 (&acc)[2][2][4][2], const Unit& u, int wr, int wc, int fr, int fq) const {
        const int row0 = u.pm * 256 + wr * 64 + fr, col0 = u.pn * 256 + wc * 32 + 8 * fq;
        f32x4 xc[2][2], xn[2][2];
        ld((size_t)row0 * DM + col0, xc);
#pragma unroll
        for (int g = 0; g < 8; ++g) {
            const int ai = g >> 2, m = g & 3; const size_t row = (size_t)(row0 + ai * 128 + m * 16); float ss = 0.f;
            if (g < 7) ld((size_t)(row0 + ((g + 1) >> 2) * 128 + ((g + 1) & 3) * 16) * DM + col0, xn);
#pragma unroll
            for (int bj = 0; bj < 2; ++bj) {
                const size_t o = row * DM + col0 + bj * 128; f32x4 a0 = acc[ai][bj][m][0] * alpha, a1 = acc[ai][bj][m][1] * alpha;
                if (GATED) { f32x4 g0, g1; unpack8(*(const u32x4*)(GP + o), g0, g1); a0 *= g0; a1 *= g1; }
                const f32x4 x0 = xc[bj][0] + a0, x1 = xc[bj][1] + a1;
                *(u32x4*)(XB + o) = pack8(x0, x1);
                ss += (x0[0] * x0[0] + x0[1] * x0[1]) + (x0[2] * x0[2] + x0[3] * x0[3]) + (x1[0] * x1[0] + x1[1] * x1[1]) + (x1[2] * x1[2] + x1[3] * x1[3]);
            }
            ss += __shfl_xor(ss, 16); ss += __shfl_xor(ss, 32);
            if (fq == 0) ssq[(size_t)u.pn * SSQ_PLANE + row * 4 + wc] = ss;
#pragma unroll
            for (int bj = 0; bj < 2; ++bj) { xc[bj][0] = xn[bj][0]; xc[bj][1] = xn[bj][1]; }
        }
    }
};
struct EpiPle {
    static constexpr bool PERM = true, AFTER_DRAIN = false;
    const bf16_t* XBc; bf16_t* XBn; const bf16_t* PP; const float* ssqc; float* ssqn;
    __device__ __forceinline__ void ld(size_t o, u32x4 (&w)[2][2]) const {
#pragma unroll
        for (int bj = 0; bj < 2; ++bj) { w[bj][0] = *(const u32x4*)(PP + o + bj * 128); w[bj][1] = *(const u32x4*)(XBc + o + bj * 128); }
    }
    __device__ __forceinline__ void operator()(const f32x4 (&acc)[2][2][4][2], const Unit& u, int wr, int wc, int fr, int fq) const {
        const int row0 = u.pm * 256 + wr * 64 + fr, col0 = u.pn * 256 + wc * 32 + 8 * fq;
        float scl[2][4]; row_scales<0>(ssqc, u.pm, wr, fr, fq, scl);
        u32x4 wc_[2][2], wn_[2][2];
        ld((size_t)row0 * DM + col0, wc_);
#pragma unroll
        for (int g = 0; g < 8; ++g) {
            const int ai = g >> 2, m = g & 3; const size_t row = (size_t)(row0 + ai * 128 + m * 16); const float s = scl[ai][m]; float ss = 0.f;
            if (g < 7) ld((size_t)(row0 + ((g + 1) >> 2) * 128 + ((g + 1) & 3) * 16) * DM + col0, wn_);
#pragma unroll
            for (int bj = 0; bj < 2; ++bj) {
                const size_t o = row * DM + col0 + bj * 128; f32x4 p0, p1, x0, x1; unpack8(wc_[bj][0], p0, p1); unpack8(wc_[bj][1], x0, x1);
                const f32x4 v0 = acc[ai][bj][m][0] * s, v1 = acc[ai][bj][m][1] * s;
#pragma unroll
                for (int e = 0; e < 4; ++e) { x0[e] += p0[e] * sigm(v0[e]); x1[e] += p1[e] * sigm(v1[e]); }
                *(u32x4*)(XBn + o) = pack8(x0, x1);
                ss += (x0[0] * x0[0] + x0[1] * x0[1]) + (x0[2] * x0[2] + x0[3] * x0[3]) + (x1[0] * x1[0] + x1[1] * x1[1]) + (x1[2] * x1[2] + x1[3] * x1[3]);
            }
            ss += __shfl_xor(ss, 16); ss += __shfl_xor(ss, 32);
            if (fq == 0) ssqn[(size_t)u.pn * SSQ_PLANE + row * 4 + wc] = ss;
#pragma unroll
            for (int bj = 0; bj < 2; ++bj) { wc_[bj][0] = wn_[bj][0]; wc_[bj][1] = wn_[bj][1]; }
        }
    }
};
template <int ACT, int RS> struct EpiCol {
    static constexpr bool PERM = true, AFTER_DRAIN = false;
    bf16_t* O; int ldc; const float* rs;
    __device__ __forceinline__ void operator()(const f32x4 (&acc)[2][2][4][2], const Unit& u, int wr, int wc, int fr, int fq) const {
        const int row0 = u.pm * 256 + wr * 64 + fr, col0 = u.pn * 256 + wc * 32 + 8 * fq;
#pragma unroll
        for (int bj = 0; bj < 2; ++bj) {
            const int col = col0 + bj * 128; f32x4 c0, c1;
            if (RS == 0) {
#pragma unroll
                for (int e = 0; e < 4; ++e) { c0[e] = rstd16(rs, (size_t)(col + e)); asm volatile("" ::: "memory"); c1[e] = rstd16(rs, (size_t)(col + 4 + e)); asm volatile("" ::: "memory"); }
            } else { c0 = *(const f32x4*)(rs + col); c1 = *(const f32x4*)(rs + col + 4); }
#pragma unroll
            for (int ai = 0; ai < 2; ++ai)
#pragma unroll
                for (int m = 0; m < 4; ++m) {
                    f32x4 v0 = acc[ai][bj][m][0] * c0, v1 = acc[ai][bj][m][1] * c1;
                    if (ACT == 1) {
#pragma unroll
                        for (int e = 0; e < 4; ++e) { v0[e] = gelu_t(v0[e]); v1[e] = gelu_t(v1[e]); } }
                    *(u32x4*)(O + (size_t)(row0 + ai * 128 + m * 16) * ldc + col) = pack8(v0, v1);
                    asm volatile("" ::: "memory");
                }
        }
    }
};
struct EpiLru {
    static constexpr bool PERM = true, AFTER_DRAIN = false;
    const bf16_t* XC; bf16_t* LA; bf16_t* U; const float* ba; const float* bx; const float* sp8;
    __device__ __forceinline__ void operator()(const f32x4 (&acc)[2][2][4][2], const Unit& u, int wr, int wc, int fr, int fq) const {
        const int row0 = u.pm * 256 + wr * 64 + fr, ch0 = (u.pn * 256 + wc * 32 + 8 * fq) >> 1;
#pragma unroll
        for (int bj = 0; bj < 2; ++bj) {
            const int ch = ch0 + bj * 64; const f32x4 vba = *(const f32x4*)(ba + ch), vbx = *(const f32x4*)(bx + ch), vsp = *(const f32x4*)(sp8 + ch);
#pragma unroll
            for (int ai = 0; ai < 2; ++ai)
#pragma unroll
                for (int m = 0; m < 4; ++m) {
                    const int row = row0 + ai * 128 + m * 16; const size_t o = (size_t)row * DM + ch; const bool first = (row & 2047) == 0;
                    const u32x2 xw = *(const u32x2*)(XC + o); const float xc[4] = {bflo(xw.x), bfhi(xw.x), bflo(xw.y), bfhi(xw.y)};
                    const f32x4 v0 = acc[ai][bj][m][0], v1 = acc[ai][bj][m][1]; const float ga[4] = {v0[0], v0[2], v1[0], v1[2]}, gx[4] = {v0[1], v0[3], v1[1], v1[3]};
                    float la[4], uu[4];
#pragma unroll
                    for (int e = 0; e < 4; ++e) { const float r = sigm(ga[e] + vba[e]), ig = sigm(gx[e] + vbx[e]); la[e] = -vsp[e] * r;
                        const float a2 = fexp2(2.f * LOG2E * la[e]); const float mult = first ? 1.f : sqrtf(fmaxf(1.f - a2, 0.f)); uu[e] = mult * ig * xc[e]; }
                    u32x2 wl, wu; wl.x = cvt_pk_bf16(la[0], la[1]); wl.y = cvt_pk_bf16(la[2], la[3]); wu.x = cvt_pk_bf16(uu[0], uu[1]); wu.y = cvt_pk_bf16(uu[2], uu[3]);
                    *(u32x2*)(LA + o) = wl; *(u32x2*)(U + o) = wu;
                    asm volatile("" ::: "memory");
                }
        }
    }
};
struct EpiQ {
    static constexpr bool PERM = true, AFTER_DRAIN = false;
    bf16_t* Q; const float* rsq; const float* rope;
    __device__ __forceinline__ void operator()(const f32x4 (&acc)[2][2][4][2], const Unit& u, int wr, int wc, int fr, int fq) const {
        const int row0 = u.pm * 256 + wr * 64 + fr, col0 = u.pn * 256 + wc * 32 + 8 * fq;
        float scl[2][4]; row_scales<1>(rsq, u.pm, wr, fr, fq, scl);
#pragma unroll
        for (int ai = 0; ai < 2; ++ai)
#pragma unroll
            for (int m = 0; m < 4; ++m) {
                const int row = row0 + ai * 128 + m * 16; const float s = scl[ai][m] * QSCALE; const int pos = row & 2047;
#pragma unroll
                for (int bj = 0; bj < 2; ++bj) {
                    const int col = col0 + bj * 128, d = col % 96; f32x4 v0 = acc[ai][bj][m][0] * s, v1 = acc[ai][bj][m][1] * s;
                    if (d >= 64) { const int i0 = (d - 64) >> 1; const f32x4 t0 = *(const f32x4*)(rope + (pos * 16 + i0) * 2), t1 = *(const f32x4*)(rope + (pos * 16 + i0 + 2) * 2);
                        const f32x4 a = v0, b = v1;
                        v0[0] = a[0] * t0[0] - a[1] * t0[1]; v0[1] = a[0] * t0[1] + a[1] * t0[0]; v0[2] = a[2] * t0[2] - a[3] * t0[3]; v0[3] = a[2] * t0[3] + a[3] * t0[2];
                        v1[0] = b[0] * t1[0] - b[1] * t1[1]; v1[1] = b[0] * t1[1] + b[1] * t1[0]; v1[2] = b[2] * t1[2] - b[3] * t1[3]; v1[3] = b[2] * t1[3] + b[3] * t1[2]; }
                    *(u32x4*)(Q + (size_t)row * 1536 + col) = pack8(v0, v1);
                }
                asm volatile("" ::: "memory");
            }
    }
};
struct EpiMerge {
    static constexpr bool PERM = true, AFTER_DRAIN = false;
    const bf16_t* G3; bf16_t* MG;
    __device__ __forceinline__ void ld(size_t row, int col0, int mcol0, bool first, u32x4 (&w)[2][2]) const {
#pragma unroll
        for (int bj = 0; bj < 2; ++bj) { w[bj][0] = *(const u32x4*)(G3 + row * 3072 + col0 + bj * 128); w[bj][1] = first ? (u32x4){0u, 0u, 0u, 0u} : *(const u32x4*)(MG + row * DM + mcol0 + bj * 128); }
    }
    __device__ __forceinline__ void operator()(const f32x4 (&acc)[2][2][4][2], const Unit& u, int wr, int wc, int fr, int fq) const {
        const int row0 = u.pm * 256 + wr * 64 + fr, col0 = u.pn * 256 + wc * 32 + 8 * fq, mcol0 = (u.pn & 3) * 256 + wc * 32 + 8 * fq; const bool first = u.pn < 4;
        u32x4 wc_[2][2], wn_[2][2];
        ld((size_t)row0, col0, mcol0, first, wc_);
#pragma unroll
        for (int g = 0; g < 8; ++g) {
            const int ai = g >> 2, m = g & 3; const size_t row = (size_t)(row0 + ai * 128 + m * 16);
            if (g < 7) ld((size_t)(row0 + ((g + 1) >> 2) * 128 + ((g + 1) & 3) * 16), col0, mcol0, first, wn_);
#pragma unroll
            for (int bj = 0; bj < 2; ++bj) {
                f32x4 g0, g1, p0, p1; unpack8(wc_[bj][0], g0, g1); unpack8(wc_[bj][1], p0, p1);
                const f32x4 v0 = acc[ai][bj][m][0] * g0 + p0, v1 = acc[ai][bj][m][1] * g1 + p1;
                *(u32x4*)(MG + row * DM + mcol0 + bj * 128) = pack8(v0, v1);
            }
#pragma unroll
            for (int bj = 0; bj < 2; ++bj) { wc_[bj][0] = wn_[bj][0]; wc_[bj][1] = wn_[bj][1]; }
        }
    }
};
enum { MAP_ID = 0, MAP_SWIGLU, MAP_WIN, MAP_UQ, MAP_KVK, MAP_KVV, MAP_GATES };
struct Job { const float* W; const float* gain; bf16_t* dst; int ldw, K, dN, map, off; };
__device__ __forceinline__ int srcmap(int map, int off, int n) {
    switch (map) {
    case MAP_SWIGLU: return (n >> 8) * 128 + (n & 127) + ((n & 128) ? DFF : 0);
    case MAP_WIN: if (n < 2048) return n; if (n < 3072) return 2720 + (n - 2048); if (n < 3328) return 2432 + (n - 3072); if (n < 3712) return 2048 + (n - 3328);
                  if (n < 3744) { const int j = n - 3712, i = j >> 1; return 2688 + ((j & 1) ? 16 + i : i); } return -1;
    case MAP_UQ: { const int h = n / 96, d = n % 96; if (d < 64) return n; const int j = d - 64, i = j >> 1; return h * 96 + 64 + ((j & 1) ? 16 + i : i); }
    case MAP_KVK: return (n >> 6) * 128 + (n & 63);
    case MAP_KVV: return (n >> 6) * 128 + 64 + (n & 63);
    case MAP_GATES: return 4768 + (n < 1024 ? n + 1024 : (n < 2048 ? n - 1024 : n));
    default: return n + off;
    }
}
#define JOB(Wp, GAIN, DST, LDW, KK, DN, MAP, OFF) do { J.W = (Wp); J.gain = (GAIN); J.dst = wb + (DST); J.ldw = (LDW); J.K = (KK); J.dN = (DN); J.map = (MAP); J.off = (OFF); } while (0)
__device__ __forceinline__ void get_job(const Params& p, int L, int j, bf16_t* wb, Job& J) {
    const size_t M1 = 1024 * 1024;
    switch (j) {
    case 0: JOB(p.in[3] + (size_t)L * 1024 * 5632, p.in[2] + L * 1024, O_WGU1, 5632, 1024, 5632, MAP_SWIGLU, 0); break;
    case 1: JOB(p.in[4] + (size_t)L * 2816 * 1024, nullptr, O_WD1, 1024, 2816, 1024, MAP_ID, 0); break;
    case 2: JOB(p.in[6] + (size_t)L * 1024 * 7840, p.in[5] + L * 1024, O_WIN, 7840, 1024, 3840, MAP_WIN, 0); break;
    case 3: JOB(p.in[6] + (size_t)L * 1024 * 7840, p.in[5] + L * 1024, O_WINV, 7840, 1024, 1024, MAP_ID, 3744); break;
    case 4: JOB(p.in[6] + (size_t)L * 1024 * 7840, p.in[5] + L * 1024, O_WING, 7840, 1024, 3072, MAP_GATES, 0); break;
    case 5: JOB(p.in[14] + L * M1, nullptr, O_WRB, 1024, 1024, 1024, MAP_ID, 0); break;
    case 6: JOB(p.in[19] + L * M1, nullptr, O_WRA, 1024, 1024, 1024, MAP_ID, 0); break;
    case 7: JOB(p.in[24] + L * M1, nullptr, O_WRC, 1024, 1024, 1024, MAP_ID, 0); break;
    case 8: JOB(p.in[26] + L * M1, nullptr, O_WOUT, 1024, 1024, 1024, MAP_ID, 0); break;
    case 9: JOB(p.in[31] + L * M1, p.in[30] + L * 1024, O_WPG, 1024, 1024, 1024, MAP_ID, 0); break;
    case 10: JOB(p.in[16] + (size_t)L * 384 * 1536, p.in[15] + L * 384, O_WUQ, 1536, 384, 1536, MAP_UQ, 0); break;
    case 11: JOB(p.in[18] + (size_t)L * 256 * 2048, p.in[17] + L * 256, O_WKVK, 2048, 256, 1024, MAP_KVK, 0); break;
    case 12: JOB(p.in[18] + (size_t)L * 256 * 2048, p.in[17] + L * 256, O_WKVV, 2048, 256, 1024, MAP_KVV, 0); break;
    case 13: JOB(p.in[28] + (size_t)L * 1024 * 5632, p.in[27] + L * 1024, O_WGU2, 5632, 1024, 5632, MAP_SWIGLU, 0); break;
    case 14: JOB(p.in[29] + (size_t)L * 2816 * 1024, nullptr, O_WD2, 1024, 2816, 1024, MAP_ID, 0); break;
    default: JOB(p.in[32] + (size_t)L * 256 * 1024, nullptr, O_WPLE, 1024, 256, 1024, MAP_ID, 0); break;
    }
}
constexpr int NJOBS = 16;
__device__ __forceinline__ void tr_item(const Job& J, int item, LAS float* scr, int lane) {
    const int nblk = J.dN >> 5, kb = item / nblk, nb = item % nblk, k0 = 64 * kb, n0 = 32 * nb;
    const int sc0 = srcmap(J.map, J.off, n0);
    if (sc0 >= 0 && srcmap(J.map, J.off, n0 + 1) == sc0 + 1 && srcmap(J.map, J.off, n0 + 31) == sc0 + 31) {
        const int kr = lane >> 3, c4 = lane & 7; f32x4 v[8];
#pragma unroll
        for (int i = 0; i < 8; ++i) v[i] = *(const f32x4*)(J.W + (size_t)(k0 + 8 * i + kr) * J.ldw + sc0 + 4 * c4);
#pragma unroll
        for (int i = 0; i < 8; ++i) { const int kk = 8 * i + kr; const float gn = J.gain ? J.gain[k0 + kk] : 1.f;
            scr[kk * 33 + 4 * c4] = v[i][0] * gn; scr[kk * 33 + 4 * c4 + 1] = v[i][1] * gn; scr[kk * 33 + 4 * c4 + 2] = v[i][2] * gn; scr[kk * 33 + 4 * c4 + 3] = v[i][3] * gn; }
    } else {
        const int sc = srcmap(J.map, J.off, n0 + (lane & 31));
#pragma unroll 8
        for (int i = 0; i < 32; ++i) { const int kk = 2 * i + (lane >> 5); float v = (sc >= 0) ? J.W[(size_t)(k0 + kk) * J.ldw + sc] : 0.f; if (J.gain) v *= J.gain[k0 + kk]; scr[kk * 33 + (lane & 31)] = v; }
    }
    asm volatile("s_waitcnt lgkmcnt(0)" ::: "memory");
    const int c = lane & 7;
#pragma unroll
    for (int j = 0; j < 4; ++j) { const int n = (lane >> 3) + 8 * j; const LAS float* s = scr + (8 * c) * 33 + n;
        u32x4 o; o.x = cvt_pk_bf16(s[0 * 33], s[1 * 33]); o.y = cvt_pk_bf16(s[2 * 33], s[3 * 33]); o.z = cvt_pk_bf16(s[4 * 33], s[5 * 33]); o.w = cvt_pk_bf16(s[6 * 33], s[7 * 33]);
        *(u32x4*)(J.dst + (size_t)(n0 + n) * J.K + k0 + 8 * c) = o; }
    asm volatile("s_waitcnt lgkmcnt(0)" ::: "memory");
}
__device__ __forceinline__ void phase0(const Params& p, int L, LAS unsigned char* lds, int G, int blk) {
    const int tid = pg8::tid_opaque(), lane = tid & 63, wave = tid >> 6;
    const int gw = blk * 8 + wave, NGW = G * 8, gt = blk * 512 + tid, NGT = G * 512;
    bf16_t* wb = (bf16_t*)(p.ws + WS_W);
    LAS float* scr = (LAS float*)(lds + wave * 8448);
    int total = 0;
    for (int j = 0; j < NJOBS; ++j) { Job J; get_job(p, L, j, wb, J); total += (J.K >> 6) * (J.dN >> 5); }
    for (int it = gw; it < total; it += NGW) {
        int r = it;
        for (int j = 0; j < NJOBS; ++j) { Job J; get_job(p, L, j, wb, J); const int n = (J.K >> 6) * (J.dN >> 5); if (r < n) { tr_item(J, r, scr, lane); break; } r -= n; }
    }
    { bf16_t* d = wb + O_WLRU; const float* wa = p.in[9] + (size_t)L * 65536; const float* wx = p.in[11] + (size_t)L * 65536;
      for (int i = gt; i < 2048 * 128; i += NGT) { const int n = i >> 7, k = i & 127, ch = n >> 1, nb = ch >> 6, dd = ch & 63;
          float v = 0.f; if ((k >> 6) == (nb & 1)) v = ((n & 1) ? wx : wa)[(size_t)nb * 4096 + (k & 63) * 64 + dd]; d[i] = f2bf(v); } }
    { bf16_t* d = wb + O_WSGU; const float* w = p.in[22] + (size_t)L * 131072;
      for (int i = gt; i < 131072; i += NGT) { const int t = (i >> 7) & 127, s = i & 127; d[i] = f2bf(((s >> 6) <= (t >> 6)) ? w[i] : 0.f); } }
    { const f32x4* src = (const f32x4*)(p.in[1] + (size_t)L * T * 256); u32x2* d = (u32x2*)(p.ws + WS_BIG + B_PB);
      for (int i = gt; i < T * 256 / 4; i += NGT) { const f32x4 v = src[i]; u32x2 w; w.x = cvt_pk_bf16(v[0], v[1]); w.y = cvt_pk_bf16(v[2], v[3]); d[i] = w; } }
    { float* sp = (float*)(p.ws + WS_SMALL + SM_SP8); const float* lam = p.in[13] + L * 1024;
      for (int i = gt; i < 1024; i += NGT) sp[i] = 8.f * 0.6931471805599453f * __builtin_amdgcn_logf(1.f + fexp2(-LOG2E * lam[i])); }
    if (L == 0) {
        float* rope = (float*)(p.ws + WS_SMALL + SM_ROPE);
        for (int i = gt; i < 2048 * 16; i += NGT) { const int pos = i >> 4, k = i & 15; const float inv = fexp2(-(float)k * (13.287712379549449f / 16.f)); const float ang = (float)pos * inv;
            double rev = (double)ang * 0.15915494309189535; rev -= floor(rev); const float fr = (float)rev; rope[2 * i] = __builtin_amdgcn_cosf(fr); rope[2 * i + 1] = __builtin_amdgcn_sinf(fr); }
        const float* x = p.in[0]; bf16_t* XB = (bf16_t*)(p.ws + WS_XB); float* ssq = (float*)(p.ws + WS_SSQ);
        for (int m = gw; m < T; m += NGW) {
            const f32x4* xr = (const f32x4*)(x + (size_t)m * DM) + lane; u32x2* o8 = (u32x2*)(XB + (size_t)m * DM) + lane; float s = 0.f;
#pragma unroll
            for (int j = 0; j < 4; ++j) { const f32x4 v = xr[64 * j]; s += (v[0] * v[0] + v[1] * v[1]) + (v[2] * v[2] + v[3] * v[3]); u32x2 w; w.x = cvt_pk_bf16(v[0], v[1]); w.y = cvt_pk_bf16(v[2], v[3]); o8[64 * j] = w; }
            s = wave_sum(s);
            if (lane < 16) ssq[(size_t)(lane >> 2) * SSQ_PLANE + (size_t)m * 4 + (lane & 3)] = (lane == 0) ? s : 0.f;
        }
    }
}

__device__ __forceinline__ void pb_convert(const Params& p, int L, int G, int blk) {
    const int tid = pg8::tid_opaque(), gt = blk * 512 + tid, NGT = G * 512;
    const f32x4* src = (const f32x4*)(p.in[1] + (size_t)L * T * 256); u32x2* d = (u32x2*)(p.ws + WS_BIG + B_PB);
    for (int i = gt; i < T * 256 / 4; i += NGT) { const f32x4 v = src[i]; u32x2 w; w.x = cvt_pk_bf16(v[0], v[1]); w.y = cvt_pk_bf16(v[2], v[3]); d[i] = w; }
}
__device__ __forceinline__ void e1_rows(const Params& p, int L, const bf16_t* Z, bf16_t* XC, float* RSQ, float* RSKV, bf16_t* KR, const float* rope, int G, int blk) {
    const int tid = pg8::tid_opaque(), lane = tid & 63, wave = tid >> 6;
    const float* cw = p.in[7] + (size_t)L * 4096; const float* cb = p.in[8] + L * 1024;
    for (int rb = blk * 64 + wave * 8; rb < TC; rb += G * 64) {
        const bool halo = (rb & 2047) != 0;
        u32x4 cqv[8]; u32x2 ckv[8];
#pragma unroll
        for (int r = 0; r < 8; ++r) { const bf16_t* zr = Z + (size_t)(rb + r) * ZLD; cqv[r] = (lane < 48) ? *(const u32x4*)(zr + ZC_CQ + 8 * lane) : (u32x4){0u, 0u, 0u, 0u}; ckv[r] = *(const u32x2*)(zr + ZC_CKV + 4 * lane); }
#pragma unroll
        for (int hf = 0; hf < 2; ++hf) {
            const int c0 = hf * 512 + 8 * lane; u32x4 xr[11];
#pragma unroll
            for (int j = 0; j < 11; ++j) xr[j] = (j >= 3 || halo) ? *(const u32x4*)(Z + (ptrdiff_t)(rb - 3 + j) * ZLD + ZC_XA + c0) : (u32x4){0u, 0u, 0u, 0u};
            f32x4 w0[4], w1[4]; const f32x4 b0 = *(const f32x4*)(cb + c0), b1 = *(const f32x4*)(cb + c0 + 4);
#pragma unroll
            for (int k = 0; k < 4; ++k) { w0[k] = *(const f32x4*)(cw + k * 1024 + c0); w1[k] = *(const f32x4*)(cw + k * 1024 + c0 + 4); }
#pragma unroll
            for (int r = 0; r < 8; ++r) { f32x4 a0 = b0, a1 = b1;
#pragma unroll
                for (int k = 0; k < 4; ++k) { f32x4 x0, x1; unpack8(xr[r + k], x0, x1); a0 += w0[k] * x0; a1 += w1[k] * x1; }
                *(u32x4*)(XC + (size_t)(rb + r) * DM + c0) = pack8(a0, a1); }
        }
        float sq[8], sk[8];
#pragma unroll
        for (int r = 0; r < 8; ++r) { f32x4 x0, x1; unpack8(cqv[r], x0, x1); sq[r] = (x0[0] * x0[0] + x0[1] * x0[1]) + (x0[2] * x0[2] + x0[3] * x0[3]) + (x1[0] * x1[0] + x1[1] * x1[1]) + (x1[2] * x1[2] + x1[3] * x1[3]);
            const float a = bflo(ckv[r].x), b = bfhi(ckv[r].x), c = bflo(ckv[r].y), d = bfhi(ckv[r].y); sk[r] = (a * a + b * b) + (c * c + d * d); }
#pragma unroll
        for (int o = 1; o < 64; o <<= 1)
#pragma unroll
            for (int r = 0; r < 8; ++r) { sq[r] += __shfl_xor(sq[r], o); sk[r] += __shfl_xor(sk[r], o); }
        { float q = sq[0], k = sk[0];
#pragma unroll
          for (int r = 1; r < 8; ++r) { if (lane == r) { q = sq[r]; k = sk[r]; } }
          if (lane < 8) { RSQ[rb + lane] = __builtin_amdgcn_rsqf(q * (1.f / 384.f) + EPS); RSKV[rb + lane] = __builtin_amdgcn_rsqf(k * (1.f / 256.f) + EPS); } }
#pragma unroll
        for (int it = 0; it < 2; ++it) { const int r = rb + it * 4 + (lane >> 4), i = lane & 15, pos = r & 2047;
            const unsigned w = *(const unsigned*)(Z + (size_t)r * ZLD + ZC_KR + 2 * i); const float x1 = bflo(w), x2 = bfhi(w); const f32x2 cs = *(const f32x2*)(rope + (pos * 16 + i) * 2);
            *(unsigned*)(KR + (size_t)r * 32 + 2 * i) = cvt_pk_bf16(x1 * cs[0] - x2 * cs[1], x1 * cs[1] + x2 * cs[0]); }
    }
}
__device__ __forceinline__ void e2_stats(LAS unsigned char* lds, const bf16_t* VTS, float* MEANV, float* RSTDV, int G, int blk) {
    const int tid = pg8::tid_opaque(), lane = tid & 63, wave = tid >> 6, tg = lane & 7, cr = lane >> 3;
    LAS float* part = (LAS float*)lds;
    for (int unit = blk; unit < TC / 64; unit += G) {
        const int tok0 = unit * 64; float s[8], q[8];
#pragma unroll
        for (int e = 0; e < 8; ++e) { s[e] = 0.f; q[e] = 0.f; }
#pragma unroll
        for (int it = 0; it < 16; ++it) { const int c = wave * 128 + it * 8 + cr; f32x4 x0, x1; unpack8(*(const u32x4*)(VTS + (size_t)c * TC + tok0 + 8 * tg), x0, x1);
#pragma unroll
            for (int e = 0; e < 4; ++e) { s[e] += x0[e]; q[e] += x0[e] * x0[e]; s[4 + e] += x1[e]; q[4 + e] += x1[e] * x1[e]; } }
#pragma unroll
        for (int e = 0; e < 8; ++e) { s[e] += __shfl_xor(s[e], 8); s[e] += __shfl_xor(s[e], 16); s[e] += __shfl_xor(s[e], 32); q[e] += __shfl_xor(q[e], 8); q[e] += __shfl_xor(q[e], 16); q[e] += __shfl_xor(q[e], 32); }
        if (cr == 0) {
#pragma unroll
            for (int e = 0; e < 8; ++e) { part[(wave * 64 + 8 * tg + e) * 2] = s[e]; part[(wave * 64 + 8 * tg + e) * 2 + 1] = q[e]; } }
        __syncthreads();
        if (tid < 64) { float ss = 0.f, qq = 0.f;
#pragma unroll
            for (int w = 0; w < 8; ++w) { ss += part[(w * 64 + tid) * 2]; qq += part[(w * 64 + tid) * 2 + 1]; }
            const float mean = ss * (1.f / 1024.f); const float var = fmaxf(qq * (1.f / 1024.f) - mean * mean, 0.f);
            MEANV[tok0 + tid] = mean; RSTDV[tok0 + tid] = __builtin_amdgcn_rsqf(var + EPS); }
        __syncthreads();
    }
}
__device__ __forceinline__ void scan_units(LAS unsigned char* lds, const bf16_t* LA, const bf16_t* U, bf16_t* Z, int G, int blk) {
    const int tid = pg8::tid_opaque(), cp = tid & 15, seg = tid >> 4;
    LAS f32x4* sc = (LAS f32x4*)lds;
    for (int idx = blk; idx < 256; idx += G) {
        const int b = idx >> 5, ch = (idx & 31) * 32 + 2 * cp; const size_t row0 = (size_t)b * 2048 + seg * 64;
        const unsigned* lap = (const unsigned*)(LA + row0 * DM + ch); const unsigned* up = (const unsigned*)(U + row0 * DM + ch);
        float h0 = 0.f, h1 = 0.f, s0 = 0.f, s1 = 0.f;
#pragma unroll 16
        for (int t = 0; t < 64; ++t) { const unsigned lw = lap[(size_t)t * 512], uw = up[(size_t)t * 512]; const float l0 = bflo(lw), l1 = bfhi(lw);
            h0 = fexp2(LOG2E * l0) * h0 + bflo(uw); h1 = fexp2(LOG2E * l1) * h1 + bfhi(uw); s0 += l0; s1 += l1; }
        sc[seg * 16 + cp] = (f32x4){s0, s1, h0, h1};
        __syncthreads();
        float c0 = 0.f, c1 = 0.f;
        for (int j = 0; j < seg; ++j) { const f32x4 v = sc[j * 16 + cp]; c0 = fexp2(LOG2E * v[0]) * c0 + v[2]; c1 = fexp2(LOG2E * v[1]) * c1 + v[3]; }
        h0 = c0; h1 = c1;
        unsigned* gp = (unsigned*)(Z + row0 * ZLD + ZC_GA + ch);
#pragma unroll 16
        for (int t = 0; t < 64; ++t) { const unsigned lw = lap[(size_t)t * 512], uw = up[(size_t)t * 512], gw = gp[(size_t)t * (ZLD / 2)];
            h0 = fexp2(LOG2E * bflo(lw)) * h0 + bflo(uw); h1 = fexp2(LOG2E * bfhi(lw)) * h1 + bfhi(uw); gp[(size_t)t * (ZLD / 2)] = cvt_pk_bf16(h0 * bflo(gw), h1 * bfhi(gw)); }
        __syncthreads();
    }
}
__device__ __forceinline__ void attn_units(LAS unsigned char* lds, const bf16_t* Q, const bf16_t* KN, const bf16_t* KR, const bf16_t* VT, bf16_t* Z, int G, int blk) {
    const int tid = pg8::tid_opaque(), lane = tid & 63, wid = __builtin_amdgcn_readfirstlane(tid >> 6), i32 = lane & 31, hi = lane >> 5;
    constexpr int KP = 208, VP = 144, KBUF = 64 * KP, VBUF = 64 * VP;
    for (int idx = blk; idx < 1024; idx += G) {
        const int j = idx & 255, rnd = idx >> 8, x = j & 7, mm = j >> 3, k = mm & 7, gq = x * 4 + (mm >> 3);
        const int bh = gq * 4 + rnd, qb = (rnd & 1) ? 7 - k : k;
        const int b = bh >> 4, h = bh & 15, q0 = qb * 256, NT = q0 / 64 + 4, ntw = (q0 + 32 * wid) / 64 + 1;
        const size_t rowb = (size_t)b * 2048;
        bf16x8 qr[6];
        { const bf16_t* qp = Q + (rowb + q0 + 32 * wid + i32) * 1536 + h * 96 + 8 * hi;
#pragma unroll
          for (int ks = 0; ks < 6; ++ks) qr[ks] = *(const bf16x8*)(qp + 16 * ks); }
        const bf16_t* kns = KN + (rowb + (tid >> 3)) * DM + h * 64 + 8 * (tid & 7);
        const bf16_t* krs = KR + (rowb + (tid >> 2)) * 32 + 8 * (tid & 3);
        const bf16_t* vts = VT + (size_t)(h * 64 + (tid >> 3)) * TC + rowb + 8 * (tid & 7);
        const int kdst = (tid >> 3) * KP + (tid & 7) * 16, krdst = (tid >> 2) * KP + 128 + (tid & 3) * 16, vdst = 2 * KBUF + (tid >> 3) * VP + (tid & 7) * 16;
        u32x4 rk, rr = (u32x4){0u, 0u, 0u, 0u}, rv;
        rk = *(const u32x4*)kns; if (tid < 256) rr = *(const u32x4*)krs; rv = *(const u32x4*)vts;
        *(LAS u32x4*)(lds + kdst) = rk; if (tid < 256) *(LAS u32x4*)(lds + krdst) = rr; *(LAS u32x4*)(lds + vdst) = rv;
        __syncthreads();
        f32x16 o0, o1;
#pragma unroll
        for (int r = 0; r < 16; ++r) { o0[r] = 0.f; o1[r] = 0.f; }
        float mrun = -1e30f, lrun = 0.f;
        for (int t = 0; t < NT; ++t) {
            const int cur = t & 1; const bool more = (t + 1 < NT);
            if (more) { rk = *(const u32x4*)(kns + (size_t)(t + 1) * 64 * DM); if (tid < 256) rr = *(const u32x4*)(krs + (size_t)(t + 1) * 64 * 32); rv = *(const u32x4*)(vts + (size_t)(t + 1) * 64); }
            if (t < ntw) {
                LAS const unsigned char* kb = lds + cur * KBUF; LAS const unsigned char* vb = lds + 2 * KBUF + cur * VBUF;
                f32x16 s0, s1;
#pragma unroll
                for (int r = 0; r < 16; ++r) { s0[r] = 0.f; s1[r] = 0.f; }
#pragma unroll
                for (int ks = 0; ks < 6; ++ks) {
                    const bf16x8 a0 = *(LAS const bf16x8*)(kb + i32 * KP + (16 * ks + 8 * hi) * 2), a1 = *(LAS const bf16x8*)(kb + (32 + i32) * KP + (16 * ks + 8 * hi) * 2);
                    s0 = __builtin_amdgcn_mfma_f32_32x32x16_bf16(a0, qr[ks], s0, 0, 0, 0); s1 = __builtin_amdgcn_mfma_f32_32x32x16_bf16(a1, qr[ks], s1, 0, 0, 0);
                }
                float mx = fmaxf(s0[0], s1[0]);
#pragma unroll
                for (int r = 1; r < 16; ++r) mx = fmaxf(mx, fmaxf(s0[r], s1[r]));
                mx = fmaxf(mx, __shfl_xor(mx, 32));
                const float mn = fmaxf(mrun, mx), alpha = fexp2(mrun - mn); mrun = mn;
                float rs = 0.f;
#pragma unroll
                for (int r = 0; r < 16; ++r) { s0[r] = fexp2(s0[r] - mn); s1[r] = fexp2(s1[r] - mn); rs += s0[r] + s1[r]; }
                lrun = lrun * alpha + rs;
#pragma unroll
                for (int r = 0; r < 16; ++r) { o0[r] *= alpha; o1[r] *= alpha; }
                bf16x8 pf[2][2];
#pragma unroll
                for (int uu = 0; uu < 2; ++uu) {
                    u32x4 w0, w1;
                    w0.x = cvt_pk_bf16(s0[8 * uu + 0], s0[8 * uu + 1]); w0.y = cvt_pk_bf16(s0[8 * uu + 2], s0[8 * uu + 3]); w0.z = cvt_pk_bf16(s0[8 * uu + 4], s0[8 * uu + 5]); w0.w = cvt_pk_bf16(s0[8 * uu + 6], s0[8 * uu + 7]);
                    w1.x = cvt_pk_bf16(s1[8 * uu + 0], s1[8 * uu + 1]); w1.y = cvt_pk_bf16(s1[8 * uu + 2], s1[8 * uu + 3]); w1.z = cvt_pk_bf16(s1[8 * uu + 4], s1[8 * uu + 5]); w1.w = cvt_pk_bf16(s1[8 * uu + 6], s1[8 * uu + 7]);
                    pf[0][uu] = __builtin_bit_cast(bf16x8, w0); pf[1][uu] = __builtin_bit_cast(bf16x8, w1);
                }
#pragma unroll
                for (int tt = 0; tt < 2; ++tt)
#pragma unroll
                    for (int uu = 0; uu < 2; ++uu) {
                        LAS const unsigned char* vp0 = vb + i32 * VP + (32 * tt + 16 * uu + 4 * hi) * 2; LAS const unsigned char* vp1 = vp0 + 32 * VP;
                        const u32x2 a = *(LAS const u32x2*)vp0, bq = *(LAS const u32x2*)(vp0 + 16), c = *(LAS const u32x2*)vp1, d = *(LAS const u32x2*)(vp1 + 16);
                        const bf16x8 vf0 = __builtin_bit_cast(bf16x8, ((u32x4){a.x, a.y, bq.x, bq.y})), vf1 = __builtin_bit_cast(bf16x8, ((u32x4){c.x, c.y, d.x, d.y}));
                        o0 = __builtin_amdgcn_mfma_f32_32x32x16_bf16(vf0, pf[tt][uu], o0, 0, 0, 0); o1 = __builtin_amdgcn_mfma_f32_32x32x16_bf16(vf1, pf[tt][uu], o1, 0, 0, 0);
                    }
            }
            if (more) { const int nb = cur ^ 1; *(LAS u32x4*)(lds + nb * KBUF + kdst) = rk; if (tid < 256) *(LAS u32x4*)(lds + nb * KBUF + krdst) = rr; *(LAS u32x4*)(lds + nb * VBUF + vdst) = rv; }
            __syncthreads();
        }
        lrun += __shfl_xor(lrun, 32); const float inv = frcp(lrun);
        bf16_t* op = Z + (rowb + q0 + 32 * wid + i32) * ZLD + ZC_XA + h * 64 + 4 * hi;
#pragma unroll
        for (int rg = 0; rg < 4; ++rg) {
            u32x2 w; w.x = cvt_pk_bf16(o0[4 * rg] * inv, o0[4 * rg + 1] * inv); w.y = cvt_pk_bf16(o0[4 * rg + 2] * inv, o0[4 * rg + 3] * inv); *(u32x2*)(op + 8 * rg) = w;
            w.x = cvt_pk_bf16(o1[4 * rg] * inv, o1[4 * rg + 1] * inv); w.y = cvt_pk_bf16(o1[4 * rg + 2] * inv, o1[4 * rg + 3] * inv); *(u32x2*)(op + 32 + 8 * rg) = w;
        }
    }
}
__device__ __forceinline__ void sgu_units(LAS unsigned char* lds, const bf16_t* VTS, const float* MEANV, const float* RSTDV, const float* lng, const float* lnb, const bf16_t* WS, const float* bs, bf16_t* Z, int G, int blk) {
    const int tid = pg8::tid_opaque(), lane = tid & 63, wid = __builtin_amdgcn_readfirstlane(tid >> 6), i32 = lane & 31, hi = lane >> 5;
    constexpr int AP = 272;
    for (int idx = blk; idx < 1024; idx += G) {
        const int tb = idx >> 3, g = idx & 7, tok0 = tb * 128, tt = wid & 3;
        u32x4 xv[4]; f32x4 m0[4], m1[4], r0[4], r1[4]; float ga[4], be[4];
#pragma unroll
        for (int jj = 0; jj < 4; ++jj) {
            const int id = tid + 512 * jj, c = id >> 4, sc = id & 15; xv[jj] = *(const u32x4*)(VTS + (size_t)(g * 128 + c) * TC + tok0 + 8 * sc);
            m0[jj] = *(const f32x4*)(MEANV + tok0 + 8 * sc); m1[jj] = *(const f32x4*)(MEANV + tok0 + 8 * sc + 4); r0[jj] = *(const f32x4*)(RSTDV + tok0 + 8 * sc); r1[jj] = *(const f32x4*)(RSTDV + tok0 + 8 * sc + 4);
            ga[jj] = lng[g * 128 + c]; be[jj] = lnb[g * 128 + c];
        }
        bf16x8 wf[8];
        { const bf16_t* wp = WS + (size_t)(g * 128 + 32 * tt + i32) * 128 + 8 * hi;
#pragma unroll
          for (int ks = 0; ks < 8; ++ks) wf[ks] = *(const bf16x8*)(wp + 16 * ks); }
        const float bsv = bs[g * 128 + 32 * tt + i32];
        bf16_t* up0 = Z + (size_t)(tok0 + 32 * tt + i32) * ZLD + ZC_U + g * 128 + 64 * (wid >> 2) + 4 * hi;
        u32x2 uv[2][4];
#pragma unroll
        for (int cc = 0; cc < 2; ++cc)
#pragma unroll
            for (int rg = 0; rg < 4; ++rg) uv[cc][rg] = *(const u32x2*)(up0 + 32 * cc + 8 * rg);
#pragma unroll
        for (int jj = 0; jj < 4; ++jj) {
            const int id = tid + 512 * jj, c = id >> 4, sc = id & 15; f32x4 x0, x1; unpack8(xv[jj], x0, x1);
            x0 = (x0 - m0[jj]) * r0[jj] * ga[jj] + be[jj]; x1 = (x1 - m1[jj]) * r1[jj] * ga[jj] + be[jj];
            *(LAS u32x4*)(lds + c * AP + sc * 16) = pack8(x0, x1);
        }
        __syncthreads();
#pragma unroll
        for (int cc = 0; cc < 2; ++cc) {
            const int ct = 2 * (wid >> 2) + cc; f32x16 acc;
#pragma unroll
            for (int r = 0; r < 16; ++r) acc[r] = 0.f;
#pragma unroll
            for (int ks = 0; ks < 8; ++ks) { const bf16x8 a = *(LAS const bf16x8*)(lds + (32 * ct + i32) * AP + (16 * ks + 8 * hi) * 2); acc = __builtin_amdgcn_mfma_f32_32x32x16_bf16(a, wf[ks], acc, 0, 0, 0); }
#pragma unroll
            for (int rg = 0; rg < 4; ++rg) { const u32x2 u2 = uv[cc][rg]; u32x2 w;
                w.x = cvt_pk_bf16((acc[4 * rg] + bsv) * bflo(u2.x), (acc[4 * rg + 1] + bsv) * bfhi(u2.x)); w.y = cvt_pk_bf16((acc[4 * rg + 2] + bsv) * bflo(u2.y), (acc[4 * rg + 3] + bsv) * bfhi(u2.y)); *(u32x2*)(up0 + 32 * cc + 8 * rg) = w; }
        }
        __syncthreads();
    }
}

#ifndef DBG_DUMP
#define DBG_DUMP 0
#define DBG_CH 0
#define DBG_TWICE 0
#define DBG_SKIP56 0
#endif
__device__ __forceinline__ void dbg_add(float* out, const bf16_t* buf, size_t n, bool first, int G, int blk) {
    const size_t gt = (size_t)blk * 512 + pg8::tid_opaque(), NGT = (size_t)G * 512;
    for (size_t i = gt; i < (size_t)T * DM; i += NGT) { float v = 0.f; for (size_t j = i; j < n; j += (size_t)T * DM) v += __uint_as_float((unsigned)buf[j] << 16); out[i] = first ? v : out[i] + v; }
}
__device__ __forceinline__ void dbg_addf(float* out, const float* buf, size_t n, int G, int blk) {
    const size_t gt = (size_t)blk * 512 + pg8::tid_opaque(), NGT = (size_t)G * 512;
    for (size_t i = gt; i < (size_t)T * DM; i += NGT) out[i] += buf[i % n];
}
#define APS 0
#define RUN_GEMM(EPI, e, Ap, Bp, M_, N_, K_, lda_, ldb_, apn_) do { int K__ = (K_), blk__ = blk; asm volatile("" : "+s"(K__), "+s"(blk__)); pg8::Gemm gg{(Ap), (Bp), (M_), (N_), K__, (lda_), (ldb_), (apn_), APS}; pg8::StaticOrder SO; SO.init((M_), (N_), G, blk__); \
    pg8::gemm_phase<decltype(e), pg8::StaticOrder, true, true>(lds, gg, SO, e); } while (0)

constexpr size_t SM_BAR = 1024 * 1024;
#define XB_TMO      128
#define XB_XCNT(j)  (256  + 64 * (j))
#define XB_XSUB(j)  (1280 + 64 * (j))
#define XB_XGEN(j)  (2304 + 64 * (j))
#define XB_TOP      3328
#define XB_TOPGEN   3392
#define XCD_BAR_WORDS 3456
#define XB_SPIN_CAP (1u << 18)

__device__ __forceinline__ unsigned xb_ld(unsigned* p)              { return __hip_atomic_load(p, __ATOMIC_RELAXED, __HIP_MEMORY_SCOPE_AGENT); }
__device__ __forceinline__ unsigned xb_add(unsigned* p, unsigned v) { return __hip_atomic_fetch_add(p, v, __ATOMIC_RELAXED, __HIP_MEMORY_SCOPE_AGENT); }
__device__ __forceinline__ unsigned xb_xcc_id() { return (unsigned)__builtin_amdgcn_s_getreg((3 << 11) | 20) & 0xFu; }
#define XB_SPIN(cond, bar) do { unsigned _sp = 0; while (cond) { __builtin_amdgcn_s_sleep(1); \
    if ((++_sp & 255u) == 0u) { if (xb_ld(&(bar)[XB_TMO])) break; if (_sp > XB_SPIN_CAP) { atomicAdd(&(bar)[XB_TMO], 1u); break; } } } } while (0)

struct XcdBarrier {
    unsigned* bar; unsigned x;
    volatile __attribute__((address_space(3))) unsigned* st;
};

__device__ __forceinline__ XcdBarrier xcd_barrier_post(unsigned* bar, volatile __attribute__((address_space(3))) unsigned* st) {
    XcdBarrier b; b.bar = bar; b.x = xb_xcc_id(); b.st = st;
    if (threadIdx.x == 0) (void)xb_add(&bar[XB_XCNT(b.x)], 1u);
    return b;
}
__device__ __forceinline__ void xcd_barrier_complete(unsigned* bar, unsigned x, unsigned& nloc, unsigned& nx) {
    const unsigned G = gridDim.x * gridDim.y * gridDim.z;
    unsigned sum, cnt, mine, sp = 0u;
    for (;;) {
        sum = 0u; cnt = 0u; mine = 0u;
#pragma unroll
        for (unsigned j = 0; j < 16; ++j) { const unsigned c = xb_ld(&bar[XB_XCNT(j)]); sum += c; cnt += (c > 0u) ? 1u : 0u; mine = (j == x) ? c : mine; }
        if (sum == G) break;
        __builtin_amdgcn_s_sleep(1);
        if ((++sp & 255u) == 0u) { if (xb_ld(&bar[XB_TMO])) break; if (sp > XB_SPIN_CAP) { atomicAdd(&bar[XB_TMO], 1u); break; } }
    }
    nloc = mine > 0u ? mine : 1u; nx = cnt > 0u ? cnt : 1u;
}

__device__ __forceinline__ void xcd_barrier(const XcdBarrier& b) {
    asm volatile("s_waitcnt vmcnt(0)" ::: "memory");
    __syncthreads();
    if (threadIdx.x == 0) {
        unsigned* bar = b.bar;
        __builtin_amdgcn_s_waitcnt(0);
        unsigned nloc = b.st[0], nx = b.st[1];
        if (nloc == 0u) { xcd_barrier_complete(bar, b.x, nloc, nx); b.st[0] = nloc; b.st[1] = nx; }
        const unsigned old = xb_add(&bar[XB_XSUB(b.x)], 1u);
        const unsigned gen = old / nloc;
        if (old + 1u == (gen + 1u) * nloc) {
            __builtin_amdgcn_fence(__ATOMIC_RELEASE, "agent");
            asm volatile("s_waitcnt vmcnt(0)" ::: "memory");
            const unsigned og = xb_add(&bar[XB_TOP], 1u);
            const unsigned tg = og / nx;
            if (og + 1u == (tg + 1u) * nx) xb_add(&bar[XB_TOPGEN], 1u);
            else XB_SPIN(xb_ld(&bar[XB_TOPGEN]) == tg, bar);
            __builtin_amdgcn_fence(__ATOMIC_ACQUIRE, "agent");
            xb_add(&bar[XB_XGEN(b.x)], 1u);
            asm volatile("s_waitcnt vmcnt(0)" ::: "memory");
        } else {
            XB_SPIN(xb_ld(&bar[XB_XGEN(b.x)]) == gen, bar);
            __builtin_amdgcn_fence(__ATOMIC_ACQUIRE, "agent");
            asm volatile("s_waitcnt vmcnt(0)" ::: "memory");
        }
    }
    __syncthreads();
}
#define GRID_SYNC() xcd_barrier(xbar)

#define DBG_DUMP_BODY(st) do { \
    dbg_add(X, G3, (size_t)TC * 3072, true, G, blk); } while (0)
__global__ void __launch_bounds__(512, 2) fwd_kernel(Params p) {
    extern __shared__ __attribute__((aligned(16))) unsigned char lds_raw[];
    LAS unsigned char* lds = (LAS unsigned char*)lds_raw;
    cg::grid_group grid = cg::this_grid();
    const int G = gridDim.x, blk = blockIdx.x;
    unsigned char* ws = p.ws;
    { volatile LAS unsigned* st0 = (volatile LAS unsigned*)(lds + 131072); if (threadIdx.x < 64) st0[threadIdx.x] = 0u; }
    __syncthreads();
    const XcdBarrier xbar = xcd_barrier_post((unsigned*)(ws + WS_SMALL + SM_BAR), (volatile LAS unsigned*)(lds + 131072));
    grid.sync();
    bf16_t* wb = (bf16_t*)(ws + WS_W); bf16_t* XB = (bf16_t*)(ws + WS_XB); float* SSQ = (float*)(ws + WS_SSQ); float* X = p.out;
    bf16_t* XBn = (bf16_t*)p.out; float* SSQn = (float*)(ws + WS_BIG + B_SSQ2);
    float* ROPE = (float*)(ws + WS_SMALL + SM_ROPE); float* RSQ = (float*)(ws + WS_SMALL + SM_RSQ); float* RSKV = (float*)(ws + WS_SMALL + SM_RSKV);
    float* MEANV = (float*)(ws + WS_SMALL + SM_MEANV); float* RSTDV = (float*)(ws + WS_SMALL + SM_RSTDV); float* SP8 = (float*)(ws + WS_SMALL + SM_SP8);
    unsigned char* big = ws + WS_BIG;
    bf16_t* H = (bf16_t*)(big + B_H); bf16_t* PB = (bf16_t*)(big + B_PB); bf16_t* GP = (bf16_t*)(big + B_GP);
    bf16_t* Z = (bf16_t*)(big + B_Z); bf16_t* VTS = (bf16_t*)(big + B_VTS); bf16_t* XC = (bf16_t*)(big + B_XC); bf16_t* LA = (bf16_t*)(big + B_LA); bf16_t* U = (bf16_t*)(big + B_U);
    bf16_t* Q = (bf16_t*)(big + B_Q); bf16_t* KN = (bf16_t*)(big + B_KN); bf16_t* VT = (bf16_t*)(big + B_VT); bf16_t* KR = (bf16_t*)(big + B_KR);
    bf16_t* G3 = (bf16_t*)(big + B_G3); bf16_t* MG = (bf16_t*)(big + B_MERGED);

#pragma unroll 1
    for (int L = 0; L < 2; ++L) {
        phase0(p, L, lds, G, blk);
        GRID_SYNC();
        { EpiSwiglu e{H, SSQ}; RUN_GEMM(EpiSwiglu, e, XB, wb + O_WGU1, T, 2 * DFF, 1024, 1024, 1024, 0); }
        GRID_SYNC();
        { EpiResid<false> e{L == 0 ? p.in[0] : nullptr, XB, SSQ, nullptr, 0.5f}; RUN_GEMM(EpiResid<false>, e, H, wb + O_WD1, T, 1024, DFF, DFF, DFF, 0); }
        GRID_SYNC();
#pragma unroll 1
        for (int c = 0; c <= 2; ++c) {
            if (c >= 1) { const size_t q0 = (size_t)(c - 1) * TC;
                EpiResid<false> e{nullptr, XB + q0 * DM, SSQ + q0 * 4, nullptr, 1.0f}; RUN_GEMM(EpiResid<false>, e, MG, wb + O_WOUT, TC, 1024, 1024, 1024, 1024, 0); }
            const size_t r0 = (size_t)c * TC;
            if (c <= 1) {
                { EpiRow<1, 0> e{Z, ZLD, SSQ + r0 * 4, nullptr, 4, 12, 0}; RUN_GEMM((EpiRow<1, 0>), e, XB + r0 * DM, wb + O_WIN, TC, ZLD, 1024, 1024, 1024, 0); }
                { EpiCol<1, 0> e{VTS, TC, SSQ + r0 * 4}; RUN_GEMM((EpiCol<1, 0>), e, wb + O_WINV, XB + r0 * DM, 1024, TC, 1024, 1024, 1024, 0); }
            }
            GRID_SYNC();
            if (c > 1) break;
            e1_rows(p, L, Z, XC, RSQ, RSKV, KR, ROPE, G, blk);
            e2_stats(lds, VTS, MEANV, RSTDV, G, blk);
            GRID_SYNC();
            { EpiLru e{XC, LA, U, p.in[10] + L * 1024, p.in[12] + L * 1024, SP8}; RUN_GEMM(EpiLru, e, XC, wb + O_WLRU, TC, 2048, 128, 1024, 128, 128); }
            { EpiQ e{Q, RSQ, ROPE}; RUN_GEMM(EpiQ, e, Z + ZC_CQ, wb + O_WUQ, TC, 1536, 384, ZLD, 384, 0); }
            { EpiRow<0, 1> e{KN, 1024, RSKV, nullptr, 0, 0, 0}; RUN_GEMM((EpiRow<0, 1>), e, Z + ZC_CKV, wb + O_WKVK, TC, 1024, 256, ZLD, 256, 0); }
            { EpiCol<0, 1> e{VT, TC, RSKV}; RUN_GEMM((EpiCol<0, 1>), e, wb + O_WKVV, Z + ZC_CKV, 1024, TC, 256, 256, ZLD, 0); }
            GRID_SYNC();
            scan_units(lds, LA, U, Z, G, blk);
            attn_units(lds, Q, KN, KR, VT, Z, G, blk);
            sgu_units(lds, VTS, MEANV, RSTDV, p.in[20] + L * 1024, p.in[21] + L * 1024, wb + O_WSGU, p.in[23] + L * 1024, Z, G, blk);
            GRID_SYNC();
            { EpiRow<2, 0> e{G3, 3072, SSQ + r0 * 4, p.in[25] + L * 3072, 0, 0, 1}; RUN_GEMM((EpiRow<2, 0>), e, XB + r0 * DM, wb + O_WING, TC, 3072, 1024, 1024, 1024, 0); }
#undef APS
#define APS 2
            { EpiMerge e{G3, MG}; RUN_GEMM(EpiMerge, e, Z, wb + O_WRA, TC, 3072, 1024, ZLD, 1024, 1024); }
#undef APS
#define APS 0
            GRID_SYNC();
        }
        { EpiSwiglu e{H, SSQ}; RUN_GEMM(EpiSwiglu, e, XB, wb + O_WGU2, T, 2 * DFF, 1024, 1024, 1024, 0); }
        { EpiRow<0, 2> e{GP, 1024, nullptr, nullptr, 0, 0, 0}; RUN_GEMM((EpiRow<0, 2>), e, PB, wb + O_WPLE, T, 1024, 256, 256, 256, 0); }
        GRID_SYNC();
        { EpiResid<false> e{nullptr, XB, SSQ, nullptr, 0.5f}; RUN_GEMM(EpiResid<false>, e, H, wb + O_WD2, T, 1024, DFF, DFF, DFF, 0); }
        GRID_SYNC();
        { EpiPle e{XB, XBn, GP, SSQ, SSQn}; RUN_GEMM(EpiPle, e, XB, wb + O_WPG, T, 1024, 1024, 1024, 1024, 0); }
        GRID_SYNC();
        { bf16_t* tx = XB; XB = XBn; XBn = tx; float* ts = SSQ; SSQ = SSQn; SSQn = ts; }
    }
    {
        const int tid = pg8::tid_opaque(), lane = tid & 63, wave = tid >> 6, gw = blk * 8 + wave, NGW = G * 8; const float* fn = p.in[33];
        for (int m = gw; m < T; m += NGW) {
            const u32x4* xr = (const u32x4*)(XB + (size_t)m * DM) + lane; f32x4* orow = (f32x4*)(X + (size_t)m * DM); f32x4 v[4]; float s = 0.f;
#pragma unroll
            for (int j = 0; j < 2; ++j) { unpack8(xr[64 * j], v[2 * j], v[2 * j + 1]); }
#pragma unroll
            for (int j = 0; j < 4; ++j) s += (v[j][0] * v[j][0] + v[j][1] * v[j][1]) + (v[j][2] * v[j][2] + v[j][3] * v[j][3]);
            const float rstd = __builtin_amdgcn_rsqf(wave_sum(s) * (1.f / 1024.f) + EPS);
#pragma unroll
            for (int j = 0; j < 2; ++j) { const int c = 512 * j + 8 * lane; orow[c / 4] = v[2 * j] * rstd * *(const f32x4*)(fn + c); orow[c / 4 + 1] = v[2 * j + 1] * rstd * *(const f32x4*)(fn + c + 4); }
        }
    }
}

extern "C" void kernel_launch(void* const* d_in, const int* in_sizes, int n_in, void* d_out, int out_size, void* d_ws, size_t ws_size, hipStream_t stream) {
    static int grid = 0;
    if (grid == 0) {
        if (n_in != 34 || ws_size < WS_NEED) { fprintf(stderr, "kernel_launch: unexpected n_in %d / ws_size %zu (need %zu)\n", n_in, ws_size, (size_t)WS_NEED); grid = -1; return; }
        int dev = 0, cus = 0, per = 0;
        (void)hipGetDevice(&dev); (void)hipDeviceGetAttribute(&cus, hipDeviceAttributeMultiprocessorCount, dev);
        (void)hipFuncSetAttribute((const void*)fwd_kernel, hipFuncAttributeMaxDynamicSharedMemorySize, LDS_BYTES);
        if (hipOccupancyMaxActiveBlocksPerMultiprocessor(&per, (const void*)fwd_kernel, 512, LDS_BYTES) != hipSuccess || per < 1) per = 1;
        (void)hipGetLastError();
        grid = cus * per;
    }
    if (grid < 0) return;
    (void)hipMemsetAsync((unsigned char*)d_ws + WS_SMALL + SM_BAR, 0, 16384, stream);
    Params prm{};
    for (int i = 0; i < 34; ++i) prm.in[i] = (const float*)d_in[i];
    prm.out = (float*)d_out; prm.ws = (unsigned char*)d_ws;
    void* args[] = {&prm};
    hipError_t e = hipLaunchCooperativeKernel((const void*)fwd_kernel, dim3(grid), dim3(512), args, LDS_BYTES, stream);
    if (e != hipSuccess) fprintf(stderr, "cooperative launch failed: %s (grid %d)\n", hipGetErrorString(e), grid);
}
```

```cpp
#include <hip/hip_runtime.h>
#include <hip/hip_cooperative_groups.h>
#include <cstdio>
#include <cstdint>
namespace cg = cooperative_groups;
namespace pg8 {
#define PG8_LAS __attribute__((address_space(3)))
typedef unsigned short bf16_t;
typedef short bf16x8 __attribute__((ext_vector_type(8)));
typedef float f32x4 __attribute__((ext_vector_type(4)));
typedef unsigned u32x4 __attribute__((ext_vector_type(4)));
typedef unsigned u32x2 __attribute__((ext_vector_type(2)));
constexpr int BM = 256, BK = 64, HALF = 128, HTB = HALF * BK * 2  , STAGE_BYTES = 8 * HTB, NXCD = 8, WGM = 8;

__host__ __device__ __forceinline__ int lds_byte(int r, int c) { const int st = (r >> 4) * 2 + (c >> 5), rr = r & 15, cc = c & 31, ob = rr * 64 + cc * 2; return st * 1024 + (ob ^ (((ob >> 9) & 1) << 5)); }
__host__ __device__ __forceinline__ void stage_rc(int b, int& R, int& C) { const int st = b / 1024, sb = b % 1024, swz = sb ^ (((sb >> 9) & 1) << 5); R = (st >> 1) * 16 + swz / 64; C = (st & 1) * 32 + (swz % 64) / 2; }
__host__ __device__ __forceinline__ int perm32(int rho) { const int n = rho >> 4, i = rho & 15; return 8 * (i >> 2) + 4 * n + (i & 3); }

struct Unit { int pm, pn; };
struct Gemm { const bf16_t* A; const bf16_t* Bt; int M, N, K, lda, ldb, apn, aps; };

struct StaticOrder {
    int nM, nN, nwg, G, c;
    __host__ __device__ void init(int M, int N, int G_, int c_) { nM = M / BM; nN = N / BM; nwg = nM * nN; G = G_; c = c_; }
    __host__ __device__ bool next(int i, Unit& u) const {
        const long L = (long)i * G + c; if (L >= nwg) return false;
        int wgid = (int)L; { const int q = nwg / NXCD, r = nwg % NXCD, xcd = wgid % NXCD, off = wgid / NXCD; wgid = (xcd < r ? xcd * (q + 1) : r * (q + 1) + (xcd - r) * q) + off; }
        const int nig = WGM * nN, gid = wgid / nig, fm = gid * WGM, gsz = (nM - fm) < WGM ? (nM - fm) : WGM;
        u.pm = fm + ((wgid % nig) % gsz); u.pn = (wgid % nig) / gsz; return true;
    }
    __device__ __forceinline__ void a_ready(const Unit&) const {}
    __device__ __forceinline__ void done(const Unit&) const {}
};
__device__ __forceinline__ int tid_opaque() { int t = threadIdx.x; asm volatile("" : "+v"(t)); return t; }
typedef float f32x2_t __attribute__((ext_vector_type(2))); typedef __bf16 bf16x2_t __attribute__((ext_vector_type(2)));
__device__ __forceinline__ unsigned cvt_pk_bf16(float lo, float hi) { const f32x2_t v = {lo, hi}; const bf16x2_t b = __builtin_convertvector(v, bf16x2_t); return __builtin_bit_cast(unsigned, b); }

template <class Epi, class Sched, bool ALIGN_EPI = false, bool SP2 = false>
__device__ __forceinline__ void gemm_phase(PG8_LAS unsigned char* lds, const Gemm g, const Sched& S, const Epi& E) {
    const int tid = pg8::tid_opaque(), wid = __builtin_amdgcn_readfirstlane(tid >> 6), lane = tid & 63, wr = wid >> 2, wc = wid & 3, fr = lane & 15, fq = lane >> 4;
    const int K = g.K, nt = K / BK;
    unsigned voffA[2], voffB[2];
#pragma unroll
    for (int i = 0; i < 2; ++i) { int R, C; stage_rc(tid * 16 + i * 8192, R, C); const int Rb = Epi::PERM ? ((R & ~31) + perm32(R & 31)) : R;
        voffA[i] = (unsigned)(R * g.lda + C) * 2u; voffB[i] = (unsigned)(Rb * g.ldb + C) * 2u; }
    const size_t kstep = (size_t)(BK * 2);
    const size_t hstepA = (size_t)HALF * g.lda * 2, hstepB = (size_t)HALF * g.ldb * 2;
    const size_t tstepA = 2 * hstepA, tstepB = 2 * hstepB; const size_t apn = (size_t)g.apn * 2;
    const unsigned ldsw = (unsigned)wid * 1024u;
    const int aoff = lds_byte(wr * 64 + fr, fq * 8), boff = lds_byte(wc * 32 + fr, fq * 8);
#define PG8_SA(b, h) (((b) * 2 + (h)) * HTB)
#define PG8_SB(b, h) ((4 + (b) * 2 + (h)) * HTB)
#define PG8_STAGE(bufoff, gbase, voff) do { _Pragma("unroll") for (int _i = 0; _i < 2; ++_i) \
        __builtin_amdgcn_global_load_lds((const unsigned*)((const char*)(gbase) + (voff)[_i]), (PG8_LAS unsigned*)(lds + (bufoff) + ldsw + _i * 8192), 16, 0, 0); } while (0)
#define PG8_LDA(dst, b, h) do { _Pragma("unroll") for (int m = 0; m < 4; ++m) _Pragma("unroll") for (int k = 0; k < 2; ++k) dst[m][k] = *(const PG8_LAS bf16x8*)(lds + PG8_SA(b, h) + aoff + m * 2048 + k * 1024); } while (0)
#define PG8_LDB(dst, b, h) do { _Pragma("unroll") for (int n = 0; n < 2; ++n) _Pragma("unroll") for (int k = 0; k < 2; ++k) dst[n][k] = *(const PG8_LAS bf16x8*)(lds + PG8_SB(b, h) + boff + n * 2048 + k * 1024); } while (0)
#define PG8_MMA(ai, bj, At, Bt) do { __builtin_amdgcn_s_setprio(1); _Pragma("unroll") for (int m = 0; m < 4; ++m) _Pragma("unroll") for (int n = 0; n < 2; ++n) _Pragma("unroll") for (int k = 0; k < 2; ++k) \
        acc[ai][bj][m][n] = __builtin_amdgcn_mfma_f32_16x16x32_bf16(Bt[n][k], At[m][k], acc[ai][bj][m][n], 0, 0, 0); __builtin_amdgcn_s_setprio(0); } while (0)
#define PG8_WAIT_V(n) asm volatile("s_waitcnt vmcnt(" #n ")" ::: "memory")
#define PG8_WAIT_L(n) asm volatile("s_waitcnt lgkmcnt(" #n ")" ::: "memory")
#define PG8_BAR __builtin_amdgcn_s_barrier()
#define PG8_SCHED __builtin_amdgcn_sched_barrier(0)
    Unit cur, nxt; int ui = 0;
    if (!S.next(0, cur)) return;
    f32x4 acc[2][2][4][2];
#pragma unroll
    for (int a = 0; a < 2; ++a)
#pragma unroll
        for (int b = 0; b < 2; ++b)
#pragma unroll
            for (int m = 0; m < 4; ++m)
#pragma unroll
                for (int n = 0; n < 2; ++n) acc[a][b][m][n] = (f32x4){0.f, 0.f, 0.f, 0.f};
    bf16x8 At[4][2], B0[2][2], B1[2][2];
    const char* cA = (const char*)g.A + (size_t)cur.pm * tstepA + (size_t)(cur.pn >> g.aps) * apn; const char* cB = (const char*)g.Bt + (size_t)cur.pn * tstepB;
    S.a_ready(cur);
    if constexpr (SP2) {
        PG8_STAGE(PG8_SB(0, 0), cB, voffB); PG8_STAGE(PG8_SB(0, 1), cB + hstepB, voffB); PG8_STAGE(PG8_SA(0, 0), cA, voffA); PG8_STAGE(PG8_SA(0, 1), cA + hstepA, voffA);
        if (wr == 1) PG8_BAR;
        PG8_WAIT_V(2); PG8_BAR;
        PG8_STAGE(PG8_SB(1, 0), cB + kstep, voffB); PG8_STAGE(PG8_SA(1, 0), cA + kstep, voffA); PG8_STAGE(PG8_SB(1, 1), cB + hstepB + kstep, voffB);
        PG8_WAIT_V(6); PG8_BAR;
    } else {
        PG8_STAGE(PG8_SB(0, 0), cB, voffB); PG8_STAGE(PG8_SA(0, 0), cA, voffA); PG8_STAGE(PG8_SB(0, 1), cB + hstepB, voffB); PG8_STAGE(PG8_SA(0, 1), cA + hstepA, voffA);
        if (wr == 1) PG8_BAR;
        PG8_WAIT_V(4); PG8_BAR;
        PG8_STAGE(PG8_SB(1, 0), cB + kstep, voffB); PG8_STAGE(PG8_SA(1, 0), cA + kstep, voffA); PG8_STAGE(PG8_SB(1, 1), cB + hstepB + kstep, voffB);
        PG8_WAIT_V(6); PG8_BAR;
    }
    for (;;) {
        const bool has_next = S.next(ui + 1, nxt);
        const char* nA = has_next ? (const char*)g.A + (size_t)nxt.pm * tstepA + (size_t)(nxt.pn >> g.aps) * apn : cA; const char* nB = has_next ? (const char*)g.Bt + (size_t)nxt.pn * tstepB : cB;
        for (int t = 0; t < nt; t += 2) {
            const bool last = (t == nt - 2);
            const char* a1 = cA + (size_t)(t + 1) * kstep;
            const char* a2 = last ? nA : cA + (size_t)(t + 2) * kstep; const char* b2 = last ? nB : cB + (size_t)(t + 2) * kstep;
            const char* a3 = a2 + kstep; const char* b3 = b2 + kstep;
            if (last && has_next) S.a_ready(nxt);
            if constexpr (SP2) {
            PG8_LDB(B0, 0, 0); PG8_LDB(B1, 0, 1); PG8_SCHED; PG8_LDA(At, 0, 0); PG8_STAGE(PG8_SA(1, 1), a1 + hstepA, voffA);
            PG8_WAIT_V(8); PG8_WAIT_L(0); PG8_BAR; PG8_MMA(0, 0, At, B0); PG8_MMA(0, 1, At, B1); PG8_BAR; PG8_SCHED;
            PG8_LDA(At, 0, 1); PG8_STAGE(PG8_SB(0, 0), b2, voffB); PG8_STAGE(PG8_SB(0, 1), b2 + hstepB, voffB); PG8_STAGE(PG8_SA(0, 0), a2, voffA);
            PG8_WAIT_V(8); PG8_WAIT_L(0); PG8_BAR; PG8_MMA(1, 0, At, B0); PG8_MMA(1, 1, At, B1); PG8_BAR; PG8_SCHED;
            PG8_LDB(B0, 1, 0); PG8_LDB(B1, 1, 1); PG8_SCHED; PG8_LDA(At, 1, 0); PG8_STAGE(PG8_SA(0, 1), a2 + hstepA, voffA);
            PG8_WAIT_V(8); PG8_WAIT_L(0); PG8_BAR; PG8_MMA(0, 0, At, B0); PG8_MMA(0, 1, At, B1); PG8_BAR; PG8_SCHED;
            PG8_LDA(At, 1, 1); PG8_STAGE(PG8_SB(1, 0), b3, voffB); PG8_STAGE(PG8_SB(1, 1), b3 + hstepB, voffB); PG8_STAGE(PG8_SA(1, 0), a3, voffA);
            PG8_WAIT_V(8); PG8_WAIT_L(0); PG8_BAR; PG8_MMA(1, 0, At, B0); PG8_MMA(1, 1, At, B1); PG8_BAR; PG8_SCHED;
            } else {
            PG8_LDB(B0, 0, 0); PG8_SCHED; PG8_LDA(At, 0, 0); PG8_STAGE(PG8_SA(1, 1), a1 + hstepA, voffA);
            PG8_WAIT_L(8); PG8_BAR; PG8_WAIT_L(0); PG8_MMA(0, 0, At, B0); PG8_BAR; PG8_SCHED;
            PG8_LDB(B1, 0, 1); PG8_STAGE(PG8_SB(0, 0), b2, voffB);
            PG8_BAR; PG8_WAIT_L(0); PG8_MMA(0, 1, At, B1); PG8_BAR;
            PG8_LDA(At, 0, 1); PG8_STAGE(PG8_SA(0, 0), a2, voffA);
            PG8_BAR; PG8_WAIT_L(0); PG8_MMA(1, 0, At, B0); PG8_BAR; PG8_SCHED;
            PG8_STAGE(PG8_SB(0, 1), b2 + hstepB, voffB);
            PG8_WAIT_V(6); PG8_BAR; PG8_MMA(1, 1, At, B1); PG8_BAR;
            PG8_LDB(B0, 1, 0); PG8_SCHED; PG8_LDA(At, 1, 0); PG8_STAGE(PG8_SA(0, 1), a2 + hstepA, voffA);
            PG8_WAIT_L(8); PG8_BAR; PG8_WAIT_L(0); PG8_MMA(0, 0, At, B0); PG8_BAR; PG8_SCHED;
            PG8_LDB(B1, 1, 1); PG8_STAGE(PG8_SB(1, 0), b3, voffB);
            PG8_BAR; PG8_WAIT_L(0); PG8_MMA(0, 1, At, B1); PG8_BAR;
            PG8_LDA(At, 1, 1); PG8_STAGE(PG8_SA(1, 0), a3, voffA);
            PG8_BAR; PG8_WAIT_L(0); PG8_MMA(1, 0, At, B0); PG8_BAR; PG8_SCHED;
            PG8_STAGE(PG8_SB(1, 1), b3 + hstepB, voffB);
            PG8_WAIT_V(6); PG8_BAR; PG8_MMA(1, 1, At, B1); PG8_BAR;
            }
        }
        if constexpr (ALIGN_EPI) { if (wr == 0) PG8_BAR; }
        if constexpr (!Epi::AFTER_DRAIN) { E(acc, cur, wr, wc, fr, fq); S.done(cur); }
        if (!has_next) break;
#pragma unroll
        for (int a = 0; a < 2; ++a)
#pragma unroll
            for (int b = 0; b < 2; ++b)
#pragma unroll
                for (int m = 0; m < 4; ++m)
#pragma unroll
                    for (int n = 0; n < 2; ++n) acc[a][b][m][n] = (f32x4){0.f, 0.f, 0.f, 0.f};
        cur = nxt; cA = nA; cB = nB; ++ui;
        if constexpr (ALIGN_EPI) { if (wr == 1) PG8_BAR; }
    }
    PG8_WAIT_V(0);
    if constexpr (!ALIGN_EPI) { if (wr == 0) PG8_BAR; }
    PG8_BAR;
    if constexpr (Epi::AFTER_DRAIN) { E.fused(acc, cur, wr, wc, fr, fq, lds, wid, lane); S.done(cur); }
#undef PG8_SA
#undef PG8_SB
#undef PG8_STAGE
#undef PG8_LDA
#undef PG8_LDB
#undef PG8_MMA
#undef PG8_WAIT_V
#undef PG8_WAIT_L
#undef PG8_BAR
#undef PG8_SCHED
}
}

using pg8::bf16_t; using pg8::bf16x8; using pg8::f32x4; using pg8::u32x4; using pg8::u32x2; using pg8::Unit; using pg8::cvt_pk_bf16;
typedef float f32x16 __attribute__((ext_vector_type(16)));
typedef float f32x2 __attribute__((ext_vector_type(2)));
#define LAS __attribute__((address_space(3)))

constexpr int T = 32768, DM = 1024, TC = 16384, DFF = 2816, ZLD = 3840;
constexpr int ZC_XA = 0, ZC_GA = 1024, ZC_U = 2048, ZC_CKV = 3072, ZC_CQ = 3328, ZC_KR = 3712;
constexpr float EPS = 1e-6f, LOG2E = 1.4426950408889634f;
constexpr float QSCALE = 0.10206207261596577f * 1.4426950408889634f;
constexpr size_t MiB = (size_t)1 << 20;
constexpr size_t WS_W = 0, WS_XB = 64 * MiB, WS_SSQ = 128 * MiB, WS_SMALL = 130 * MiB, WS_BIG = 132 * MiB;
constexpr size_t SM_ROPE = 0, SM_RSQ = 256 * 1024, SM_RSKV = 320 * 1024, SM_MEANV = 384 * 1024, SM_RSTDV = 448 * 1024, SM_SP8 = 512 * 1024;
constexpr size_t B_H = 0, B_PB = 361 * MiB, B_GP = 192 * MiB, B_SSQ2 = 377 * MiB;
constexpr size_t B_Z = 0, B_VTS = 120 * MiB, B_XC = 152 * MiB, B_LA = 184 * MiB, B_U = 216 * MiB, B_Q = 248 * MiB, B_KN = 296 * MiB, B_VT = 328 * MiB, B_KR = 360 * MiB;
constexpr size_t B_G3 = 248 * MiB, B_MERGED = 184 * MiB;
constexpr size_t WS_NEED = WS_BIG + 379 * MiB;
constexpr size_t O_WGU1 = 0, O_WD1 = O_WGU1 + 5632 * 1024, O_WIN = O_WD1 + 1024 * 2816, O_WINV = O_WIN + 3840 * 1024, O_WING = O_WINV + 1024 * 1024,
                 O_WLRU = O_WING + 3072 * 1024, O_WRA = O_WLRU + 2048 * 128, O_WRB = O_WRA + 1024 * 1024, O_WRC = O_WRB + 1024 * 1024, O_WOUT = O_WRC + 1024 * 1024,
                 O_WPG = O_WOUT + 1024 * 1024, O_WUQ = O_WPG + 1024 * 1024, O_WKVK = O_WUQ + 1536 * 384, O_WKVV = O_WKVK + 1024 * 256, O_WGU2 = O_WKVV + 1024 * 256,
                 O_WD2 = O_WGU2 + 5632 * 1024, O_WPLE = O_WD2 + 1024 * 2816, O_WSGU = O_WPLE + 1024 * 256, O_WEND = O_WSGU + 8 * 128 * 128;
static_assert(O_WEND * 2 <= 64 * MiB, "weights fit");
constexpr int LDS_BYTES = 131072 + 256;
#ifndef DBG_STOP
#define DBG_STOP 0
#endif
#ifndef DBG_BR
#define DBG_BR 7
#endif

struct Params { const float* in[34]; float* out; unsigned char* ws; };

__device__ __forceinline__ float fexp2(float x) { return __builtin_amdgcn_exp2f(x); }
__device__ __forceinline__ float frcp(float x) { return __builtin_amdgcn_rcpf(x); }
__device__ __forceinline__ float sigm(float x) { return frcp(1.f + fexp2(-LOG2E * x)); }
__device__ __forceinline__ float gelu_t(float x) { const float t = x + 0.044715f * x * x * x; return x * frcp(1.f + fexp2(-2.3022081985f * t)); }
__device__ __forceinline__ float bflo(unsigned w) { return __uint_as_float(w << 16); }
__device__ __forceinline__ float bfhi(unsigned w) { return __uint_as_float(w & 0xffff0000u); }
__device__ __forceinline__ bf16_t f2bf(float v) { return (bf16_t)(cvt_pk_bf16(v, 0.f) & 0xffffu); }
__device__ __forceinline__ float wave_sum(float v) {
#pragma unroll
    for (int o = 1; o < 64; o <<= 1) v += __shfl_xor(v, o);
    return v;
}
constexpr size_t SSQ_PLANE = (size_t)T * 4;
__device__ __forceinline__ float rstd16(const float* ssq, size_t row) {
    const float* q = ssq + row * 4; const f32x4 a = *(const f32x4*)q, b = *(const f32x4*)(q + SSQ_PLANE), c = *(const f32x4*)(q + 2 * SSQ_PLANE), d = *(const f32x4*)(q + 3 * SSQ_PLANE);
    const float s = ((a.x + a.y) + (a.z + a.w)) + ((b.x + b.y) + (b.z + b.w)) + ((c.x + c.y) + (c.z + c.w)) + ((d.x + d.y) + (d.z + d.w));
    return __builtin_amdgcn_rsqf(s * (1.0f / 1024.0f) + EPS);
}
__device__ __forceinline__ u32x4 pack8(const f32x4 v0, const f32x4 v1) { u32x4 w; w.x = cvt_pk_bf16(v0[0], v0[1]); w.y = cvt_pk_bf16(v0[2], v0[3]); w.z = cvt_pk_bf16(v1[0], v1[1]); w.w = cvt_pk_bf16(v1[2], v1[3]); return w; }
__device__ __forceinline__ void unpack8(const u32x4 w, f32x4& v0, f32x4& v1) { v0 = (f32x4){bflo(w.x), bfhi(w.x), bflo(w.y), bfhi(w.y)}; v1 = (f32x4){bflo(w.z), bfhi(w.z), bflo(w.w), bfhi(w.w)}; }

template <int MODE> __device__ __forceinline__ void row_scales(const float* rs, int pm, int wr, int fr, int fq, float (&sc)[2][4]) {
    if (MODE == 2) {
#pragma unroll
        for (int m = 0; m < 4; ++m) { sc[0][m] = 1.f; sc[1][m] = 1.f; }
        return; }
    const int lane = fq * 16 + fr; const size_t r = (size_t)pm * 256 + wr * 64 + lane;
    const float sA = (MODE == 0) ? rstd16(rs, r) : rs[r], sB = (MODE == 0) ? rstd16(rs, r + 128) : rs[r + 128];
#pragma unroll
    for (int m = 0; m < 4; ++m) { sc[0][m] = __shfl(sA, 16 * m + fr); sc[1][m] = __shfl(sB, 16 * m + fr); }
}
template <int ACT, int RS> struct EpiRow {
    static constexpr bool PERM = true, AFTER_DRAIN = false;
    bf16_t* O; int ldc; const float* rs; const float* bias; int t0, t1; int bswap;
    __device__ __forceinline__ void operator()(const f32x4 (&acc)[2][2][4][2], const Unit& u, int wr, int wc, int fr, int fq) const {
        const int row0 = u.pm * 256 + wr * 64 + fr, col0 = u.pn * 256 + wc * 32 + 8 * fq;
        const bool act = (ACT == 1) ? (u.pn >= t0 && u.pn < t1) : true;
        float scl[2][4]; row_scales<RS>(rs, u.pm, wr, fr, fq, scl);
        f32x4 bv[2][2];
#pragma unroll
        for (int bj = 0; bj < 2; ++bj)
#pragma unroll
            for (int n = 0; n < 2; ++n) bv[bj][n] = bias ? *(const f32x4*)(bias + col0 + (bswap ? (u.pn < 4 ? 1024 : (u.pn < 8 ? -1024 : 0)) : 0) + bj * 128 + 4 * n) : (f32x4){0.f, 0.f, 0.f, 0.f};
#pragma unroll
        for (int ai = 0; ai < 2; ++ai)
#pragma unroll
            for (int m = 0; m < 4; ++m) {
                const size_t row = (size_t)(row0 + ai * 128 + m * 16); const float s = scl[ai][m];
                bf16_t* rowp = O + row * ldc + col0;
#pragma unroll
                for (int bj = 0; bj < 2; ++bj) {
                    f32x4 v0 = acc[ai][bj][m][0] * s + bv[bj][0], v1 = acc[ai][bj][m][1] * s + bv[bj][1];
                    if (ACT == 1) { if (act) {
#pragma unroll
                        for (int e = 0; e < 4; ++e) { v0[e] = gelu_t(v0[e]); v1[e] = gelu_t(v1[e]); } } }
                    if (ACT == 2) {
#pragma unroll
                        for (int e = 0; e < 4; ++e) { v0[e] = sigm(v0[e]); v1[e] = sigm(v1[e]); } }
                    *(u32x4*)(rowp + bj * 128) = pack8(v0, v1);
                }
                asm volatile("" ::: "memory");
            }
    }
};
struct EpiSwiglu {
    static constexpr bool PERM = true, AFTER_DRAIN = false;
    bf16_t* H; const float* ssq;
    __device__ __forceinline__ void operator()(const f32x4 (&acc)[2][2][4][2], const Unit& u, int wr, int wc, int fr, int fq) const {
        const int row0 = u.pm * 256 + wr * 64 + fr, col0 = u.pn * 128 + wc * 32 + 8 * fq;
        float scl[2][4]; row_scales<0>(ssq, u.pm, wr, fr, fq, scl);
#pragma unroll
        for (int ai = 0; ai < 2; ++ai)
#pragma unroll
            for (int m = 0; m < 4; ++m) {
                const size_t row = (size_t)(row0 + ai * 128 + m * 16); const float s = scl[ai][m];
                f32x4 h0, h1;
#pragma unroll
                for (int e = 0; e < 4; ++e) { const float g0 = acc[ai][0][m][0][e] * s, g1 = acc[ai][0][m][1][e] * s; h0[e] = g0 * sigm(g0) * (acc[ai][1][m][0][e] * s); h1[e] = g1 * sigm(g1) * (acc[ai][1][m][1][e] * s); }
                *(u32x4*)(H + row * DFF + col0) = pack8(h0, h1);
                asm volatile("" ::: "memory");
            }
    }
};
template <bool GATED> struct EpiResid {
    static constexpr bool PERM = true, AFTER_DRAIN = false;
    const float* X32; bf16_t* XB; float* ssq; const bf16_t* GP; float alpha;
    __device__ __forceinline__ void ld(size_t o, f32x4 (&x)[2][2]) const {
#pragma unroll
        for (int bj = 0; bj < 2; ++bj) { if (X32) { x[bj][0] = *(const f32x4*)(X32 + o + bj * 128); x[bj][1] = *(const f32x4*)(X32 + o + bj * 128 + 4); } else unpack8(*(const u32x4*)(XB + o + bj * 128), x[bj][0], x[bj][1]); }
    }
    __device__ __forceinline__ void operator()(const f32x4 (&acc)[2][2][4][2], const Unit& u, int wr, int wc, int fr, int fq) const {
        const int row0 = u.pm * 256 + wr * 64 + fr, col0 = u.pn * 256 + wc * 32 + 8 * fq;
        f32x4 xc[2][2], xn[2][2];
        ld((size_t)row0 * DM + col0, xc);
#pragma unroll
        for (int g = 0; g < 8; ++g) {
            const int ai = g >> 2, m = g & 3; const size_t row = (size_t)(row0 + ai * 128 + m * 16); float ss = 0.f;
            if (g < 7) ld((size_t)(row0 + ((g + 1) >> 2) * 128 + ((g + 1) & 3) * 16) * DM + col0, xn);
#pragma unroll
            for (int bj = 0; bj < 2; ++bj) {
                const size_t o = row * DM + col0 + bj * 128; f32x4 a0 = acc[ai][bj][m][0] * alpha, a1 = acc[ai][bj][m][1] * alpha;
                if (GATED) { f32x4 g0, g1; unpack8(*(const u32x4*)(GP + o), g0, g1); a0 *= g0; a1 *= g1; }
                const f32x4 x0 = xc[bj][0] + a0, x1 = xc[bj][1] + a1;
                *(u32x4*)(XB + o) = pack8(x0, x1);
                ss += (x0[0] * x0[0] + x0[1] * x0[1]) + (x0[2] * x0[2] + x0[3] * x0[3]) + (x1[0] * x1[0] + x1[1] * x1[1]) + (x1[2] * x1[2] + x1[3] * x1[3]);
            }
            ss += __shfl_xor(ss, 16); ss += __shfl_xor(ss, 32);
            if (fq == 0) ssq[(size_t)u.pn * SSQ_PLANE + row * 4 + wc] = ss;
#pragma unroll
            for (int bj = 0; bj < 2; ++bj) { xc[bj][0] = xn[bj][0]; xc[bj][1] = xn[bj][1]; }
        }
    }
};
struct EpiPle {
    static constexpr bool PERM = true, AFTER_DRAIN = false;
    const bf16_t* XBc; bf16_t* XBn; const bf16_t* PP; const float* ssqc; float* ssqn;
    __device__ __forceinline__ void ld(size_t o, u32x4 (&w)[2][2]) const {
#pragma unroll
        for (int bj = 0; bj < 2; ++bj) { w[bj][0] = *(const u32x4*)(PP + o + bj * 128); w[bj][1] = *(const u32x4*)(XBc + o + bj * 128); }
    }
    __device__ __forceinline__ void operator()(const f32x4 (&acc)[2][2][4][2], const Unit& u, int wr, int wc, int fr, int fq) const {
        const int row0 = u.pm * 256 + wr * 64 + fr, col0 = u.pn * 256 + wc * 32 + 8 * fq;
        float scl[2][4]; row_scales<0>(ssqc, u.pm, wr, fr, fq, scl);
        u32x4 wc_[2][2], wn_[2][2];
        ld((size_t)row0 * DM + col0, wc_);
#pragma unroll
        for (int g = 0; g < 8; ++g) {
            const int ai = g >> 2, m = g & 3; const size_t row = (size_t)(row0 + ai * 128 + m * 16); const float s = scl[ai][m]; float ss = 0.f;
            if (g < 7) ld((size_t)(row0 + ((g + 1) >> 2) * 128 + ((g + 1) & 3) * 16) * DM + col0, wn_);
#pragma unroll
            for (int bj = 0; bj < 2; ++bj) {
                const size_t o = row * DM + col0 + bj * 128; f32x4 p0, p1, x0, x1; unpack8(wc_[bj][0], p0, p1); unpack8(wc_[bj][1], x0, x1);
                const f32x4 v0 = acc[ai][bj][m][0] * s, v1 = acc[ai][bj][m][1] * s;
#pragma unroll
                for (int e = 0; e < 4; ++e) { x0[e] += p0[e] * sigm(v0[e]); x1[e] += p1[e] * sigm(v1[e]); }
                *(u32x4*)(XBn + o) = pack8(x0, x1);
                ss += (x0[0] * x0[0] + x0[1] * x0[1]) + (x0[2] * x0[2] + x0[3] * x0[3]) + (x1[0] * x1[0] + x1[1] * x1[1]) + (x1[2] * x1[2] + x1[3] * x1[3]);
            }
            ss += __shfl_xor(ss, 16); ss += __shfl_xor(ss, 32);
            if (fq == 0) ssqn[(size_t)u.pn * SSQ_PLANE + row * 4 + wc] = ss;
#pragma unroll
            for (int bj = 0; bj < 2; ++bj) { wc_[bj][0] = wn_[bj][0]; wc_[bj][1] = wn_[bj][1]; }
        }
    }
};
template <int ACT, int RS> struct EpiCol {
    static constexpr bool PERM = true, AFTER_DRAIN = false;
    bf16_t* O; int ldc; const float* rs;
    __device__ __forceinline__ void operator()(const f32x4 (&acc)[2][2][4][2], const Unit& u, int wr, int wc, int fr, int fq) const {
        const int row0 = u.pm * 256 + wr * 64 + fr, col0 = u.pn * 256 + wc * 32 + 8 * fq;
#pragma unroll
        for (int bj = 0; bj < 2; ++bj) {
            const int col = col0 + bj * 128; f32x4 c0, c1;
            if (RS == 0) {
#pragma unroll
                for (int e = 0; e < 4; ++e) { c0[e] = rstd16(rs, (size_t)(col + e)); asm volatile("" ::: "memory"); c1[e] = rstd16(rs, (size_t)(col + 4 + e)); asm volatile("" ::: "memory"); }
            } else { c0 = *(const f32x4*)(rs + col); c1 = *(const f32x4*)(rs + col + 4); }
#pragma unroll
            for (int ai = 0; ai < 2; ++ai)
#pragma unroll
                for (int m = 0; m < 4; ++m) {
                    f32x4 v0 = acc[ai][bj][m][0] * c0, v1 = acc[ai][bj][m][1] * c1;
                    if (ACT == 1) {
#pragma unroll
                        for (int e = 0; e < 4; ++e) { v0[e] = gelu_t(v0[e]); v1[e] = gelu_t(v1[e]); } }
                    *(u32x4*)(O + (size_t)(row0 + ai * 128 + m * 16) * ldc + col) = pack8(v0, v1);
                    asm volatile("" ::: "memory");
                }
        }
    }
};
struct EpiLru {
    static constexpr bool PERM = true, AFTER_DRAIN = false;
    const bf16_t* XC; bf16_t* LA; bf16_t* U; const float* ba; const float* bx; const float* sp8;
    __device__ __forceinline__ void operator()(const f32x4 (&acc)[2][2][4][2], const Unit& u, int wr, int wc, int fr, int fq) const {
        const int row0 = u.pm * 256 + wr * 64 + fr, ch0 = (u.pn * 256 + wc * 32 + 8 * fq) >> 1;
#pragma unroll
        for (int bj = 0; bj < 2; ++bj) {
            const int ch = ch0 + bj * 64; const f32x4 vba = *(const f32x4*)(ba + ch), vbx = *(const f32x4*)(bx + ch), vsp = *(const f32x4*)(sp8 + ch);
#pragma unroll
            for (int ai = 0; ai < 2; ++ai)
#pragma unroll
                for (int m = 0; m < 4; ++m) {
                    const int row = row0 + ai * 128 + m * 16; const size_t o = (size_t)row * DM + ch; const bool first = (row & 2047) == 0;
                    const u32x2 xw = *(const u32x2*)(XC + o); const float xc[4] = {bflo(xw.x), bfhi(xw.x), bflo(xw.y), bfhi(xw.y)};
                    const f32x4 v0 = acc[ai][bj][m][0], v1 = acc[ai][bj][m][1]; const float ga[4] = {v0[0], v0[2], v1[0], v1[2]}, gx[4] = {v0[1], v0[3], v1[1], v1[3]};
                    float la[4], uu[4];
#pragma unroll
                    for (int e = 0; e < 4; ++e) { const float r = sigm(ga[e] + vba[e]), ig = sigm(gx[e] + vbx[e]); la[e] = -vsp[e] * r;
                        const float a2 = fexp2(2.f * LOG2E * la[e]); const float mult = first ? 1.f : sqrtf(fmaxf(1.f - a2, 0.f)); uu[e] = mult * ig * xc[e]; }
                    u32x2 wl, wu; wl.x = cvt_pk_bf16(la[0], la[1]); wl.y = cvt_pk_bf16(la[2], la[3]); wu.x = cvt_pk_bf16(uu[0], uu[1]); wu.y = cvt_pk_bf16(uu[2], uu[3]);
                    *(u32x2*)(LA + o) = wl; *(u32x2*)(U + o) = wu;
                    asm volatile("" ::: "memory");
                }
        }
    }
};
struct EpiQ {
    static constexpr bool PERM = true, AFTER_DRAIN = false;
    bf16_t* Q; const float* rsq; const float* rope;
    __device__ __forceinline__ void operator()(const f32x4 (&acc)[2][2][4][2], const Unit& u, int wr, int wc, int fr, int fq) const {
        const int row0 = u.pm * 256 + wr * 64 + fr, col0 = u.pn * 256 + wc * 32 + 8 * fq;
        float scl[2][4]; row_scales<1>(rsq, u.pm, wr, fr, fq, scl);
#pragma unroll
        for (int ai = 0; ai < 2; ++ai)
#pragma unroll
            for (int m = 0; m < 4; ++m) {
                const int row = row0 + ai * 128 + m * 16; const float s = scl[ai][m] * QSCALE; const int pos = row & 2047;
#pragma unroll
                for (int bj = 0; bj < 2; ++bj) {
                    const int col = col0 + bj * 128, d = col % 96; f32x4 v0 = acc[ai][bj][m][0] * s, v1 = acc[ai][bj][m][1] * s;
                    if (d >= 64) { const int i0 = (d - 64) >> 1; const f32x4 t0 = *(const f32x4*)(rope + (pos * 16 + i0) * 2), t1 = *(const f32x4*)(rope + (pos * 16 + i0 + 2) * 2);
                        const f32x4 a = v0, b = v1;
                        v0[0] = a[0] * t0[0] - a[1] * t0[1]; v0[1] = a[0] * t0[1] + a[1] * t0[0]; v0[2] = a[2] * t0[2] - a[3] * t0[3]; v0[3] = a[2] * t0[3] + a[3] * t0[2];
                        v1[0] = b[0] * t1[0] - b[1] * t1[1]; v1[1] = b[0] * t1[1] + b[1] * t1[0]; v1[2] = b[2] * t1[2] - b[3] * t1[3]; v1[3] = b[2] * t1[3] + b[3] * t1[2]; }
                    *(u32x4*)(Q + (size_t)row * 1536 + col) = pack8(v0, v1);
                }
                asm volatile("" ::: "memory");
            }
    }
};
struct EpiMerge {
    static constexpr bool PERM = true, AFTER_DRAIN = false;
    const bf16_t* G3; bf16_t* MG;
    __device__ __forceinline__ void ld(size_t row, int col0, int mcol0, bool first, u32x4 (&w)[2][2]) const {
#pragma unroll
        for (int bj = 0; bj < 2; ++bj) { w[bj][0] = *(const u32x4*)(G3 + row * 3072 + col0 + bj * 128); w[bj][1] = first ? (u32x4){0u, 0u, 0u, 0u} : *(const u32x4*)(MG + row * DM + mcol0 + bj * 128); }
    }
    __device__ __forceinline__ void operator()(const f32x4 (&acc)[2][2][4][2], const Unit& u, int wr, int wc, int fr, int fq) const {
        const int row0 = u.pm * 256 + wr * 64 + fr, col0 = u.pn * 256 + wc * 32 + 8 * fq, mcol0 = (u.pn & 3) * 256 + wc * 32 + 8 * fq; const bool first = u.pn < 4;
        u32x4 wc_[2][2], wn_[2][2];
        ld((size_t)row0, col0, mcol0, first, wc_);
#pragma unroll
        for (int g = 0; g < 8; ++g) {
            const int ai = g >> 2, m = g & 3; const size_t row = (size_t)(row0 + ai * 128 + m * 16);
            if (g < 7) ld((size_t)(row0 + ((g + 1) >> 2) * 128 + ((g + 1) & 3) * 16), col0, mcol0, first, wn_);
#pragma unroll
            for (int bj = 0; bj < 2; ++bj) {
                f32x4 g0, g1, p0, p1; unpack8(wc_[bj][0], g0, g1); unpack8(wc_[bj][1], p0, p1);
                const f32x4 v0 = acc[ai][bj][m][0] * g0 + p0, v1 = acc[ai][bj][m][1] * g1 + p1;
                *(u32x4*)(MG + row * DM + mcol0 + bj * 128) = pack8(v0, v1);
            }
#pragma unroll
            for (int bj = 0; bj < 2; ++bj) { wc_[bj][0] = wn_[bj][0]; wc_[bj][1] = wn_[bj][1]; }
        }
    }
};
enum { MAP_ID = 0, MAP_SWIGLU, MAP_WIN, MAP_UQ, MAP_KVK, MAP_KVV, MAP_GATES };
struct Job { const float* W; const float* gain; bf16_t* dst; int ldw, K, dN, map, off; };
__device__ __forceinline__ int srcmap(int map, int off, int n) {
    switch (map) {
    case MAP_SWIGLU: return (n >> 8) * 128 + (n & 127) + ((n & 128) ? DFF : 0);
    case MAP_WIN: if (n < 2048) return n; if (n < 3072) return 2720 + (n - 2048); if (n < 3328) return 2432 + (n - 3072); if (n < 3712) return 2048 + (n - 3328);
                  if (n < 3744) { const int j = n - 3712, i = j >> 1; return 2688 + ((j & 1) ? 16 + i : i); } return -1;
    case MAP_UQ: { const int h = n / 96, d = n % 96; if (d < 64) return n; const int j = d - 64, i = j >> 1; return h * 96 + 64 + ((j & 1) ? 16 + i : i); }
    case MAP_KVK: return (n >> 6) * 128 + (n & 63);
    case MAP_KVV: return (n >> 6) * 128 + 64 + (n & 63);
    case MAP_GATES: return 4768 + (n < 1024 ? n + 1024 : (n < 2048 ? n - 1024 : n));
    default: return n + off;
    }
}
#define JOB(Wp, GAIN, DST, LDW, KK, DN, MAP, OFF) do { J.W = (Wp); J.gain = (GAIN); J.dst = wb + (DST); J.ldw = (LDW); J.K = (KK); J.dN = (DN); J.map = (MAP); J.off = (OFF); } while (0)
__device__ __forceinline__ void get_job(const Params& p, int L, int j, bf16_t* wb, Job& J) {
    const size_t M1 = 1024 * 1024;
    switch (j) {
    case 0: JOB(p.in[3] + (size_t)L * 1024 * 5632, p.in[2] + L * 1024, O_WGU1, 5632, 1024, 5632, MAP_SWIGLU, 0); break;
    case 1: JOB(p.in[4] + (size_t)L * 2816 * 1024, nullptr, O_WD1, 1024, 2816, 1024, MAP_ID, 0); break;
    case 2: JOB(p.in[6] + (size_t)L * 1024 * 7840, p.in[5] + L * 1024, O_WIN, 7840, 1024, 3840, MAP_WIN, 0); break;
    case 3: JOB(p.in[6] + (size_t)L * 1024 * 7840, p.in[5] + L * 1024, O_WINV, 7840, 1024, 1024, MAP_ID, 3744); break;
    case 4: JOB(p.in[6] + (size_t)L * 1024 * 7840, p.in[5] + L * 1024, O_WING, 7840, 1024, 3072, MAP_GATES, 0); break;
    case 5: JOB(p.in[14] + L * M1, nullptr, O_WRB, 1024, 1024, 1024, MAP_ID, 0); break;
    case 6: JOB(p.in[19] + L * M1, nullptr, O_WRA, 1024, 1024, 1024, MAP_ID, 0); break;
    case 7: JOB(p.in[24] + L * M1, nullptr, O_WRC, 1024, 1024, 1024, MAP_ID, 0); break;
    case 8: JOB(p.in[26] + L * M1, nullptr, O_WOUT, 1024, 1024, 1024, MAP_ID, 0); break;
    case 9: JOB(p.in[31] + L * M1, p.in[30] + L * 1024, O_WPG, 1024, 1024, 1024, MAP_ID, 0); break;
    case 10: JOB(p.in[16] + (size_t)L * 384 * 1536, p.in[15] + L * 384, O_WUQ, 1536, 384, 1536, MAP_UQ, 0); break;
    case 11: JOB(p.in[18] + (size_t)L * 256 * 2048, p.in[17] + L * 256, O_WKVK, 2048, 256, 1024, MAP_KVK, 0); break;
    case 12: JOB(p.in[18] + (size_t)L * 256 * 2048, p.in[17] + L * 256, O_WKVV, 2048, 256, 1024, MAP_KVV, 0); break;
    case 13: JOB(p.in[28] + (size_t)L * 1024 * 5632, p.in[27] + L * 1024, O_WGU2, 5632, 1024, 5632, MAP_SWIGLU, 0); break;
    case 14: JOB(p.in[29] + (size_t)L * 2816 * 1024, nullptr, O_WD2, 1024, 2816, 1024, MAP_ID, 0); break;
    default: JOB(p.in[32] + (size_t)L * 256 * 1024, nullptr, O_WPLE, 1024, 256, 1024, MAP_ID, 0); break;
    }
}
constexpr int NJOBS = 16;
__device__ __forceinline__ void tr_item(const Job& J, int item, LAS float* scr, int lane) {
    const int nblk = J.dN >> 5, kb = item / nblk, nb = item % nblk, k0 = 64 * kb, n0 = 32 * nb;
    const int sc0 = srcmap(J.map, J.off, n0);
    if (sc0 >= 0 && srcmap(J.map, J.off, n0 + 1) == sc0 + 1 && srcmap(J.map, J.off, n0 + 31) == sc0 + 31) {
        const int kr = lane >> 3, c4 = lane & 7; f32x4 v[8];
#pragma unroll
        for (int i = 0; i < 8; ++i) v[i] = *(const f32x4*)(J.W + (size_t)(k0 + 8 * i + kr) * J.ldw + sc0 + 4 * c4);
#pragma unroll
        for (int i = 0; i < 8; ++i) { const int kk = 8 * i + kr; const float gn = J.gain ? J.gain[k0 + kk] : 1.f;
            scr[kk * 33 + 4 * c4] = v[i][0] * gn; scr[kk * 33 + 4 * c4 + 1] = v[i][1] * gn; scr[kk * 33 + 4 * c4 + 2] = v[i][2] * gn; scr[kk * 33 + 4 * c4 + 3] = v[i][3] * gn; }
    } else {
        const int sc = srcmap(J.map, J.off, n0 + (lane & 31));
#pragma unroll 8
        for (int i = 0; i < 32; ++i) { const int kk = 2 * i + (lane >> 5); float v = (sc >= 0) ? J.W[(size_t)(k0 + kk) * J.ldw + sc] : 0.f; if (J.gain) v *= J.gain[k0 + kk]; scr[kk * 33 + (lane & 31)] = v; }
    }
    asm volatile("s_waitcnt lgkmcnt(0)" ::: "memory");
    const int c = lane & 7;
#pragma unroll
    for (int j = 0; j < 4; ++j) { const int n = (lane >> 3) + 8 * j; const LAS float* s = scr + (8 * c) * 33 + n;
        u32x4 o; o.x = cvt_pk_bf16(s[0 * 33], s[1 * 33]); o.y = cvt_pk_bf16(s[2 * 33], s[3 * 33]); o.z = cvt_pk_bf16(s[4 * 33], s[5 * 33]); o.w = cvt_pk_bf16(s[6 * 33], s[7 * 33]);
        *(u32x4*)(J.dst + (size_t)(n0 + n) * J.K + k0 + 8 * c) = o; }
    asm volatile("s_waitcnt lgkmcnt(0)" ::: "memory");
}
__device__ __forceinline__ void phase0(const Params& p, int L, LAS unsigned char* lds, int G, int blk) {
    const int tid = pg8::tid_opaque(), lane = tid & 63, wave = tid >> 6;
    const int gw = blk * 8 + wave, NGW = G * 8, gt = blk * 512 + tid, NGT = G * 512;
    bf16_t* wb = (bf16_t*)(p.ws + WS_W);
    LAS float* scr = (LAS float*)(lds + wave * 8448);
    int total = 0;
    for (int j = 0; j < NJOBS; ++j) { Job J; get_job(p, L, j, wb, J); total += (J.K >> 6) * (J.dN >> 5); }
    for (int it = gw; it < total; it += NGW) {
        int r = it;
        for (int j = 0; j < NJOBS; ++j) { Job J; get_job(p, L, j, wb, J); const int n = (J.K >> 6) * (J.dN >> 5); if (r < n) { tr_item(J, r, scr, lane); break; } r -= n; }
    }
    { bf16_t* d = wb + O_WLRU; const float* wa = p.in[9] + (size_t)L * 65536; const float* wx = p.in[11] + (size_t)L * 65536;
      for (int i = gt; i < 2048 * 128; i += NGT) { const int n = i >> 7, k = i & 127, ch = n >> 1, nb = ch >> 6, dd = ch & 63;
          float v = 0.f; if ((k >> 6) == (nb & 1)) v = ((n & 1) ? wx : wa)[(size_t)nb * 4096 + (k & 63) * 64 + dd]; d[i] = f2bf(v); } }
    { bf16_t* d = wb + O_WSGU; const float* w = p.in[22] + (size_t)L * 131072;
      for (int i = gt; i < 131072; i += NGT) { const int t = (i >> 7) & 127, s = i & 127; d[i] = f2bf(((s >> 6) <= (t >> 6)) ? w[i] : 0.f); } }
    { const f32x4* src = (const f32x4*)(p.in[1] + (size_t)L * T * 256); u32x2* d = (u32x2*)(p.ws + WS_BIG + B_PB);
      for (int i = gt; i < T * 256 / 4; i += NGT) { const f32x4 v = src[i]; u32x2 w; w.x = cvt_pk_bf16(v[0], v[1]); w.y = cvt_pk_bf16(v[2], v[3]); d[i] = w; } }
    { float* sp = (float*)(p.ws + WS_SMALL + SM_SP8); const float* lam = p.in[13] + L * 1024;
      for (int i = gt; i < 1024; i += NGT) sp[i] = 8.f * 0.6931471805599453f * __builtin_amdgcn_logf(1.f + fexp2(-LOG2E * lam[i])); }
    if (L == 0) {
        float* rope = (float*)(p.ws + WS_SMALL + SM_ROPE);
        for (int i = gt; i < 2048 * 16; i += NGT) { const int pos = i >> 4, k = i & 15; const float inv = fexp2(-(float)k * (13.287712379549449f / 16.f)); const float ang = (float)pos * inv;
            double rev = (double)ang * 0.15915494309189535; rev -= floor(rev); const float fr = (float)rev; rope[2 * i] = __builtin_amdgcn_cosf(fr); rope[2 * i + 1] = __builtin_amdgcn_sinf(fr); }
        const float* x = p.in[0]; bf16_t* XB = (bf16_t*)(p.ws + WS_XB); float* ssq = (float*)(p.ws + WS_SSQ);
        for (int m = gw; m < T; m += NGW) {
            const f32x4* xr = (const f32x4*)(x + (size_t)m * DM) + lane; u32x2* o8 = (u32x2*)(XB + (size_t)m * DM) + lane; float s = 0.f;
#pragma unroll
            for (int j = 0; j < 4; ++j) { const f32x4 v = xr[64 * j]; s += (v[0] * v[0] + v[1] * v[1]) + (v[2] * v[2] + v[3] * v[3]); u32x2 w; w.x = cvt_pk_bf16(v[0], v[1]); w.y = cvt_pk_bf16(v[2], v[3]); o8[64 * j] = w; }
            s = wave_sum(s);
            if (lane < 16) ssq[(size_t)(lane >> 2) * SSQ_PLANE + (size_t)m * 4 + (lane & 3)] = (lane == 0) ? s : 0.f;
        }
    }
}

__device__ __forceinline__ void pb_convert(const Params& p, int L, int G, int blk) {
    const int tid = pg8::tid_opaque(), gt = blk * 512 + tid, NGT = G * 512;
    const f32x4* src = (const f32x4*)(p.in[1] + (size_t)L * T * 256); u32x2* d = (u32x2*)(p.ws + WS_BIG + B_PB);
    for (int i = gt; i < T * 256 / 4; i += NGT) { const f32x4 v = src[i]; u32x2 w; w.x = cvt_pk_bf16(v[0], v[1]); w.y = cvt_pk_bf16(v[2], v[3]); d[i] = w; }
}
__device__ __forceinline__ void e1_rows(const Params& p, int L, const bf16_t* Z, bf16_t* XC, float* RSQ, float* RSKV, bf16_t* KR, const float* rope, int G, int blk) {
    const int tid = pg8::tid_opaque(), lane = tid & 63, wave = tid >> 6;
    const float* cw = p.in[7] + (size_t)L * 4096; const float* cb = p.in[8] + L * 1024;
    for (int rb = blk * 64 + wave * 8; rb < TC; rb += G * 64) {
        const bool halo = (rb & 2047) != 0;
        u32x4 cqv[8]; u32x2 ckv[8];
#pragma unroll
        for (int r = 0; r < 8; ++r) { const bf16_t* zr = Z + (size_t)(rb + r) * ZLD; cqv[r] = (lane < 48) ? *(const u32x4*)(zr + ZC_CQ + 8 * lane) : (u32x4){0u, 0u, 0u, 0u}; ckv[r] = *(const u32x2*)(zr + ZC_CKV + 4 * lane); }
#pragma unroll
        for (int hf = 0; hf < 2; ++hf) {
            const int c0 = hf * 512 + 8 * lane; u32x4 xr[11];
#pragma unroll
            for (int j = 0; j < 11; ++j) xr[j] = (j >= 3 || halo) ? *(const u32x4*)(Z + (ptrdiff_t)(rb - 3 + j) * ZLD + ZC_XA + c0) : (u32x4){0u, 0u, 0u, 0u};
            f32x4 w0[4], w1[4]; const f32x4 b0 = *(const f32x4*)(cb + c0), b1 = *(const f32x4*)(cb + c0 + 4);
#pragma unroll
            for (int k = 0; k < 4; ++k) { w0[k] = *(const f32x4*)(cw + k * 1024 + c0); w1[k] = *(const f32x4*)(cw + k * 1024 + c0 + 4); }
#pragma unroll
            for (int r = 0; r < 8; ++r) { f32x4 a0 = b0, a1 = b1;
#pragma unroll
                for (int k = 0; k < 4; ++k) { f32x4 x0, x1; unpack8(xr[r + k], x0, x1); a0 += w0[k] * x0; a1 += w1[k] * x1; }
                *(u32x4*)(XC + (size_t)(rb + r) * DM + c0) = pack8(a0, a1); }
        }
        float sq[8], sk[8];
#pragma unroll
        for (int r = 0; r < 8; ++r) { f32x4 x0, x1; unpack8(cqv[r], x0, x1); sq[r] = (x0[0] * x0[0] + x0[1] * x0[1]) + (x0[2] * x0[2] + x0[3] * x0[3]) + (x1[0] * x1[0] + x1[1] * x1[1]) + (x1[2] * x1[2] + x1[3] * x1[3]);
            const float a = bflo(ckv[r].x), b = bfhi(ckv[r].x), c = bflo(ckv[r].y), d = bfhi(ckv[r].y); sk[r] = (a * a + b * b) + (c * c + d * d); }
#pragma unroll
        for (int o = 1; o < 64; o <<= 1)
#pragma unroll
            for (int r = 0; r < 8; ++r) { sq[r] += __shfl_xor(sq[r], o); sk[r] += __shfl_xor(sk[r], o); }
        { float q = sq[0], k = sk[0];
#pragma unroll
          for (int r = 1; r < 8; ++r) { if (lane == r) { q = sq[r]; k = sk[r]; } }
          if (lane < 8) { RSQ[rb + lane] = __builtin_amdgcn_rsqf(q * (1.f / 384.f) + EPS); RSKV[rb + lane] = __builtin_amdgcn_rsqf(k * (1.f / 256.f) + EPS); } }
#pragma unroll
        for (int it = 0; it < 2; ++it) { const int r = rb + it * 4 + (lane >> 4), i = lane & 15, pos = r & 2047;
            const unsigned w = *(const unsigned*)(Z + (size_t)r * ZLD + ZC_KR + 2 * i); const float x1 = bflo(w), x2 = bfhi(w); const f32x2 cs = *(const f32x2*)(rope + (pos * 16 + i) * 2);
            *(unsigned*)(KR + (size_t)r * 32 + 2 * i) = cvt_pk_bf16(x1 * cs[0] - x2 * cs[1], x1 * cs[1] + x2 * cs[0]); }
    }
}
__device__ __forceinline__ void e2_stats(LAS unsigned char* lds, const bf16_t* VTS, float* MEANV, float* RSTDV, int G, int blk) {
    const int tid = pg8::tid_opaque(), lane = tid & 63, wave = tid >> 6, tg = lane & 7, cr = lane >> 3;
    LAS float* part = (LAS float*)lds;
    for (int unit = blk; unit < TC / 64; unit += G) {
        const int tok0 = unit * 64; float s[8], q[8];
#pragma unroll
        for (int e = 0; e < 8; ++e) { s[e] = 0.f; q[e] = 0.f; }
#pragma unroll
        for (int it = 0; it < 16; ++it) { const int c = wave * 128 + it * 8 + cr; f32x4 x0, x1; unpack8(*(const u32x4*)(VTS + (size_t)c * TC + tok0 + 8 * tg), x0, x1);
#pragma unroll
            for (int e = 0; e < 4; ++e) { s[e] += x0[e]; q[e] += x0[e] * x0[e]; s[4 + e] += x1[e]; q[4 + e] += x1[e] * x1[e]; } }
#pragma unroll
        for (int e = 0; e < 8; ++e) { s[e] += __shfl_xor(s[e], 8); s[e] += __shfl_xor(s[e], 16); s[e] += __shfl_xor(s[e], 32); q[e] += __shfl_xor(q[e], 8); q[e] += __shfl_xor(q[e], 16); q[e] += __shfl_xor(q[e], 32); }
        if (cr == 0) {
#pragma unroll
            for (int e = 0; e < 8; ++e) { part[(wave * 64 + 8 * tg + e) * 2] = s[e]; part[(wave * 64 + 8 * tg + e) * 2 + 1] = q[e]; } }
        __syncthreads();
        if (tid < 64) { float ss = 0.f, qq = 0.f;
#pragma unroll
            for (int w = 0; w < 8; ++w) { ss += part[(w * 64 + tid) * 2]; qq += part[(w * 64 + tid) * 2 + 1]; }
            const float mean = ss * (1.f / 1024.f); const float var = fmaxf(qq * (1.f / 1024.f) - mean * mean, 0.f);
            MEANV[tok0 + tid] = mean; RSTDV[tok0 + tid] = __builtin_amdgcn_rsqf(var + EPS); }
        __syncthreads();
    }
}
__device__ __forceinline__ void scan_units(LAS unsigned char* lds, const bf16_t* LA, const bf16_t* U, bf16_t* Z, int G, int blk) {
    const int tid = pg8::tid_opaque(), cp = tid & 15, seg = tid >> 4;
    LAS f32x4* sc = (LAS f32x4*)lds;
    for (int idx = blk; idx < 256; idx += G) {
        const int b = idx >> 5, ch = (idx & 31) * 32 + 2 * cp; const size_t row0 = (size_t)b * 2048 + seg * 64;
        const unsigned* lap = (const unsigned*)(LA + row0 * DM + ch); const unsigned* up = (const unsigned*)(U + row0 * DM + ch);
        float h0 = 0.f, h1 = 0.f, s0 = 0.f, s1 = 0.f;
#pragma unroll 16
        for (int t = 0; t < 64; ++t) { const unsigned lw = lap[(size_t)t * 512], uw = up[(size_t)t * 512]; const float l0 = bflo(lw), l1 = bfhi(lw);
            h0 = fexp2(LOG2E * l0) * h0 + bflo(uw); h1 = fexp2(LOG2E * l1) * h1 + bfhi(uw); s0 += l0; s1 += l1; }
        sc[seg * 16 + cp] = (f32x4){s0, s1, h0, h1};
        __syncthreads();
        float c0 = 0.f, c1 = 0.f;
        for (int j = 0; j < seg; ++j) { const f32x4 v = sc[j * 16 + cp]; c0 = fexp2(LOG2E * v[0]) * c0 + v[2]; c1 = fexp2(LOG2E * v[1]) * c1 + v[3]; }
        h0 = c0; h1 = c1;
        unsigned* gp = (unsigned*)(Z + row0 * ZLD + ZC_GA + ch);
#pragma unroll 16
        for (int t = 0; t < 64; ++t) { const unsigned lw = lap[(size_t)t * 512], uw = up[(size_t)t * 512], gw = gp[(size_t)t * (ZLD / 2)];
            h0 = fexp2(LOG2E * bflo(lw)) * h0 + bflo(uw); h1 = fexp2(LOG2E * bfhi(lw)) * h1 + bfhi(uw); gp[(size_t)t * (ZLD / 2)] = cvt_pk_bf16(h0 * bflo(gw), h1 * bfhi(gw)); }
        __syncthreads();
    }
}
__device__ __forceinline__ void attn_units(LAS unsigned char* lds, const bf16_t* Q, const bf16_t* KN, const bf16_t* KR, const bf16_t* VT, bf16_t* Z, int G, int blk) {
    const int tid = pg8::tid_opaque(), lane = tid & 63, wid = __builtin_amdgcn_readfirstlane(tid >> 6), i32 = lane & 31, hi = lane >> 5;
    constexpr int KP = 208, VP = 144, KBUF = 64 * KP, VBUF = 64 * VP;
    const int kdst = (tid >> 3) * KP + (tid & 7) * 16, krdst = (tid >> 2) * KP + 128 + (tid & 3) * 16, vdst = 2 * KBUF + (tid >> 3) * VP + (tid & 7) * 16;
#define ATT_UNIT(idx_, b_, h_, q0_) do { const int j_ = (idx_) & 255, rnd_ = (idx_) >> 8, x_ = j_ & 7, mm_ = j_ >> 3, k_ = mm_ & 7, gq_ = x_ * 4 + (mm_ >> 3); \
        const int bh_ = gq_ * 4 + rnd_, qb_ = (rnd_ & 1) ? 7 - k_ : k_; b_ = bh_ >> 4; h_ = bh_ & 15; q0_ = qb_ * 256; } while (0)
    int idx = blk; if (idx >= 1024) return;
    int b, h, q0; ATT_UNIT(idx, b, h, q0);
    u32x4 rk, rr = (u32x4){0u, 0u, 0u, 0u}, rv; bf16x8 qr[6], qn[6];
    {
        const size_t rowb = (size_t)b * 2048; const bf16_t* qp = Q + (rowb + q0 + 32 * wid + i32) * 1536 + h * 96 + 8 * hi;
#pragma unroll
        for (int ks = 0; ks < 6; ++ks) { qr[ks] = *(const bf16x8*)(qp + 16 * ks); qn[ks] = qr[ks]; }
        rk = *(const u32x4*)(KN + (rowb + (tid >> 3)) * DM + h * 64 + 8 * (tid & 7)); if (tid < 256) rr = *(const u32x4*)(KR + (rowb + (tid >> 2)) * 32 + 8 * (tid & 3));
        rv = *(const u32x4*)(VT + (size_t)(h * 64 + (tid >> 3)) * TC + rowb + 8 * (tid & 7));
        *(LAS u32x4*)(lds + kdst) = rk; if (tid < 256) *(LAS u32x4*)(lds + krdst) = rr; *(LAS u32x4*)(lds + vdst) = rv;
        __syncthreads();
    }
    for (;;) {
        const int NT = q0 / 64 + 4, ntw = (q0 + 32 * wid) / 64 + 1;
        const size_t rowb = (size_t)b * 2048;
        const bf16_t* kns = KN + (rowb + (tid >> 3)) * DM + h * 64 + 8 * (tid & 7);
        const bf16_t* krs = KR + (rowb + (tid >> 2)) * 32 + 8 * (tid & 3);
        const bf16_t* vts = VT + (size_t)(h * 64 + (tid >> 3)) * TC + rowb + 8 * (tid & 7);
        const int idxn = idx + G; const bool has_next = idxn < 1024; int bn = b, hn = h, q0n = q0; if (has_next) ATT_UNIT(idxn, bn, hn, q0n);
        const size_t rowbn = (size_t)bn * 2048;
        f32x16 o0, o1;
#pragma unroll
        for (int r = 0; r < 16; ++r) { o0[r] = 0.f; o1[r] = 0.f; }
        float mrun = -1e30f, lrun = 0.f;
        for (int t = 0; t < NT; ++t) {
            const int cur = t & 1; const bool more = (t + 1 < NT), stage = more || has_next;
            if (more) { rk = *(const u32x4*)(kns + (size_t)(t + 1) * 64 * DM); if (tid < 256) rr = *(const u32x4*)(krs + (size_t)(t + 1) * 64 * 32); rv = *(const u32x4*)(vts + (size_t)(t + 1) * 64); }
            else if (has_next) {
                rk = *(const u32x4*)(KN + (rowbn + (tid >> 3)) * DM + hn * 64 + 8 * (tid & 7)); if (tid < 256) rr = *(const u32x4*)(KR + (rowbn + (tid >> 2)) * 32 + 8 * (tid & 3));
                rv = *(const u32x4*)(VT + (size_t)(hn * 64 + (tid >> 3)) * TC + rowbn + 8 * (tid & 7));
                const bf16_t* qp = Q + (rowbn + q0n + 32 * wid + i32) * 1536 + hn * 96 + 8 * hi;
#pragma unroll
                for (int ks = 0; ks < 6; ++ks) qn[ks] = *(const bf16x8*)(qp + 16 * ks);
            }
            if (t < ntw) {
                LAS const unsigned char* kb = lds + cur * KBUF; LAS const unsigned char* vb = lds + 2 * KBUF + cur * VBUF;
                f32x16 s0, s1;
#pragma unroll
                for (int r = 0; r < 16; ++r) { s0[r] = 0.f; s1[r] = 0.f; }
#pragma unroll
                for (int ks = 0; ks < 6; ++ks) {
                    const bf16x8 a0 = *(LAS const bf16x8*)(kb + i32 * KP + (16 * ks + 8 * hi) * 2), a1 = *(LAS const bf16x8*)(kb + (32 + i32) * KP + (16 * ks + 8 * hi) * 2);
                    s0 = __builtin_amdgcn_mfma_f32_32x32x16_bf16(a0, qr[ks], s0, 0, 0, 0); s1 = __builtin_amdgcn_mfma_f32_32x32x16_bf16(a1, qr[ks], s1, 0, 0, 0);
                }
                float mx = fmaxf(s0[0], s1[0]);
#pragma unroll
                for (int r = 1; r < 16; ++r) mx = fmaxf(mx, fmaxf(s0[r], s1[r]));
                mx = fmaxf(mx, __shfl_xor(mx, 32));
                const float mn = fmaxf(mrun, mx), alpha = fexp2(mrun - mn); mrun = mn;
                float rs = 0.f;
#pragma unroll
                for (int r = 0; r < 16; ++r) { s0[r] = fexp2(s0[r] - mn); s1[r] = fexp2(s1[r] - mn); rs += s0[r] + s1[r]; }
                lrun = lrun * alpha + rs;
#pragma unroll
                for (int r = 0; r < 16; ++r) { o0[r] *= alpha; o1[r] *= alpha; }
                bf16x8 pf[2][2];
#pragma unroll
                for (int uu = 0; uu < 2; ++uu) {
                    u32x4 w0, w1;
                    w0.x = cvt_pk_bf16(s0[8 * uu + 0], s0[8 * uu + 1]); w0.y = cvt_pk_bf16(s0[8 * uu + 2], s0[8 * uu + 3]); w0.z = cvt_pk_bf16(s0[8 * uu + 4], s0[8 * uu + 5]); w0.w = cvt_pk_bf16(s0[8 * uu + 6], s0[8 * uu + 7]);
                    w1.x = cvt_pk_bf16(s1[8 * uu + 0], s1[8 * uu + 1]); w1.y = cvt_pk_bf16(s1[8 * uu + 2], s1[8 * uu + 3]); w1.z = cvt_pk_bf16(s1[8 * uu + 4], s1[8 * uu + 5]); w1.w = cvt_pk_bf16(s1[8 * uu + 6], s1[8 * uu + 7]);
                    pf[0][uu] = __builtin_bit_cast(bf16x8, w0); pf[1][uu] = __builtin_bit_cast(bf16x8, w1);
                }
#pragma unroll
                for (int tt = 0; tt < 2; ++tt)
#pragma unroll
                    for (int uu = 0; uu < 2; ++uu) {
                        LAS const unsigned char* vp0 = vb + i32 * VP + (32 * tt + 16 * uu + 4 * hi) * 2; LAS const unsigned char* vp1 = vp0 + 32 * VP;
                        const u32x2 a = *(LAS const u32x2*)vp0, bq = *(LAS const u32x2*)(vp0 + 16), c = *(LAS const u32x2*)vp1, d = *(LAS const u32x2*)(vp1 + 16);
                        const bf16x8 vf0 = __builtin_bit_cast(bf16x8, ((u32x4){a.x, a.y, bq.x, bq.y})), vf1 = __builtin_bit_cast(bf16x8, ((u32x4){c.x, c.y, d.x, d.y}));
                        o0 = __builtin_amdgcn_mfma_f32_32x32x16_bf16(vf0, pf[tt][uu], o0, 0, 0, 0); o1 = __builtin_amdgcn_mfma_f32_32x32x16_bf16(vf1, pf[tt][uu], o1, 0, 0, 0);
                    }
            }
            if (stage) { const int nb = cur ^ 1; *(LAS u32x4*)(lds + nb * KBUF + kdst) = rk; if (tid < 256) *(LAS u32x4*)(lds + nb * KBUF + krdst) = rr; *(LAS u32x4*)(lds + nb * VBUF + vdst) = rv; }
            __syncthreads();
        }
        lrun += __shfl_xor(lrun, 32); const float inv = frcp(lrun);
        bf16_t* op = Z + (rowb + q0 + 32 * wid + i32) * ZLD + ZC_XA + h * 64 + 4 * hi;
#pragma unroll
        for (int rg = 0; rg < 4; ++rg) {
            u32x2 w; w.x = cvt_pk_bf16(o0[4 * rg] * inv, o0[4 * rg + 1] * inv); w.y = cvt_pk_bf16(o0[4 * rg + 2] * inv, o0[4 * rg + 3] * inv); *(u32x2*)(op + 8 * rg) = w;
            w.x = cvt_pk_bf16(o1[4 * rg] * inv, o1[4 * rg + 1] * inv); w.y = cvt_pk_bf16(o1[4 * rg + 2] * inv, o1[4 * rg + 3] * inv); *(u32x2*)(op + 32 + 8 * rg) = w;
        }
        if (!has_next) break;
        idx = idxn; b = bn; h = hn; q0 = q0n;
#pragma unroll
        for (int ks = 0; ks < 6; ++ks) qr[ks] = qn[ks];
    }
#undef ATT_UNIT
}
__device__ __forceinline__ void sgu_units(LAS unsigned char* lds, const bf16_t* VTS, const float* MEANV, const float* RSTDV, const float* lng, const float* lnb, const bf16_t* WS, const float* bs, bf16_t* Z, int G, int blk) {
    const int tid = pg8::tid_opaque(), lane = tid & 63, wid = __builtin_amdgcn_readfirstlane(tid >> 6), i32 = lane & 31, hi = lane >> 5;
    constexpr int AP = 272;
    for (int idx = blk; idx < 1024; idx += G) {
        const int tb = idx >> 3, g = idx & 7, tok0 = tb * 128, tt = wid & 3;
        u32x4 xv[4]; f32x4 m0[4], m1[4], r0[4], r1[4]; float ga[4], be[4];
#pragma unroll
        for (int jj = 0; jj < 4; ++jj) {
            const int id = tid + 512 * jj, c = id >> 4, sc = id & 15; xv[jj] = *(const u32x4*)(VTS + (size_t)(g * 128 + c) * TC + tok0 + 8 * sc);
            m0[jj] = *(const f32x4*)(MEANV + tok0 + 8 * sc); m1[jj] = *(const f32x4*)(MEANV + tok0 + 8 * sc + 4); r0[jj] = *(const f32x4*)(RSTDV + tok0 + 8 * sc); r1[jj] = *(const f32x4*)(RSTDV + tok0 + 8 * sc + 4);
            ga[jj] = lng[g * 128 + c]; be[jj] = lnb[g * 128 + c];
        }
        bf16x8 wf[8];
        { const bf16_t* wp = WS + (size_t)(g * 128 + 32 * tt + i32) * 128 + 8 * hi;
#pragma unroll
          for (int ks = 0; ks < 8; ++ks) wf[ks] = *(const bf16x8*)(wp + 16 * ks); }
        const float bsv = bs[g * 128 + 32 * tt + i32];
        bf16_t* up0 = Z + (size_t)(tok0 + 32 * tt + i32) * ZLD + ZC_U + g * 128 + 64 * (wid >> 2) + 4 * hi;
        u32x2 uv[2][4];
#pragma unroll
        for (int cc = 0; cc < 2; ++cc)
#pragma unroll
            for (int rg = 0; rg < 4; ++rg) uv[cc][rg] = *(const u32x2*)(up0 + 32 * cc + 8 * rg);
#pragma unroll
        for (int jj = 0; jj < 4; ++jj) {
            const int id = tid + 512 * jj, c = id >> 4, sc = id & 15; f32x4 x0, x1; unpack8(xv[jj], x0, x1);
            x0 = (x0 - m0[jj]) * r0[jj] * ga[jj] + be[jj]; x1 = (x1 - m1[jj]) * r1[jj] * ga[jj] + be[jj];
            *(LAS u32x4*)(lds + c * AP + sc * 16) = pack8(x0, x1);
        }
        __syncthreads();
#pragma unroll
        for (int cc = 0; cc < 2; ++cc) {
            const int ct = 2 * (wid >> 2) + cc; f32x16 acc;
#pragma unroll
            for (int r = 0; r < 16; ++r) acc[r] = 0.f;
#pragma unroll
            for (int ks = 0; ks < 8; ++ks) { const bf16x8 a = *(LAS const bf16x8*)(lds + (32 * ct + i32) * AP + (16 * ks + 8 * hi) * 2); acc = __builtin_amdgcn_mfma_f32_32x32x16_bf16(a, wf[ks], acc, 0, 0, 0); }
#pragma unroll
            for (int rg = 0; rg < 4; ++rg) { const u32x2 u2 = uv[cc][rg]; u32x2 w;
                w.x = cvt_pk_bf16((acc[4 * rg] + bsv) * bflo(u2.x), (acc[4 * rg + 1] + bsv) * bfhi(u2.x)); w.y = cvt_pk_bf16((acc[4 * rg + 2] + bsv) * bflo(u2.y), (acc[4 * rg + 3] + bsv) * bfhi(u2.y)); *(u32x2*)(up0 + 32 * cc + 8 * rg) = w; }
        }
        __syncthreads();
    }
}

#ifndef DBG_DUMP
#define DBG_DUMP 0
#define DBG_CH 0
#define DBG_TWICE 0
#define DBG_SKIP56 0
#endif
__device__ __forceinline__ void dbg_add(float* out, const bf16_t* buf, size_t n, bool first, int G, int blk) {
    const size_t gt = (size_t)blk * 512 + pg8::tid_opaque(), NGT = (size_t)G * 512;
    for (size_t i = gt; i < (size_t)T * DM; i += NGT) { float v = 0.f; for (size_t j = i; j < n; j += (size_t)T * DM) v += __uint_as_float((unsigned)buf[j] << 16); out[i] = first ? v : out[i] + v; }
}
__device__ __forceinline__ void dbg_addf(float* out, const float* buf, size_t n, int G, int blk) {
    const size_t gt = (size_t)blk * 512 + pg8::tid_opaque(), NGT = (size_t)G * 512;
    for (size_t i = gt; i < (size_t)T * DM; i += NGT) out[i] += buf[i % n];
}
#define APS 0
#define RUN_GEMM(EPI, e, Ap, Bp, M_, N_, K_, lda_, ldb_, apn_) do { int K__ = (K_), blk__ = blk; asm volatile("" : "+s"(K__), "+s"(blk__)); pg8::Gemm gg{(Ap), (Bp), (M_), (N_), K__, (lda_), (ldb_), (apn_), APS}; pg8::StaticOrder SO; SO.init((M_), (N_), G, blk__); \
    pg8::gemm_phase<decltype(e), pg8::StaticOrder, true, true>(lds, gg, SO, e); } while (0)

constexpr size_t SM_BAR = 1024 * 1024;
#define XB_TMO      128
#define XB_XCNT(j)  (256  + 64 * (j))
#define XB_XSUB(j)  (1280 + 64 * (j))
#define XB_XGEN(j)  (2304 + 64 * (j))
#define XB_TOP      3328
#define XB_TOPGEN   3392
#define XCD_BAR_WORDS 3456
#define XB_SPIN_CAP (1u << 18)

__device__ __forceinline__ unsigned xb_ld(unsigned* p)              { return __hip_atomic_load(p, __ATOMIC_RELAXED, __HIP_MEMORY_SCOPE_AGENT); }
__device__ __forceinline__ unsigned xb_add(unsigned* p, unsigned v) { return __hip_atomic_fetch_add(p, v, __ATOMIC_RELAXED, __HIP_MEMORY_SCOPE_AGENT); }
__device__ __forceinline__ unsigned xb_xcc_id() { return (unsigned)__builtin_amdgcn_s_getreg((3 << 11) | 20) & 0xFu; }
#define XB_SPIN(cond, bar) do { unsigned _sp = 0; while (cond) { __builtin_amdgcn_s_sleep(1); \
    if ((++_sp & 255u) == 0u) { if (xb_ld(&(bar)[XB_TMO])) break; if (_sp > XB_SPIN_CAP) { atomicAdd(&(bar)[XB_TMO], 1u); break; } } } } while (0)

struct XcdBarrier {
    unsigned* bar; unsigned x;
    volatile __attribute__((address_space(3))) unsigned* st;
};

__device__ __forceinline__ XcdBarrier xcd_barrier_post(unsigned* bar, volatile __attribute__((address_space(3))) unsigned* st) {
    XcdBarrier b; b.bar = bar; b.x = xb_xcc_id(); b.st = st;
    if (threadIdx.x == 0) (void)xb_add(&bar[XB_XCNT(b.x)], 1u);
    return b;
}
__device__ __forceinline__ void xcd_barrier_complete(unsigned* bar, unsigned x, unsigned& nloc, unsigned& nx) {
    const unsigned G = gridDim.x * gridDim.y * gridDim.z;
    unsigned sum, cnt, mine, sp = 0u;
    for (;;) {
        sum = 0u; cnt = 0u; mine = 0u;
#pragma unroll
        for (unsigned j = 0; j < 16; ++j) { const unsigned c = xb_ld(&bar[XB_XCNT(j)]); sum += c; cnt += (c > 0u) ? 1u : 0u; mine = (j == x) ? c : mine; }
        if (sum == G) break;
        __builtin_amdgcn_s_sleep(1);
        if ((++sp & 255u) == 0u) { if (xb_ld(&bar[XB_TMO])) break; if (sp > XB_SPIN_CAP) { atomicAdd(&bar[XB_TMO], 1u); break; } }
    }
    nloc = mine > 0u ? mine : 1u; nx = cnt > 0u ? cnt : 1u;
}

__device__ __forceinline__ void xcd_barrier(const XcdBarrier& b) {
    asm volatile("s_waitcnt vmcnt(0)" ::: "memory");
    __syncthreads();
    if (threadIdx.x == 0) {
        unsigned* bar = b.bar;
        __builtin_amdgcn_s_waitcnt(0);
        unsigned nloc = b.st[0], nx = b.st[1];
        if (nloc == 0u) { xcd_barrier_complete(bar, b.x, nloc, nx); b.st[0] = nloc; b.st[1] = nx; }
        const unsigned old = xb_add(&bar[XB_XSUB(b.x)], 1u);
        const unsigned gen = old / nloc;
        if (old + 1u == (gen + 1u) * nloc) {
            __builtin_amdgcn_fence(__ATOMIC_RELEASE, "agent");
            asm volatile("s_waitcnt vmcnt(0)" ::: "memory");
            const unsigned og = xb_add(&bar[XB_TOP], 1u);
            const unsigned tg = og / nx;
            if (og + 1u == (tg + 1u) * nx) xb_add(&bar[XB_TOPGEN], 1u);
            else XB_SPIN(xb_ld(&bar[XB_TOPGEN]) == tg, bar);
            __builtin_amdgcn_fence(__ATOMIC_ACQUIRE, "agent");
            xb_add(&bar[XB_XGEN(b.x)], 1u);
            asm volatile("s_waitcnt vmcnt(0)" ::: "memory");
        } else {
            XB_SPIN(xb_ld(&bar[XB_XGEN(b.x)]) == gen, bar);
            __builtin_amdgcn_fence(__ATOMIC_ACQUIRE, "agent");
            asm volatile("s_waitcnt vmcnt(0)" ::: "memory");
        }
    }
    __syncthreads();
}
#define GRID_SYNC() xcd_barrier(xbar)

#define DBG_DUMP_BODY(st) do { \
    dbg_add(X, G3, (size_t)TC * 3072, true, G, blk); } while (0)
__global__ void __launch_bounds__(512, 2) fwd_kernel(Params p) {
    extern __shared__ __attribute__((aligned(16))) unsigned char lds_raw[];
    LAS unsigned char* lds = (LAS unsigned char*)lds_raw;
    cg::grid_group grid = cg::this_grid();
    const int G = gridDim.x, blk = blockIdx.x;
    unsigned char* ws = p.ws;
    { volatile LAS unsigned* st0 = (volatile LAS unsigned*)(lds + 131072); if (threadIdx.x < 64) st0[threadIdx.x] = 0u; }
    __syncthreads();
    const XcdBarrier xbar = xcd_barrier_post((unsigned*)(ws + WS_SMALL + SM_BAR), (volatile LAS unsigned*)(lds + 131072));
    grid.sync();
    bf16_t* wb = (bf16_t*)(ws + WS_W); bf16_t* XB = (bf16_t*)(ws + WS_XB); float* SSQ = (float*)(ws + WS_SSQ); float* X = p.out;
    bf16_t* XBn = (bf16_t*)p.out; float* SSQn = (float*)(ws + WS_BIG + B_SSQ2);
    float* ROPE = (float*)(ws + WS_SMALL + SM_ROPE); float* RSQ = (float*)(ws + WS_SMALL + SM_RSQ); float* RSKV = (float*)(ws + WS_SMALL + SM_RSKV);
    float* MEANV = (float*)(ws + WS_SMALL + SM_MEANV); float* RSTDV = (float*)(ws + WS_SMALL + SM_RSTDV); float* SP8 = (float*)(ws + WS_SMALL + SM_SP8);
    unsigned char* big = ws + WS_BIG;
    bf16_t* H = (bf16_t*)(big + B_H); bf16_t* PB = (bf16_t*)(big + B_PB); bf16_t* GP = (bf16_t*)(big + B_GP);
    bf16_t* Z = (bf16_t*)(big + B_Z); bf16_t* VTS = (bf16_t*)(big + B_VTS); bf16_t* XC = (bf16_t*)(big + B_XC); bf16_t* LA = (bf16_t*)(big + B_LA); bf16_t* U = (bf16_t*)(big + B_U);
    bf16_t* Q = (bf16_t*)(big + B_Q); bf16_t* KN = (bf16_t*)(big + B_KN); bf16_t* VT = (bf16_t*)(big + B_VT); bf16_t* KR = (bf16_t*)(big + B_KR);
    bf16_t* G3 = (bf16_t*)(big + B_G3); bf16_t* MG = (bf16_t*)(big + B_MERGED);

#pragma unroll 1
    for (int L = 0; L < 2; ++L) {
        phase0(p, L, lds, G, blk);
        GRID_SYNC();
        { EpiSwiglu e{H, SSQ}; RUN_GEMM(EpiSwiglu, e, XB, wb + O_WGU1, T, 2 * DFF, 1024, 1024, 1024, 0); }
        GRID_SYNC();
        { EpiResid<false> e{L == 0 ? p.in[0] : nullptr, XB, SSQ, nullptr, 0.5f}; RUN_GEMM(EpiResid<false>, e, H, wb + O_WD1, T, 1024, DFF, DFF, DFF, 0); }
        GRID_SYNC();
#pragma unroll 1
        for (int c = 0; c <= 2; ++c) {
            if (c >= 1) { const size_t q0 = (size_t)(c - 1) * TC;
                EpiResid<false> e{nullptr, XB + q0 * DM, SSQ + q0 * 4, nullptr, 1.0f}; RUN_GEMM(EpiResid<false>, e, MG, wb + O_WOUT, TC, 1024, 1024, 1024, 1024, 0); }
            const size_t r0 = (size_t)c * TC;
            if (c <= 1) {
                { EpiRow<1, 0> e{Z, ZLD, SSQ + r0 * 4, nullptr, 4, 12, 0}; RUN_GEMM((EpiRow<1, 0>), e, XB + r0 * DM, wb + O_WIN, TC, ZLD, 1024, 1024, 1024, 0); }
                { EpiCol<1, 0> e{VTS, TC, SSQ + r0 * 4}; RUN_GEMM((EpiCol<1, 0>), e, wb + O_WINV, XB + r0 * DM, 1024, TC, 1024, 1024, 1024, 0); }
            }
            GRID_SYNC();
            if (c > 1) break;
            e1_rows(p, L, Z, XC, RSQ, RSKV, KR, ROPE, G, blk);
            e2_stats(lds, VTS, MEANV, RSTDV, G, blk);
            GRID_SYNC();
            { EpiLru e{XC, LA, U, p.in[10] + L * 1024, p.in[12] + L * 1024, SP8}; RUN_GEMM(EpiLru, e, XC, wb + O_WLRU, TC, 2048, 128, 1024, 128, 128); }
            { EpiQ e{Q, RSQ, ROPE}; RUN_GEMM(EpiQ, e, Z + ZC_CQ, wb + O_WUQ, TC, 1536, 384, ZLD, 384, 0); }
            { EpiRow<0, 1> e{KN, 1024, RSKV, nullptr, 0, 0, 0}; RUN_GEMM((EpiRow<0, 1>), e, Z + ZC_CKV, wb + O_WKVK, TC, 1024, 256, ZLD, 256, 0); }
            { EpiCol<0, 1> e{VT, TC, RSKV}; RUN_GEMM((EpiCol<0, 1>), e, wb + O_WKVV, Z + ZC_CKV, 1024, TC, 256, 256, ZLD, 0); }
            GRID_SYNC();
            scan_units(lds, LA, U, Z, G, blk);
            attn_units(lds, Q, KN, KR, VT, Z, G, blk);
            sgu_units(lds, VTS, MEANV, RSTDV, p.in[20] + L * 1024, p.in[21] + L * 1024, wb + O_WSGU, p.in[23] + L * 1024, Z, G, blk);
            GRID_SYNC();
            { EpiRow<2, 0> e{G3, 3072, SSQ + r0 * 4, p.in[25] + L * 3072, 0, 0, 1}; RUN_GEMM((EpiRow<2, 0>), e, XB + r0 * DM, wb + O_WING, TC, 3072, 1024, 1024, 1024, 0); }
#undef APS
#define APS 2
            { EpiMerge e{G3, MG}; RUN_GEMM(EpiMerge, e, Z, wb + O_WRA, TC, 3072, 1024, ZLD, 1024, 1024); }
#undef APS
#define APS 0
            GRID_SYNC();
        }
        { EpiSwiglu e{H, SSQ}; RUN_GEMM(EpiSwiglu, e, XB, wb + O_WGU2, T, 2 * DFF, 1024, 1024, 1024, 0); }
        { EpiRow<0, 2> e{GP, 1024, nullptr, nullptr, 0, 0, 0}; RUN_GEMM((EpiRow<0, 2>), e, PB, wb + O_WPLE, T, 1024, 256, 256, 256, 0); }
        GRID_SYNC();
        { EpiResid<false> e{nullptr, XB, SSQ, nullptr, 0.5f}; RUN_GEMM(EpiResid<false>, e, H, wb + O_WD2, T, 1024, DFF, DFF, DFF, 0); }
        GRID_SYNC();
        { EpiPle e{XB, XBn, GP, SSQ, SSQn}; RUN_GEMM(EpiPle, e, XB, wb + O_WPG, T, 1024, 1024, 1024, 1024, 0); }
        GRID_SYNC();
        { bf16_t* tx = XB; XB = XBn; XBn = tx; float* ts = SSQ; SSQ = SSQn; SSQn = ts; }
    }
    {
        const int tid = pg8::tid_opaque(), lane = tid & 63, wave = tid >> 6, gw = blk * 8 + wave, NGW = G * 8; const float* fn = p.in[33];
        for (int m = gw; m < T; m += NGW) {
            const u32x4* xr = (const u32x4*)(XB + (size_t)m * DM) + lane; f32x4* orow = (f32x4*)(X + (size_t)m * DM); f32x4 v[4]; float s = 0.f;
#pragma unroll
            for (int j = 0; j < 2; ++j) { unpack8(xr[64 * j], v[2 * j], v[2 * j + 1]); }
#pragma unroll
            for (int j = 0; j < 4; ++j) s += (v[j][0] * v[j][0] + v[j][1] * v[j][1]) + (v[j][2] * v[j][2] + v[j][3] * v[j][3]);
            const float rstd = __builtin_amdgcn_rsqf(wave_sum(s) * (1.f / 1024.f) + EPS);
#pragma unroll
            for (int j = 0; j < 2; ++j) { const int c = 512 * j + 8 * lane; orow[c / 4] = v[2 * j] * rstd * *(const f32x4*)(fn + c); orow[c / 4 + 1] = v[2 * j + 1] * rstd * *(const f32x4*)(fn + c + 4); }
        }
    }
}

extern "C" void kernel_launch(void* const* d_in, const int* in_sizes, int n_in, void* d_out, int out_size, void* d_ws, size_t ws_size, hipStream_t stream) {
    static int grid = 0;
    if (grid == 0) {
        if (n_in != 34 || ws_size < WS_NEED) { fprintf(stderr, "kernel_launch: unexpected n_in %d / ws_size %zu (need %zu)\n", n_in, ws_size, (size_t)WS_NEED); grid = -1; return; }
        int dev = 0, cus = 0, per = 0;
        (void)hipGetDevice(&dev); (void)hipDeviceGetAttribute(&cus, hipDeviceAttributeMultiprocessorCount, dev);
        (void)hipFuncSetAttribute((const void*)fwd_kernel, hipFuncAttributeMaxDynamicSharedMemorySize, LDS_BYTES);
        if (hipOccupancyMaxActiveBlocksPerMultiprocessor(&per, (const void*)fwd_kernel, 512, LDS_BYTES) != hipSuccess || per < 1) per = 1;
        (void)hipGetLastError();
        grid = cus * per;
    }
    if (grid < 0) return;
    (void)hipMemsetAsync((unsigned char*)d_ws + WS_SMALL + SM_BAR, 0, 16384, stream);
    Params prm{};
    for (int i = 0; i < 34; ++i) prm.in[i] = (const float*)d_in[i];
    prm.out = (float*)d_out; prm.ws = (unsigned char*)d_ws;
    void* args[] = {&prm};
    hipError_t e = hipLaunchCooperativeKernel((const void*)fwd_kernel, dim3(grid), dim3(512), args, LDS_BYTES, stream);
    if (e != hipSuccess) fprintf(stderr, "cooperative launch failed: %s (grid %d)\n", hipGetErrorString(e), grid);
}
```
